# Optimizing an MI355X kernel written in HIP

```python
import jax
import jax.numpy as jnp
from jax import lax
import numpy as np

D_MODEL = 2048
BATCH = 2
SEQ = 8192
DEPTH = 2

GRID_W = 64
CTX_LEN = 256
HEAD_DIM = 128
ROPE_BASE = 10000.0
EPS = 1e-6
Q_BLOCK = 128
NEG = -1e30

A_HEADS = 8
A_KV_HEADS = 2
B_HEADS = 8
B_Q_RANK = 512
B_KV_RANK = 512
B_NOPE = 128
B_ROPE = 64
B_V = 128
C_HEADS = 8
C_KV_HEADS = 2
C_WINDOW = 128
D_HEADS = 8
NA_KH = 8
NA_KW = 16

A_IN = (A_HEADS + 2 * A_KV_HEADS) * HEAD_DIM
B_IN = B_Q_RANK + B_KV_RANK + B_ROPE
AB_IN = A_IN + B_IN
AB_MIX = A_HEADS * HEAD_DIM + B_HEADS * B_V
C_IN = (C_HEADS + 2 * C_KV_HEADS) * HEAD_DIM
D_IN = 3 * D_HEADS * HEAD_DIM
CD_IN = C_IN + D_IN
CD_MIX = (C_HEADS + D_HEADS) * HEAD_DIM
D_FF = -(-8 * D_MODEL // (3 * 256)) * 256
N_AB = (DEPTH + 1) // 2
N_CD = DEPTH // 2

kernel_name = 'hybrid_dit_prefix_block'


def rmsnorm(x, g):
    xf = x.astype(jnp.float32)
    xf = xf * lax.rsqrt(jnp.mean(xf * xf, axis=-1, keepdims=True) + EPS)
    return (xf * g.astype(jnp.float32)).astype(x.dtype)


def modulate(n, shift, scale):
    return n * (1 + scale) + shift


def swiglu(u, wg, wu, wd):
    return (jax.nn.silu(u @ wg) * (u @ wu)) @ wd


def rope_2d(n_tok, dim, dtype):
    t = jnp.arange(n_tok, dtype=jnp.int32)
    row = (t // GRID_W).astype(jnp.float32)
    col = (t % GRID_W).astype(jnp.float32)
    half = dim // 2
    inv_freq = ROPE_BASE ** (-jnp.arange(0, half, 2, dtype=jnp.float32) / half)
    ar = row[:, None] * inv_freq[None, :]
    ac = col[:, None] * inv_freq[None, :]
    ang = jnp.concatenate([ar, ar, ac, ac], axis=-1)
    return jnp.cos(ang).astype(dtype), jnp.sin(ang).astype(dtype)


def apply_rope(x, cos, sin):
    x1, x2, x3, x4 = jnp.split(x, 4, axis=-1)
    rot = jnp.concatenate([-x2, x1, -x4, x3], axis=-1)
    return x * cos[:, None, :] + rot * sin[:, None, :]


def softmax_attend(q, k, v, scale):
    s = jnp.einsum('bqgrd,bkgd->bgrqk', q, k, preferred_element_type=jnp.float32) * scale
    p = jax.nn.softmax(s, axis=-1).astype(v.dtype)
    return jnp.einsum('bgrqk,bkgd->bqgrd', p, v)


def dense_blocked(q, k, v, scale):
    B, L = q.shape[:2]
    nb = L // Q_BLOCK
    qb = jnp.moveaxis(q.reshape((B, nb, Q_BLOCK) + q.shape[2:]), 1, 0)
    ob = lax.map(lambda qi: softmax_attend(qi, k, v, scale), qb)
    return jnp.moveaxis(ob, 0, 1).reshape((B, L) + ob.shape[3:])


def qkv_heads(p, n_q, n_kv, qn, kn):
    B, L = p.shape[:2]
    q, k, v = jnp.split(p, [n_q * HEAD_DIM, (n_q + n_kv) * HEAD_DIM], axis=-1)
    q = rmsnorm(q.reshape(B, L, n_q, HEAD_DIM), qn)
    k = rmsnorm(k.reshape(B, L, n_kv, HEAD_DIM), kn)
    return q, k, v.reshape(B, L, n_kv, HEAD_DIM)


def mixer_a(p_lat, p_ctx, qn, kn, cos, sin, need_ctx):
    B, L = p_lat.shape[:2]
    n_ctx = p_ctx.shape[1]
    R = A_HEADS // A_KV_HEADS
    scale = HEAD_DIM ** -0.5
    qc, kc, vc = qkv_heads(p_ctx, A_HEADS, A_KV_HEADS, qn, kn)
    ql, kl, vl = qkv_heads(p_lat, A_HEADS, A_KV_HEADS, qn, kn)
    ql = apply_rope(ql, cos, sin)
    kl = apply_rope(kl, cos, sin)
    k_all = jnp.concatenate([kc, kl], axis=1)
    v_all = jnp.concatenate([vc, vl], axis=1)
    o_lat = dense_blocked(ql.reshape(B, L, A_KV_HEADS, R, HEAD_DIM), k_all, v_all, scale).reshape(B, L, A_HEADS * HEAD_DIM)
    o_ctx = None
    if need_ctx:
        o_ctx = softmax_attend(qc.reshape(B, n_ctx, A_KV_HEADS, R, HEAD_DIM), kc, vc, scale).reshape(B, n_ctx, A_HEADS * HEAD_DIM)
    return o_lat, o_ctx


def mla_heads(p, qa_n, kva_n, w_uq, w_ukv, rope):
    B, L = p.shape[:2]
    cq, ckv, kr = jnp.split(p, [B_Q_RANK, B_Q_RANK + B_KV_RANK], axis=-1)
    q = (rmsnorm(cq, qa_n) @ w_uq).reshape(B, L, B_HEADS, B_NOPE + B_ROPE)
    kv = (rmsnorm(ckv, kva_n) @ w_ukv).reshape(B, L, B_HEADS, B_NOPE + B_V)
    q_nope, q_rope = jnp.split(q, [B_NOPE], axis=-1)
    k_nope, v = jnp.split(kv, [B_NOPE], axis=-1)
    kr = kr[:, :, None, :]
    if rope is not None:
        q_rope = apply_rope(q_rope, rope[0], rope[1])
        kr = apply_rope(kr, rope[0], rope[1])
    q = jnp.concatenate([q_nope, q_rope], axis=-1)[:, :, :, None, :]
    k = jnp.concatenate([k_nope, jnp.broadcast_to(kr, (B, L, B_HEADS, B_ROPE))], axis=-1)
    return q, k, v


def mixer_b(p_lat, p_ctx, qa_n, kva_n, w_uq, w_ukv, cos, sin, need_ctx):
    B, L = p_lat.shape[:2]
    n_ctx = p_ctx.shape[1]
    scale = (B_NOPE + B_ROPE) ** -0.5
    qc, kc, vc = mla_heads(p_ctx, qa_n, kva_n, w_uq, w_ukv, None)
    ql, kl, vl = mla_heads(p_lat, qa_n, kva_n, w_uq, w_ukv, (cos, sin))
    k_all = jnp.concatenate([kc, kl], axis=1)
    v_all = jnp.concatenate([vc, vl], axis=1)
    o_lat = dense_blocked(ql, k_all, v_all, scale).reshape(B, L, B_HEADS * B_V)
    o_ctx = None
    if need_ctx:
        o_ctx = softmax_attend(qc, kc, vc, scale).reshape(B, n_ctx, B_HEADS * B_V)
    return o_lat, o_ctx


def mixer_c(p_lat, p_ctx, qn, kn, sink, cos, sin, need_ctx):
    B, L = p_lat.shape[:2]
    n_ctx = p_ctx.shape[1]
    G, R = C_KV_HEADS, C_HEADS // C_KV_HEADS
    nb = L // Q_BLOCK
    scale = HEAD_DIM ** -0.5
    sink_gr = sink.reshape(G, R).astype(jnp.float32)
    qc, kc, vc = qkv_heads(p_ctx, C_HEADS, C_KV_HEADS, qn, kn)
    ql, kl, vl = qkv_heads(p_lat, C_HEADS, C_KV_HEADS, qn, kn)
    ql = apply_rope(ql, cos, sin)
    kl = apply_rope(kl, cos, sin)
    qb = ql.reshape(B, nb, Q_BLOCK, G, R, HEAD_DIM)

    def band(t):
        tp = jnp.pad(t, ((0, 0), (Q_BLOCK, Q_BLOCK), (0, 0), (0, 0)))
        tb = tp.reshape(B, nb + 2, Q_BLOCK, G, HEAD_DIM)
        return jnp.concatenate([tb[:, :-2], tb[:, 1:-1], tb[:, 2:]], axis=2)

    kb, vb = band(kl), band(vl)
    n_idx = jnp.arange(nb)[:, None, None]
    qpos = n_idx * Q_BLOCK + jnp.arange(Q_BLOCK)[None, :, None]
    kpos = (n_idx - 1) * Q_BLOCK + jnp.arange(3 * Q_BLOCK)[None, None, :]
    valid = (jnp.abs(kpos - qpos) <= C_WINDOW) & (kpos >= 0) & (kpos < L)
    s_win = jnp.einsum('bnqgrd,bnkgd->bngrqk', qb, kb, preferred_element_type=jnp.float32) * scale
    s_win = jnp.where(valid[None, :, None, None], s_win, NEG)
    s_ctx = jnp.einsum('bnqgrd,bkgd->bngrqk', qb, kc, preferred_element_type=jnp.float32) * scale
    s_sink = jnp.broadcast_to(sink_gr[None, None, :, :, None, None], s_ctx.shape[:-1] + (1,))
    p = jax.nn.softmax(jnp.concatenate([s_ctx, s_win, s_sink], axis=-1), axis=-1).astype(vb.dtype)
    o = (jnp.einsum('bngrqk,bkgd->bnqgrd', p[..., :n_ctx], vc)
         + jnp.einsum('bngrqk,bnkgd->bnqgrd', p[..., n_ctx:n_ctx + 3 * Q_BLOCK], vb))
    o_lat = o.reshape(B, L, C_HEADS * HEAD_DIM)
    o_ctx = None
    if need_ctx:
        qcg = qc.reshape(B, n_ctx, G, R, HEAD_DIM)
        s = jnp.einsum('bqgrd,bkgd->bgrqk', qcg, kc, preferred_element_type=jnp.float32) * scale
        s_sink_c = jnp.broadcast_to(sink_gr[None, :, :, None, None], s.shape[:-1] + (1,))
        pc = jax.nn.softmax(jnp.concatenate([s, s_sink_c], axis=-1), axis=-1)[..., :n_ctx].astype(vc.dtype)
        o_ctx = jnp.einsum('bgrqk,bkgd->bqgrd', pc, vc).reshape(B, n_ctx, C_HEADS * HEAD_DIM)
    return o_lat, o_ctx


def mixer_d(p_lat, p_ctx, qn, kn, rpb, need_ctx):
    B, L = p_lat.shape[:2]
    n_ctx = p_ctx.shape[1]
    rows = L // GRID_W
    kh = min(NA_KH, rows)
    scale = HEAD_DIM ** -0.5
    qc, kc, vc = qkv_heads(p_ctx, D_HEADS, D_HEADS, qn, kn)
    ql, kl, vl = qkv_heads(p_lat, D_HEADS, D_HEADS, qn, kn)
    grid = (B, rows, GRID_W, D_HEADS, HEAD_DIM)
    qg, kg, vg = ql.reshape(grid), kl.reshape(grid), vl.reshape(grid)
    cols = jnp.arange(GRID_W)
    col_start = jnp.clip(cols - NA_KW // 2, 0, GRID_W - NA_KW)
    col_idx = col_start[:, None] + jnp.arange(NA_KW)[None, :]
    bias_cols = rpb[:, :, col_idx - cols[:, None] + NA_KW - 1].astype(jnp.float32)

    def row_block(args):
        qr, r = args
        rs = jnp.clip(r - kh // 2, 0, rows - kh)
        kq = lax.dynamic_slice_in_dim(kg, rs, kh, axis=1)[:, :, col_idx]
        vq = lax.dynamic_slice_in_dim(vg, rs, kh, axis=1)[:, :, col_idx]
        s_nb = jnp.einsum('bchd,bicjhd->bhcij', qr, kq, preferred_element_type=jnp.float32) * scale
        di = rs + jnp.arange(kh) - r
        s_nb = s_nb + jnp.transpose(bias_cols[:, di + NA_KH - 1], (0, 2, 1, 3))[None]
        s_ctx = jnp.einsum('bchd,bkhd->bhck', qr, kc, preferred_element_type=jnp.float32) * scale
        s = jnp.concatenate([s_ctx, s_nb.reshape(B, D_HEADS, GRID_W, kh * NA_KW)], axis=-1)
        p = jax.nn.softmax(s, axis=-1).astype(vq.dtype)
        p_nb = p[..., n_ctx:].reshape(B, D_HEADS, GRID_W, kh, NA_KW)
        return (jnp.einsum('bhck,bkhd->bchd', p[..., :n_ctx], vc)
                + jnp.einsum('bhcij,bicjhd->bchd', p_nb, vq))

    o = lax.map(row_block, (jnp.moveaxis(qg, 1, 0), jnp.arange(rows)))
    o_lat = jnp.moveaxis(o, 0, 1).reshape(B, L, D_HEADS * HEAD_DIM)
    o_ctx = None
    if need_ctx:
        o_ctx = softmax_attend(qc[:, :, :, None, :], kc, vc, scale).reshape(B, n_ctx, D_HEADS * HEAD_DIM)
    return o_lat, o_ctx


def setup_inputs(seed: int = 0) -> dict:
    key = jax.random.key(seed)
    ks = iter(jax.random.split(key, 32))
    f32 = jnp.float32

    def nrm(shape, s=1.0):
        return jax.random.normal(next(ks), shape, f32) * s

    def gain(shape):
        return 1.0 + nrm(shape, 0.02)

    D = D_MODEL
    return {
        'x': nrm((BATCH, SEQ, D)),
        'c': nrm((BATCH, D)),
        'ctx': nrm((BATCH, CTX_LEN, D)),
        'c_ctx': nrm((D,)),
        'w_mod': nrm((DEPTH, D, 6 * D), D ** -0.5),
        'b_mod': nrm((DEPTH, 6 * D), 0.02),
        'g_mix_pre': gain((DEPTH, D)),
        'g_mix_post': gain((DEPTH, D)),
        'g_ffn_pre': gain((DEPTH, D)),
        'g_ffn_post': gain((DEPTH, D)),
        'w_gate': nrm((DEPTH, D, D_FF), D ** -0.5),
        'w_up': nrm((DEPTH, D, D_FF), D ** -0.5),
        'w_down': nrm((DEPTH, D_FF, D), D_FF ** -0.5),
        'ab_w_in': nrm((N_AB, D, AB_IN), D ** -0.5),
        'ab_w_out': nrm((N_AB, AB_MIX, D), AB_MIX ** -0.5),
        'a_q_norm': gain((N_AB, HEAD_DIM)),
        'a_k_norm': gain((N_AB, HEAD_DIM)),
        'b_q_norm': gain((N_AB, B_Q_RANK)),
        'b_kv_norm': gain((N_AB, B_KV_RANK)),
        'b_w_uq': nrm((N_AB, B_Q_RANK, B_HEADS * (B_NOPE + B_ROPE)), B_Q_RANK ** -0.5),
        'b_w_ukv': nrm((N_AB, B_KV_RANK, B_HEADS * (B_NOPE + B_V)), B_KV_RANK ** -0.5),
        'cd_w_in': nrm((N_CD, D, CD_IN), D ** -0.5),
        'cd_w_out': nrm((N_CD, CD_MIX, D), CD_MIX ** -0.5),
        'c_q_norm': gain((N_CD, HEAD_DIM)),
        'c_k_norm': gain((N_CD, HEAD_DIM)),
        'c_sink': nrm((N_CD, C_HEADS), 0.5),
        'd_q_norm': gain((N_CD, HEAD_DIM)),
        'd_k_norm': gain((N_CD, HEAD_DIM)),
        'd_rpb': nrm((N_CD, D_HEADS, 2 * NA_KH - 1, 2 * NA_KW - 1), 0.1),
    }


def reference(x, c, ctx, c_ctx, w_mod, b_mod, g_mix_pre, g_mix_post, g_ffn_pre, g_ffn_post,
              w_gate, w_up, w_down, ab_w_in, ab_w_out, a_q_norm, a_k_norm, b_q_norm, b_kv_norm,
              b_w_uq, b_w_ukv, cd_w_in, cd_w_out, c_q_norm, c_k_norm, c_sink, d_q_norm, d_k_norm, d_rpb):
    L = x.shape[1]
    cos_h, sin_h = rope_2d(L, HEAD_DIM, x.dtype)
    cos_r, sin_r = rope_2d(L, B_ROPE, x.dtype)
    h_lat, h_ctx = x, ctx
    for i in range(DEPTH):
        last = i == DEPTH - 1
        need_ctx = not last
        mod_lat = (jax.nn.silu(c) @ w_mod[i] + b_mod[i])[:, None, :]
        mod_ctx = (jax.nn.silu(c_ctx) @ w_mod[i] + b_mod[i])[None, None, :]
        sh1_l, sc1_l, gt1_l, sh2_l, sc2_l, gt2_l = jnp.split(mod_lat, 6, axis=-1)
        sh1_c, sc1_c, gt1_c, sh2_c, sc2_c, gt2_c = jnp.split(mod_ctx, 6, axis=-1)

        u_lat = modulate(rmsnorm(h_lat, g_mix_pre[i]), sh1_l, sc1_l)
        u_ctx = modulate(rmsnorm(h_ctx, g_mix_pre[i]), sh1_c, sc1_c)
        if i % 2 == 0:
            j = i // 2
            p_lat = u_lat @ ab_w_in[j]
            p_ctx = u_ctx @ ab_w_in[j]
            oa_l, oa_c = mixer_a(p_lat[..., :A_IN], p_ctx[..., :A_IN], a_q_norm[j], a_k_norm[j], cos_h, sin_h, need_ctx)
            ob_l, ob_c = mixer_b(p_lat[..., A_IN:], p_ctx[..., A_IN:], b_q_norm[j], b_kv_norm[j],
                                 b_w_uq[j], b_w_ukv[j], cos_r, sin_r, need_ctx)
            o_lat = jnp.concatenate([oa_l, ob_l], axis=-1) @ ab_w_out[j]
            if need_ctx:
                o_ctx = jnp.concatenate([oa_c, ob_c], axis=-1) @ ab_w_out[j]
        else:
            j = i // 2
            p_lat = u_lat @ cd_w_in[j]
            p_ctx = u_ctx @ cd_w_in[j]
            oc_l, oc_c = mixer_c(p_lat[..., :C_IN], p_ctx[..., :C_IN], c_q_norm[j], c_k_norm[j], c_sink[j],
                                 cos_h, sin_h, need_ctx)
            od_l, od_c = mixer_d(p_lat[..., C_IN:], p_ctx[..., C_IN:], d_q_norm[j], d_k_norm[j], d_rpb[j], need_ctx)
            o_lat = jnp.concatenate([oc_l, od_l], axis=-1) @ cd_w_out[j]
            if need_ctx:
                o_ctx = jnp.concatenate([oc_c, od_c], axis=-1) @ cd_w_out[j]
        h_lat = h_lat + gt1_l * rmsnorm(o_lat, g_mix_post[i])
        if need_ctx:
            h_ctx = h_ctx + gt1_c * rmsnorm(o_ctx, g_mix_post[i])

        f_lat = swiglu(modulate(rmsnorm(h_lat, g_ffn_pre[i]), sh2_l, sc2_l), w_gate[i], w_up[i], w_down[i])
        h_lat = h_lat + gt2_l * rmsnorm(f_lat, g_ffn_post[i])
        if need_ctx:
            f_ctx = swiglu(modulate(rmsnorm(h_ctx, g_ffn_pre[i]), sh2_c, sc2_c), w_gate[i], w_up[i], w_down[i])
            h_ctx = h_ctx + gt2_c * rmsnorm(f_ctx, g_ffn_post[i])
    return h_lat
```

```cpp
#include <hip/hip_runtime.h>
#include <hip/hip_cooperative_groups.h>
#include <cstdio>
#include <cstdint>
namespace cg = cooperative_groups;
__device__ __forceinline__ int fresh_tid() { int t = threadIdx.x; asm volatile("" : "+v"(t)); return t; }
namespace pg8 {
#define PG8_LAS __attribute__((address_space(3)))
typedef unsigned short bf16_t;
typedef short bf16x8 __attribute__((ext_vector_type(8)));
typedef float f32x4 __attribute__((ext_vector_type(4)));
typedef unsigned u32x4 __attribute__((ext_vector_type(4)));
constexpr int BM = 256, BK = 64, HALF = 128, HTB = HALF * BK * 2  , STAGE_BYTES = 8 * HTB, NXCD = 8, WGM = 8;

__host__ __device__ __forceinline__ int lds_byte(int r, int c) { const int st = (r >> 4) * 2 + (c >> 5), rr = r & 15, cc = c & 31, ob = rr * 64 + cc * 2; return st * 1024 + (ob ^ (((ob >> 9) & 1) << 5)); }
__host__ __device__ __forceinline__ void stage_rc(int b, int& R, int& C) { const int st = b / 1024, sb = b % 1024, swz = sb ^ (((sb >> 9) & 1) << 5); R = (st >> 1) * 16 + swz / 64; C = (st & 1) * 32 + (swz % 64) / 2; }
__host__ __device__ __forceinline__ int perm32(int rho) { const int n = rho >> 4, i = rho & 15; return 8 * (i >> 2) + 4 * n + (i & 3); }

struct Unit { int pm, pn; };
struct Gemm { const bf16_t* A; const bf16_t* Bt; int M, N, K, lda; };

struct StaticOrder {
    int nM, nN, nwg, G, c;
    __host__ __device__ void init(int M, int N, int G_, int c_) { nM = M / BM; nN = N / BM; nwg = nM * nN; G = G_; c = c_; }
    __host__ __device__ bool next(int i, Unit& u) const {
        const long L = (long)i * G + c; if (L >= nwg) return false;
        int wgid = (int)L; { const int q = nwg / NXCD, r = nwg % NXCD, xcd = wgid % NXCD, off = wgid / NXCD; wgid = (xcd < r ? xcd * (q + 1) : r * (q + 1) + (xcd - r) * q) + off; }
        const int nig = WGM * nN, gid = wgid / nig, fm = gid * WGM, gsz = (nM - fm) < WGM ? (nM - fm) : WGM;
        u.pm = fm + ((wgid % nig) % gsz); u.pn = (wgid % nig) / gsz; return true;
    }
    __device__ __forceinline__ void a_ready(const Unit&) const {}
    __device__ __forceinline__ void done(const Unit&) const {}
};


__device__ __forceinline__ unsigned cvt_pk_bf16(float lo, float hi) { unsigned r; asm volatile("v_cvt_pk_bf16_f32 %0, %1, %2" : "=v"(r) : "v"(lo), "v"(hi)); return r; }
struct EpiBf16 {
    static constexpr bool PERM = true, AFTER_DRAIN = false;
    bf16_t* O; int ldc;
    __device__ __forceinline__ void operator()(const f32x4 (&acc)[2][2][4][2], const Unit& u, int wr, int wc, int fr, int fq) const {
        const int row0 = u.pm * BM + wr * 64 + fr, col0 = u.pn * BM + wc * 32 + 8 * fq;
#pragma unroll
        for (int ai = 0; ai < 2; ++ai)
#pragma unroll
            for (int m = 0; m < 4; ++m) { bf16_t* rowp = O + (size_t)(row0 + ai * HALF + m * 16) * ldc + col0;
#pragma unroll
                for (int bj = 0; bj < 2; ++bj) { const f32x4 v0 = acc[ai][bj][m][0], v1 = acc[ai][bj][m][1];
                    u32x4 w; w.x = cvt_pk_bf16(v0[0], v0[1]); w.y = cvt_pk_bf16(v0[2], v0[3]); w.z = cvt_pk_bf16(v1[0], v1[1]); w.w = cvt_pk_bf16(v1[2], v1[3]);
                    *(u32x4*)(rowp + bj * HALF) = w; } }
    }
};
struct EpiF32 {
    static constexpr bool PERM = false, AFTER_DRAIN = false;
    float* O; int ldc;
    __device__ __forceinline__ void operator()(const f32x4 (&acc)[2][2][4][2], const Unit& u, int wr, int wc, int fr, int fq) const {
        const int row0 = u.pm * BM + wr * 64 + fr, col0 = u.pn * BM + wc * 32 + 4 * fq;
#pragma unroll
        for (int ai = 0; ai < 2; ++ai)
#pragma unroll
            for (int m = 0; m < 4; ++m) { float* rowp = O + (size_t)(row0 + ai * HALF + m * 16) * ldc + col0;
#pragma unroll
                for (int bj = 0; bj < 2; ++bj)
#pragma unroll
                    for (int n = 0; n < 2; ++n) *(f32x4*)(rowp + bj * HALF + n * 16) = acc[ai][bj][m][n]; }
    }
};
__device__ __forceinline__ float silu_mul(float g, float u) { return g * __builtin_amdgcn_rcpf(1.0f + __builtin_amdgcn_exp2f(-1.4426950408889634f * g)) * u; }
struct EpiSwiglu {
    static constexpr bool PERM = true, AFTER_DRAIN = false;
    bf16_t* O; int ldc;
    __device__ __forceinline__ void operator()(const f32x4 (&acc)[2][2][4][2], const Unit& u, int wr, int wc, int fr, int fq) const {
        const int row0 = u.pm * BM + wr * 64 + fr, col0 = u.pn * HALF + wc * 32 + 8 * fq;
#pragma unroll
        for (int ai = 0; ai < 2; ++ai)
#pragma unroll
            for (int m = 0; m < 4; ++m) { bf16_t* rowp = O + (size_t)(row0 + ai * HALF + m * 16) * ldc + col0;
                const f32x4 g0 = acc[ai][0][m][0], g1 = acc[ai][0][m][1], u0 = acc[ai][1][m][0], u1 = acc[ai][1][m][1];
                u32x4 w; w.x = cvt_pk_bf16(silu_mul(g0[0], u0[0]), silu_mul(g0[1], u0[1])); w.y = cvt_pk_bf16(silu_mul(g0[2], u0[2]), silu_mul(g0[3], u0[3]));
                w.z = cvt_pk_bf16(silu_mul(g1[0], u1[0]), silu_mul(g1[1], u1[1])); w.w = cvt_pk_bf16(silu_mul(g1[2], u1[2]), silu_mul(g1[3], u1[3]));
                *(u32x4*)rowp = w; }
    }
};

template <class Epi, class Sched, bool ALIGN_EPI = false, bool SP2 = false>
__device__ __forceinline__ void gemm_phase(PG8_LAS unsigned char* lds, const Gemm g, const Sched& S, const Epi& E) {
    const int tid = fresh_tid(), wid = __builtin_amdgcn_readfirstlane(tid >> 6), lane = tid & 63, wr = wid >> 2, wc = wid & 3, fr = lane & 15, fq = lane >> 4;
    const int K = g.K, nt = K / BK;
    unsigned voffA[2], voffB[2];
#pragma unroll
    for (int i = 0; i < 2; ++i) { int R, C; stage_rc(tid * 16 + i * 8192, R, C); const int Rb = Epi::PERM ? ((R & ~31) + perm32(R & 31)) : R;
        voffA[i] = (unsigned)(R * g.lda + C) * 2u; voffB[i] = (unsigned)(Rb * K + C) * 2u; }
    const size_t kstep = (size_t)(BK * 2);
    const size_t hstepA = (size_t)HALF * g.lda * 2, hstepB = (size_t)HALF * K * 2;
    const size_t tstepA = 2 * hstepA, tstepB = 2 * hstepB;
    const unsigned ldsw = (unsigned)wid * 1024u;
    const int aoff = lds_byte(wr * 64 + fr, fq * 8), boff = lds_byte(wc * 32 + fr, fq * 8);
#define PG8_SA(b, h) (((b) * 2 + (h)) * HTB)
#define PG8_SB(b, h) ((4 + (b) * 2 + (h)) * HTB)
#define PG8_STAGE(bufoff, gbase, voff) do { _Pragma("unroll") for (int _i = 0; _i < 2; ++_i) \
        __builtin_amdgcn_global_load_lds((const unsigned*)((const char*)(gbase) + (voff)[_i]), (PG8_LAS unsigned*)(lds + (bufoff) + ldsw + _i * 8192), 16, 0, 0); } while (0)
#define PG8_LDA(dst, b, h) do { _Pragma("unroll") for (int m = 0; m < 4; ++m) _Pragma("unroll") for (int k = 0; k < 2; ++k) dst[m][k] = *(const PG8_LAS bf16x8*)(lds + PG8_SA(b, h) + aoff + m * 2048 + k * 1024); } while (0)
#define PG8_LDB(dst, b, h) do { _Pragma("unroll") for (int n = 0; n < 2; ++n) _Pragma("unroll") for (int k = 0; k < 2; ++k) dst[n][k] = *(const PG8_LAS bf16x8*)(lds + PG8_SB(b, h) + boff + n * 2048 + k * 1024); } while (0)
#define PG8_MMA(ai, bj, At, Bt) do { __builtin_amdgcn_s_setprio(1); _Pragma("unroll") for (int m = 0; m < 4; ++m) _Pragma("unroll") for (int n = 0; n < 2; ++n) _Pragma("unroll") for (int k = 0; k < 2; ++k) \
        acc[ai][bj][m][n] = __builtin_amdgcn_mfma_f32_16x16x32_bf16(Bt[n][k], At[m][k], acc[ai][bj][m][n], 0, 0, 0); __builtin_amdgcn_s_setprio(0); } while (0)
#define PG8_WAIT_V(n) asm volatile("s_waitcnt vmcnt(" #n ")" ::: "memory")
#define PG8_WAIT_L(n) asm volatile("s_waitcnt lgkmcnt(" #n ")" ::: "memory")
#define PG8_BAR __builtin_amdgcn_s_barrier()
#define PG8_SCHED __builtin_amdgcn_sched_barrier(0)
    Unit cur, nxt; int ui = 0;
    if (!S.next(0, cur)) return;
    f32x4 acc[2][2][4][2];
#pragma unroll
    for (int a = 0; a < 2; ++a)
#pragma unroll
        for (int b = 0; b < 2; ++b)
#pragma unroll
            for (int m = 0; m < 4; ++m)
#pragma unroll
                for (int n = 0; n < 2; ++n) acc[a][b][m][n] = (f32x4){0.f, 0.f, 0.f, 0.f};
    bf16x8 At[4][2], B0[2][2], B1[2][2];
    const char* cA = (const char*)g.A + (size_t)cur.pm * tstepA; const char* cB = (const char*)g.Bt + (size_t)cur.pn * tstepB;
    S.a_ready(cur);
    if constexpr (SP2) {
        PG8_STAGE(PG8_SB(0, 0), cB, voffB); PG8_STAGE(PG8_SB(0, 1), cB + hstepB, voffB); PG8_STAGE(PG8_SA(0, 0), cA, voffA); PG8_STAGE(PG8_SA(0, 1), cA + hstepA, voffA);
        if (wr == 1) PG8_BAR;
        PG8_WAIT_V(2); PG8_BAR;
        PG8_STAGE(PG8_SB(1, 0), cB + kstep, voffB); PG8_STAGE(PG8_SA(1, 0), cA + kstep, voffA); PG8_STAGE(PG8_SB(1, 1), cB + hstepB + kstep, voffB);
        PG8_WAIT_V(6); PG8_BAR;
    } else {
        PG8_STAGE(PG8_SB(0, 0), cB, voffB); PG8_STAGE(PG8_SA(0, 0), cA, voffA); PG8_STAGE(PG8_SB(0, 1), cB + hstepB, voffB); PG8_STAGE(PG8_SA(0, 1), cA + hstepA, voffA);
        if (wr == 1) PG8_BAR;
        PG8_WAIT_V(4); PG8_BAR;
        PG8_STAGE(PG8_SB(1, 0), cB + kstep, voffB); PG8_STAGE(PG8_SA(1, 0), cA + kstep, voffA); PG8_STAGE(PG8_SB(1, 1), cB + hstepB + kstep, voffB);
        PG8_WAIT_V(6); PG8_BAR;
    }
    for (;;) {
        const bool has_next = S.next(ui + 1, nxt);
        const char* nA = has_next ? (const char*)g.A + (size_t)nxt.pm * tstepA : cA; const char* nB = has_next ? (const char*)g.Bt + (size_t)nxt.pn * tstepB : cB;
        for (int t = 0; t < nt; t += 2) {
            const bool last = (t == nt - 2);
            const char* a1 = cA + (size_t)(t + 1) * kstep;
            const char* a2 = last ? nA : cA + (size_t)(t + 2) * kstep; const char* b2 = last ? nB : cB + (size_t)(t + 2) * kstep;
            const char* a3 = a2 + kstep; const char* b3 = b2 + kstep;
            if (last && has_next) S.a_ready(nxt);
            if constexpr (SP2) {
            PG8_LDB(B0, 0, 0); PG8_LDB(B1, 0, 1); PG8_SCHED; PG8_LDA(At, 0, 0); PG8_STAGE(PG8_SA(1, 1), a1 + hstepA, voffA);
            PG8_WAIT_V(8); PG8_WAIT_L(0); PG8_BAR; PG8_MMA(0, 0, At, B0); PG8_MMA(0, 1, At, B1); PG8_BAR; PG8_SCHED;
            PG8_LDA(At, 0, 1); PG8_STAGE(PG8_SB(0, 0), b2, voffB); PG8_STAGE(PG8_SB(0, 1), b2 + hstepB, voffB); PG8_STAGE(PG8_SA(0, 0), a2, voffA);
            PG8_WAIT_V(8); PG8_WAIT_L(0); PG8_BAR; PG8_MMA(1, 0, At, B0); PG8_MMA(1, 1, At, B1); PG8_BAR; PG8_SCHED;
            PG8_LDB(B0, 1, 0); PG8_LDB(B1, 1, 1); PG8_SCHED; PG8_LDA(At, 1, 0); PG8_STAGE(PG8_SA(0, 1), a2 + hstepA, voffA);
            PG8_WAIT_V(8); PG8_WAIT_L(0); PG8_BAR; PG8_MMA(0, 0, At, B0); PG8_MMA(0, 1, At, B1); PG8_BAR; PG8_SCHED;
            PG8_LDA(At, 1, 1); PG8_STAGE(PG8_SB(1, 0), b3, voffB); PG8_STAGE(PG8_SB(1, 1), b3 + hstepB, voffB); PG8_STAGE(PG8_SA(1, 0), a3, voffA);
            PG8_WAIT_V(8); PG8_WAIT_L(0); PG8_BAR; PG8_MMA(1, 0, At, B0); PG8_MMA(1, 1, At, B1); PG8_BAR; PG8_SCHED;
            } else {
            PG8_LDB(B0, 0, 0); PG8_SCHED; PG8_LDA(At, 0, 0); PG8_STAGE(PG8_SA(1, 1), a1 + hstepA, voffA);
            PG8_WAIT_L(8); PG8_BAR; PG8_WAIT_L(0); PG8_MMA(0, 0, At, B0); PG8_BAR; PG8_SCHED;
            PG8_LDB(B1, 0, 1); PG8_STAGE(PG8_SB(0, 0), b2, voffB);
            PG8_BAR; PG8_WAIT_L(0); PG8_MMA(0, 1, At, B1); PG8_BAR;
            PG8_LDA(At, 0, 1); PG8_STAGE(PG8_SA(0, 0), a2, voffA);
            PG8_BAR; PG8_WAIT_L(0); PG8_MMA(1, 0, At, B0); PG8_BAR; PG8_SCHED;
            PG8_STAGE(PG8_SB(0, 1), b2 + hstepB, voffB);
            PG8_WAIT_V(6); PG8_BAR; PG8_MMA(1, 1, At, B1); PG8_BAR;
            PG8_LDB(B0, 1, 0); PG8_SCHED; PG8_LDA(At, 1, 0); PG8_STAGE(PG8_SA(0, 1), a2 + hstepA, voffA);
            PG8_WAIT_L(8); PG8_BAR; PG8_WAIT_L(0); PG8_MMA(0, 0, At, B0); PG8_BAR; PG8_SCHED;
            PG8_LDB(B1, 1, 1); PG8_STAGE(PG8_SB(1, 0), b3, voffB);
            PG8_BAR; PG8_WAIT_L(0); PG8_MMA(0, 1, At, B1); PG8_BAR;
            PG8_LDA(At, 1, 1); PG8_STAGE(PG8_SA(1, 0), a3, voffA);
            PG8_BAR; PG8_WAIT_L(0); PG8_MMA(1, 0, At, B0); PG8_BAR; PG8_SCHED;
            PG8_STAGE(PG8_SB(1, 1), b3 + hstepB, voffB);
            PG8_WAIT_V(6); PG8_BAR; PG8_MMA(1, 1, At, B1); PG8_BAR;
            }
        }
        if constexpr (ALIGN_EPI) { if (wr == 0) PG8_BAR; }
        if constexpr (!Epi::AFTER_DRAIN) { E(acc, cur, wr, wc, fr, fq); S.done(cur); }
        if (!has_next) break;
#pragma unroll
        for (int a = 0; a < 2; ++a)
#pragma unroll
            for (int b = 0; b < 2; ++b)
#pragma unroll
                for (int m = 0; m < 4; ++m)
#pragma unroll
                    for (int n = 0; n < 2; ++n) acc[a][b][m][n] = (f32x4){0.f, 0.f, 0.f, 0.f};
        cur = nxt; cA = nA; cB = nB; ++ui;
        if constexpr (ALIGN_EPI) { if (wr == 1) PG8_BAR; }
    }
    PG8_WAIT_V(0);
    if constexpr (!ALIGN_EPI) { if (wr == 0) PG8_BAR; }
    PG8_BAR;
    if constexpr (Epi::AFTER_DRAIN) { E.fused(acc, cur, wr, wc, fr, fq, lds, wid, lane); S.done(cur); }
#undef PG8_SA
#undef PG8_SB
#undef PG8_STAGE
#undef PG8_LDA
#undef PG8_LDB
#undef PG8_MMA
#undef PG8_WAIT_V
#undef PG8_WAIT_L
#undef PG8_BAR
#undef PG8_SCHED
}
}
namespace att {
typedef unsigned short bf16;
typedef short bf16x8 __attribute__((ext_vector_type(8)));
typedef short s16x4 __attribute__((ext_vector_type(4)));
typedef float f32x16 __attribute__((ext_vector_type(16)));
typedef unsigned u32x4 __attribute__((ext_vector_type(4)));
constexpr int NW = 8, QBLK = 32, KVBLK = 64;
constexpr int SHM_V = KVBLK * 128 * 2;
#define SBAR() __builtin_amdgcn_sched_barrier(0)
__device__ __forceinline__ int crow(int r, int hi) { return (r & 3) + 8 * (r >> 2) + 4 * hi; }
__device__ __forceinline__ unsigned cvtpk(float lo, float hi) { unsigned r; asm volatile("v_cvt_pk_bf16_f32 %0, %1, %2" : "=v"(r) : "v"(lo), "v"(hi)); return r; }

struct Args {
  const bf16* Q; const bf16* K; const bf16* K2; const bf16* V; bf16* O;
  int ldq, ldk, ldk2, ldv, ldo;
  int NT, nctx, ctx_row0, lat_row0;
  float C, thr_raw;
  int qpos0, kpos0;
  float sink_l2;
  int r0, klo;
  const float* rpb; float inv_scale;
};

__device__ __forceinline__ void partialSM(f32x16& p0, f32x16& p1, float& m_reg, float& mn, float& alpha, const float C, const float thr_raw) {
  float pmax = p0[0];
#pragma unroll
  for (int r = 1; r < 16; ++r) pmax = fmaxf(pmax, p0[r]);
#pragma unroll
  for (int r = 0; r < 16; ++r) pmax = fmaxf(pmax, p1[r]);
  { auto rr = __builtin_amdgcn_permlane32_swap(__float_as_uint(pmax), __float_as_uint(pmax), false, false);
    pmax = fmaxf(__uint_as_float(rr[0]), __uint_as_float(rr[1])); }
  if (__builtin_expect(__all(pmax - m_reg <= thr_raw), 1)) { mn = m_reg; alpha = 1.f; }
  else { mn = fmaxf(m_reg, pmax); alpha = __builtin_amdgcn_exp2f((m_reg - mn) * C); m_reg = mn; }
  const float mnC = -mn * C;
#pragma unroll
  for (int r = 0; r < 16; ++r) p0[r] = fmaf(p0[r], C, mnC);
#pragma unroll
  for (int r = 0; r < 16; ++r) p1[r] = fmaf(p1[r], C, mnC);
#pragma unroll
  for (int r = 0; r < 16; ++r) p0[r] = __builtin_amdgcn_exp2f(p0[r]);
}
__device__ __forceinline__ void finishSM(f32x16& p0, f32x16& p1, float alpha, float& l_reg, bf16x8& pa0, bf16x8& pa1, bf16x8& pa2, bf16x8& pa3) {
#pragma unroll
  for (int r = 0; r < 16; ++r) p1[r] = __builtin_amdgcn_exp2f(p1[r]);
  float ps = 0;
#pragma unroll
  for (int r = 0; r < 16; ++r) ps += p0[r];
#pragma unroll
  for (int r = 0; r < 16; ++r) ps += p1[r];
  { auto rr = __builtin_amdgcn_permlane32_swap(__float_as_uint(ps), __float_as_uint(ps), false, false);
    ps = __uint_as_float(rr[0]) + __uint_as_float(rr[1]); }
  l_reg = l_reg * alpha + ps;
#define PK4(P, BASE, OUT) do { unsigned a0 = cvtpk(P[BASE + 0], P[BASE + 1]), a1 = cvtpk(P[BASE + 2], P[BASE + 3]);   \
    unsigned b0 = cvtpk(P[BASE + 4], P[BASE + 5]), b1 = cvtpk(P[BASE + 6], P[BASE + 7]);                              \
    auto r0 = __builtin_amdgcn_permlane32_swap(a0, b0, false, false); auto r1 = __builtin_amdgcn_permlane32_swap(a1, b1, false, false); \
    u32x4 w = {r0[0], r1[0], r0[1], r1[1]}; OUT = *reinterpret_cast<bf16x8*>(&w); } while (0)
  PK4(p0, 0, pa0); PK4(p0, 8, pa1); PK4(p1, 0, pa2); PK4(p1, 8, pa3);
#undef PK4
}
template <int DQ> __device__ __forceinline__ int kswz(int row, int colB) { return row * (DQ * 2) + (colB ^ ((row & 7) << 4)); }
template <int DQ> __device__ __forceinline__ void qkt(f32x16& p0, f32x16& p1, const char* Ks, const bf16x8* qr, int r32, int hi) {
  p0 = f32x16{}; p1 = f32x16{};
#pragma unroll
  for (int d0 = 0; d0 < DQ / 16; ++d0) { const int cb = (d0 * 16 + hi * 8) * 2;
    const bf16x8 b0 = *reinterpret_cast<const bf16x8*>(Ks + kswz<DQ>(r32, cb));
    const bf16x8 b1 = *reinterpret_cast<const bf16x8*>(Ks + kswz<DQ>(32 + r32, cb));
    p0 = __builtin_amdgcn_mfma_f32_32x32x16_bf16(b0, qr[d0], p0, 0, 0, 0);
    p1 = __builtin_amdgcn_mfma_f32_32x32x16_bf16(b1, qr[d0], p1, 0, 0, 0); }
}
__device__ __forceinline__ int v_st(int k, int c) { const int kk = (k & ~0xC) | ((k & 4) << 1) | ((k & 8) >> 1); return ((kk >> 3) * 4 + (c >> 5)) * 512 + ((kk & 7) * 32 + (c & 31)) * 2; }
__device__ __forceinline__ int v_rd_base(int lane) { return ((lane & 3) << 3) | (((lane >> 2) & 3) << 6) | (((lane >> 4) & 1) << 5) | (((lane >> 5) & 1) << 8); }
constexpr int v_rd_off(int d0, int ks, int half) { return d0 * 512 + ks * 4096 + half * 2048; }
template <int OFF> __device__ __forceinline__ s16x4 tr_read(int vb) {
  s16x4 r; asm volatile("ds_read_b64_tr_b16 %0, %1 offset:%2" : "=&v"(r) : "v"(vb), "i"(OFF) : "memory"); return r;
}
template <int D0> __device__ __forceinline__ void pv_one(f32x16& od, int vb, bf16x8 pa0, bf16x8 pa1, bf16x8 pa2, bf16x8 pa3) {
  const s16x4 l0 = tr_read<v_rd_off(D0, 0, 0)>(vb), h0 = tr_read<v_rd_off(D0, 0, 1)>(vb), l1 = tr_read<v_rd_off(D0, 1, 0)>(vb), h1 = tr_read<v_rd_off(D0, 1, 1)>(vb);
  const s16x4 l2 = tr_read<v_rd_off(D0, 2, 0)>(vb), h2 = tr_read<v_rd_off(D0, 2, 1)>(vb), l3 = tr_read<v_rd_off(D0, 3, 0)>(vb), h3 = tr_read<v_rd_off(D0, 3, 1)>(vb);
  asm volatile("s_waitcnt lgkmcnt(0)" ::: "memory"); SBAR();
#define PK(L, H) (bf16x8){L[0], L[1], L[2], L[3], H[0], H[1], H[2], H[3]}
  od = __builtin_amdgcn_mfma_f32_32x32x16_bf16(pa0, PK(l0, h0), od, 0, 0, 0);
  od = __builtin_amdgcn_mfma_f32_32x32x16_bf16(pa1, PK(l1, h1), od, 0, 0, 0);
  od = __builtin_amdgcn_mfma_f32_32x32x16_bf16(pa2, PK(l2, h2), od, 0, 0, 0);
  od = __builtin_amdgcn_mfma_f32_32x32x16_bf16(pa3, PK(l3, h3), od, 0, 0, 0);
#undef PK
}
__device__ __forceinline__ void pv_d0(f32x16* o, int vb, bf16x8 pa0, bf16x8 pa1, bf16x8 pa2, bf16x8 pa3) {
  pv_one<0>(o[0], vb, pa0, pa1, pa2, pa3); pv_one<1>(o[1], vb, pa0, pa1, pa2, pa3); pv_one<2>(o[2], vb, pa0, pa1, pa2, pa3); pv_one<3>(o[3], vb, pa0, pa1, pa2, pa3);
}
template <int MODE> __device__ __forceinline__ void maskf(f32x16& p0, f32x16& p1, int t, const Args& a, int wid, int r32, int hi, const float* bias_lds) {
  if constexpr (MODE == 0) { return; }
  else {
    if (t < a.nctx) return;
    if constexpr (MODE == 1) {
      const int kb = a.kpos0 + (t - a.nctx) * 64, qw = a.qpos0 + wid * 32;
      if (kb + 63 - qw <= 128 && qw + 31 - kb <= 128) return;
      const int q = qw + r32;
#pragma unroll
      for (int r = 0; r < 16; ++r) { const int d0 = kb + crow(r, hi) - q, d1 = d0 + 32;
        if (d0 > 128 || d0 < -128) p0[r] = -1e30f;
        if (d1 > 128 || d1 < -128) p1[r] = -1e30f; }
    } else {
      const int kr = a.klo + (t - a.nctx), rq = a.r0 + (wid >> 1);
      const int rs = min(max(rq - 4, 0), 120);
      if (kr < rs || kr >= rs + 8) {
#pragma unroll
        for (int r = 0; r < 16; ++r) { p0[r] = -1e30f; p1[r] = -1e30f; }
        return; }
      const int c = (wid & 1) * 32 + r32, cs = min(max(c - 8, 0), 48);
      int cb = 4 * hi - c + 63, vb = 4 * hi - cs;
      asm volatile("" : "+v"(cb), "+v"(vb));
      const float* bp = bias_lds + (kr - rq + 7) * 128 + cb;
#pragma unroll
      for (int r = 0; r < 16; ++r) { const int k0 = (r & 3) + 8 * (r >> 2), k1 = k0 + 32;
        const float b0 = bp[k0], b1 = bp[k1];
        p0[r] = ((unsigned)(k0 + vb) < 16u) ? fmaf(b0, a.inv_scale, p0[r]) : -1e30f;
        p1[r] = ((unsigned)(k1 + vb) < 16u) ? fmaf(b1, a.inv_scale, p1[r]) : -1e30f;
        if ((r & 3) == 3) SBAR(); }
    }
  }
}

template <int DQ, int MODE>
__device__ __forceinline__ void attn_unit(const Args& a, char* lds) {
  constexpr int SHM_K = KVBLK * DQ * 2, NQ = DQ / 16, SDEPTH = (DQ == 192 || MODE == 2) ? 1 : 2;
  const int tid = fresh_tid(), wid = tid >> 6, lane = tid & 63, r32 = lane & 31, hi = lane >> 5;
  char* V_lds = lds; char* K_lds = lds + 2 * SHM_V;
  float* ws = (float*)(lds + 2 * SHM_V + 2 * SHM_K) + wid * 64; float* li_l = ws; float* al_l = ws + 32;
  float* bias_l = (float*)(lds + 2 * SHM_V + 2 * SHM_K + 2048);
  if constexpr (MODE == 2) { if (tid < 465) bias_l[(tid / 31) * 128 + 48 + (tid % 31)] = a.rpb[tid]; }
  float m_reg = -1e30f, l_reg = 0; f32x16 o[4] = {}; bf16x8 qr[NQ];
  const float C = a.C, thr_raw = a.thr_raw;
  const bf16* Qw = a.Q + (long)(wid * QBLK + r32) * a.ldq + hi * 8;
#pragma unroll
  for (int d0 = 0; d0 < NQ; ++d0) qr[d0] = *reinterpret_cast<const bf16x8*>(Qw + d0 * 16);
  const int sr = tid >> 4, sc = (tid & 15) * 8, vst0 = v_st(sr, sc), vst1 = v_st(32 + sr, sc);
  const int sr2 = tid >> 3, sc2 = (tid & 7) * 8;
  const int vb0 = (int)(uintptr_t)V_lds + v_rd_base(lane);
  struct { bf16x8 vs0, vs1, ks0, ks1, ks2; } sr_[SDEPTH];
  const int vo0 = sr * a.ldv + sc, vo1 = (32 + sr) * a.ldv + sc, ko0 = sr * a.ldk + sc, ko1 = (32 + sr) * a.ldk + sc, ko2 = sr2 * a.ldk2 + sc2;
#define KROW(t) ((t) < a.nctx ? a.ctx_row0 + 64 * (t) : a.lat_row0 + 64 * ((t) - a.nctx))
#define SLOAD(i, t) do { const long kr_ = KROW(t); const bf16* vp_ = a.V + kr_ * a.ldv; const bf16* kp_ = a.K + kr_ * a.ldk; \
    sr_[i].vs0 = *reinterpret_cast<const bf16x8*>(vp_ + vo0); sr_[i].vs1 = *reinterpret_cast<const bf16x8*>(vp_ + vo1); \
    sr_[i].ks0 = *reinterpret_cast<const bf16x8*>(kp_ + ko0); sr_[i].ks1 = *reinterpret_cast<const bf16x8*>(kp_ + ko1); \
    if constexpr (DQ == 192) sr_[i].ks2 = *reinterpret_cast<const bf16x8*>(a.K2 + kr_ * a.ldk2 + ko2); } while (0)
#define SWRITE(b, i) do { *(bf16x8*)(V_lds + (b) * SHM_V + vst0) = sr_[i].vs0; *(bf16x8*)(V_lds + (b) * SHM_V + vst1) = sr_[i].vs1; \
    *(bf16x8*)(K_lds + (b) * SHM_K + kswz<DQ>(sr, sc * 2)) = sr_[i].ks0; *(bf16x8*)(K_lds + (b) * SHM_K + kswz<DQ>(32 + sr, sc * 2)) = sr_[i].ks1; \
    if constexpr (DQ == 192) *(bf16x8*)(K_lds + (b) * SHM_K + kswz<DQ>(sr2, 256 + sc2 * 2)) = sr_[i].ks2; } while (0)
#define SWAIT() do { if constexpr (SDEPTH == 1) asm volatile("s_waitcnt vmcnt(0)" ::: "memory"); else asm volatile("s_waitcnt vmcnt(4)" ::: "memory"); } while (0)
#define RESC(al) do { if (__any((al) < 1.f)) { if (hi == 0) al_l[r32] = (al); asm volatile("s_waitcnt lgkmcnt(0)" ::: "memory"); \
    _Pragma("unroll") for (int d = 0; d < 4; ++d) _Pragma("unroll") for (int r = 0; r < 16; ++r) o[d][r] *= al_l[crow(r, hi)]; } } while (0)
  f32x16 pA0, pA1, pB0, pB1; float mnA, mnB, alA, alB; bf16x8 pa0, pa1, pa2, pa3; const int NT = a.NT;
  constexpr int SE = 0, SO = SDEPTH - 1;
  SLOAD(SE, 0); asm volatile("s_waitcnt vmcnt(0)" ::: "memory"); SWRITE(0, SE); __syncthreads();
  qkt<DQ>(pA0, pA1, K_lds, qr, r32, hi); maskf<MODE>(pA0, pA1, 0, a, wid, r32, hi, bias_l); partialSM(pA0, pA1, m_reg, mnA, alA, C, thr_raw);
  SLOAD(SO, 1); if constexpr (SDEPTH == 2) { if (2 < NT) SLOAD(SE, 2); }
  SWAIT(); SWRITE(1, SO); __syncthreads();
  for (int j = 1; j + 1 < NT; j += 2) {
    SBAR(); qkt<DQ>(pB0, pB1, K_lds + SHM_K, qr, r32, hi); maskf<MODE>(pB0, pB1, j, a, wid, r32, hi, bias_l);
    finishSM(pA0, pA1, alA, l_reg, pa0, pa1, pa2, pa3); SBAR();
    SLOAD(SO, j + SDEPTH); SBAR();
    pv_d0(o, vb0, pa0, pa1, pa2, pa3); partialSM(pB0, pB1, m_reg, mnB, alB, C, thr_raw);
    __syncthreads(); SWAIT(); SWRITE(0, SE);
    RESC(alB); __syncthreads();
    SBAR(); qkt<DQ>(pA0, pA1, K_lds, qr, r32, hi); maskf<MODE>(pA0, pA1, j + 1, a, wid, r32, hi, bias_l);
    finishSM(pB0, pB1, alB, l_reg, pa0, pa1, pa2, pa3); SBAR();
    if (SDEPTH == 1 || j + 3 < NT) SLOAD(SE, j + 1 + SDEPTH); SBAR();
    pv_d0(o, vb0 + SHM_V, pa0, pa1, pa2, pa3); partialSM(pA0, pA1, m_reg, mnA, alA, C, thr_raw);
    __syncthreads(); SWAIT(); SWRITE(1, SO);
    RESC(alA); __syncthreads();
  }
  SBAR(); qkt<DQ>(pB0, pB1, K_lds + SHM_K, qr, r32, hi); maskf<MODE>(pB0, pB1, NT - 1, a, wid, r32, hi, bias_l);
  finishSM(pA0, pA1, alA, l_reg, pa0, pa1, pa2, pa3); SBAR();
  pv_d0(o, vb0, pa0, pa1, pa2, pa3); partialSM(pB0, pB1, m_reg, mnB, alB, C, thr_raw);
  __syncthreads(); RESC(alB);
  finishSM(pB0, pB1, alB, l_reg, pa0, pa1, pa2, pa3); SBAR();
  pv_d0(o, vb0 + SHM_V, pa0, pa1, pa2, pa3);
  if constexpr (MODE == 1) l_reg += __builtin_amdgcn_exp2f(a.sink_l2 - m_reg * C);
  if (hi == 0) li_l[r32] = l_reg; asm volatile("s_waitcnt lgkmcnt(0)" ::: "memory");
  float rli[16];
#pragma unroll
  for (int r = 0; r < 16; ++r) rli[r] = __builtin_amdgcn_rcpf(li_l[crow(r, hi)]);
  bf16* Ow = a.O + (long)(wid * QBLK) * a.ldo;
#pragma unroll
  for (int r = 0; r < 16; ++r) { const int orow = crow(r, hi);
#pragma unroll
    for (int d0 = 0; d0 < 4; ++d0) { const float v = o[d0][r] * rli[r]; unsigned u = __float_as_uint(v); u = (u + 0x7fffu + ((u >> 16) & 1u)) >> 16; Ow[(long)orow * a.ldo + d0 * 32 + r32] = (bf16)u; } }
  __syncthreads();
#undef KROW
#undef SLOAD
#undef SWRITE
#undef SWAIT
#undef RESC
}
#undef SBAR
}
#define LAS __attribute__((address_space(3)))
typedef unsigned short bf16;
typedef float f32x4 __attribute__((ext_vector_type(4)));
typedef unsigned v4u __attribute__((ext_vector_type(4)));
typedef unsigned v2u __attribute__((ext_vector_type(2)));
constexpr int NWAVES = 8, NTHR = 512;
constexpr int DM = 2048, SEQ = 8192, NCTX = 256, MLAT = 2 * SEQ, MALL = MLAT + 2 * NCTX, DFF = 5632;
constexpr int N_IN0 = 2816, N_IN1 = 4608, N_UQ = 1536, N_UKV = 2048, N_GU = 2 * DFF;
constexpr float EPS = 1e-6f;
constexpr size_t MiB = 1u << 20;
constexpr size_t WS_MOD = 0;
constexpr size_t WS_WIN0 = 1 * MiB, WS_WUQ = WS_WIN0 + 11 * MiB, WS_WUKV = WS_WUQ + 2 * MiB, WS_WOUT0 = WS_WUKV + 2 * MiB, WS_WIN1 = WS_WOUT0 + 8 * MiB, WS_WOUT1 = WS_WIN1 + 18 * MiB,
                 WS_WGU = WS_WOUT1 + 8 * MiB, WS_WD = WS_WGU + 88 * MiB, WS_HCTX = WS_WD + 44 * MiB;
constexpr size_t WS_UO = WS_HCTX + 4 * MiB;
constexpr size_t WS_OB = WS_UO + 66 * MiB;
constexpr size_t WS_BIG = WS_UO + 132 * MiB;
constexpr size_t WS_QB = WS_BIG + 91 * MiB, WS_KVB = WS_BIG + 141 * MiB, WS_UB = WS_BIG + 149 * MiB, WS_END = WS_BIG + 215 * MiB;
static_assert((size_t)MALL * DM * 2 == 66 * MiB && (size_t)MALL * N_IN0 * 2 <= 91 * MiB && (size_t)MALL * N_UQ * 2 <= 50 * MiB && (size_t)MALL * N_IN1 * 2 <= 149 * MiB && (size_t)MALL * DFF * 2 <= 215 * MiB, "ws map");

__device__ __forceinline__ unsigned f2bf(float f) { unsigned u = __builtin_bit_cast(unsigned, f); return (u + 0x7fffu + ((u >> 16) & 1u)) >> 16; }
__device__ __forceinline__ unsigned pk2(float lo, float hi) { return f2bf(lo) | (f2bf(hi) << 16); }
__device__ __forceinline__ float bf2f(bf16 v) { return __uint_as_float(((unsigned)v) << 16); }
__device__ __forceinline__ float wave_sum(float v, int lane) {
#pragma unroll
    for (int o = 1; o < 64; o <<= 1) v += __int_as_float(__builtin_amdgcn_ds_bpermute((lane ^ o) << 2, __float_as_int(v)));
    return v;
}
__device__ __forceinline__ float silu_f(float x) { return x / (1.0f + __expf(-x)); }

struct KArgs { const float* in[29]; float* out; unsigned char* ws; };
typedef const __attribute__((address_space(4))) KArgs* KAP;
__device__ __forceinline__ KAP kargs() { KAP p = (KAP)__builtin_amdgcn_kernarg_segment_ptr(); asm volatile("" : "+s"(p)); return p; }

__device__ __forceinline__ void transpose_item(const float* W, int K, int N, bf16* WT, int k0, int n0, int drow0, LAS float* scr, int lane) {
#pragma unroll 8
    for (int i = 0; i < 32; ++i) { const int kk = 2 * i + (lane >> 5); scr[kk * 33 + (lane & 31)] = W[(size_t)(k0 + kk) * N + n0 + (lane & 31)]; }
    asm volatile("s_waitcnt lgkmcnt(0)" ::: "memory");
    const int c = lane & 7;
#pragma unroll
    for (int j = 0; j < 4; ++j) { const int n = (lane >> 3) + 8 * j; const LAS float* s = scr + (8 * c) * 33 + n;
        v4u o; o.x = pk2(s[0 * 33], s[1 * 33]); o.y = pk2(s[2 * 33], s[3 * 33]); o.z = pk2(s[4 * 33], s[5 * 33]); o.w = pk2(s[6 * 33], s[7 * 33]);
        *(v4u*)(WT + (size_t)(drow0 + n) * K + k0 + 8 * c) = o; }
    asm volatile("s_waitcnt lgkmcnt(0)" ::: "memory");
}
__device__ __forceinline__ bool conv_matrix(int& it, const float* W, int K, int N, bf16* WT, int mode, LAS float* scr, int lane) {
    const int nblk = N / 32, items = (K / 64) * nblk;
    if (it >= items) { it -= items; return false; }
    const int kb = it / nblk, nb = it % nblk, n0 = 32 * nb;
    const int drow0 = mode == 0 ? n0 : ((n0 >> 7) * 256 + (mode == 2 ? 128 : 0) + (n0 & 127));
    transpose_item(W, K, N, WT, 64 * kb, n0, drow0, scr, lane);
    return true;
}
__device__ __forceinline__ void p0_weights(KAP a, LAS unsigned char* lds, int gw, int NGW, int wave, int lane) {
    LAS float* scr = (LAS float*)(lds + wave * 8704);
    unsigned char* ws = a->ws;
    constexpr int I_TOTAL = (2048 / 64) * (2624 / 32) + (512 / 64) * (1536 / 32) + (512 / 64) * (2048 / 32) + 2 * (2048 / 64) * (2048 / 32) + (2048 / 64) * (4608 / 32)
                          + 4 * (2048 / 64) * (DFF / 32) + 2 * (DFF / 64) * (2048 / 32);
    for (int item = gw; item < I_TOTAL; item += NGW) {
        int it = item;
        if (conv_matrix(it, a->in[13], 2048, 2624, (bf16*)(ws + WS_WIN0), 0, scr, lane)) continue;
        if (conv_matrix(it, a->in[19], 512, 1536, (bf16*)(ws + WS_WUQ), 0, scr, lane)) continue;
        if (conv_matrix(it, a->in[20], 512, 2048, (bf16*)(ws + WS_WUKV), 0, scr, lane)) continue;
        if (conv_matrix(it, a->in[14], 2048, 2048, (bf16*)(ws + WS_WOUT0), 0, scr, lane)) continue;
        if (conv_matrix(it, a->in[21], 2048, 4608, (bf16*)(ws + WS_WIN1), 0, scr, lane)) continue;
        if (conv_matrix(it, a->in[22], 2048, 2048, (bf16*)(ws + WS_WOUT1), 0, scr, lane)) continue;
        if (conv_matrix(it, a->in[10], 2048, DFF, (bf16*)(ws + WS_WGU), 1, scr, lane)) continue;
        if (conv_matrix(it, a->in[10] + (size_t)2048 * DFF, 2048, DFF, (bf16*)(ws + WS_WGU + 44 * MiB), 1, scr, lane)) continue;
        if (conv_matrix(it, a->in[11], 2048, DFF, (bf16*)(ws + WS_WGU), 2, scr, lane)) continue;
        if (conv_matrix(it, a->in[11] + (size_t)2048 * DFF, 2048, DFF, (bf16*)(ws + WS_WGU + 44 * MiB), 2, scr, lane)) continue;
        if (conv_matrix(it, a->in[12], DFF, 2048, (bf16*)(ws + WS_WD), 0, scr, lane)) continue;
        conv_matrix(it, a->in[12] + (size_t)2048 * DFF, DFF, 2048, (bf16*)(ws + WS_WD + 22 * MiB), 0, scr, lane);
    }
}
__device__ __forceinline__ void p0_mod(KAP a, LAS unsigned char* lds, int tid) {
    LAS float* sv = (LAS float*)lds;
    LAS float* red = (LAS float*)(lds + 24576);
    const int blk = blockIdx.x; if (blk >= 256) return;
    const int layer = blk >> 7, col0 = (blk & 127) * 96;
    for (int i = tid; i < 3 * 2048; i += NTHR) { const int v = i >> 11, k = i & 2047; const float x = v < 2 ? a->in[1][v * 2048 + k] : a->in[3][k]; sv[i] = silu_f(x); }
    __syncthreads();
    const int c4 = tid % 24, ks = tid / 24;
    if (ks < 21) {
        const float* W = a->in[4] + (size_t)layer * 2048 * 12288 + col0 + 4 * c4;
        f32x4 a0 = {0, 0, 0, 0}, a1 = a0, a2 = a0;
#pragma unroll 4
        for (int k = ks; k < 2048; k += 21) { const f32x4 w = *(const f32x4*)(W + (size_t)k * 12288); a0 += w * sv[k]; a1 += w * sv[2048 + k]; a2 += w * sv[4096 + k]; }
        LAS float* r = red + ks * 288 + 4 * c4;
        *(LAS f32x4*)(r) = a0; *(LAS f32x4*)(r + 96) = a1; *(LAS f32x4*)(r + 192) = a2;
    }
    __syncthreads();
    if (tid < 288) { float s = 0.f;
        for (int q = 0; q < 21; ++q) s += red[q * 288 + tid];
        const int v = tid / 96, j = tid % 96;
        ((float*)(a->ws + WS_MOD))[(size_t)(layer * 3 + v) * 12288 + col0 + j] = s + a->in[5][layer * 12288 + col0 + j]; }
    __syncthreads();
}
__device__ __forceinline__ void store_u(bf16* urow, int lane, const f32x4 (&v)[8], float rstd, const float* g, const float* sh, const float* sc) {
#pragma unroll
    for (int j = 0; j < 8; ++j) { const int ci = 256 * j + 4 * lane; const f32x4 g4 = *(const f32x4*)(g + ci), s4 = *(const f32x4*)(sc + ci), h4 = *(const f32x4*)(sh + ci);
        const f32x4 t = (v[j] * rstd * g4) * (1.0f + s4) + h4; v2u w; w.x = pk2(t[0], t[1]); w.y = pk2(t[2], t[3]); *(v2u*)(urow + ci) = w; }
}
__device__ __forceinline__ void pass_pre(const float* hlat, const float* hctx, const float* g, const float* mod, int sh_off, int sc_off, bf16* U, int nrows, int gw, int NGW, int lane) {
    for (int m = gw; m < nrows; m += NGW) {
        const float* src = m < MLAT ? hlat + (size_t)m * DM : hctx + (size_t)(m - MLAT) * DM; const float* mv = mod + (m < MLAT ? (m >> 13) : 2) * 12288;
        f32x4 v[8]; float ss = 0.f;
#pragma unroll
        for (int j = 0; j < 8; ++j) { v[j] = *(const f32x4*)(src + 256 * j + 4 * lane); ss += (v[j][0] * v[j][0] + v[j][1] * v[j][1]) + (v[j][2] * v[j][2] + v[j][3] * v[j][3]); }
        const float rstd = rsqrtf(wave_sum(ss, lane) * (1.0f / DM) + EPS);
        store_u(U + (size_t)m * DM, lane, v, rstd, g, mv + sh_off, mv + sc_off);
    }
}
__device__ __forceinline__ void pass_post(const float* o, const float* hlat, const float* hctx, float* olat, float* octx, const float* gpost, const float* mod, int gt_off,
                                          const float* gpre, const float* modu, int sh_off, int sc_off, bf16* U, int nrows, int gw, int NGW, int lane) {
    for (int m = gw; m < nrows; m += NGW) {
        const float* hs = m < MLAT ? hlat + (size_t)m * DM : hctx + (size_t)(m - MLAT) * DM; float* hd = m < MLAT ? olat + (size_t)m * DM : octx + (size_t)(m - MLAT) * DM;
        const float* mv = mod + (m < MLAT ? (m >> 13) : 2) * 12288; const float* orow = o + (size_t)m * DM;
        f32x4 v[8]; float ss = 0.f;
#pragma unroll
        for (int j = 0; j < 8; ++j) { v[j] = *(const f32x4*)(orow + 256 * j + 4 * lane); ss += (v[j][0] * v[j][0] + v[j][1] * v[j][1]) + (v[j][2] * v[j][2] + v[j][3] * v[j][3]); }
        const float rstd = rsqrtf(wave_sum(ss, lane) * (1.0f / DM) + EPS); float s2 = 0.f;
#pragma unroll
        for (int j = 0; j < 8; ++j) { const int ci = 256 * j + 4 * lane; const f32x4 g4 = *(const f32x4*)(gpost + ci), t4 = *(const f32x4*)(mv + gt_off + ci), h4 = *(const f32x4*)(hs + ci);
            v[j] = h4 + t4 * (v[j] * rstd * g4); *(f32x4*)(hd + ci) = v[j]; s2 += (v[j][0] * v[j][0] + v[j][1] * v[j][1]) + (v[j][2] * v[j][2] + v[j][3] * v[j][3]); }
        if (U) { const float* mu = modu + (m < MLAT ? (m >> 13) : 2) * 12288; const float rstd2 = rsqrtf(wave_sum(s2, lane) * (1.0f / DM) + EPS); store_u(U + (size_t)m * DM, lane, v, rstd2, gpre, mu + sh_off, mu + sc_off); }
    }
}
__device__ __forceinline__ void rope_cs(float pos, int j, float inv_nf, float& cs, float& sn) {
    const float inv_freq = __builtin_amdgcn_exp2f(-(float)j * inv_nf * 13.287712379549449f);
    float rev = pos * inv_freq * 0.15915494309189535f; rev -= rintf(rev);
    sn = __builtin_amdgcn_sinf(rev); cs = __builtin_amdgcn_cosf(rev);
}
__device__ __forceinline__ void head128(bf16* hp, const float* gain, bool rope, float prow, float pcol, int lane) {
    const int j = lane & 31, s = lane >> 5, ia = 64 * s + j, ib = ia + 32;
    float x = bf2f(hp[ia]), y = bf2f(hp[ib]);
    const float rstd = rsqrtf(wave_sum(x * x + y * y, lane) * (1.0f / 128.0f) + EPS);
    x = x * rstd * gain[ia]; y = y * rstd * gain[ib];
    if (rope) { float cs, sn; rope_cs(s ? pcol : prow, j, 1.0f / 32.0f, cs, sn); const float nx = x * cs - y * sn, ny = y * cs + x * sn; x = nx; y = ny; }
    hp[ia] = (bf16)f2bf(x); hp[ib] = (bf16)f2bf(y);
}
__device__ __forceinline__ void rope64(bf16* p, float prow, float pcol, int l32) {
    const int j = l32 & 15, s = (l32 >> 4) & 1, ia = 32 * s + j, ib = ia + 16;
    const float x = bf2f(p[ia]), y = bf2f(p[ib]); float cs, sn; rope_cs(s ? pcol : prow, j, 1.0f / 16.0f, cs, sn);
    p[ia] = (bf16)f2bf(x * cs - y * sn); p[ib] = (bf16)f2bf(y * cs + x * sn);
}
__device__ __forceinline__ void norm512(bf16* p, const float* gain, int lane) {
    const v4u raw = *(const v4u*)(p + 8 * lane); float x[8];
#pragma unroll
    for (int i = 0; i < 4; ++i) { x[2 * i] = __uint_as_float(raw[i] << 16); x[2 * i + 1] = __uint_as_float(raw[i] & 0xffff0000u); }
    float ss = 0.f;
#pragma unroll
    for (int i = 0; i < 8; ++i) ss += x[i] * x[i];
    const float rstd = rsqrtf(wave_sum(ss, lane) * (1.0f / 512.0f) + EPS);
    const f32x4 g0 = *(const f32x4*)(gain + 8 * lane), g1 = *(const f32x4*)(gain + 8 * lane + 4);
    v4u w; w.x = pk2(x[0] * rstd * g0[0], x[1] * rstd * g0[1]); w.y = pk2(x[2] * rstd * g0[2], x[3] * rstd * g0[3]); w.z = pk2(x[4] * rstd * g1[0], x[5] * rstd * g1[1]); w.w = pk2(x[6] * rstd * g1[2], x[7] * rstd * g1[3]);
    *(v4u*)(p + 8 * lane) = w;
}
__device__ __forceinline__ void prep_ab(bf16* P, const float* aqn, const float* akn, const float* bqn, const float* bkvn, int gw, int NGW, int lane) {
    for (int m = gw; m < MALL; m += NGW) {
        bf16* row = P + (size_t)m * N_IN0; const bool lat = m < MLAT; const int t = m & (SEQ - 1); const float pr = (float)(t >> 6), pc = (float)(t & 63);
        for (int h = 0; h < 8; ++h) head128(row + h * 128, aqn, lat, pr, pc, lane);
        for (int h = 0; h < 2; ++h) head128(row + 1024 + h * 128, akn, lat, pr, pc, lane);
        norm512(row + 1536, bqn, lane); norm512(row + 2048, bkvn, lane);
        if (lat && lane < 32) rope64(row + 2560, pr, pc, lane);
    }
}
__device__ __forceinline__ void prep_qb(bf16* QB, int gw, int NGW, int lane) {
    for (int m = gw; m < MLAT; m += NGW) {
        bf16* row = QB + (size_t)m * N_UQ; const int t = m & (SEQ - 1); const float pr = (float)(t >> 6), pc = (float)(t & 63);
#pragma unroll
        for (int i = 0; i < 4; ++i) rope64(row + (2 * i + (lane >> 5)) * 192 + 128, pr, pc, lane & 31);
    }
}
__device__ __forceinline__ void prep_cd(bf16* P, const float* cqn, const float* ckn, const float* dqn, const float* dkn, int gw, int NGW, int lane) {
    for (int m = gw; m < MALL; m += NGW) {
        bf16* row = P + (size_t)m * N_IN1; const bool lat = m < MLAT; const int t = m & (SEQ - 1); const float pr = (float)(t >> 6), pc = (float)(t & 63);
        if (lat) for (int h = 0; h < 8; ++h) head128(row + h * 128, cqn, true, pr, pc, lane);
        for (int h = 0; h < 2; ++h) head128(row + 1024 + h * 128, ckn, lat, pr, pc, lane);
        if (lat) for (int h = 0; h < 8; ++h) head128(row + 1536 + h * 128, dqn, false, 0.f, 0.f, lane);
        for (int h = 0; h < 8; ++h) head128(row + 2560 + h * 128, dkn, false, 0.f, 0.f, lane);
    }
}
constexpr float LOG2E = 1.4426950408889634f;
__device__ __forceinline__ void attn_phase_ab(const bf16* P0, const bf16* QB, const bf16* KVB, bf16* OB, char* lds) {
    const int c = blockIdx.x, G = gridDim.x;
    for (int id = c; id < 1024 + 32; id += G) {
        att::Args a{};
        int mixer, b, h, qrow0, NT;
        if (id < 1024) { const int rnd = id >> 8, cc = id & 255; mixer = rnd >> 1; b = rnd & 1; h = cc & 7; qrow0 = b * SEQ + (cc >> 3) * 256; NT = 132; }
        else { const int cc = id - 1024; mixer = cc >> 4; b = (cc >> 3) & 1; h = cc & 7; qrow0 = MLAT + b * NCTX; NT = 4; }
        a.NT = NT; a.nctx = 4; a.ctx_row0 = MLAT + b * NCTX; a.lat_row0 = b * SEQ; a.ldo = DM;
        if (mixer == 0) {
            a.Q = P0 + (size_t)qrow0 * N_IN0 + h * 128; a.ldq = N_IN0; a.K = P0 + 1024 + (h >> 2) * 128; a.ldk = N_IN0; a.K2 = nullptr; a.ldk2 = 0; a.V = P0 + 1280 + (h >> 2) * 128; a.ldv = N_IN0;
            a.O = OB + (size_t)qrow0 * DM + h * 128; const float scale = 0.08838834764831845f; a.C = scale * LOG2E; a.thr_raw = 8.0f / scale;

#ifndef DIS_A
            att::attn_unit<128, 0>(a, lds);
#endif

        } else {
            a.Q = QB + (size_t)qrow0 * N_UQ + h * 192; a.ldq = N_UQ; a.K = KVB + h * 256; a.ldk = N_UKV; a.K2 = P0 + 2560; a.ldk2 = N_IN0; a.V = KVB + h * 256 + 128; a.ldv = N_UKV;
            a.O = OB + (size_t)qrow0 * DM + 1024 + h * 128; const float scale = 0.07216878364870322f; a.C = scale * LOG2E; a.thr_raw = 8.0f / scale;

#ifndef DIS_B
            att::attn_unit<192, 0>(a, lds);
#endif

        }
    }
}
__device__ __forceinline__ void attn_phase_cd(const bf16* P1, bf16* OB, const float* sink, const float* rpb, char* lds) {
    const int c = blockIdx.x, G = gridDim.x;
    for (int id = c; id < 1024; id += G) {
        att::Args a{};
        const int rnd = id >> 8, cc = id & 255, mixer = rnd >> 1, b = rnd & 1, h = cc & 7, qb = cc >> 3, qrow0 = b * SEQ + qb * 256;
        a.nctx = 4; a.ctx_row0 = MLAT + b * NCTX; a.ldo = DM; a.ldq = a.ldk = a.ldv = N_IN1; a.K2 = nullptr; a.ldk2 = 0;
        const float scale = 0.08838834764831845f; a.C = scale * LOG2E; a.thr_raw = 8.0f / scale; a.inv_scale = 1.0f / scale;
        if (mixer == 0) {
            const int kbase = min(max(qb * 256 - 128, 0), SEQ - 512);
            a.NT = 12; a.lat_row0 = b * SEQ + kbase; a.qpos0 = qb * 256; a.kpos0 = kbase; a.sink_l2 = sink[h] * LOG2E;
            a.Q = P1 + (size_t)qrow0 * N_IN1 + h * 128; a.K = P1 + 1024 + (h >> 2) * 128; a.V = P1 + 1280 + (h >> 2) * 128; a.O = OB + (size_t)qrow0 * DM + h * 128;

#ifndef DIS_C
            att::attn_unit<128, 1>(a, lds);
#endif

        } else {
            const int r0 = qb * 4, klo = min(max(r0 - 4, 0), 116);
            a.NT = 16; a.lat_row0 = b * SEQ + klo * 64; a.r0 = r0; a.klo = klo; a.rpb = rpb + h * (15 * 31);
            a.Q = P1 + (size_t)qrow0 * N_IN1 + 1536 + h * 128; a.K = P1 + 2560 + h * 128; a.V = P1 + 3584 + h * 128; a.O = OB + (size_t)qrow0 * DM + 1024 + h * 128;

#ifndef DIS_D
            att::attn_unit<128, 2>(a, lds);
#endif

        }
    }
}

__global__ void __launch_bounds__(NTHR, 2) fwd_megakernel(KArgs args) {
    extern __shared__ __attribute__((aligned(16))) unsigned char lds[];
    cg::grid_group grid = cg::this_grid();
    LAS unsigned char* ldsl = (LAS unsigned char*)lds;
    const int G = gridDim.x, NGW = G * NWAVES;
#define PHASE_IDS() const int tid = fresh_tid(); const int lane = tid & 63, wave = __builtin_amdgcn_readfirstlane(tid >> 6), gw = blockIdx.x * NWAVES + wave; (void)wave; (void)gw; (void)lane
#define WSB (kargs()->ws)
#define x_ (kargs()->in[0])
#define ctx_ (kargs()->in[2])
#define out_ (kargs()->out)
#define hctx_ ((float*)(WSB + WS_HCTX))
#define MOD_ ((const float*)(WSB + WS_MOD))
#define UA_ ((bf16*)(WSB + WS_UO))
#define OB_ ((bf16*)(WSB + WS_OB))
#define F_ ((float*)(WSB + WS_UO))
#define PB_ ((bf16*)(WSB + WS_BIG))
#define OF_ ((float*)(WSB + WS_BIG))
#define ACT_ ((bf16*)(WSB + WS_BIG))
#define QB_ ((bf16*)(WSB + WS_QB))
#define KVB_ ((bf16*)(WSB + WS_KVB))
#define UB_ ((bf16*)(WSB + WS_UB))
#define GSYNC() do { __threadfence(); grid.sync(); __threadfence(); } while (0)

    { PHASE_IDS(); p0_mod(kargs(), ldsl, tid); }
    { PHASE_IDS(); p0_weights(kargs(), ldsl, gw, NGW, wave, lane); }
    GSYNC();
    { PHASE_IDS(); pass_pre(x_, ctx_, kargs()->in[6], MOD_, 0, DM, UA_, MALL, gw, NGW, lane); }
    GSYNC();
    for (int L = 0; L < 2; ++L) {

        const int Mrows = L == 0 ? MALL : MLAT;
        { pg8::Gemm g{L == 0 ? UA_ : UB_, (const bf16*)(WSB + (L == 0 ? WS_WIN0 : WS_WIN1)), MALL, L == 0 ? N_IN0 : N_IN1, DM, DM};
          pg8::StaticOrder S; S.init(g.M, g.N, G, (int)blockIdx.x); pg8::EpiBf16 E{PB_, g.N};
          pg8::gemm_phase<pg8::EpiBf16, pg8::StaticOrder, true, true>(ldsl, g, S, E); }
        GSYNC();
        if (L == 0) {
            { PHASE_IDS(); prep_ab(PB_, kargs()->in[15], kargs()->in[16], kargs()->in[17], kargs()->in[18], gw, NGW, lane); }
            GSYNC();
            for (int q = 0; q < 2; ++q) {
                pg8::Gemm g{PB_ + (q == 0 ? 1536 : 2048), (const bf16*)(WSB + (q == 0 ? WS_WUQ : WS_WUKV)), MALL, q == 0 ? N_UQ : N_UKV, 512, N_IN0};
                pg8::StaticOrder S; S.init(g.M, g.N, G, (int)blockIdx.x); pg8::EpiBf16 E{q == 0 ? QB_ : KVB_, g.N};
                pg8::gemm_phase<pg8::EpiBf16, pg8::StaticOrder, true, true>(ldsl, g, S, E);
            }
            GSYNC();
            { PHASE_IDS(); prep_qb(QB_, gw, NGW, lane); }
            GSYNC();
            attn_phase_ab(PB_, QB_, KVB_, OB_, (char*)lds);
        } else {
            { PHASE_IDS(); prep_cd(PB_, kargs()->in[23], kargs()->in[24], kargs()->in[26], kargs()->in[27], gw, NGW, lane); }
            GSYNC();
            attn_phase_cd(PB_, OB_, kargs()->in[25], kargs()->in[28], (char*)lds);
        }
        GSYNC();
        { pg8::Gemm g{OB_, (const bf16*)(WSB + (L == 0 ? WS_WOUT0 : WS_WOUT1)), Mrows, DM, DM, DM};
          pg8::StaticOrder S; S.init(g.M, g.N, G, (int)blockIdx.x); pg8::EpiF32 E{OF_, DM};
          pg8::gemm_phase<pg8::EpiF32, pg8::StaticOrder, true, true>(ldsl, g, S, E); }
        GSYNC();
        { PHASE_IDS(); pass_post(OF_, L == 0 ? x_ : out_, L == 0 ? ctx_ : hctx_, out_, hctx_, kargs()->in[7] + L * DM, MOD_ + (size_t)L * 3 * 12288, 2 * DM, kargs()->in[8] + L * DM, MOD_ + (size_t)L * 3 * 12288, 3 * DM, 4 * DM, UA_, Mrows, gw, NGW, lane); }
        GSYNC();
        { pg8::Gemm g{UA_, (const bf16*)(WSB + WS_WGU + (size_t)L * 44 * MiB), Mrows, N_GU, DM, DM};
          pg8::StaticOrder S; S.init(g.M, g.N, G, (int)blockIdx.x); pg8::EpiSwiglu E{ACT_, DFF};
          pg8::gemm_phase<pg8::EpiSwiglu, pg8::StaticOrder, true, true>(ldsl, g, S, E); }
        GSYNC();
        { pg8::Gemm g{ACT_, (const bf16*)(WSB + WS_WD + (size_t)L * 22 * MiB), Mrows, DM, DFF, DFF};
          pg8::StaticOrder S; S.init(g.M, g.N, G, (int)blockIdx.x); pg8::EpiF32 E{F_, DM};
          pg8::gemm_phase<pg8::EpiF32, pg8::StaticOrder, true, true>(ldsl, g, S, E); }
        GSYNC();
        { PHASE_IDS(); pass_post(F_, out_, hctx_, out_, hctx_, kargs()->in[9] + L * DM, MOD_ + (size_t)L * 3 * 12288, 5 * DM, kargs()->in[6] + DM, MOD_ + (size_t)3 * 12288, 0, DM, L == 0 ? UB_ : nullptr, Mrows, gw, NGW, lane); }
        if (L == 0) GSYNC();
    }
#undef GSYNC
}

constexpr int LDS_BYTES = 131072 + 1024;
extern "C" void kernel_launch(void* const* d_in, const int* in_sizes, int n_in, void* d_out, int out_size, void* d_ws, size_t ws_size, hipStream_t stream) {
    static int grid = 0;
    if (grid == 0) {
        if (n_in != 29 || out_size != MLAT * DM || ws_size < WS_END) { fprintf(stderr, "kernel_launch: unexpected shapes: n_in %d out %d ws %zu (need %zu)\n", n_in, out_size, ws_size, (size_t)WS_END); grid = -1; return; }
        int dev = 0, cus = 0, per_cu = 0;
        hipGetDevice(&dev); hipDeviceGetAttribute(&cus, hipDeviceAttributeMultiprocessorCount, dev);
        if (hipFuncSetAttribute((const void*)fwd_megakernel, hipFuncAttributeMaxDynamicSharedMemorySize, LDS_BYTES) != hipSuccess) { fprintf(stderr, "kernel_launch: hipFuncSetAttribute failed\n"); grid = -1; return; }
        if (hipOccupancyMaxActiveBlocksPerMultiprocessor(&per_cu, (const void*)fwd_megakernel, NTHR, LDS_BYTES) != hipSuccess || per_cu < 1) { fprintf(stderr, "kernel_launch: occupancy query says %d\n", per_cu); per_cu = 1; }
        (void)hipGetLastError();
        grid = cus;
        fprintf(stderr, "kernel_launch: grid %d (per_cu %d)\n", grid, per_cu);
    }
    if (grid < 0) return;
    KArgs a{};
    for (int i = 0; i < 29; ++i) a.in[i] = (const float*)d_in[i];
    a.out = (float*)d_out; a.ws = (unsigned char*)d_ws;
    void* params[] = {&a};
    const hipError_t e = hipLaunchCooperativeKernel((const void*)fwd_megakernel, dim3(grid), dim3(NTHR), params, LDS_BYTES, stream);
    if (e != hipSuccess) fprintf(stderr, "kernel_launch: cooperative launch failed: %s (grid %d)\n", hipGetErrorString(e), grid);
}
```

```cpp
#include <hip/hip_runtime.h>
#include <hip/hip_cooperative_groups.h>
#include <cstdio>
#include <cstdint>
namespace cg = cooperative_groups;
__device__ __forceinline__ int fresh_tid() { int t = threadIdx.x; asm volatile("" : "+v"(t)); return t; }
namespace pg8 {
#define PG8_LAS __attribute__((address_space(3)))
typedef unsigned short bf16_t;
typedef short bf16x8 __attribute__((ext_vector_type(8)));
typedef float f32x4 __attribute__((ext_vector_type(4)));
typedef unsigned u32x4 __attribute__((ext_vector_type(4)));
constexpr int BM = 256, BK = 64, HALF = 128, HTB = HALF * BK * 2  , STAGE_BYTES = 8 * HTB, NXCD = 8, WGM = 8;

__host__ __device__ __forceinline__ int lds_byte(int r, int c) { const int st = (r >> 4) * 2 + (c >> 5), rr = r & 15, cc = c & 31, ob = rr * 64 + cc * 2; return st * 1024 + (ob ^ (((ob >> 9) & 1) << 5)); }
__host__ __device__ __forceinline__ void stage_rc(int b, int& R, int& C) { const int st = b / 1024, sb = b % 1024, swz = sb ^ (((sb >> 9) & 1) << 5); R = (st >> 1) * 16 + swz / 64; C = (st & 1) * 32 + (swz % 64) / 2; }
__host__ __device__ __forceinline__ int perm32(int rho) { const int n = rho >> 4, i = rho & 15; return 8 * (i >> 2) + 4 * n + (i & 3); }

struct Unit { int pm, pn; };
struct Gemm { const bf16_t* A; const bf16_t* Bt; int M, N, K, lda; };

struct StaticOrder {
    int nM, nN, nwg, G, c;
    __host__ __device__ void init(int M, int N, int G_, int c_) { nM = M / BM; nN = N / BM; nwg = nM * nN; G = G_; c = c_; }
    __host__ __device__ bool next(int i, Unit& u) const {
        const long L = (long)i * G + c; if (L >= nwg) return false;
        int wgid = (int)L; { const int q = nwg / NXCD, r = nwg % NXCD, xcd = wgid % NXCD, off = wgid / NXCD; wgid = (xcd < r ? xcd * (q + 1) : r * (q + 1) + (xcd - r) * q) + off; }
        const int nig = WGM * nN, gid = wgid / nig, fm = gid * WGM, gsz = (nM - fm) < WGM ? (nM - fm) : WGM;
        u.pm = fm + ((wgid % nig) % gsz); u.pn = (wgid % nig) / gsz; return true;
    }
    __device__ __forceinline__ void a_ready(const Unit&) const {}
    __device__ __forceinline__ void done(const Unit&) const {}
};


__device__ __forceinline__ unsigned cvt_pk_bf16(float lo, float hi) { unsigned r; asm volatile("v_cvt_pk_bf16_f32 %0, %1, %2" : "=v"(r) : "v"(lo), "v"(hi)); return r; }
struct EpiBf16 {
    static constexpr bool PERM = true, AFTER_DRAIN = false;
    bf16_t* O; int ldc;
    __device__ __forceinline__ void operator()(const f32x4 (&acc)[2][2][4][2], const Unit& u, int wr, int wc, int fr, int fq) const {
        const int row0 = u.pm * BM + wr * 64 + fr, col0 = u.pn * BM + wc * 32 + 8 * fq;
#pragma unroll
        for (int ai = 0; ai < 2; ++ai)
#pragma unroll
            for (int m = 0; m < 4; ++m) { bf16_t* rowp = O + (size_t)(row0 + ai * HALF + m * 16) * ldc + col0;
#pragma unroll
                for (int bj = 0; bj < 2; ++bj) { const f32x4 v0 = acc[ai][bj][m][0], v1 = acc[ai][bj][m][1];
                    u32x4 w; w.x = cvt_pk_bf16(v0[0], v0[1]); w.y = cvt_pk_bf16(v0[2], v0[3]); w.z = cvt_pk_bf16(v1[0], v1[1]); w.w = cvt_pk_bf16(v1[2], v1[3]);
                    *(u32x4*)(rowp + bj * HALF) = w; } }
    }
};
struct EpiF32 {
    static constexpr bool PERM = false, AFTER_DRAIN = false;
    float* O; int ldc;
    __device__ __forceinline__ void operator()(const f32x4 (&acc)[2][2][4][2], const Unit& u, int wr, int wc, int fr, int fq) const {
        const int row0 = u.pm * BM + wr * 64 + fr, col0 = u.pn * BM + wc * 32 + 4 * fq;
#pragma unroll
        for (int ai = 0; ai < 2; ++ai)
#pragma unroll
            for (int m = 0; m < 4; ++m) { float* rowp = O + (size_t)(row0 + ai * HALF + m * 16) * ldc + col0;
#pragma unroll
                for (int bj = 0; bj < 2; ++bj)
#pragma unroll
                    for (int n = 0; n < 2; ++n) *(f32x4*)(rowp + bj * HALF + n * 16) = acc[ai][bj][m][n]; }
    }
};
__device__ __forceinline__ float silu_mul(float g, float u) { return g * __builtin_amdgcn_rcpf(1.0f + __builtin_amdgcn_exp2f(-1.4426950408889634f * g)) * u; }
struct EpiSwiglu {
    static constexpr bool PERM = true, AFTER_DRAIN = false;
    bf16_t* O; int ldc;
    __device__ __forceinline__ void operator()(const f32x4 (&acc)[2][2][4][2], const Unit& u, int wr, int wc, int fr, int fq) const {
        const int row0 = u.pm * BM + wr * 64 + fr, col0 = u.pn * HALF + wc * 32 + 8 * fq;
#pragma unroll
        for (int ai = 0; ai < 2; ++ai)
#pragma unroll
            for (int m = 0; m < 4; ++m) { bf16_t* rowp = O + (size_t)(row0 + ai * HALF + m * 16) * ldc + col0;
                const f32x4 g0 = acc[ai][0][m][0], g1 = acc[ai][0][m][1], u0 = acc[ai][1][m][0], u1 = acc[ai][1][m][1];
                u32x4 w; w.x = cvt_pk_bf16(silu_mul(g0[0], u0[0]), silu_mul(g0[1], u0[1])); w.y = cvt_pk_bf16(silu_mul(g0[2], u0[2]), silu_mul(g0[3], u0[3]));
                w.z = cvt_pk_bf16(silu_mul(g1[0], u1[0]), silu_mul(g1[1], u1[1])); w.w = cvt_pk_bf16(silu_mul(g1[2], u1[2]), silu_mul(g1[3], u1[3]));
                *(u32x4*)rowp = w; }
    }
};

template <class Epi, class Sched, bool ALIGN_EPI = false, bool SP2 = false>
__device__ __forceinline__ void gemm_phase(PG8_LAS unsigned char* lds, const Gemm g, const Sched& S, const Epi& E) {
    const int tid = fresh_tid(), wid = __builtin_amdgcn_readfirstlane(tid >> 6), lane = tid & 63, wr = wid >> 2, wc = wid & 3, fr = lane & 15, fq = lane >> 4;
    const int K = g.K, nt = K / BK;
    unsigned voffA[2], voffB[2];
#pragma unroll
    for (int i = 0; i < 2; ++i) { int R, C; stage_rc(tid * 16 + i * 8192, R, C); const int Rb = Epi::PERM ? ((R & ~31) + perm32(R & 31)) : R;
        voffA[i] = (unsigned)(R * g.lda + C) * 2u; voffB[i] = (unsigned)(Rb * K + C) * 2u; }
    const size_t kstep = (size_t)(BK * 2);
    const size_t hstepA = (size_t)HALF * g.lda * 2, hstepB = (size_t)HALF * K * 2;
    const size_t tstepA = 2 * hstepA, tstepB = 2 * hstepB;
    const unsigned ldsw = (unsigned)wid * 1024u;
    const int aoff = lds_byte(wr * 64 + fr, fq * 8), boff = lds_byte(wc * 32 + fr, fq * 8);
#define PG8_SA(b, h) (((b) * 2 + (h)) * HTB)
#define PG8_SB(b, h) ((4 + (b) * 2 + (h)) * HTB)
#define PG8_STAGE(bufoff, gbase, voff) do { _Pragma("unroll") for (int _i = 0; _i < 2; ++_i) \
        __builtin_amdgcn_global_load_lds((const unsigned*)((const char*)(gbase) + (voff)[_i]), (PG8_LAS unsigned*)(lds + (bufoff) + ldsw + _i * 8192), 16, 0, 0); } while (0)
#define PG8_LDA(dst, b, h) do { _Pragma("unroll") for (int m = 0; m < 4; ++m) _Pragma("unroll") for (int k = 0; k < 2; ++k) dst[m][k] = *(const PG8_LAS bf16x8*)(lds + PG8_SA(b, h) + aoff + m * 2048 + k * 1024); } while (0)
#define PG8_LDB(dst, b, h) do { _Pragma("unroll") for (int n = 0; n < 2; ++n) _Pragma("unroll") for (int k = 0; k < 2; ++k) dst[n][k] = *(const PG8_LAS bf16x8*)(lds + PG8_SB(b, h) + boff + n * 2048 + k * 1024); } while (0)
#define PG8_MMA(ai, bj, At, Bt) do { __builtin_amdgcn_s_setprio(1); _Pragma("unroll") for (int m = 0; m < 4; ++m) _Pragma("unroll") for (int n = 0; n < 2; ++n) _Pragma("unroll") for (int k = 0; k < 2; ++k) \
        acc[ai][bj][m][n] = __builtin_amdgcn_mfma_f32_16x16x32_bf16(Bt[n][k], At[m][k], acc[ai][bj][m][n], 0, 0, 0); __builtin_amdgcn_s_setprio(0); } while (0)
#define PG8_WAIT_V(n) asm volatile("s_waitcnt vmcnt(" #n ")" ::: "memory")
#define PG8_WAIT_L(n) asm volatile("s_waitcnt lgkmcnt(" #n ")" ::: "memory")
#define PG8_BAR __builtin_amdgcn_s_barrier()
#define PG8_SCHED __builtin_amdgcn_sched_barrier(0)
    Unit cur, nxt; int ui = 0;
    if (!S.next(0, cur)) return;
    f32x4 acc[2][2][4][2];
#pragma unroll
    for (int a = 0; a < 2; ++a)
#pragma unroll
        for (int b = 0; b < 2; ++b)
#pragma unroll
            for (int m = 0; m < 4; ++m)
#pragma unroll
                for (int n = 0; n < 2; ++n) acc[a][b][m][n] = (f32x4){0.f, 0.f, 0.f, 0.f};
    bf16x8 At[4][2], B0[2][2], B1[2][2];
    const char* cA = (const char*)g.A + (size_t)cur.pm * tstepA; const char* cB = (const char*)g.Bt + (size_t)cur.pn * tstepB;
    S.a_ready(cur);
    if constexpr (SP2) {
        PG8_STAGE(PG8_SB(0, 0), cB, voffB); PG8_STAGE(PG8_SB(0, 1), cB + hstepB, voffB); PG8_STAGE(PG8_SA(0, 0), cA, voffA); PG8_STAGE(PG8_SA(0, 1), cA + hstepA, voffA);
        if (wr == 1) PG8_BAR;
        PG8_WAIT_V(2); PG8_BAR;
        PG8_STAGE(PG8_SB(1, 0), cB + kstep, voffB); PG8_STAGE(PG8_SA(1, 0), cA + kstep, voffA); PG8_STAGE(PG8_SB(1, 1), cB + hstepB + kstep, voffB);
        PG8_WAIT_V(6); PG8_BAR;
    } else {
        PG8_STAGE(PG8_SB(0, 0), cB, voffB); PG8_STAGE(PG8_SA(0, 0), cA, voffA); PG8_STAGE(PG8_SB(0, 1), cB + hstepB, voffB); PG8_STAGE(PG8_SA(0, 1), cA + hstepA, voffA);
        if (wr == 1) PG8_BAR;
        PG8_WAIT_V(4); PG8_BAR;
        PG8_STAGE(PG8_SB(1, 0), cB + kstep, voffB); PG8_STAGE(PG8_SA(1, 0), cA + kstep, voffA); PG8_STAGE(PG8_SB(1, 1), cB + hstepB + kstep, voffB);
        PG8_WAIT_V(6); PG8_BAR;
    }
    for (;;) {
        const bool has_next = S.next(ui + 1, nxt);
        const char* nA = has_next ? (const char*)g.A + (size_t)nxt.pm * tstepA : cA; const char* nB = has_next ? (const char*)g.Bt + (size_t)nxt.pn * tstepB : cB;
        for (int t = 0; t < nt; t += 2) {
            const bool last = (t == nt - 2);
            const char* a1 = cA + (size_t)(t + 1) * kstep;
            const char* a2 = last ? nA : cA + (size_t)(t + 2) * kstep; const char* b2 = last ? nB : cB + (size_t)(t + 2) * kstep;
            const char* a3 = a2 + kstep; const char* b3 = b2 + kstep;
            if (last && has_next) S.a_ready(nxt);
            if constexpr (SP2) {
            PG8_LDB(B0, 0, 0); PG8_LDB(B1, 0, 1); PG8_SCHED; PG8_LDA(At, 0, 0); PG8_STAGE(PG8_SA(1, 1), a1 + hstepA, voffA);
            PG8_WAIT_V(8); PG8_WAIT_L(0); PG8_BAR; PG8_MMA(0, 0, At, B0); PG8_MMA(0, 1, At, B1); PG8_BAR; PG8_SCHED;
            PG8_LDA(At, 0, 1); PG8_STAGE(PG8_SB(0, 0), b2, voffB); PG8_STAGE(PG8_SB(0, 1), b2 + hstepB, voffB); PG8_STAGE(PG8_SA(0, 0), a2, voffA);
            PG8_WAIT_V(8); PG8_WAIT_L(0); PG8_BAR; PG8_MMA(1, 0, At, B0); PG8_MMA(1, 1, At, B1); PG8_BAR; PG8_SCHED;
            PG8_LDB(B0, 1, 0); PG8_LDB(B1, 1, 1); PG8_SCHED; PG8_LDA(At, 1, 0); PG8_STAGE(PG8_SA(0, 1), a2 + hstepA, voffA);
            PG8_WAIT_V(8); PG8_WAIT_L(0); PG8_BAR; PG8_MMA(0, 0, At, B0); PG8_MMA(0, 1, At, B1); PG8_BAR; PG8_SCHED;
            PG8_LDA(At, 1, 1); PG8_STAGE(PG8_SB(1, 0), b3, voffB); PG8_STAGE(PG8_SB(1, 1), b3 + hstepB, voffB); PG8_STAGE(PG8_SA(1, 0), a3, voffA);
            PG8_WAIT_V(8); PG8_WAIT_L(0); PG8_BAR; PG8_MMA(1, 0, At, B0); PG8_MMA(1, 1, At, B1); PG8_BAR; PG8_SCHED;
            } else {
            PG8_LDB(B0, 0, 0); PG8_SCHED; PG8_LDA(At, 0, 0); PG8_STAGE(PG8_SA(1, 1), a1 + hstepA, voffA);
            PG8_WAIT_L(8); PG8_BAR; PG8_WAIT_L(0); PG8_MMA(0, 0, At, B0); PG8_BAR; PG8_SCHED;
            PG8_LDB(B1, 0, 1); PG8_STAGE(PG8_SB(0, 0), b2, voffB);
            PG8_BAR; PG8_WAIT_L(0); PG8_MMA(0, 1, At, B1); PG8_BAR;
            PG8_LDA(At, 0, 1); PG8_STAGE(PG8_SA(0, 0), a2, voffA);
            PG8_BAR; PG8_WAIT_L(0); PG8_MMA(1, 0, At, B0); PG8_BAR; PG8_SCHED;
            PG8_STAGE(PG8_SB(0, 1), b2 + hstepB, voffB);
            PG8_WAIT_V(6); PG8_BAR; PG8_MMA(1, 1, At, B1); PG8_BAR;
            PG8_LDB(B0, 1, 0); PG8_SCHED; PG8_LDA(At, 1, 0); PG8_STAGE(PG8_SA(0, 1), a2 + hstepA, voffA);
            PG8_WAIT_L(8); PG8_BAR; PG8_WAIT_L(0); PG8_MMA(0, 0, At, B0); PG8_BAR; PG8_SCHED;
            PG8_LDB(B1, 1, 1); PG8_STAGE(PG8_SB(1, 0), b3, voffB);
            PG8_BAR; PG8_WAIT_L(0); PG8_MMA(0, 1, At, B1); PG8_BAR;
            PG8_LDA(At, 1, 1); PG8_STAGE(PG8_SA(1, 0), a3, voffA);
            PG8_BAR; PG8_WAIT_L(0); PG8_MMA(1, 0, At, B0); PG8_BAR; PG8_SCHED;
            PG8_STAGE(PG8_SB(1, 1), b3 + hstepB, voffB);
            PG8_WAIT_V(6); PG8_BAR; PG8_MMA(1, 1, At, B1); PG8_BAR;
            }
        }
        if constexpr (ALIGN_EPI) { if (wr == 0) PG8_BAR; }
        if constexpr (!Epi::AFTER_DRAIN) { E(acc, cur, wr, wc, fr, fq); S.done(cur); }
        if (!has_next) break;
#pragma unroll
        for (int a = 0; a < 2; ++a)
#pragma unroll
            for (int b = 0; b < 2; ++b)
#pragma unroll
                for (int m = 0; m < 4; ++m)
#pragma unroll
                    for (int n = 0; n < 2; ++n) acc[a][b][m][n] = (f32x4){0.f, 0.f, 0.f, 0.f};
        cur = nxt; cA = nA; cB = nB; ++ui;
        if constexpr (ALIGN_EPI) { if (wr == 1) PG8_BAR; }
    }
    PG8_WAIT_V(0);
    if constexpr (!ALIGN_EPI) { if (wr == 0) PG8_BAR; }
    PG8_BAR;
    if constexpr (Epi::AFTER_DRAIN) { E.fused(acc, cur, wr, wc, fr, fq, lds, wid, lane); S.done(cur); }
#undef PG8_SA
#undef PG8_SB
#undef PG8_STAGE
#undef PG8_LDA
#undef PG8_LDB
#undef PG8_MMA
#undef PG8_WAIT_V
#undef PG8_WAIT_L
#undef PG8_BAR
#undef PG8_SCHED
}
}
namespace att {
typedef unsigned short bf16;
typedef short bf16x8 __attribute__((ext_vector_type(8)));
typedef short s16x4 __attribute__((ext_vector_type(4)));
typedef float f32x16 __attribute__((ext_vector_type(16)));
typedef unsigned u32x4 __attribute__((ext_vector_type(4)));
constexpr int NW = 8, QBLK = 32, KVBLK = 64;
constexpr int SHM_V = KVBLK * 128 * 2;
#define SBAR() __builtin_amdgcn_sched_barrier(0)
__device__ __forceinline__ int crow(int r, int hi) { return (r & 3) + 8 * (r >> 2) + 4 * hi; }
__device__ __forceinline__ unsigned cvtpk(float lo, float hi) { unsigned r; asm volatile("v_cvt_pk_bf16_f32 %0, %1, %2" : "=v"(r) : "v"(lo), "v"(hi)); return r; }

struct Args {
  const bf16* Q; const bf16* K; const bf16* K2; const bf16* V; bf16* O;
  int ldq, ldk, ldk2, ldv, ldo;
  int NT, nctx, ctx_row0, lat_row0;
  float C, thr_raw;
  int qpos0, kpos0;
  float sink_l2;
  int r0, klo;
  const float* rpb; float inv_scale;
};

__device__ __forceinline__ void partialSM(f32x16& p0, f32x16& p1, float& m_reg, float& mn, float& alpha, const float C, const float thr_raw) {
  float pmax = p0[0];
#pragma unroll
  for (int r = 1; r < 16; ++r) pmax = fmaxf(pmax, p0[r]);
#pragma unroll
  for (int r = 0; r < 16; ++r) pmax = fmaxf(pmax, p1[r]);
  { auto rr = __builtin_amdgcn_permlane32_swap(__float_as_uint(pmax), __float_as_uint(pmax), false, false);
    pmax = fmaxf(__uint_as_float(rr[0]), __uint_as_float(rr[1])); }
  if (__builtin_expect(__all(pmax - m_reg <= thr_raw), 1)) { mn = m_reg; alpha = 1.f; }
  else { mn = fmaxf(m_reg, pmax); alpha = __builtin_amdgcn_exp2f((m_reg - mn) * C); m_reg = mn; }
  const float mnC = -mn * C;
#pragma unroll
  for (int r = 0; r < 16; ++r) p0[r] = fmaf(p0[r], C, mnC);
#pragma unroll
  for (int r = 0; r < 16; ++r) p1[r] = fmaf(p1[r], C, mnC);
#pragma unroll
  for (int r = 0; r < 16; ++r) p0[r] = __builtin_amdgcn_exp2f(p0[r]);
}
__device__ __forceinline__ void finishSM(f32x16& p0, f32x16& p1, float alpha, float& l_reg, bf16x8& pa0, bf16x8& pa1, bf16x8& pa2, bf16x8& pa3) {
#pragma unroll
  for (int r = 0; r < 16; ++r) p1[r] = __builtin_amdgcn_exp2f(p1[r]);
  float ps = 0;
#pragma unroll
  for (int r = 0; r < 16; ++r) ps += p0[r];
#pragma unroll
  for (int r = 0; r < 16; ++r) ps += p1[r];
  { auto rr = __builtin_amdgcn_permlane32_swap(__float_as_uint(ps), __float_as_uint(ps), false, false);
    ps = __uint_as_float(rr[0]) + __uint_as_float(rr[1]); }
  l_reg = l_reg * alpha + ps;
#define PK4(P, BASE, OUT) do { unsigned a0 = cvtpk(P[BASE + 0], P[BASE + 1]), a1 = cvtpk(P[BASE + 2], P[BASE + 3]);   \
    unsigned b0 = cvtpk(P[BASE + 4], P[BASE + 5]), b1 = cvtpk(P[BASE + 6], P[BASE + 7]);                              \
    auto r0 = __builtin_amdgcn_permlane32_swap(a0, b0, false, false); auto r1 = __builtin_amdgcn_permlane32_swap(a1, b1, false, false); \
    u32x4 w = {r0[0], r1[0], r0[1], r1[1]}; OUT = *reinterpret_cast<bf16x8*>(&w); } while (0)
  PK4(p0, 0, pa0); PK4(p0, 8, pa1); PK4(p1, 0, pa2); PK4(p1, 8, pa3);
#undef PK4
}
template <int DQ> __device__ __forceinline__ int kswz(int row, int colB) { return row * (DQ * 2) + (colB ^ ((row & 7) << 4)); }
template <int DQ> __device__ __forceinline__ void qkt(f32x16& p0, f32x16& p1, const char* Ks, const bf16x8* qr, int r32, int hi) {
  p0 = f32x16{}; p1 = f32x16{};
#pragma unroll
  for (int d0 = 0; d0 < DQ / 16; ++d0) { const int cb = (d0 * 16 + hi * 8) * 2;
    const bf16x8 b0 = *reinterpret_cast<const bf16x8*>(Ks + kswz<DQ>(r32, cb));
    const bf16x8 b1 = *reinterpret_cast<const bf16x8*>(Ks + kswz<DQ>(32 + r32, cb));
    p0 = __builtin_amdgcn_mfma_f32_32x32x16_bf16(b0, qr[d0], p0, 0, 0, 0);
    p1 = __builtin_amdgcn_mfma_f32_32x32x16_bf16(b1, qr[d0], p1, 0, 0, 0); }
}
__device__ __forceinline__ int v_st(int k, int c) { const int kk = (k & ~0xC) | ((k & 4) << 1) | ((k & 8) >> 1); return ((kk >> 3) * 4 + (c >> 5)) * 512 + ((kk & 7) * 32 + (c & 31)) * 2; }
__device__ __forceinline__ int v_rd_base(int lane) { return ((lane & 3) << 3) | (((lane >> 2) & 3) << 6) | (((lane >> 4) & 1) << 5) | (((lane >> 5) & 1) << 8); }
constexpr int v_rd_off(int d0, int ks, int half) { return d0 * 512 + ks * 4096 + half * 2048; }
template <int OFF> __device__ __forceinline__ s16x4 tr_read(int vb) {
  s16x4 r; asm volatile("ds_read_b64_tr_b16 %0, %1 offset:%2" : "=&v"(r) : "v"(vb), "i"(OFF) : "memory"); return r;
}
template <int D0> __device__ __forceinline__ void pv_one(f32x16& od, int vb, bf16x8 pa0, bf16x8 pa1, bf16x8 pa2, bf16x8 pa3) {
  const s16x4 l0 = tr_read<v_rd_off(D0, 0, 0)>(vb), h0 = tr_read<v_rd_off(D0, 0, 1)>(vb), l1 = tr_read<v_rd_off(D0, 1, 0)>(vb), h1 = tr_read<v_rd_off(D0, 1, 1)>(vb);
  const s16x4 l2 = tr_read<v_rd_off(D0, 2, 0)>(vb), h2 = tr_read<v_rd_off(D0, 2, 1)>(vb), l3 = tr_read<v_rd_off(D0, 3, 0)>(vb), h3 = tr_read<v_rd_off(D0, 3, 1)>(vb);
  asm volatile("s_waitcnt lgkmcnt(0)" ::: "memory"); SBAR();
#define PK(L, H) (bf16x8){L[0], L[1], L[2], L[3], H[0], H[1], H[2], H[3]}
  od = __builtin_amdgcn_mfma_f32_32x32x16_bf16(pa0, PK(l0, h0), od, 0, 0, 0);
  od = __builtin_amdgcn_mfma_f32_32x32x16_bf16(pa1, PK(l1, h1), od, 0, 0, 0);
  od = __builtin_amdgcn_mfma_f32_32x32x16_bf16(pa2, PK(l2, h2), od, 0, 0, 0);
  od = __builtin_amdgcn_mfma_f32_32x32x16_bf16(pa3, PK(l3, h3), od, 0, 0, 0);
#undef PK
}
__device__ __forceinline__ void pv_d0(f32x16* o, int vb, bf16x8 pa0, bf16x8 pa1, bf16x8 pa2, bf16x8 pa3) {
  pv_one<0>(o[0], vb, pa0, pa1, pa2, pa3); pv_one<1>(o[1], vb, pa0, pa1, pa2, pa3); pv_one<2>(o[2], vb, pa0, pa1, pa2, pa3); pv_one<3>(o[3], vb, pa0, pa1, pa2, pa3);
}
template <int MODE> __device__ __forceinline__ void maskf(f32x16& p0, f32x16& p1, int t, const Args& a, int wid, int r32, int hi, const float* bias_lds) {
  if constexpr (MODE == 0) { return; }
  else {
    if (t < a.nctx) return;
    if constexpr (MODE == 1) {
      const int kb = a.kpos0 + (t - a.nctx) * 64, qw = a.qpos0 + wid * 32;
      if (kb + 63 - qw <= 128 && qw + 31 - kb <= 128) return;
      const int q = qw + r32;
#pragma unroll
      for (int r = 0; r < 16; ++r) { const int d0 = kb + crow(r, hi) - q, d1 = d0 + 32;
        if (d0 > 128 || d0 < -128) p0[r] = -1e30f;
        if (d1 > 128 || d1 < -128) p1[r] = -1e30f; }
    } else {
      const int kr = a.klo + (t - a.nctx), rq = a.r0 + (wid >> 1);
      const int rs = min(max(rq - 4, 0), 120);
      if (kr < rs || kr >= rs + 8) {
#pragma unroll
        for (int r = 0; r < 16; ++r) { p0[r] = -1e30f; p1[r] = -1e30f; }
        return; }
      const int c = (wid & 1) * 32 + r32, cs = min(max(c - 8, 0), 48);
      int cb = 4 * hi - c + 63, vb = 4 * hi - cs;
      asm volatile("" : "+v"(cb), "+v"(vb));
      const float* bp = bias_lds + (kr - rq + 7) * 128 + cb;
#pragma unroll
      for (int r = 0; r < 16; ++r) { const int k0 = (r & 3) + 8 * (r >> 2), k1 = k0 + 32;
        const float b0 = bp[k0], b1 = bp[k1];
        p0[r] = ((unsigned)(k0 + vb) < 16u) ? fmaf(b0, a.inv_scale, p0[r]) : -1e30f;
        p1[r] = ((unsigned)(k1 + vb) < 16u) ? fmaf(b1, a.inv_scale, p1[r]) : -1e30f;
        if ((r & 3) == 3) SBAR(); }
    }
  }
}

template <int DQ, int MODE>
__device__ __forceinline__ void attn_unit(const Args& a, char* lds) {
  constexpr int SHM_K = KVBLK * DQ * 2, NQ = DQ / 16, SDEPTH = (DQ == 192 || MODE == 2) ? 1 : 2;
  const int tid = fresh_tid(), wid = tid >> 6, lane = tid & 63, r32 = lane & 31, hi = lane >> 5;
  char* V_lds = lds; char* K_lds = lds + 2 * SHM_V;
  float* ws = (float*)(lds + 2 * SHM_V + 2 * SHM_K) + wid * 64; float* li_l = ws; float* al_l = ws + 32;
  float* bias_l = (float*)(lds + 2 * SHM_V + 2 * SHM_K + 2048);
  if constexpr (MODE == 2) { if (tid < 465) bias_l[(tid / 31) * 128 + 48 + (tid % 31)] = a.rpb[tid]; }
  float m_reg = -1e30f, l_reg = 0; f32x16 o[4] = {}; bf16x8 qr[NQ];
  const float C = a.C, thr_raw = a.thr_raw;
  const bf16* Qw = a.Q + (long)(wid * QBLK + r32) * a.ldq + hi * 8;
#pragma unroll
  for (int d0 = 0; d0 < NQ; ++d0) qr[d0] = *reinterpret_cast<const bf16x8*>(Qw + d0 * 16);
  const int sr = tid >> 4, sc = (tid & 15) * 8, vst0 = v_st(sr, sc), vst1 = v_st(32 + sr, sc);
  const int sr2 = tid >> 3, sc2 = (tid & 7) * 8;
  const int vb0 = (int)(uintptr_t)V_lds + v_rd_base(lane);
  struct { bf16x8 vs0, vs1, ks0, ks1, ks2; } sr_[SDEPTH];
  const int vo0 = sr * a.ldv + sc, vo1 = (32 + sr) * a.ldv + sc, ko0 = sr * a.ldk + sc, ko1 = (32 + sr) * a.ldk + sc, ko2 = sr2 * a.ldk2 + sc2;
#define KROW(t) ((t) < a.nctx ? a.ctx_row0 + 64 * (t) : a.lat_row0 + 64 * ((t) - a.nctx))
#define SLOAD(i, t) do { const long kr_ = KROW(t); const bf16* vp_ = a.V + kr_ * a.ldv; const bf16* kp_ = a.K + kr_ * a.ldk; \
    sr_[i].vs0 = *reinterpret_cast<const bf16x8*>(vp_ + vo0); sr_[i].vs1 = *reinterpret_cast<const bf16x8*>(vp_ + vo1); \
    sr_[i].ks0 = *reinterpret_cast<const bf16x8*>(kp_ + ko0); sr_[i].ks1 = *reinterpret_cast<const bf16x8*>(kp_ + ko1); \
    if constexpr (DQ == 192) sr_[i].ks2 = *reinterpret_cast<const bf16x8*>(a.K2 + kr_ * a.ldk2 + ko2); } while (0)
#define SWRITE(b, i) do { *(bf16x8*)(V_lds + (b) * SHM_V + vst0) = sr_[i].vs0; *(bf16x8*)(V_lds + (b) * SHM_V + vst1) = sr_[i].vs1; \
    *(bf16x8*)(K_lds + (b) * SHM_K + kswz<DQ>(sr, sc * 2)) = sr_[i].ks0; *(bf16x8*)(K_lds + (b) * SHM_K + kswz<DQ>(32 + sr, sc * 2)) = sr_[i].ks1; \
    if constexpr (DQ == 192) *(bf16x8*)(K_lds + (b) * SHM_K + kswz<DQ>(sr2, 256 + sc2 * 2)) = sr_[i].ks2; } while (0)
#define SWAIT() do { if constexpr (SDEPTH == 1) asm volatile("s_waitcnt vmcnt(0)" ::: "memory"); else asm volatile("s_waitcnt vmcnt(4)" ::: "memory"); } while (0)
#define RESC(al) do { if (__any((al) < 1.f)) { if (hi == 0) al_l[r32] = (al); asm volatile("s_waitcnt lgkmcnt(0)" ::: "memory"); \
    _Pragma("unroll") for (int d = 0; d < 4; ++d) _Pragma("unroll") for (int r = 0; r < 16; ++r) o[d][r] *= al_l[crow(r, hi)]; } } while (0)
  f32x16 pA0, pA1, pB0, pB1; float mnA, mnB, alA, alB; bf16x8 pa0, pa1, pa2, pa3; const int NT = a.NT;
  constexpr int SE = 0, SO = SDEPTH - 1;
  SLOAD(SE, 0); asm volatile("s_waitcnt vmcnt(0)" ::: "memory"); SWRITE(0, SE); __syncthreads();
  qkt<DQ>(pA0, pA1, K_lds, qr, r32, hi); maskf<MODE>(pA0, pA1, 0, a, wid, r32, hi, bias_l); partialSM(pA0, pA1, m_reg, mnA, alA, C, thr_raw);
  SLOAD(SO, 1); if constexpr (SDEPTH == 2) { if (2 < NT) SLOAD(SE, 2); }
  SWAIT(); SWRITE(1, SO); __syncthreads();
  for (int j = 1; j + 1 < NT; j += 2) {
    SBAR(); qkt<DQ>(pB0, pB1, K_lds + SHM_K, qr, r32, hi); maskf<MODE>(pB0, pB1, j, a, wid, r32, hi, bias_l);
    finishSM(pA0, pA1, alA, l_reg, pa0, pa1, pa2, pa3); SBAR();
    SLOAD(SO, j + SDEPTH); SBAR();
    pv_d0(o, vb0, pa0, pa1, pa2, pa3); partialSM(pB0, pB1, m_reg, mnB, alB, C, thr_raw);
    __syncthreads(); SWAIT(); SWRITE(0, SE);
    RESC(alB); __syncthreads();
    SBAR(); qkt<DQ>(pA0, pA1, K_lds, qr, r32, hi); maskf<MODE>(pA0, pA1, j + 1, a, wid, r32, hi, bias_l);
    finishSM(pB0, pB1, alB, l_reg, pa0, pa1, pa2, pa3); SBAR();
    if (SDEPTH == 1 || j + 3 < NT) SLOAD(SE, j + 1 + SDEPTH); SBAR();
    pv_d0(o, vb0 + SHM_V, pa0, pa1, pa2, pa3); partialSM(pA0, pA1, m_reg, mnA, alA, C, thr_raw);
    __syncthreads(); SWAIT(); SWRITE(1, SO);
    RESC(alA); __syncthreads();
  }
  SBAR(); qkt<DQ>(pB0, pB1, K_lds + SHM_K, qr, r32, hi); maskf<MODE>(pB0, pB1, NT - 1, a, wid, r32, hi, bias_l);
  finishSM(pA0, pA1, alA, l_reg, pa0, pa1, pa2, pa3); SBAR();
  pv_d0(o, vb0, pa0, pa1, pa2, pa3); partialSM(pB0, pB1, m_reg, mnB, alB, C, thr_raw);
  __syncthreads(); RESC(alB);
  finishSM(pB0, pB1, alB, l_reg, pa0, pa1, pa2, pa3); SBAR();
  pv_d0(o, vb0 + SHM_V, pa0, pa1, pa2, pa3);
  if constexpr (MODE == 1) l_reg += __builtin_amdgcn_exp2f(a.sink_l2 - m_reg * C);
  if (hi == 0) li_l[r32] = l_reg; asm volatile("s_waitcnt lgkmcnt(0)" ::: "memory");
  float rli[16];
#pragma unroll
  for (int r = 0; r < 16; ++r) rli[r] = __builtin_amdgcn_rcpf(li_l[crow(r, hi)]);
  bf16* Ow = a.O + (long)(wid * QBLK) * a.ldo;
#pragma unroll
  for (int r = 0; r < 16; ++r) { const int orow = crow(r, hi);
#pragma unroll
    for (int d0 = 0; d0 < 4; ++d0) { const float v = o[d0][r] * rli[r]; unsigned u = __float_as_uint(v); u = (u + 0x7fffu + ((u >> 16) & 1u)) >> 16; Ow[(long)orow * a.ldo + d0 * 32 + r32] = (bf16)u; } }
  __syncthreads();
#undef KROW
#undef SLOAD
#undef SWRITE
#undef SWAIT
#undef RESC
}
#undef SBAR
}
#define LAS __attribute__((address_space(3)))
typedef unsigned short bf16;
typedef float f32x4 __attribute__((ext_vector_type(4)));
typedef unsigned v4u __attribute__((ext_vector_type(4)));
typedef unsigned v2u __attribute__((ext_vector_type(2)));
constexpr int NWAVES = 8, NTHR = 512;
constexpr int DM = 2048, SEQ = 8192, NCTX = 256, MLAT = 2 * SEQ, MALL = MLAT + 2 * NCTX, DFF = 5632;
constexpr int N_IN0 = 2816, N_IN1 = 4608, N_UQ = 1536, N_UKV = 2048, N_GU = 2 * DFF;
constexpr float EPS = 1e-6f;
constexpr size_t MiB = 1u << 20;
constexpr size_t WS_MOD = 0, WS_BAR = 512 * 1024, BAR_BYTES = 16384;
constexpr size_t WS_WIN0 = 1 * MiB, WS_WUQ = WS_WIN0 + 11 * MiB, WS_WUKV = WS_WUQ + 2 * MiB, WS_WOUT0 = WS_WUKV + 2 * MiB, WS_WIN1 = WS_WOUT0 + 8 * MiB, WS_WOUT1 = WS_WIN1 + 18 * MiB,
                 WS_WGU = WS_WOUT1 + 8 * MiB, WS_WD = WS_WGU + 88 * MiB, WS_HCTX = WS_WD + 44 * MiB;
constexpr size_t WS_UO = WS_HCTX + 4 * MiB;
constexpr size_t WS_OB = WS_UO + 66 * MiB;
constexpr size_t WS_BIG = WS_UO + 132 * MiB;
constexpr size_t WS_QB = WS_BIG + 91 * MiB, WS_KVB = WS_BIG + 141 * MiB, WS_UB = WS_BIG + 149 * MiB, WS_END = WS_BIG + 215 * MiB;
static_assert((size_t)MALL * DM * 2 == 66 * MiB && (size_t)MALL * N_IN0 * 2 <= 91 * MiB && (size_t)MALL * N_UQ * 2 <= 50 * MiB && (size_t)MALL * N_IN1 * 2 <= 149 * MiB && (size_t)MALL * DFF * 2 <= 215 * MiB, "ws map");

__device__ __forceinline__ unsigned f2bf(float f) { unsigned u = __builtin_bit_cast(unsigned, f); return (u + 0x7fffu + ((u >> 16) & 1u)) >> 16; }
__device__ __forceinline__ unsigned pk2(float lo, float hi) { return f2bf(lo) | (f2bf(hi) << 16); }
__device__ __forceinline__ float bf2f(bf16 v) { return __uint_as_float(((unsigned)v) << 16); }
__device__ __forceinline__ float wave_sum(float v, int lane) {
#pragma unroll
    for (int o = 1; o < 64; o <<= 1) v += __int_as_float(__builtin_amdgcn_ds_bpermute((lane ^ o) << 2, __float_as_int(v)));
    return v;
}
__device__ __forceinline__ float silu_f(float x) { return x / (1.0f + __expf(-x)); }

#define GAS __attribute__((address_space(1)))
#define XB_TMO      128
#define XB_XCNT(j)  (256  + 64 * (j))
#define XB_XSUB(j)  (1280 + 64 * (j))
#define XB_XGEN(j)  (2304 + 64 * (j))
#define XB_TOP      3328
#define XB_TOPGEN   3392
#define XCD_BAR_WORDS 3456
#define XB_SPIN_CAP (1u << 18)

__device__ __forceinline__ unsigned xb_ld(unsigned* p)              { return __hip_atomic_load(p, __ATOMIC_RELAXED, __HIP_MEMORY_SCOPE_AGENT); }
__device__ __forceinline__ unsigned xb_add(unsigned* p, unsigned v) { return __hip_atomic_fetch_add(p, v, __ATOMIC_RELAXED, __HIP_MEMORY_SCOPE_AGENT); }
__device__ __forceinline__ unsigned xb_xcc_id() { return (unsigned)__builtin_amdgcn_s_getreg((3 << 11) | 20) & 0xFu; }
#define XB_SPIN(cond, bar) do { unsigned _sp = 0; while (cond) { __builtin_amdgcn_s_sleep(1); \
    if ((++_sp & 255u) == 0u) { if (xb_ld(&(bar)[XB_TMO])) break; if (_sp > XB_SPIN_CAP) { atomicAdd(&(bar)[XB_TMO], 1u); break; } } } } while (0)

struct XcdBarrier {
    unsigned* bar; unsigned x;
    volatile LAS unsigned* st;
};

__device__ __forceinline__ XcdBarrier xcd_barrier_post(unsigned* bar, volatile LAS unsigned* st) {
    XcdBarrier b; b.bar = bar; b.x = xb_xcc_id(); b.st = st;
    if (threadIdx.x == 0) (void)xb_add(&bar[XB_XCNT(b.x)], 1u);
    return b;
}
__device__ __forceinline__ void xcd_barrier_complete(unsigned* bar, unsigned x, unsigned& nloc, unsigned& nx) {
    const unsigned G = gridDim.x * gridDim.y * gridDim.z;
    unsigned sum, cnt, mine, sp = 0u;
    for (;;) {
        sum = 0u; cnt = 0u; mine = 0u;
#pragma unroll
        for (unsigned j = 0; j < 16; ++j) { const unsigned c = xb_ld(&bar[XB_XCNT(j)]); sum += c; cnt += (c > 0u) ? 1u : 0u; mine = (j == x) ? c : mine; }
        if (sum == G) break;
        __builtin_amdgcn_s_sleep(1);
        if ((++sp & 255u) == 0u) { if (xb_ld(&bar[XB_TMO])) break; if (sp > XB_SPIN_CAP) { atomicAdd(&bar[XB_TMO], 1u); break; } }
    }
    nloc = mine > 0u ? mine : 1u; nx = cnt > 0u ? cnt : 1u;
}

__device__ __forceinline__ void xcd_barrier(const XcdBarrier& b) {
    asm volatile("s_waitcnt vmcnt(0)" ::: "memory");
    __syncthreads();
    if (threadIdx.x == 0) {
        unsigned* bar = b.bar;
        __builtin_amdgcn_s_waitcnt(0);
        unsigned nloc = b.st[0], nx = b.st[1];
        if (nloc == 0u) { xcd_barrier_complete(bar, b.x, nloc, nx); b.st[0] = nloc; b.st[1] = nx; }
        const unsigned old = xb_add(&bar[XB_XSUB(b.x)], 1u);
        const unsigned gen = old / nloc;
        if (old + 1u == (gen + 1u) * nloc) {
            __builtin_amdgcn_fence(__ATOMIC_RELEASE, "agent");
            asm volatile("s_waitcnt vmcnt(0)" ::: "memory");
            const unsigned og = xb_add(&bar[XB_TOP], 1u);
            const unsigned tg = og / nx;
            if (og + 1u == (tg + 1u) * nx) xb_add(&bar[XB_TOPGEN], 1u);
            else XB_SPIN(xb_ld(&bar[XB_TOPGEN]) == tg, bar);
            __builtin_amdgcn_fence(__ATOMIC_ACQUIRE, "agent");
            xb_add(&bar[XB_XGEN(b.x)], 1u);
            asm volatile("s_waitcnt vmcnt(0)" ::: "memory");
        } else {
            XB_SPIN(xb_ld(&bar[XB_XGEN(b.x)]) == gen, bar);
            __builtin_amdgcn_fence(__ATOMIC_ACQUIRE, "agent");
            asm volatile("s_waitcnt vmcnt(0)" ::: "memory");
        }
    }
    __syncthreads();
}

struct KArgs { const float* in[29]; float* out; unsigned char* ws; };
typedef const __attribute__((address_space(4))) KArgs* KAP;
__device__ __forceinline__ KAP kargs() { KAP p = (KAP)__builtin_amdgcn_kernarg_segment_ptr(); asm volatile("" : "+s"(p)); return p; }

__device__ __forceinline__ void transpose_item(const float* W, int K, int N, bf16* WT, int k0, int n0, int drow0, LAS float* scr, int lane) {
#pragma unroll 8
    for (int i = 0; i < 32; ++i) { const int kk = 2 * i + (lane >> 5); scr[kk * 33 + (lane & 31)] = W[(size_t)(k0 + kk) * N + n0 + (lane & 31)]; }
    asm volatile("s_waitcnt lgkmcnt(0)" ::: "memory");
    const int c = lane & 7;
#pragma unroll
    for (int j = 0; j < 4; ++j) { const int n = (lane >> 3) + 8 * j; const LAS float* s = scr + (8 * c) * 33 + n;
        v4u o; o.x = pk2(s[0 * 33], s[1 * 33]); o.y = pk2(s[2 * 33], s[3 * 33]); o.z = pk2(s[4 * 33], s[5 * 33]); o.w = pk2(s[6 * 33], s[7 * 33]);
        *(v4u*)(WT + (size_t)(drow0 + n) * K + k0 + 8 * c) = o; }
    asm volatile("s_waitcnt lgkmcnt(0)" ::: "memory");
}
__device__ __forceinline__ bool conv_matrix(int& it, const float* W, int K, int N, bf16* WT, int mode, LAS float* scr, int lane) {
    const int nblk = N / 32, items = (K / 64) * nblk;
    if (it >= items) { it -= items; return false; }
    const int kb = it / nblk, nb = it % nblk, n0 = 32 * nb;
    const int drow0 = mode == 0 ? n0 : ((n0 >> 7) * 256 + (mode == 2 ? 128 : 0) + (n0 & 127));
    transpose_item(W, K, N, WT, 64 * kb, n0, drow0, scr, lane);
    return true;
}
__device__ __forceinline__ void p0_weights(KAP a, LAS unsigned char* lds, int gw, int NGW, int wave, int lane) {
    LAS float* scr = (LAS float*)(lds + wave * 8704);
    unsigned char* ws = a->ws;
    constexpr int I_TOTAL = (2048 / 64) * (2624 / 32) + (512 / 64) * (1536 / 32) + (512 / 64) * (2048 / 32) + 2 * (2048 / 64) * (2048 / 32) + (2048 / 64) * (4608 / 32)
                          + 4 * (2048 / 64) * (DFF / 32) + 2 * (DFF / 64) * (2048 / 32);
    for (int item = gw; item < I_TOTAL; item += NGW) {
        int it = item;
        if (conv_matrix(it, a->in[13], 2048, 2624, (bf16*)(ws + WS_WIN0), 0, scr, lane)) continue;
        if (conv_matrix(it, a->in[19], 512, 1536, (bf16*)(ws + WS_WUQ), 0, scr, lane)) continue;
        if (conv_matrix(it, a->in[20], 512, 2048, (bf16*)(ws + WS_WUKV), 0, scr, lane)) continue;
        if (conv_matrix(it, a->in[14], 2048, 2048, (bf16*)(ws + WS_WOUT0), 0, scr, lane)) continue;
        if (conv_matrix(it, a->in[21], 2048, 4608, (bf16*)(ws + WS_WIN1), 0, scr, lane)) continue;
        if (conv_matrix(it, a->in[22], 2048, 2048, (bf16*)(ws + WS_WOUT1), 0, scr, lane)) continue;
        if (conv_matrix(it, a->in[10], 2048, DFF, (bf16*)(ws + WS_WGU), 1, scr, lane)) continue;
        if (conv_matrix(it, a->in[10] + (size_t)2048 * DFF, 2048, DFF, (bf16*)(ws + WS_WGU + 44 * MiB), 1, scr, lane)) continue;
        if (conv_matrix(it, a->in[11], 2048, DFF, (bf16*)(ws + WS_WGU), 2, scr, lane)) continue;
        if (conv_matrix(it, a->in[11] + (size_t)2048 * DFF, 2048, DFF, (bf16*)(ws + WS_WGU + 44 * MiB), 2, scr, lane)) continue;
        if (conv_matrix(it, a->in[12], DFF, 2048, (bf16*)(ws + WS_WD), 0, scr, lane)) continue;
        conv_matrix(it, a->in[12] + (size_t)2048 * DFF, DFF, 2048, (bf16*)(ws + WS_WD + 22 * MiB), 0, scr, lane);
    }
}
__device__ __forceinline__ void p0_mod(KAP a, LAS unsigned char* lds, int tid) {
    LAS float* sv = (LAS float*)lds;
    LAS float* red = (LAS float*)(lds + 24576);
    const int blk = blockIdx.x; if (blk >= 256) return;
    const int layer = blk >> 7, col0 = (blk & 127) * 96;
    for (int i = tid; i < 3 * 2048; i += NTHR) { const int v = i >> 11, k = i & 2047; const float x = v < 2 ? a->in[1][v * 2048 + k] : a->in[3][k]; sv[i] = silu_f(x); }
    __syncthreads();
    const int c4 = tid % 24, ks = tid / 24;
    if (ks < 21) {
        const float* W = a->in[4] + (size_t)layer * 2048 * 12288 + col0 + 4 * c4;
        f32x4 a0 = {0, 0, 0, 0}, a1 = a0, a2 = a0;
#pragma unroll 4
        for (int k = ks; k < 2048; k += 21) { const f32x4 w = *(const f32x4*)(W + (size_t)k * 12288); a0 += w * sv[k]; a1 += w * sv[2048 + k]; a2 += w * sv[4096 + k]; }
        LAS float* r = red + ks * 288 + 4 * c4;
        *(LAS f32x4*)(r) = a0; *(LAS f32x4*)(r + 96) = a1; *(LAS f32x4*)(r + 192) = a2;
    }
    __syncthreads();
    if (tid < 288) { float s = 0.f;
        for (int q = 0; q < 21; ++q) s += red[q * 288 + tid];
        const int v = tid / 96, j = tid % 96;
        ((float*)(a->ws + WS_MOD))[(size_t)(layer * 3 + v) * 12288 + col0 + j] = s + a->in[5][layer * 12288 + col0 + j]; }
    __syncthreads();
}
__device__ __forceinline__ void store_u(bf16* urow, int lane, const f32x4 (&v)[8], float rstd, const float* g, const float* sh, const float* sc) {
#pragma unroll
    for (int j = 0; j < 8; ++j) { const int ci = 256 * j + 4 * lane; const f32x4 g4 = *(const f32x4*)(g + ci), s4 = *(const f32x4*)(sc + ci), h4 = *(const f32x4*)(sh + ci);
        const f32x4 t = (v[j] * rstd * g4) * (1.0f + s4) + h4; v2u w; w.x = pk2(t[0], t[1]); w.y = pk2(t[2], t[3]); *(v2u*)(urow + ci) = w; }
}
__device__ __forceinline__ void pass_pre(const float* hlat, const float* hctx, const float* g, const float* mod, int sh_off, int sc_off, bf16* U, int nrows, int gw, int NGW, int lane) {
    for (int m = gw; m < nrows; m += NGW) {
        const float* src = m < MLAT ? hlat + (size_t)m * DM : hctx + (size_t)(m - MLAT) * DM; const float* mv = mod + (m < MLAT ? (m >> 13) : 2) * 12288;
        f32x4 v[8]; float ss = 0.f;
#pragma unroll
        for (int j = 0; j < 8; ++j) { v[j] = *(const f32x4*)(src + 256 * j + 4 * lane); ss += (v[j][0] * v[j][0] + v[j][1] * v[j][1]) + (v[j][2] * v[j][2] + v[j][3] * v[j][3]); }
        const float rstd = rsqrtf(wave_sum(ss, lane) * (1.0f / DM) + EPS);
        store_u(U + (size_t)m * DM, lane, v, rstd, g, mv + sh_off, mv + sc_off);
    }
}
__device__ __forceinline__ void pass_post(const float* o, const float* hlat, const float* hctx, float* olat, float* octx, const float* gpost, const float* mod, int gt_off,
                                          const float* gpre, const float* modu, int sh_off, int sc_off, bf16* U, int nrows, int gw, int NGW, int lane) {
    for (int m = gw; m < nrows; m += NGW) {
        const float* hs = m < MLAT ? hlat + (size_t)m * DM : hctx + (size_t)(m - MLAT) * DM; float* hd = m < MLAT ? olat + (size_t)m * DM : octx + (size_t)(m - MLAT) * DM;
        const float* mv = mod + (m < MLAT ? (m >> 13) : 2) * 12288; const float* orow = o + (size_t)m * DM;
        f32x4 v[8]; float ss = 0.f;
#pragma unroll
        for (int j = 0; j < 8; ++j) { v[j] = *(const f32x4*)(orow + 256 * j + 4 * lane); ss += (v[j][0] * v[j][0] + v[j][1] * v[j][1]) + (v[j][2] * v[j][2] + v[j][3] * v[j][3]); }
        const float rstd = rsqrtf(wave_sum(ss, lane) * (1.0f / DM) + EPS); float s2 = 0.f;
#pragma unroll
        for (int j = 0; j < 8; ++j) { const int ci = 256 * j + 4 * lane; const f32x4 g4 = *(const f32x4*)(gpost + ci), t4 = *(const f32x4*)(mv + gt_off + ci), h4 = *(const f32x4*)(hs + ci);
            v[j] = h4 + t4 * (v[j] * rstd * g4); *(f32x4*)(hd + ci) = v[j]; s2 += (v[j][0] * v[j][0] + v[j][1] * v[j][1]) + (v[j][2] * v[j][2] + v[j][3] * v[j][3]); }
        if (U) { const float* mu = modu + (m < MLAT ? (m >> 13) : 2) * 12288; const float rstd2 = rsqrtf(wave_sum(s2, lane) * (1.0f / DM) + EPS); store_u(U + (size_t)m * DM, lane, v, rstd2, gpre, mu + sh_off, mu + sc_off); }
    }
}
__device__ __forceinline__ void rope_cs(float pos, int j, float inv_nf, float& cs, float& sn) {
    const float inv_freq = __builtin_amdgcn_exp2f(-(float)j * inv_nf * 13.287712379549449f);
    float rev = pos * inv_freq * 0.15915494309189535f; rev -= rintf(rev);
    sn = __builtin_amdgcn_sinf(rev); cs = __builtin_amdgcn_cosf(rev);
}
__device__ __forceinline__ void head128(bf16* hp, const float* gain, bool rope, float prow, float pcol, int lane) {
    const int j = lane & 31, s = lane >> 5, ia = 64 * s + j, ib = ia + 32;
    float x = bf2f(hp[ia]), y = bf2f(hp[ib]);
    const float rstd = rsqrtf(wave_sum(x * x + y * y, lane) * (1.0f / 128.0f) + EPS);
    x = x * rstd * gain[ia]; y = y * rstd * gain[ib];
    if (rope) { float cs, sn; rope_cs(s ? pcol : prow, j, 1.0f / 32.0f, cs, sn); const float nx = x * cs - y * sn, ny = y * cs + x * sn; x = nx; y = ny; }
    hp[ia] = (bf16)f2bf(x); hp[ib] = (bf16)f2bf(y);
}
__device__ __forceinline__ void rope64(bf16* p, float prow, float pcol, int l32) {
    const int j = l32 & 15, s = (l32 >> 4) & 1, ia = 32 * s + j, ib = ia + 16;
    const float x = bf2f(p[ia]), y = bf2f(p[ib]); float cs, sn; rope_cs(s ? pcol : prow, j, 1.0f / 16.0f, cs, sn);
    p[ia] = (bf16)f2bf(x * cs - y * sn); p[ib] = (bf16)f2bf(y * cs + x * sn);
}
__device__ __forceinline__ void norm512(bf16* p, const float* gain, int lane) {
    const v4u raw = *(const v4u*)(p + 8 * lane); float x[8];
#pragma unroll
    for (int i = 0; i < 4; ++i) { x[2 * i] = __uint_as_float(raw[i] << 16); x[2 * i + 1] = __uint_as_float(raw[i] & 0xffff0000u); }
    float ss = 0.f;
#pragma unroll
    for (int i = 0; i < 8; ++i) ss += x[i] * x[i];
    const float rstd = rsqrtf(wave_sum(ss, lane) * (1.0f / 512.0f) + EPS);
    const f32x4 g0 = *(const f32x4*)(gain + 8 * lane), g1 = *(const f32x4*)(gain + 8 * lane + 4);
    v4u w; w.x = pk2(x[0] * rstd * g0[0], x[1] * rstd * g0[1]); w.y = pk2(x[2] * rstd * g0[2], x[3] * rstd * g0[3]); w.z = pk2(x[4] * rstd * g1[0], x[5] * rstd * g1[1]); w.w = pk2(x[6] * rstd * g1[2], x[7] * rstd * g1[3]);
    *(v4u*)(p + 8 * lane) = w;
}
__device__ __forceinline__ void prep_ab(bf16* P, const float* aqn, const float* akn, const float* bqn, const float* bkvn, int gw, int NGW, int lane) {
    for (int m = gw; m < MALL; m += NGW) {
        bf16* row = P + (size_t)m * N_IN0; const bool lat = m < MLAT; const int t = m & (SEQ - 1); const float pr = (float)(t >> 6), pc = (float)(t & 63);
        for (int h = 0; h < 8; ++h) head128(row + h * 128, aqn, lat, pr, pc, lane);
        for (int h = 0; h < 2; ++h) head128(row + 1024 + h * 128, akn, lat, pr, pc, lane);
        norm512(row + 1536, bqn, lane); norm512(row + 2048, bkvn, lane);
        if (lat && lane < 32) rope64(row + 2560, pr, pc, lane);
    }
}
__device__ __forceinline__ void prep_qb(bf16* QB, int gw, int NGW, int lane) {
    for (int m = gw; m < MLAT; m += NGW) {
        bf16* row = QB + (size_t)m * N_UQ; const int t = m & (SEQ - 1); const float pr = (float)(t >> 6), pc = (float)(t & 63);
#pragma unroll
        for (int i = 0; i < 4; ++i) rope64(row + (2 * i + (lane >> 5)) * 192 + 128, pr, pc, lane & 31);
    }
}
__device__ __forceinline__ void prep_cd(bf16* P, const float* cqn, const float* ckn, const float* dqn, const float* dkn, int gw, int NGW, int lane) {
    for (int m = gw; m < MALL; m += NGW) {
        bf16* row = P + (size_t)m * N_IN1; const bool lat = m < MLAT; const int t = m & (SEQ - 1); const float pr = (float)(t >> 6), pc = (float)(t & 63);
        if (lat) for (int h = 0; h < 8; ++h) head128(row + h * 128, cqn, true, pr, pc, lane);
        for (int h = 0; h < 2; ++h) head128(row + 1024 + h * 128, ckn, lat, pr, pc, lane);
        if (lat) for (int h = 0; h < 8; ++h) head128(row + 1536 + h * 128, dqn, false, 0.f, 0.f, lane);
        for (int h = 0; h < 8; ++h) head128(row + 2560 + h * 128, dkn, false, 0.f, 0.f, lane);
    }
}
constexpr float LOG2E = 1.4426950408889634f;
__device__ __forceinline__ void attn_phase_ab(const bf16* P0, const bf16* QB, const bf16* KVB, bf16* OB, char* lds) {
    const int c = blockIdx.x, G = gridDim.x;
    for (int id = c; id < 1024 + 32; id += G) {
        att::Args a{};
        int mixer, b, h, qrow0, NT;
        if (id < 1024) { const int rnd = id >> 8, cc = id & 255; mixer = rnd >> 1; b = rnd & 1; h = cc & 7; qrow0 = b * SEQ + (cc >> 3) * 256; NT = 132; }
        else { const int cc = id - 1024; mixer = cc >> 4; b = (cc >> 3) & 1; h = cc & 7; qrow0 = MLAT + b * NCTX; NT = 4; }
        a.NT = NT; a.nctx = 4; a.ctx_row0 = MLAT + b * NCTX; a.lat_row0 = b * SEQ; a.ldo = DM;
        if (mixer == 0) {
            a.Q = P0 + (size_t)qrow0 * N_IN0 + h * 128; a.ldq = N_IN0; a.K = P0 + 1024 + (h >> 2) * 128; a.ldk = N_IN0; a.K2 = nullptr; a.ldk2 = 0; a.V = P0 + 1280 + (h >> 2) * 128; a.ldv = N_IN0;
            a.O = OB + (size_t)qrow0 * DM + h * 128; const float scale = 0.08838834764831845f; a.C = scale * LOG2E; a.thr_raw = 8.0f / scale;

#ifndef DIS_A
            att::attn_unit<128, 0>(a, lds);
#endif

        } else {
            a.Q = QB + (size_t)qrow0 * N_UQ + h * 192; a.ldq = N_UQ; a.K = KVB + h * 256; a.ldk = N_UKV; a.K2 = P0 + 2560; a.ldk2 = N_IN0; a.V = KVB + h * 256 + 128; a.ldv = N_UKV;
            a.O = OB + (size_t)qrow0 * DM + 1024 + h * 128; const float scale = 0.07216878364870322f; a.C = scale * LOG2E; a.thr_raw = 8.0f / scale;

#ifndef DIS_B
            att::attn_unit<192, 0>(a, lds);
#endif

        }
    }
}
__device__ __forceinline__ void attn_phase_cd(const bf16* P1, bf16* OB, const float* sink, const float* rpb, char* lds) {
    const int c = blockIdx.x, G = gridDim.x;
    for (int id = c; id < 1024; id += G) {
        att::Args a{};
        const int rnd = id >> 8, cc = id & 255, mixer = rnd >> 1, b = rnd & 1, h = cc & 7, qb = cc >> 3, qrow0 = b * SEQ + qb * 256;
        a.nctx = 4; a.ctx_row0 = MLAT + b * NCTX; a.ldo = DM; a.ldq = a.ldk = a.ldv = N_IN1; a.K2 = nullptr; a.ldk2 = 0;
        const float scale = 0.08838834764831845f; a.C = scale * LOG2E; a.thr_raw = 8.0f / scale; a.inv_scale = 1.0f / scale;
        if (mixer == 0) {
            const int kbase = min(max(qb * 256 - 128, 0), SEQ - 512);
            a.NT = 12; a.lat_row0 = b * SEQ + kbase; a.qpos0 = qb * 256; a.kpos0 = kbase; a.sink_l2 = sink[h] * LOG2E;
            a.Q = P1 + (size_t)qrow0 * N_IN1 + h * 128; a.K = P1 + 1024 + (h >> 2) * 128; a.V = P1 + 1280 + (h >> 2) * 128; a.O = OB + (size_t)qrow0 * DM + h * 128;

#ifndef DIS_C
            att::attn_unit<128, 1>(a, lds);
#endif

        } else {
            const int r0 = qb * 4, klo = min(max(r0 - 4, 0), 116);
            a.NT = 16; a.lat_row0 = b * SEQ + klo * 64; a.r0 = r0; a.klo = klo; a.rpb = rpb + h * (15 * 31);
            a.Q = P1 + (size_t)qrow0 * N_IN1 + 1536 + h * 128; a.K = P1 + 2560 + h * 128; a.V = P1 + 3584 + h * 128; a.O = OB + (size_t)qrow0 * DM + 1024 + h * 128;

#ifndef DIS_D
            att::attn_unit<128, 2>(a, lds);
#endif

        }
    }
}

__global__ void __launch_bounds__(NTHR, 2) fwd_megakernel(KArgs args) {
    extern __shared__ __attribute__((aligned(16))) unsigned char lds[];
    cg::grid_group grid = cg::this_grid();
    LAS unsigned char* ldsl = (LAS unsigned char*)lds;
    const int G = gridDim.x, NGW = G * NWAVES;
#define PHASE_IDS() const int tid = fresh_tid(); const int lane = tid & 63, wave = __builtin_amdgcn_readfirstlane(tid >> 6), gw = blockIdx.x * NWAVES + wave; (void)wave; (void)gw; (void)lane
#define WSB (kargs()->ws)
#define x_ (kargs()->in[0])
#define ctx_ (kargs()->in[2])
#define out_ (kargs()->out)
#define hctx_ ((float*)(WSB + WS_HCTX))
#define MOD_ ((const float*)(WSB + WS_MOD))
#define UA_ ((bf16*)(WSB + WS_UO))
#define OB_ ((bf16*)(WSB + WS_OB))
#define F_ ((float*)(WSB + WS_UO))
#define PB_ ((bf16*)(WSB + WS_BIG))
#define OF_ ((float*)(WSB + WS_BIG))
#define ACT_ ((bf16*)(WSB + WS_BIG))
#define QB_ ((bf16*)(WSB + WS_QB))
#define KVB_ ((bf16*)(WSB + WS_KVB))
#define UB_ ((bf16*)(WSB + WS_UB))
#ifndef PROBE_G
#define PROBE_G 1
#endif
#ifndef PROBE_A
#define PROBE_A 1
#endif
#ifndef PROBE_S
#define PROBE_S 1
#endif
#define GSYNC() do { for (int s_ = 0; s_ < PROBE_S; ++s_) { xcd_barrier(bar); } } while (0)
    volatile LAS unsigned* MISC = (volatile LAS unsigned*)(ldsl + 131072 + 64);
    if (threadIdx.x < 2) MISC[threadIdx.x] = 0u;
    __syncthreads();
    grid.sync();
    XcdBarrier bar = xcd_barrier_post((unsigned*)(kargs()->ws + WS_BAR), MISC);

    for (int rep_ = 0; rep_ < PROBE_S; ++rep_) {
    { PHASE_IDS(); p0_mod(kargs(), ldsl, tid); }
    { PHASE_IDS(); p0_weights(kargs(), ldsl, gw, NGW, wave, lane); }
    }
    GSYNC();
    { PHASE_IDS(); pass_pre(x_, ctx_, kargs()->in[6], MOD_, 0, DM, UA_, MALL, gw, NGW, lane); }
    GSYNC();
    for (int L = 0; L < 2; ++L) {

        const int Mrows = L == 0 ? MALL : MLAT;
        { pg8::Gemm g{L == 0 ? UA_ : UB_, (const bf16*)(WSB + (L == 0 ? WS_WIN0 : WS_WIN1)), MALL, L == 0 ? N_IN0 : N_IN1, DM, DM};
          pg8::StaticOrder S; S.init(g.M, g.N, G, (int)blockIdx.x); pg8::EpiBf16 E{PB_, g.N};
          for (int rep_ = 0; rep_ < PROBE_G; ++rep_) pg8::gemm_phase<pg8::EpiBf16, pg8::StaticOrder, true, true>(ldsl, g, S, E); }
        GSYNC();
        if (L == 0) {
            { PHASE_IDS(); prep_ab(PB_, kargs()->in[15], kargs()->in[16], kargs()->in[17], kargs()->in[18], gw, NGW, lane); }
            GSYNC();
            for (int q = 0; q < 2; ++q) {
                pg8::Gemm g{PB_ + (q == 0 ? 1536 : 2048), (const bf16*)(WSB + (q == 0 ? WS_WUQ : WS_WUKV)), MALL, q == 0 ? N_UQ : N_UKV, 512, N_IN0};
                pg8::StaticOrder S; S.init(g.M, g.N, G, (int)blockIdx.x); pg8::EpiBf16 E{q == 0 ? QB_ : KVB_, g.N};
                for (int rep_ = 0; rep_ < PROBE_G; ++rep_) pg8::gemm_phase<pg8::EpiBf16, pg8::StaticOrder, true, true>(ldsl, g, S, E);
            }
            GSYNC();
            { PHASE_IDS(); prep_qb(QB_, gw, NGW, lane); }
            GSYNC();
            for (int rep_ = 0; rep_ < PROBE_A; ++rep_) attn_phase_ab(PB_, QB_, KVB_, OB_, (char*)lds);
        } else {
            { PHASE_IDS(); prep_cd(PB_, kargs()->in[23], kargs()->in[24], kargs()->in[26], kargs()->in[27], gw, NGW, lane); }
            GSYNC();
            for (int rep_ = 0; rep_ < PROBE_A; ++rep_) attn_phase_cd(PB_, OB_, kargs()->in[25], kargs()->in[28], (char*)lds);
        }
        GSYNC();
        { pg8::Gemm g{OB_, (const bf16*)(WSB + (L == 0 ? WS_WOUT0 : WS_WOUT1)), Mrows, DM, DM, DM};
          pg8::StaticOrder S; S.init(g.M, g.N, G, (int)blockIdx.x); pg8::EpiF32 E{OF_, DM};
          for (int rep_ = 0; rep_ < PROBE_G; ++rep_) pg8::gemm_phase<pg8::EpiF32, pg8::StaticOrder, true, true>(ldsl, g, S, E); }
        GSYNC();
        { PHASE_IDS(); pass_post(OF_, L == 0 ? x_ : out_, L == 0 ? ctx_ : hctx_, out_, hctx_, kargs()->in[7] + L * DM, MOD_ + (size_t)L * 3 * 12288, 2 * DM, kargs()->in[8] + L * DM, MOD_ + (size_t)L * 3 * 12288, 3 * DM, 4 * DM, UA_, Mrows, gw, NGW, lane); }
        GSYNC();
        { pg8::Gemm g{UA_, (const bf16*)(WSB + WS_WGU + (size_t)L * 44 * MiB), Mrows, N_GU, DM, DM};
          pg8::StaticOrder S; S.init(g.M, g.N, G, (int)blockIdx.x); pg8::EpiSwiglu E{ACT_, DFF};
          for (int rep_ = 0; rep_ < PROBE_G; ++rep_) pg8::gemm_phase<pg8::EpiSwiglu, pg8::StaticOrder, true, true>(ldsl, g, S, E); }
        GSYNC();
        { pg8::Gemm g{ACT_, (const bf16*)(WSB + WS_WD + (size_t)L * 22 * MiB), Mrows, DM, DFF, DFF};
          pg8::StaticOrder S; S.init(g.M, g.N, G, (int)blockIdx.x); pg8::EpiF32 E{F_, DM};
          for (int rep_ = 0; rep_ < PROBE_G; ++rep_) pg8::gemm_phase<pg8::EpiF32, pg8::StaticOrder, true, true>(ldsl, g, S, E); }
        GSYNC();
        { PHASE_IDS(); pass_post(F_, out_, hctx_, out_, hctx_, kargs()->in[9] + L * DM, MOD_ + (size_t)L * 3 * 12288, 5 * DM, kargs()->in[6] + DM, MOD_ + (size_t)3 * 12288, 0, DM, L == 0 ? UB_ : nullptr, Mrows, gw, NGW, lane); }
        if (L == 0) GSYNC();
    }
#undef GSYNC
}

constexpr int LDS_BYTES = 131072 + 1024;
extern "C" void kernel_launch(void* const* d_in, const int* in_sizes, int n_in, void* d_out, int out_size, void* d_ws, size_t ws_size, hipStream_t stream) {
    static int grid = 0;
    if (grid == 0) {
        if (n_in != 29 || out_size != MLAT * DM || ws_size < WS_END) { fprintf(stderr, "kernel_launch: unexpected shapes: n_in %d out %d ws %zu (need %zu)\n", n_in, out_size, ws_size, (size_t)WS_END); grid = -1; return; }
        int dev = 0, cus = 0, per_cu = 0;
        hipGetDevice(&dev); hipDeviceGetAttribute(&cus, hipDeviceAttributeMultiprocessorCount, dev);
        if (hipFuncSetAttribute((const void*)fwd_megakernel, hipFuncAttributeMaxDynamicSharedMemorySize, LDS_BYTES) != hipSuccess) { fprintf(stderr, "kernel_launch: hipFuncSetAttribute failed\n"); grid = -1; return; }
        if (hipOccupancyMaxActiveBlocksPerMultiprocessor(&per_cu, (const void*)fwd_megakernel, NTHR, LDS_BYTES) != hipSuccess || per_cu < 1) { fprintf(stderr, "kernel_launch: occupancy query says %d\n", per_cu); per_cu = 1; }
        (void)hipGetLastError();
        grid = cus;
        fprintf(stderr, "kernel_launch: grid %d (per_cu %d)\n", grid, per_cu);
    }
    if (grid < 0) return;
    if (hipMemsetAsync((char*)d_ws + WS_BAR, 0, BAR_BYTES, stream) != hipSuccess) { fprintf(stderr, "kernel_launch: hipMemsetAsync failed\n"); return; }
    KArgs a{};
    for (int i = 0; i < 29; ++i) a.in[i] = (const float*)d_in[i];
    a.out = (float*)d_out; a.ws = (unsigned char*)d_ws;
    void* params[] = {&a};
    const hipError_t e = hipLaunchCooperativeKernel((const void*)fwd_megakernel, dim3(grid), dim3(NTHR), params, LDS_BYTES, stream);
    if (e != hipSuccess) fprintf(stderr, "kernel_launch: cooperative launch failed: %s (grid %d)\n", hipGetErrorString(e), grid);
}
```

```cpp
#include <hip/hip_runtime.h>
#include <hip/hip_cooperative_groups.h>
#include <cstdio>
#include <cstdint>
namespace cg = cooperative_groups;
__device__ __forceinline__ int fresh_tid(int wave0) { int l; asm volatile("v_mbcnt_lo_u32_b32 %0, -1, 0\n\tv_mbcnt_hi_u32_b32 %0, -1, %0" : "=v"(l)); return wave0 * 64 + l; }
namespace pg8 {
#define PG8_LAS __attribute__((address_space(3)))
typedef unsigned short bf16_t;
typedef short bf16x8 __attribute__((ext_vector_type(8)));
typedef float f32x4 __attribute__((ext_vector_type(4)));
typedef unsigned u32x4 __attribute__((ext_vector_type(4)));
constexpr int BM = 256, BK = 64, HALF = 128, HTB = HALF * BK * 2  , STAGE_BYTES = 8 * HTB, NXCD = 8, WGM = 8;

__host__ __device__ __forceinline__ int lds_byte(int r, int c) { const int st = (r >> 4) * 2 + (c >> 5), rr = r & 15, cc = c & 31, ob = rr * 64 + cc * 2; return st * 1024 + (ob ^ (((ob >> 9) & 1) << 5)); }
__host__ __device__ __forceinline__ void stage_rc(int b, int& R, int& C) { const int st = b / 1024, sb = b % 1024, swz = sb ^ (((sb >> 9) & 1) << 5); R = (st >> 1) * 16 + swz / 64; C = (st & 1) * 32 + (swz % 64) / 2; }
__host__ __device__ __forceinline__ int perm32(int rho) { const int n = rho >> 4, i = rho & 15; return 8 * (i >> 2) + 4 * n + (i & 3); }

struct Unit { int pm, pn; };
struct Gemm { const bf16_t* A; const bf16_t* Bt; int M, N, K, lda, ldb, nNr; };
__host__ __device__ __forceinline__ Gemm mk_gemm(const bf16_t* A, const bf16_t* Bt, int M, int N, int K, int lda) { Gemm g; g.A = A; g.Bt = Bt; g.M = M; g.N = N; g.K = K; g.lda = lda; g.ldb = K; g.nNr = N / BM; return g; }

struct StaticOrder {
    int nM, nN, nwg, G, c;
    __host__ __device__ void init(int M, int N, int G_, int c_) { nM = M / BM; nN = N / BM; nwg = nM * nN; G = G_; c = c_; }
    __host__ __device__ bool next(int i, Unit& u) const {
        const long L = (long)i * G + c; if (L >= nwg) return false;
        int wgid = (int)L; { const int q = nwg / NXCD, r = nwg % NXCD, xcd = wgid % NXCD, off = wgid / NXCD; wgid = (xcd < r ? xcd * (q + 1) : r * (q + 1) + (xcd - r) * q) + off; }
        const int nig = WGM * nN, gid = wgid / nig, fm = gid * WGM, gsz = (nM - fm) < WGM ? (nM - fm) : WGM;
        u.pm = fm + ((wgid % nig) % gsz); u.pn = (wgid % nig) / gsz; return true;
    }
    __device__ __forceinline__ void a_ready(const Unit&) const {}
    __device__ __forceinline__ void done(const Unit&) const {}
};


__device__ __forceinline__ unsigned cvt_pk_bf16(float lo, float hi) { unsigned r; asm volatile("v_cvt_pk_bf16_f32 %0, %1, %2" : "=v"(r) : "v"(lo), "v"(hi)); return r; }
struct EpiBf16 {
    static constexpr bool PERM = true, AFTER_DRAIN = false;
    bf16_t* O; int ldc;
    __device__ __forceinline__ void operator()(const f32x4 (&acc)[2][2][4][2], const Unit& u, int wr, int wc, int fr, int fq) const {
        const int row0 = u.pm * BM + wr * 64 + fr, col0 = u.pn * BM + wc * 32 + 8 * fq;
#pragma unroll
        for (int ai = 0; ai < 2; ++ai)
#pragma unroll
            for (int m = 0; m < 4; ++m) { bf16_t* rowp = O + (size_t)(row0 + ai * HALF + m * 16) * ldc + col0;
#pragma unroll
                for (int bj = 0; bj < 2; ++bj) { const f32x4 v0 = acc[ai][bj][m][0], v1 = acc[ai][bj][m][1];
                    u32x4 w; w.x = cvt_pk_bf16(v0[0], v0[1]); w.y = cvt_pk_bf16(v0[2], v0[3]); w.z = cvt_pk_bf16(v1[0], v1[1]); w.w = cvt_pk_bf16(v1[2], v1[3]);
                    *(u32x4*)(rowp + bj * HALF) = w; } }
    }
};
struct EpiF32 {
    static constexpr bool PERM = false, AFTER_DRAIN = false;
    float* O; int ldc;
    __device__ __forceinline__ void operator()(const f32x4 (&acc)[2][2][4][2], const Unit& u, int wr, int wc, int fr, int fq) const {
        const int row0 = u.pm * BM + wr * 64 + fr, col0 = u.pn * BM + wc * 32 + 4 * fq;
#pragma unroll
        for (int ai = 0; ai < 2; ++ai)
#pragma unroll
            for (int m = 0; m < 4; ++m) { float* rowp = O + (size_t)(row0 + ai * HALF + m * 16) * ldc + col0;
#pragma unroll
                for (int bj = 0; bj < 2; ++bj)
#pragma unroll
                    for (int n = 0; n < 2; ++n) *(f32x4*)(rowp + bj * HALF + n * 16) = acc[ai][bj][m][n]; }
    }
};
struct EpiF32Split {
    static constexpr bool PERM = false, AFTER_DRAIN = false;
    float* O; int ldc; int nNr; size_t sstride;
    __device__ __forceinline__ void operator()(const f32x4 (&acc)[2][2][4][2], const Unit& u, int wr, int wc, int fr, int fq) const {
        const int s = u.pn / nNr, pn = u.pn - s * nNr;
        const int row0 = u.pm * BM + wr * 64 + fr, col0 = pn * BM + wc * 32 + 4 * fq; float* Ob = O + (size_t)s * sstride;
#pragma unroll
        for (int ai = 0; ai < 2; ++ai)
#pragma unroll
            for (int m = 0; m < 4; ++m) { float* rowp = Ob + (size_t)(row0 + ai * HALF + m * 16) * ldc + col0;
#pragma unroll
                for (int bj = 0; bj < 2; ++bj)
#pragma unroll
                    for (int n = 0; n < 2; ++n) *(f32x4*)(rowp + bj * HALF + n * 16) = acc[ai][bj][m][n]; }
    }
};
__device__ __forceinline__ float silu_mul(float g, float u) { return g * __builtin_amdgcn_rcpf(1.0f + __builtin_amdgcn_exp2f(-1.4426950408889634f * g)) * u; }
struct EpiSwiglu {
    static constexpr bool PERM = true, AFTER_DRAIN = false;
    bf16_t* O; int ldc;
    __device__ __forceinline__ void operator()(const f32x4 (&acc)[2][2][4][2], const Unit& u, int wr, int wc, int fr, int fq) const {
        const int row0 = u.pm * BM + wr * 64 + fr, col0 = u.pn * HALF + wc * 32 + 8 * fq;
#pragma unroll
        for (int ai = 0; ai < 2; ++ai)
#pragma unroll
            for (int m = 0; m < 4; ++m) { bf16_t* rowp = O + (size_t)(row0 + ai * HALF + m * 16) * ldc + col0;
                const f32x4 g0 = acc[ai][0][m][0], g1 = acc[ai][0][m][1], u0 = acc[ai][1][m][0], u1 = acc[ai][1][m][1];
                u32x4 w; w.x = cvt_pk_bf16(silu_mul(g0[0], u0[0]), silu_mul(g0[1], u0[1])); w.y = cvt_pk_bf16(silu_mul(g0[2], u0[2]), silu_mul(g0[3], u0[3]));
                w.z = cvt_pk_bf16(silu_mul(g1[0], u1[0]), silu_mul(g1[1], u1[1])); w.w = cvt_pk_bf16(silu_mul(g1[2], u1[2]), silu_mul(g1[3], u1[3]));
                *(u32x4*)rowp = w; }
    }
};

template <class Epi, class Sched, bool ALIGN_EPI = false, bool SP2 = false>
__device__ __forceinline__ void gemm_phase(PG8_LAS unsigned char* lds, const Gemm g, const Sched& S, const Epi& E, const int wave0) {
    const int tid = fresh_tid(wave0), wid = __builtin_amdgcn_readfirstlane(tid >> 6), lane = tid & 63, wr = wid >> 2, wc = wid & 3, fr = lane & 15, fq = lane >> 4;
    const int K = g.K, nt = K / BK;
    unsigned voffA[2], voffB[2];
#pragma unroll
    for (int i = 0; i < 2; ++i) { int R, C; stage_rc(tid * 16 + i * 8192, R, C); const int Rb = Epi::PERM ? ((R & ~31) + perm32(R & 31)) : R;
        voffA[i] = (unsigned)(R * g.lda + C) * 2u; voffB[i] = (unsigned)(Rb * g.ldb + C) * 2u; }
    const size_t kstep = (size_t)(BK * 2);
    const size_t hstepA = (size_t)HALF * g.lda * 2, hstepB = (size_t)HALF * g.ldb * 2; const size_t ksb = (size_t)K * 2;
#define PG8_APTR(u) ((const char*)g.A + (size_t)(u).pm * tstepA + (size_t)((u).pn / g.nNr) * ksb)
#define PG8_BPTR(u) ((const char*)g.Bt + (size_t)((u).pn % g.nNr) * tstepB + (size_t)((u).pn / g.nNr) * ksb)
    const size_t tstepA = 2 * hstepA, tstepB = 2 * hstepB;
    const unsigned ldsw = (unsigned)wid * 1024u;
    const int aoff = lds_byte(wr * 64 + fr, fq * 8), boff = lds_byte(wc * 32 + fr, fq * 8);
#define PG8_SA(b, h) (((b) * 2 + (h)) * HTB)
#define PG8_SB(b, h) ((4 + (b) * 2 + (h)) * HTB)
#define PG8_STAGE(bufoff, gbase, voff) do { _Pragma("unroll") for (int _i = 0; _i < 2; ++_i) \
        __builtin_amdgcn_global_load_lds((const unsigned*)((const char*)(gbase) + (voff)[_i]), (PG8_LAS unsigned*)(lds + (bufoff) + ldsw + _i * 8192), 16, 0, 0); } while (0)
#define PG8_LDA(dst, b, h) do { _Pragma("unroll") for (int m = 0; m < 4; ++m) _Pragma("unroll") for (int k = 0; k < 2; ++k) dst[m][k] = *(const PG8_LAS bf16x8*)(lds + PG8_SA(b, h) + aoff + m * 2048 + k * 1024); } while (0)
#define PG8_LDB(dst, b, h) do { _Pragma("unroll") for (int n = 0; n < 2; ++n) _Pragma("unroll") for (int k = 0; k < 2; ++k) dst[n][k] = *(const PG8_LAS bf16x8*)(lds + PG8_SB(b, h) + boff + n * 2048 + k * 1024); } while (0)
#define PG8_MMA(ai, bj, At, Bt) do { __builtin_amdgcn_s_setprio(1); _Pragma("unroll") for (int m = 0; m < 4; ++m) _Pragma("unroll") for (int n = 0; n < 2; ++n) _Pragma("unroll") for (int k = 0; k < 2; ++k) \
        acc[ai][bj][m][n] = __builtin_amdgcn_mfma_f32_16x16x32_bf16(Bt[n][k], At[m][k], acc[ai][bj][m][n], 0, 0, 0); __builtin_amdgcn_s_setprio(0); } while (0)
#define PG8_WAIT_V(n) asm volatile("s_waitcnt vmcnt(" #n ")" ::: "memory")
#define PG8_WAIT_L(n) asm volatile("s_waitcnt lgkmcnt(" #n ")" ::: "memory")
#define PG8_BAR __builtin_amdgcn_s_barrier()
#define PG8_SCHED __builtin_amdgcn_sched_barrier(0)
    Unit cur, nxt; int ui = 0;
    if (!S.next(0, cur)) return;
    f32x4 acc[2][2][4][2];
#pragma unroll
    for (int a = 0; a < 2; ++a)
#pragma unroll
        for (int b = 0; b < 2; ++b)
#pragma unroll
            for (int m = 0; m < 4; ++m)
#pragma unroll
                for (int n = 0; n < 2; ++n) acc[a][b][m][n] = (f32x4){0.f, 0.f, 0.f, 0.f};
    bf16x8 At[4][2], B0[2][2], B1[2][2];
    const char* cA = PG8_APTR(cur); const char* cB = PG8_BPTR(cur);
    S.a_ready(cur);
    if constexpr (SP2) {
        PG8_STAGE(PG8_SB(0, 0), cB, voffB); PG8_STAGE(PG8_SB(0, 1), cB + hstepB, voffB); PG8_STAGE(PG8_SA(0, 0), cA, voffA); PG8_STAGE(PG8_SA(0, 1), cA + hstepA, voffA);
        if (wr == 1) PG8_BAR;
        PG8_WAIT_V(2); PG8_BAR;
        PG8_STAGE(PG8_SB(1, 0), cB + kstep, voffB); PG8_STAGE(PG8_SA(1, 0), cA + kstep, voffA); PG8_STAGE(PG8_SB(1, 1), cB + hstepB + kstep, voffB);
        PG8_WAIT_V(6); PG8_BAR;
    } else {
        PG8_STAGE(PG8_SB(0, 0), cB, voffB); PG8_STAGE(PG8_SA(0, 0), cA, voffA); PG8_STAGE(PG8_SB(0, 1), cB + hstepB, voffB); PG8_STAGE(PG8_SA(0, 1), cA + hstepA, voffA);
        if (wr == 1) PG8_BAR;
        PG8_WAIT_V(4); PG8_BAR;
        PG8_STAGE(PG8_SB(1, 0), cB + kstep, voffB); PG8_STAGE(PG8_SA(1, 0), cA + kstep, voffA); PG8_STAGE(PG8_SB(1, 1), cB + hstepB + kstep, voffB);
        PG8_WAIT_V(6); PG8_BAR;
    }
    for (;;) {
        const bool has_next = S.next(ui + 1, nxt);
        const char* nA = has_next ? PG8_APTR(nxt) : cA; const char* nB = has_next ? PG8_BPTR(nxt) : cB;
        for (int t = 0; t < nt; t += 2) {
            const bool last = (t == nt - 2);
            const char* a1 = cA + (size_t)(t + 1) * kstep;
            const char* a2 = last ? nA : cA + (size_t)(t + 2) * kstep; const char* b2 = last ? nB : cB + (size_t)(t + 2) * kstep;
            const char* a3 = a2 + kstep; const char* b3 = b2 + kstep;
            if (last && has_next) S.a_ready(nxt);
            if constexpr (SP2) {
            PG8_LDB(B0, 0, 0); PG8_LDB(B1, 0, 1); PG8_SCHED; PG8_LDA(At, 0, 0); PG8_STAGE(PG8_SA(1, 1), a1 + hstepA, voffA);
            PG8_WAIT_V(8); PG8_WAIT_L(0); PG8_BAR; PG8_MMA(0, 0, At, B0); PG8_MMA(0, 1, At, B1); PG8_BAR; PG8_SCHED;
            PG8_LDA(At, 0, 1); PG8_STAGE(PG8_SB(0, 0), b2, voffB); PG8_STAGE(PG8_SB(0, 1), b2 + hstepB, voffB); PG8_STAGE(PG8_SA(0, 0), a2, voffA);
            PG8_WAIT_V(8); PG8_WAIT_L(0); PG8_BAR; PG8_MMA(1, 0, At, B0); PG8_MMA(1, 1, At, B1); PG8_BAR; PG8_SCHED;
            PG8_LDB(B0, 1, 0); PG8_LDB(B1, 1, 1); PG8_SCHED; PG8_LDA(At, 1, 0); PG8_STAGE(PG8_SA(0, 1), a2 + hstepA, voffA);
            PG8_WAIT_V(8); PG8_WAIT_L(0); PG8_BAR; PG8_MMA(0, 0, At, B0); PG8_MMA(0, 1, At, B1); PG8_BAR; PG8_SCHED;
            PG8_LDA(At, 1, 1); PG8_STAGE(PG8_SB(1, 0), b3, voffB); PG8_STAGE(PG8_SB(1, 1), b3 + hstepB, voffB); PG8_STAGE(PG8_SA(1, 0), a3, voffA);
            PG8_WAIT_V(8); PG8_WAIT_L(0); PG8_BAR; PG8_MMA(1, 0, At, B0); PG8_MMA(1, 1, At, B1); PG8_BAR; PG8_SCHED;
            } else {
            PG8_LDB(B0, 0, 0); PG8_SCHED; PG8_LDA(At, 0, 0); PG8_STAGE(PG8_SA(1, 1), a1 + hstepA, voffA);
            PG8_WAIT_L(8); PG8_BAR; PG8_WAIT_L(0); PG8_MMA(0, 0, At, B0); PG8_BAR; PG8_SCHED;
            PG8_LDB(B1, 0, 1); PG8_STAGE(PG8_SB(0, 0), b2, voffB);
            PG8_BAR; PG8_WAIT_L(0); PG8_MMA(0, 1, At, B1); PG8_BAR;
            PG8_LDA(At, 0, 1); PG8_STAGE(PG8_SA(0, 0), a2, voffA);
            PG8_BAR; PG8_WAIT_L(0); PG8_MMA(1, 0, At, B0); PG8_BAR; PG8_SCHED;
            PG8_STAGE(PG8_SB(0, 1), b2 + hstepB, voffB);
            PG8_WAIT_V(6); PG8_BAR; PG8_MMA(1, 1, At, B1); PG8_BAR;
            PG8_LDB(B0, 1, 0); PG8_SCHED; PG8_LDA(At, 1, 0); PG8_STAGE(PG8_SA(0, 1), a2 + hstepA, voffA);
            PG8_WAIT_L(8); PG8_BAR; PG8_WAIT_L(0); PG8_MMA(0, 0, At, B0); PG8_BAR; PG8_SCHED;
            PG8_LDB(B1, 1, 1); PG8_STAGE(PG8_SB(1, 0), b3, voffB);
            PG8_BAR; PG8_WAIT_L(0); PG8_MMA(0, 1, At, B1); PG8_BAR;
            PG8_LDA(At, 1, 1); PG8_STAGE(PG8_SA(1, 0), a3, voffA);
            PG8_BAR; PG8_WAIT_L(0); PG8_MMA(1, 0, At, B0); PG8_BAR; PG8_SCHED;
            PG8_STAGE(PG8_SB(1, 1), b3 + hstepB, voffB);
            PG8_WAIT_V(6); PG8_BAR; PG8_MMA(1, 1, At, B1); PG8_BAR;
            }
        }
        if constexpr (ALIGN_EPI) { if (wr == 0) PG8_BAR; }
        if constexpr (!Epi::AFTER_DRAIN) { E(acc, cur, wr, wc, fr, fq); S.done(cur); }
        if (!has_next) break;
#pragma unroll
        for (int a = 0; a < 2; ++a)
#pragma unroll
            for (int b = 0; b < 2; ++b)
#pragma unroll
                for (int m = 0; m < 4; ++m)
#pragma unroll
                    for (int n = 0; n < 2; ++n) acc[a][b][m][n] = (f32x4){0.f, 0.f, 0.f, 0.f};
        cur = nxt; cA = nA; cB = nB; ++ui;
        if constexpr (ALIGN_EPI) { if (wr == 1) PG8_BAR; }
    }
    PG8_WAIT_V(0);
    if constexpr (!ALIGN_EPI) { if (wr == 0) PG8_BAR; }
    PG8_BAR;
    if constexpr (Epi::AFTER_DRAIN) { E.fused(acc, cur, wr, wc, fr, fq, lds, wid, lane); S.done(cur); }
#undef PG8_APTR
#undef PG8_BPTR
#undef PG8_SA
#undef PG8_SB
#undef PG8_STAGE
#undef PG8_LDA
#undef PG8_LDB
#undef PG8_MMA
#undef PG8_WAIT_V
#undef PG8_WAIT_L
#undef PG8_BAR
#undef PG8_SCHED
}
}
namespace att {
typedef unsigned short bf16;
typedef short bf16x8 __attribute__((ext_vector_type(8)));
typedef short s16x4 __attribute__((ext_vector_type(4)));
typedef float f32x16 __attribute__((ext_vector_type(16)));
typedef unsigned u32x4 __attribute__((ext_vector_type(4)));
constexpr int NW = 8, QBLK = 32, KVBLK = 64;
constexpr int SHM_V = KVBLK * 128 * 2;
#define SBAR() __builtin_amdgcn_sched_barrier(0)
__device__ __forceinline__ int crow(int r, int hi) { return (r & 3) + 8 * (r >> 2) + 4 * hi; }
__device__ __forceinline__ unsigned cvtpk(float lo, float hi) { unsigned r; asm volatile("v_cvt_pk_bf16_f32 %0, %1, %2" : "=v"(r) : "v"(lo), "v"(hi)); return r; }

struct Args {
  const bf16* Q; const bf16* K; const bf16* K2; const bf16* V; bf16* O;
  int ldq, ldk, ldk2, ldv, ldo;
  int NT, nctx, ctx_row0, lat_row0;
  float C, thr_raw;
  int qpos0, kpos0;
  float sink_l2;
  int r0, klo;
  const float* rpb; float inv_scale;
};

__device__ __forceinline__ void partialSM(f32x16& p0, f32x16& p1, float& m_reg, float& mn, float& alpha, const float C, const float thr_raw) {
  float pmax = p0[0];
#pragma unroll
  for (int r = 1; r < 16; ++r) pmax = fmaxf(pmax, p0[r]);
#pragma unroll
  for (int r = 0; r < 16; ++r) pmax = fmaxf(pmax, p1[r]);
  { auto rr = __builtin_amdgcn_permlane32_swap(__float_as_uint(pmax), __float_as_uint(pmax), false, false);
    pmax = fmaxf(__uint_as_float(rr[0]), __uint_as_float(rr[1])); }
  if (__builtin_expect(__all(pmax - m_reg <= thr_raw), 1)) { mn = m_reg; alpha = 1.f; }
  else { mn = fmaxf(m_reg, pmax); alpha = __builtin_amdgcn_exp2f((m_reg - mn) * C); m_reg = mn; }
  const float mnC = -mn * C;
#pragma unroll
  for (int r = 0; r < 16; ++r) p0[r] = fmaf(p0[r], C, mnC);
#pragma unroll
  for (int r = 0; r < 16; ++r) p1[r] = fmaf(p1[r], C, mnC);
#pragma unroll
  for (int r = 0; r < 16; ++r) p0[r] = __builtin_amdgcn_exp2f(p0[r]);
}
__device__ __forceinline__ void finishSM(f32x16& p0, f32x16& p1, float alpha, float& l_reg, bf16x8& pa0, bf16x8& pa1, bf16x8& pa2, bf16x8& pa3) {
#pragma unroll
  for (int r = 0; r < 16; ++r) p1[r] = __builtin_amdgcn_exp2f(p1[r]);
  float ps = 0;
#pragma unroll
  for (int r = 0; r < 16; ++r) ps += p0[r];
#pragma unroll
  for (int r = 0; r < 16; ++r) ps += p1[r];
  { auto rr = __builtin_amdgcn_permlane32_swap(__float_as_uint(ps), __float_as_uint(ps), false, false);
    ps = __uint_as_float(rr[0]) + __uint_as_float(rr[1]); }
  l_reg = l_reg * alpha + ps;
#define PK4(P, BASE, OUT) do { unsigned a0 = cvtpk(P[BASE + 0], P[BASE + 1]), a1 = cvtpk(P[BASE + 2], P[BASE + 3]);   \
    unsigned b0 = cvtpk(P[BASE + 4], P[BASE + 5]), b1 = cvtpk(P[BASE + 6], P[BASE + 7]);                              \
    auto r0 = __builtin_amdgcn_permlane32_swap(a0, b0, false, false); auto r1 = __builtin_amdgcn_permlane32_swap(a1, b1, false, false); \
    u32x4 w = {r0[0], r1[0], r0[1], r1[1]}; OUT = *reinterpret_cast<bf16x8*>(&w); } while (0)
  PK4(p0, 0, pa0); PK4(p0, 8, pa1); PK4(p1, 0, pa2); PK4(p1, 8, pa3);
#undef PK4
}
template <int DQ> __device__ __forceinline__ int kswz(int row, int colB) { return row * (DQ * 2) + (colB ^ ((row & 7) << 4)); }
template <int DQ> __device__ __forceinline__ void qkt(f32x16& p0, f32x16& p1, const char* Ks, const bf16x8* qr, int r32, int hi) {
  p0 = f32x16{}; p1 = f32x16{};
#pragma unroll
  for (int d0 = 0; d0 < DQ / 16; ++d0) { const int cb = (d0 * 16 + hi * 8) * 2;
    const bf16x8 b0 = *reinterpret_cast<const bf16x8*>(Ks + kswz<DQ>(r32, cb));
    const bf16x8 b1 = *reinterpret_cast<const bf16x8*>(Ks + kswz<DQ>(32 + r32, cb));
    p0 = __builtin_amdgcn_mfma_f32_32x32x16_bf16(b0, qr[d0], p0, 0, 0, 0);
    p1 = __builtin_amdgcn_mfma_f32_32x32x16_bf16(b1, qr[d0], p1, 0, 0, 0); }
}
__device__ __forceinline__ int v_st(int k, int c) { const int kk = (k & ~0xC) | ((k & 4) << 1) | ((k & 8) >> 1); return ((kk >> 3) * 4 + (c >> 5)) * 512 + ((kk & 7) * 32 + (c & 31)) * 2; }
__device__ __forceinline__ int v_rd_base(int lane) { return ((lane & 3) << 3) | (((lane >> 2) & 3) << 6) | (((lane >> 4) & 1) << 5) | (((lane >> 5) & 1) << 8); }
constexpr int v_rd_off(int d0, int ks, int half) { return d0 * 512 + ks * 4096 + half * 2048; }
template <int OFF> __device__ __forceinline__ s16x4 tr_read(int vb) {
  s16x4 r; asm volatile("ds_read_b64_tr_b16 %0, %1 offset:%2" : "=&v"(r) : "v"(vb), "i"(OFF) : "memory"); return r;
}
template <int D0> __device__ __forceinline__ void pv_one(f32x16& od, int vb, bf16x8 pa0, bf16x8 pa1, bf16x8 pa2, bf16x8 pa3) {
  const s16x4 l0 = tr_read<v_rd_off(D0, 0, 0)>(vb), h0 = tr_read<v_rd_off(D0, 0, 1)>(vb), l1 = tr_read<v_rd_off(D0, 1, 0)>(vb), h1 = tr_read<v_rd_off(D0, 1, 1)>(vb);
  const s16x4 l2 = tr_read<v_rd_off(D0, 2, 0)>(vb), h2 = tr_read<v_rd_off(D0, 2, 1)>(vb), l3 = tr_read<v_rd_off(D0, 3, 0)>(vb), h3 = tr_read<v_rd_off(D0, 3, 1)>(vb);
  asm volatile("s_waitcnt lgkmcnt(0)" ::: "memory"); SBAR();
#define PK(L, H) (bf16x8){L[0], L[1], L[2], L[3], H[0], H[1], H[2], H[3]}
  od = __builtin_amdgcn_mfma_f32_32x32x16_bf16(pa0, PK(l0, h0), od, 0, 0, 0);
  od = __builtin_amdgcn_mfma_f32_32x32x16_bf16(pa1, PK(l1, h1), od, 0, 0, 0);
  od = __builtin_amdgcn_mfma_f32_32x32x16_bf16(pa2, PK(l2, h2), od, 0, 0, 0);
  od = __builtin_amdgcn_mfma_f32_32x32x16_bf16(pa3, PK(l3, h3), od, 0, 0, 0);
#undef PK
}
__device__ __forceinline__ void pv_d0(f32x16* o, int vb, bf16x8 pa0, bf16x8 pa1, bf16x8 pa2, bf16x8 pa3) {
  pv_one<0>(o[0], vb, pa0, pa1, pa2, pa3); pv_one<1>(o[1], vb, pa0, pa1, pa2, pa3); pv_one<2>(o[2], vb, pa0, pa1, pa2, pa3); pv_one<3>(o[3], vb, pa0, pa1, pa2, pa3);
}
template <int MODE> __device__ __forceinline__ void maskf(f32x16& p0, f32x16& p1, int t, const Args& a, int wid, int r32, int hi, const float* bias_lds) {
  if constexpr (MODE == 0) { return; }
  else {
    if (t < a.nctx) return;
    if constexpr (MODE == 1) {
      const int kb = a.kpos0 + (t - a.nctx) * 64, qw = a.qpos0 + wid * 32;
      if (kb + 63 - qw <= 128 && qw + 31 - kb <= 128) return;
      const int q = qw + r32;
#pragma unroll
      for (int r = 0; r < 16; ++r) { const int d0 = kb + crow(r, hi) - q, d1 = d0 + 32;
        if (d0 > 128 || d0 < -128) p0[r] = -1e30f;
        if (d1 > 128 || d1 < -128) p1[r] = -1e30f; }
    } else {
      const int kr = a.klo + (t - a.nctx), rq = a.r0 + (wid >> 1);
      const int rs = min(max(rq - 4, 0), 120);
      if (kr < rs || kr >= rs + 8) {
#pragma unroll
        for (int r = 0; r < 16; ++r) { p0[r] = -1e30f; p1[r] = -1e30f; }
        return; }
      const int c = (wid & 1) * 32 + r32, cs = min(max(c - 8, 0), 48);
      int cb = 4 * hi - c + 63, vb = 4 * hi - cs;
      asm volatile("" : "+v"(cb), "+v"(vb));
      const float* bp = bias_lds + (kr - rq + 7) * 128 + cb;
#pragma unroll
      for (int r = 0; r < 16; ++r) { const int k0 = (r & 3) + 8 * (r >> 2), k1 = k0 + 32;
        const float b0 = bp[k0], b1 = bp[k1];
        p0[r] = ((unsigned)(k0 + vb) < 16u) ? fmaf(b0, a.inv_scale, p0[r]) : -1e30f;
        p1[r] = ((unsigned)(k1 + vb) < 16u) ? fmaf(b1, a.inv_scale, p1[r]) : -1e30f;
        if ((r & 3) == 3) SBAR(); }
    }
  }
}

template <int DQ, int MODE>
__device__ __forceinline__ void attn_unit(const Args& a, char* lds, const int wave0) {
  constexpr int SHM_K = KVBLK * DQ * 2, NQ = DQ / 16, SDEPTH = (DQ == 192 || MODE == 2) ? 1 : 2;
  const int tid = fresh_tid(wave0), wid = tid >> 6, lane = tid & 63, r32 = lane & 31, hi = lane >> 5;
  char* V_lds = lds; char* K_lds = lds + 2 * SHM_V;
  float* ws = (float*)(lds + 2 * SHM_V + 2 * SHM_K) + wid * 64; float* li_l = ws; float* al_l = ws + 32;
  float* bias_l = (float*)(lds + 2 * SHM_V + 2 * SHM_K + 2048);
  if constexpr (MODE == 2) { if (tid < 465) bias_l[(tid / 31) * 128 + 48 + (tid % 31)] = a.rpb[tid]; }
  float m_reg = -1e30f, l_reg = 0; f32x16 o[4] = {}; bf16x8 qr[NQ];
  const float C = a.C, thr_raw = a.thr_raw;
  const bf16* Qw = a.Q + (long)(wid * QBLK + r32) * a.ldq + hi * 8;
#pragma unroll
  for (int d0 = 0; d0 < NQ; ++d0) qr[d0] = *reinterpret_cast<const bf16x8*>(Qw + d0 * 16);
  const int sr = tid >> 4, sc = (tid & 15) * 8, vst0 = v_st(sr, sc), vst1 = v_st(32 + sr, sc);
  const int sr2 = tid >> 3, sc2 = (tid & 7) * 8;
  const int vb0 = (int)(uintptr_t)V_lds + v_rd_base(lane);
  struct { bf16x8 vs0, vs1, ks0, ks1, ks2; } sr_[SDEPTH];
  const int vo0 = sr * a.ldv + sc, vo1 = (32 + sr) * a.ldv + sc, ko0 = sr * a.ldk + sc, ko1 = (32 + sr) * a.ldk + sc, ko2 = sr2 * a.ldk2 + sc2;
#define KROW(t) ((t) < a.nctx ? a.ctx_row0 + 64 * (t) : a.lat_row0 + 64 * ((t) - a.nctx))
#define SLOAD(i, t) do { const long kr_ = KROW(t); const bf16* vp_ = a.V + kr_ * a.ldv; const bf16* kp_ = a.K + kr_ * a.ldk; \
    sr_[i].vs0 = *reinterpret_cast<const bf16x8*>(vp_ + vo0); sr_[i].vs1 = *reinterpret_cast<const bf16x8*>(vp_ + vo1); \
    sr_[i].ks0 = *reinterpret_cast<const bf16x8*>(kp_ + ko0); sr_[i].ks1 = *reinterpret_cast<const bf16x8*>(kp_ + ko1); \
    if constexpr (DQ == 192) sr_[i].ks2 = *reinterpret_cast<const bf16x8*>(a.K2 + kr_ * a.ldk2 + ko2); } while (0)
#define SWRITE(b, i) do { *(bf16x8*)(V_lds + (b) * SHM_V + vst0) = sr_[i].vs0; *(bf16x8*)(V_lds + (b) * SHM_V + vst1) = sr_[i].vs1; \
    *(bf16x8*)(K_lds + (b) * SHM_K + kswz<DQ>(sr, sc * 2)) = sr_[i].ks0; *(bf16x8*)(K_lds + (b) * SHM_K + kswz<DQ>(32 + sr, sc * 2)) = sr_[i].ks1; \
    if constexpr (DQ == 192) *(bf16x8*)(K_lds + (b) * SHM_K + kswz<DQ>(sr2, 256 + sc2 * 2)) = sr_[i].ks2; } while (0)
#define SWAIT() do { if constexpr (SDEPTH == 1) asm volatile("s_waitcnt vmcnt(0)" ::: "memory"); else asm volatile("s_waitcnt vmcnt(4)" ::: "memory"); } while (0)
#define RESC(al) do { if (__any((al) < 1.f)) { if (hi == 0) al_l[r32] = (al); asm volatile("s_waitcnt lgkmcnt(0)" ::: "memory"); \
    _Pragma("unroll") for (int d = 0; d < 4; ++d) _Pragma("unroll") for (int r = 0; r < 16; ++r) o[d][r] *= al_l[crow(r, hi)]; } } while (0)
  f32x16 pA0, pA1, pB0, pB1; float mnA, mnB, alA, alB; bf16x8 pa0, pa1, pa2, pa3; const int NT = a.NT;
  constexpr int SE = 0, SO = SDEPTH - 1;
  SLOAD(SE, 0); asm volatile("s_waitcnt vmcnt(0)" ::: "memory"); SWRITE(0, SE); __syncthreads();
  qkt<DQ>(pA0, pA1, K_lds, qr, r32, hi); maskf<MODE>(pA0, pA1, 0, a, wid, r32, hi, bias_l); partialSM(pA0, pA1, m_reg, mnA, alA, C, thr_raw);
  SLOAD(SO, 1); if constexpr (SDEPTH == 2) { if (2 < NT) SLOAD(SE, 2); }
  SWAIT(); SWRITE(1, SO); __syncthreads();
  for (int j = 1; j + 1 < NT; j += 2) {
    SBAR(); qkt<DQ>(pB0, pB1, K_lds + SHM_K, qr, r32, hi); maskf<MODE>(pB0, pB1, j, a, wid, r32, hi, bias_l);
    finishSM(pA0, pA1, alA, l_reg, pa0, pa1, pa2, pa3); SBAR();
    SLOAD(SO, j + SDEPTH); SBAR();
    pv_d0(o, vb0, pa0, pa1, pa2, pa3); partialSM(pB0, pB1, m_reg, mnB, alB, C, thr_raw);
    __syncthreads(); SWAIT(); SWRITE(0, SE);
    RESC(alB); __syncthreads();
    SBAR(); qkt<DQ>(pA0, pA1, K_lds, qr, r32, hi); maskf<MODE>(pA0, pA1, j + 1, a, wid, r32, hi, bias_l);
    finishSM(pB0, pB1, alB, l_reg, pa0, pa1, pa2, pa3); SBAR();
    if (SDEPTH == 1 || j + 3 < NT) SLOAD(SE, j + 1 + SDEPTH); SBAR();
    pv_d0(o, vb0 + SHM_V, pa0, pa1, pa2, pa3); partialSM(pA0, pA1, m_reg, mnA, alA, C, thr_raw);
    __syncthreads(); SWAIT(); SWRITE(1, SO);
    RESC(alA); __syncthreads();
  }
  SBAR(); qkt<DQ>(pB0, pB1, K_lds + SHM_K, qr, r32, hi); maskf<MODE>(pB0, pB1, NT - 1, a, wid, r32, hi, bias_l);
  finishSM(pA0, pA1, alA, l_reg, pa0, pa1, pa2, pa3); SBAR();
  pv_d0(o, vb0, pa0, pa1, pa2, pa3); partialSM(pB0, pB1, m_reg, mnB, alB, C, thr_raw);
  __syncthreads(); RESC(alB);
  finishSM(pB0, pB1, alB, l_reg, pa0, pa1, pa2, pa3); SBAR();
  pv_d0(o, vb0 + SHM_V, pa0, pa1, pa2, pa3);
  if constexpr (MODE == 1) l_reg += __builtin_amdgcn_exp2f(a.sink_l2 - m_reg * C);
  if (hi == 0) li_l[r32] = l_reg; asm volatile("s_waitcnt lgkmcnt(0)" ::: "memory");
  float rli[16];
#pragma unroll
  for (int r = 0; r < 16; ++r) rli[r] = __builtin_amdgcn_rcpf(li_l[crow(r, hi)]);
  bf16* Ow = a.O + (long)(wid * QBLK) * a.ldo;
#pragma unroll
  for (int r = 0; r < 16; ++r) { const int orow = crow(r, hi);
#pragma unroll
    for (int d0 = 0; d0 < 4; ++d0) { const float v = o[d0][r] * rli[r]; unsigned u = __float_as_uint(v); u = (u + 0x7fffu + ((u >> 16) & 1u)) >> 16; Ow[(long)orow * a.ldo + d0 * 32 + r32] = (bf16)u; } }
  __syncthreads();
#undef KROW
#undef SLOAD
#undef SWRITE
#undef SWAIT
#undef RESC
}
#undef SBAR
}
#define LAS __attribute__((address_space(3)))
typedef unsigned short bf16;
typedef float f32x4 __attribute__((ext_vector_type(4)));
typedef unsigned v4u __attribute__((ext_vector_type(4)));
typedef unsigned v2u __attribute__((ext_vector_type(2)));
constexpr int NWAVES = 8, NTHR = 512;
constexpr int DM = 2048, SEQ = 8192, NCTX = 256, MLAT = 2 * SEQ, MALL = MLAT + 2 * NCTX, DFF = 5632;
constexpr int N_IN0 = 2816, N_IN1 = 4608, N_UQ = 1536, N_UKV = 2048, N_GU = 2 * DFF;
constexpr float EPS = 1e-6f;
constexpr size_t MiB = 1u << 20;
constexpr size_t WS_MOD = 0, WS_BAR = 512 * 1024, BAR_BYTES = 16384;
constexpr size_t WS_WIN0 = 1 * MiB, WS_WUQ = WS_WIN0 + 11 * MiB, WS_WUKV = WS_WUQ + 2 * MiB, WS_WOUT0 = WS_WUKV + 2 * MiB, WS_WIN1 = WS_WOUT0 + 8 * MiB, WS_WOUT1 = WS_WIN1 + 18 * MiB,
                 WS_WGU = WS_WOUT1 + 8 * MiB, WS_WD = WS_WGU + 88 * MiB, WS_HCTX = WS_WD + 44 * MiB;
constexpr size_t WS_UO = WS_HCTX + 4 * MiB;
constexpr size_t WS_OB = WS_UO + 66 * MiB;
constexpr size_t WS_BIG = WS_UO + 132 * MiB;
constexpr size_t WS_QB = WS_BIG + 91 * MiB, WS_KVB = WS_BIG + 141 * MiB, WS_UB = WS_BIG + 149 * MiB, WS_END = WS_BIG + 215 * MiB;
static_assert((size_t)MALL * DM * 2 == 66 * MiB && (size_t)MALL * N_IN0 * 2 <= 91 * MiB && (size_t)MALL * N_UQ * 2 <= 50 * MiB && (size_t)MALL * N_IN1 * 2 <= 149 * MiB && (size_t)MALL * DFF * 2 <= 215 * MiB, "ws map");

__device__ __forceinline__ unsigned f2bf(float f) { unsigned u = __builtin_bit_cast(unsigned, f); return (u + 0x7fffu + ((u >> 16) & 1u)) >> 16; }
__device__ __forceinline__ unsigned pk2(float lo, float hi) { return f2bf(lo) | (f2bf(hi) << 16); }
__device__ __forceinline__ float bf2f(bf16 v) { return __uint_as_float(((unsigned)v) << 16); }
__device__ __forceinline__ float wave_sum(float v, int lane) {
#pragma unroll
    for (int o = 1; o < 64; o <<= 1) v += __int_as_float(__builtin_amdgcn_ds_bpermute((lane ^ o) << 2, __float_as_int(v)));
    return v;
}
__device__ __forceinline__ float silu_f(float x) { return x / (1.0f + __expf(-x)); }

#define GAS __attribute__((address_space(1)))
#define XB_TMO      128
#define XB_XCNT(j)  (256  + 64 * (j))
#define XB_XSUB(j)  (1280 + 64 * (j))
#define XB_XGEN(j)  (2304 + 64 * (j))
#define XB_TOP      3328
#define XB_TOPGEN   3392
#define XCD_BAR_WORDS 3456
#define XB_SPIN_CAP (1u << 18)

__device__ __forceinline__ unsigned xb_ld(unsigned* p)              { return __hip_atomic_load(p, __ATOMIC_RELAXED, __HIP_MEMORY_SCOPE_AGENT); }
__device__ __forceinline__ unsigned xb_add(unsigned* p, unsigned v) { return __hip_atomic_fetch_add(p, v, __ATOMIC_RELAXED, __HIP_MEMORY_SCOPE_AGENT); }
__device__ __forceinline__ unsigned xb_xcc_id() { return (unsigned)__builtin_amdgcn_s_getreg((3 << 11) | 20) & 0xFu; }
#define XB_SPIN(cond, bar) do { unsigned _sp = 0; while (cond) { __builtin_amdgcn_s_sleep(1); \
    if ((++_sp & 255u) == 0u) { if (xb_ld(&(bar)[XB_TMO])) break; if (_sp > XB_SPIN_CAP) { atomicAdd(&(bar)[XB_TMO], 1u); break; } } } } while (0)

struct XcdBarrier {
    unsigned* bar; unsigned x;
    volatile LAS unsigned* st;
};

__device__ __forceinline__ XcdBarrier xcd_barrier_post(unsigned* bar, volatile LAS unsigned* st) {
    XcdBarrier b; b.bar = bar; b.x = xb_xcc_id(); b.st = st;
    if (threadIdx.x == 0) (void)xb_add(&bar[XB_XCNT(b.x)], 1u);
    return b;
}
__device__ __forceinline__ void xcd_barrier_complete(unsigned* bar, unsigned x, unsigned& nloc, unsigned& nx) {
    const unsigned G = gridDim.x * gridDim.y * gridDim.z;
    unsigned sum, cnt, mine, sp = 0u;
    for (;;) {
        sum = 0u; cnt = 0u; mine = 0u;
#pragma unroll
        for (unsigned j = 0; j < 16; ++j) { const unsigned c = xb_ld(&bar[XB_XCNT(j)]); sum += c; cnt += (c > 0u) ? 1u : 0u; mine = (j == x) ? c : mine; }
        if (sum == G) break;
        __builtin_amdgcn_s_sleep(1);
        if ((++sp & 255u) == 0u) { if (xb_ld(&bar[XB_TMO])) break; if (sp > XB_SPIN_CAP) { atomicAdd(&bar[XB_TMO], 1u); break; } }
    }
    nloc = mine > 0u ? mine : 1u; nx = cnt > 0u ? cnt : 1u;
}

__device__ __forceinline__ void xcd_barrier(const XcdBarrier& b) {
    asm volatile("s_waitcnt vmcnt(0)" ::: "memory");
    __syncthreads();
    if (threadIdx.x == 0) {
        unsigned* bar = b.bar;
        __builtin_amdgcn_s_waitcnt(0);
        unsigned nloc = b.st[0], nx = b.st[1];
        if (nloc == 0u) { xcd_barrier_complete(bar, b.x, nloc, nx); b.st[0] = nloc; b.st[1] = nx; }
        const unsigned old = xb_add(&bar[XB_XSUB(b.x)], 1u);
        const unsigned gen = old / nloc;
        if (old + 1u == (gen + 1u) * nloc) {
            __builtin_amdgcn_fence(__ATOMIC_RELEASE, "agent");
            asm volatile("s_waitcnt vmcnt(0)" ::: "memory");
            const unsigned og = xb_add(&bar[XB_TOP], 1u);
            const unsigned tg = og / nx;
            if (og + 1u == (tg + 1u) * nx) xb_add(&bar[XB_TOPGEN], 1u);
            else XB_SPIN(xb_ld(&bar[XB_TOPGEN]) == tg, bar);
            __builtin_amdgcn_fence(__ATOMIC_ACQUIRE, "agent");
            xb_add(&bar[XB_XGEN(b.x)], 1u);
            asm volatile("s_waitcnt vmcnt(0)" ::: "memory");
        } else {
            XB_SPIN(xb_ld(&bar[XB_XGEN(b.x)]) == gen, bar);
            __builtin_amdgcn_fence(__ATOMIC_ACQUIRE, "agent");
            asm volatile("s_waitcnt vmcnt(0)" ::: "memory");
        }
    }
    __syncthreads();
}

struct KArgs { const float* in[29]; float* out; unsigned char* ws; };
typedef const __attribute__((address_space(4))) KArgs* KAP;
__device__ __forceinline__ KAP kargs() { KAP p = (KAP)__builtin_amdgcn_kernarg_segment_ptr(); asm volatile("" : "+s"(p)); return p; }

__device__ __forceinline__ void transpose_item(const float* W, int K, int N, bf16* WT, int k0, int n0, int drow0, LAS float* scr, int lane) {
#pragma unroll 8
    for (int i = 0; i < 32; ++i) { const int kk = 2 * i + (lane >> 5); scr[kk * 33 + (lane & 31)] = W[(size_t)(k0 + kk) * N + n0 + (lane & 31)]; }
    asm volatile("s_waitcnt lgkmcnt(0)" ::: "memory");
    const int c = lane & 7;
#pragma unroll
    for (int j = 0; j < 4; ++j) { const int n = (lane >> 3) + 8 * j; const LAS float* s = scr + (8 * c) * 33 + n;
        v4u o; o.x = pk2(s[0 * 33], s[1 * 33]); o.y = pk2(s[2 * 33], s[3 * 33]); o.z = pk2(s[4 * 33], s[5 * 33]); o.w = pk2(s[6 * 33], s[7 * 33]);
        *(v4u*)(WT + (size_t)(drow0 + n) * K + k0 + 8 * c) = o; }
    asm volatile("s_waitcnt lgkmcnt(0)" ::: "memory");
}
__device__ __forceinline__ bool conv_matrix(int& it, const float* W, int K, int N, bf16* WT, int mode, LAS float* scr, int lane) {
    const int nblk = N / 32, items = (K / 64) * nblk;
    if (it >= items) { it -= items; return false; }
    const int kb = it / nblk, nb = it % nblk, n0 = 32 * nb;
    const int drow0 = mode == 0 ? n0 : ((n0 >> 7) * 256 + (mode == 2 ? 128 : 0) + (n0 & 127));
    transpose_item(W, K, N, WT, 64 * kb, n0, drow0, scr, lane);
    return true;
}
__device__ __forceinline__ void p0_weights(KAP a, LAS unsigned char* lds, int gw, int NGW, int wave, int lane) {
    LAS float* scr = (LAS float*)(lds + wave * 8704);
    unsigned char* ws = a->ws;
    constexpr int I_TOTAL = (2048 / 64) * (2624 / 32) + (512 / 64) * (1536 / 32) + (512 / 64) * (2048 / 32) + 2 * (2048 / 64) * (2048 / 32) + (2048 / 64) * (4608 / 32)
                          + 4 * (2048 / 64) * (DFF / 32) + 2 * (DFF / 64) * (2048 / 32);
    for (int item = gw; item < I_TOTAL; item += NGW) {
        int it = item;
        if (conv_matrix(it, a->in[13], 2048, 2624, (bf16*)(ws + WS_WIN0), 0, scr, lane)) continue;
        if (conv_matrix(it, a->in[19], 512, 1536, (bf16*)(ws + WS_WUQ), 0, scr, lane)) continue;
        if (conv_matrix(it, a->in[20], 512, 2048, (bf16*)(ws + WS_WUKV), 0, scr, lane)) continue;
        if (conv_matrix(it, a->in[14], 2048, 2048, (bf16*)(ws + WS_WOUT0), 0, scr, lane)) continue;
        if (conv_matrix(it, a->in[21], 2048, 4608, (bf16*)(ws + WS_WIN1), 0, scr, lane)) continue;
        if (conv_matrix(it, a->in[22], 2048, 2048, (bf16*)(ws + WS_WOUT1), 0, scr, lane)) continue;
        if (conv_matrix(it, a->in[10], 2048, DFF, (bf16*)(ws + WS_WGU), 1, scr, lane)) continue;
        if (conv_matrix(it, a->in[10] + (size_t)2048 * DFF, 2048, DFF, (bf16*)(ws + WS_WGU + 44 * MiB), 1, scr, lane)) continue;
        if (conv_matrix(it, a->in[11], 2048, DFF, (bf16*)(ws + WS_WGU), 2, scr, lane)) continue;
        if (conv_matrix(it, a->in[11] + (size_t)2048 * DFF, 2048, DFF, (bf16*)(ws + WS_WGU + 44 * MiB), 2, scr, lane)) continue;
        if (conv_matrix(it, a->in[12], DFF, 2048, (bf16*)(ws + WS_WD), 0, scr, lane)) continue;
        conv_matrix(it, a->in[12] + (size_t)2048 * DFF, DFF, 2048, (bf16*)(ws + WS_WD + 22 * MiB), 0, scr, lane);
    }
}
__device__ __forceinline__ void p0_mod(KAP a, LAS unsigned char* lds, int tid) {
    LAS float* sv = (LAS float*)lds;
    LAS float* red = (LAS float*)(lds + 24576);
    const int blk = blockIdx.x; if (blk >= 256) return;
    const int layer = blk >> 7, col0 = (blk & 127) * 96;
    for (int i = tid; i < 3 * 2048; i += NTHR) { const int v = i >> 11, k = i & 2047; const float x = v < 2 ? a->in[1][v * 2048 + k] : a->in[3][k]; sv[i] = silu_f(x); }
    __syncthreads();
    const int c4 = tid % 24, ks = tid / 24;
    if (ks < 21) {
        const float* W = a->in[4] + (size_t)layer * 2048 * 12288 + col0 + 4 * c4;
        f32x4 a0 = {0, 0, 0, 0}, a1 = a0, a2 = a0;
#pragma unroll 4
        for (int k = ks; k < 2048; k += 21) { const f32x4 w = *(const f32x4*)(W + (size_t)k * 12288); a0 += w * sv[k]; a1 += w * sv[2048 + k]; a2 += w * sv[4096 + k]; }
        LAS float* r = red + ks * 288 + 4 * c4;
        *(LAS f32x4*)(r) = a0; *(LAS f32x4*)(r + 96) = a1; *(LAS f32x4*)(r + 192) = a2;
    }
    __syncthreads();
    if (tid < 288) { float s = 0.f;
        for (int q = 0; q < 21; ++q) s += red[q * 288 + tid];
        const int v = tid / 96, j = tid % 96;
        ((float*)(a->ws + WS_MOD))[(size_t)(layer * 3 + v) * 12288 + col0 + j] = s + a->in[5][layer * 12288 + col0 + j]; }
    __syncthreads();
}
__device__ __forceinline__ void store_u(bf16* urow, int lane, const f32x4 (&v)[8], float rstd, const float* g, const float* sh, const float* sc) {
#pragma unroll
    for (int j = 0; j < 8; ++j) { const int ci = 256 * j + 4 * lane; const f32x4 g4 = *(const f32x4*)(g + ci), s4 = *(const f32x4*)(sc + ci), h4 = *(const f32x4*)(sh + ci);
        const f32x4 t = (v[j] * rstd * g4) * (1.0f + s4) + h4; v2u w; w.x = pk2(t[0], t[1]); w.y = pk2(t[2], t[3]); *(v2u*)(urow + ci) = w; }
}
__device__ __forceinline__ void pass_pre(const float* hlat, const float* hctx, const float* g, const float* mod, int sh_off, int sc_off, bf16* U, int nrows, int gw, int NGW, int lane) {
    for (int m = gw; m < nrows; m += NGW) {
        const float* src = m < MLAT ? hlat + (size_t)m * DM : hctx + (size_t)(m - MLAT) * DM; const float* mv = mod + (m < MLAT ? (m >> 13) : 2) * 12288;
        f32x4 v[8]; float ss = 0.f;
#pragma unroll
        for (int j = 0; j < 8; ++j) { v[j] = *(const f32x4*)(src + 256 * j + 4 * lane); ss += (v[j][0] * v[j][0] + v[j][1] * v[j][1]) + (v[j][2] * v[j][2] + v[j][3] * v[j][3]); }
        const float rstd = rsqrtf(wave_sum(ss, lane) * (1.0f / DM) + EPS);
        store_u(U + (size_t)m * DM, lane, v, rstd, g, mv + sh_off, mv + sc_off);
    }
}
__device__ __forceinline__ void pass_post(const bf16* o16, const float* opart, const float* hlat, const float* hctx, float* olat, float* octx, const float* gpost, const float* mod, int gt_off,
                                          const float* gpre, const float* modu, int sh_off, int sc_off, bf16* U, int nrows, int gw, int NGW, int lane) {
    for (int m0 = gw; m0 < nrows; m0 += 2 * NGW) {
        int mr[2]; mr[0] = m0; mr[1] = m0 + NGW; const bool two = mr[1] < nrows; if (!two) mr[1] = m0;
        f32x4 v[2][8], hh[2][8]; float ss[2];
#pragma unroll
        for (int r = 0; r < 2; ++r) { const int m = mr[r]; ss[r] = 0.f;
            const float* hs = m < MLAT ? hlat + (size_t)m * DM : hctx + (size_t)(m - MLAT) * DM;
            if (m < MLAT) { const bf16* orow = o16 + (size_t)m * DM;
#pragma unroll
                for (int j = 0; j < 8; ++j) { const v2u raw = *(const v2u*)(orow + 256 * j + 4 * lane);
                    v[r][j] = (f32x4){__uint_as_float(raw.x << 16), __uint_as_float(raw.x & 0xffff0000u), __uint_as_float(raw.y << 16), __uint_as_float(raw.y & 0xffff0000u)}; }
            } else { const float* orow = opart + (size_t)(m - MLAT) * DM;
#pragma unroll
                for (int j = 0; j < 8; ++j) { const int ci = 256 * j + 4 * lane;
                    v[r][j] = (*(const f32x4*)(orow + ci) + *(const f32x4*)(orow + ci + (size_t)512 * DM)) + (*(const f32x4*)(orow + ci + (size_t)1024 * DM) + *(const f32x4*)(orow + ci + (size_t)1536 * DM)); } }
#pragma unroll
            for (int j = 0; j < 8; ++j) hh[r][j] = *(const f32x4*)(hs + 256 * j + 4 * lane);
        }
#pragma unroll
        for (int r = 0; r < 2; ++r)
#pragma unroll
            for (int j = 0; j < 8; ++j) ss[r] += (v[r][j][0] * v[r][j][0] + v[r][j][1] * v[r][j][1]) + (v[r][j][2] * v[r][j][2] + v[r][j][3] * v[r][j][3]);
#pragma unroll
        for (int r = 0; r < 2; ++r) { const int m = mr[r]; if (r == 1 && !two) break;
            float* hd = m < MLAT ? olat + (size_t)m * DM : octx + (size_t)(m - MLAT) * DM; const int vi = (m < MLAT ? (m >> 13) : 2); const float* mv = mod + vi * 12288;
            const float rstd = rsqrtf(wave_sum(ss[r], lane) * (1.0f / DM) + EPS); float s2 = 0.f;
#pragma unroll
            for (int j = 0; j < 8; ++j) { const int ci = 256 * j + 4 * lane; const f32x4 g4 = *(const f32x4*)(gpost + ci), t4 = *(const f32x4*)(mv + gt_off + ci);
                const f32x4 nv = hh[r][j] + t4 * (v[r][j] * rstd * g4); v[r][j] = nv; *(f32x4*)(hd + ci) = nv; s2 += (nv[0] * nv[0] + nv[1] * nv[1]) + (nv[2] * nv[2] + nv[3] * nv[3]); }
            if (U) { const float* mu = modu + vi * 12288; const float rstd2 = rsqrtf(wave_sum(s2, lane) * (1.0f / DM) + EPS); store_u(U + (size_t)m * DM, lane, v[r], rstd2, gpre, mu + sh_off, mu + sc_off); }
        }
    }
}
__device__ __forceinline__ void rope_cs(float pos, int j, float inv_nf, float& cs, float& sn) {
    const float inv_freq = __builtin_amdgcn_exp2f(-(float)j * inv_nf * 13.287712379549449f);
    float rev = pos * inv_freq * 0.15915494309189535f; rev -= rintf(rev);
    sn = __builtin_amdgcn_sinf(rev); cs = __builtin_amdgcn_cosf(rev);
}
template <int NH> __device__ __forceinline__ void heads_load(const bf16* base, int ia, float (&x)[NH], float (&y)[NH]) {
#pragma unroll
    for (int h = 0; h < NH; ++h) { x[h] = bf2f(base[h * 128 + ia]); y[h] = bf2f(base[h * 128 + ia + 32]); }
}
template <int NH> __device__ __forceinline__ void heads_finish(bf16* base, int ia, float (&x)[NH], float (&y)[NH], const float* gain, bool rope, float cs, float sn, int lane) {
    const float ga = gain[ia], gb = gain[ia + 32];
#pragma unroll
    for (int h = 0; h < NH; ++h) {
        const float rstd = rsqrtf(wave_sum(x[h] * x[h] + y[h] * y[h], lane) * (1.0f / 128.0f) + EPS);
        float a = x[h] * rstd * ga, b = y[h] * rstd * gb;
        if (rope) { const float na = a * cs - b * sn, nb = b * cs + a * sn; a = na; b = nb; }
        base[h * 128 + ia] = (bf16)f2bf(a); base[h * 128 + ia + 32] = (bf16)f2bf(b); }
}
__device__ __forceinline__ void unpack8(const v4u raw, float (&x)[8]) {
#pragma unroll
    for (int i = 0; i < 4; ++i) { x[2 * i] = __uint_as_float(raw[i] << 16); x[2 * i + 1] = __uint_as_float(raw[i] & 0xffff0000u); }
}
__device__ __forceinline__ void norm512_finish(bf16* p, const float (&x)[8], const float* gain, int lane) {
    float ss = 0.f;
#pragma unroll
    for (int i = 0; i < 8; ++i) ss += x[i] * x[i];
    const float rstd = rsqrtf(wave_sum(ss, lane) * (1.0f / 512.0f) + EPS);
    const f32x4 g0 = *(const f32x4*)(gain + 8 * lane), g1 = *(const f32x4*)(gain + 8 * lane + 4);
    v4u w; w.x = pk2(x[0] * rstd * g0[0], x[1] * rstd * g0[1]); w.y = pk2(x[2] * rstd * g0[2], x[3] * rstd * g0[3]); w.z = pk2(x[4] * rstd * g1[0], x[5] * rstd * g1[1]); w.w = pk2(x[6] * rstd * g1[2], x[7] * rstd * g1[3]);
    *(v4u*)(p + 8 * lane) = w;
}
__device__ __forceinline__ void rope64(bf16* p, float prow, float pcol, int l32) {
    const int j = l32 & 15, s = (l32 >> 4) & 1, ia = 32 * s + j, ib = ia + 16;
    const float x = bf2f(p[ia]), y = bf2f(p[ib]); float cs, sn; rope_cs(s ? pcol : prow, j, 1.0f / 16.0f, cs, sn);
    p[ia] = (bf16)f2bf(x * cs - y * sn); p[ib] = (bf16)f2bf(y * cs + x * sn);
}
__device__ __forceinline__ void prep_ab(bf16* P, const float* aqn, const float* akn, const float* bqn, const float* bkvn, int gw, int NGW, int lane) {
    const int ia = 64 * (lane >> 5) + (lane & 31);
    for (int m = gw; m < MALL; m += NGW) {
        bf16* row = P + (size_t)m * N_IN0; const bool lat = m < MLAT; const int t = m & (SEQ - 1); const float pr = (float)(t >> 6), pc = (float)(t & 63);
        float xq[8], yq[8], xk[2], yk[2], c1[8], c2[8];
        heads_load<8>(row, ia, xq, yq); heads_load<2>(row + 1024, ia, xk, yk);
        unpack8(*(const v4u*)(row + 1536 + 8 * lane), c1); unpack8(*(const v4u*)(row + 2048 + 8 * lane), c2);
        if (lat && lane < 32) rope64(row + 2560, pr, pc, lane);
        float cs = 1.f, sn = 0.f; if (lat) rope_cs((lane >> 5) ? pc : pr, lane & 31, 1.0f / 32.0f, cs, sn);
        heads_finish<8>(row, ia, xq, yq, aqn, lat, cs, sn, lane); heads_finish<2>(row + 1024, ia, xk, yk, akn, lat, cs, sn, lane);
        norm512_finish(row + 1536, c1, bqn, lane); norm512_finish(row + 2048, c2, bkvn, lane);
    }
}
__device__ __forceinline__ void prep_qb(bf16* QB, int gw, int NGW, int lane) {
    for (int m = gw; m < MLAT; m += NGW) {
        bf16* row = QB + (size_t)m * N_UQ; const int t = m & (SEQ - 1); const float pr = (float)(t >> 6), pc = (float)(t & 63);
#pragma unroll
        for (int i = 0; i < 4; ++i) rope64(row + (2 * i + (lane >> 5)) * 192 + 128, pr, pc, lane & 31);
    }
}
__device__ __forceinline__ void prep_cd(bf16* P, const float* cqn, const float* ckn, const float* dqn, const float* dkn, int gw, int NGW, int lane) {
    const int ia = 64 * (lane >> 5) + (lane & 31);
    for (int m = gw; m < MALL; m += NGW) {
        bf16* row = P + (size_t)m * N_IN1; const bool lat = m < MLAT; const int t = m & (SEQ - 1); const float pr = (float)(t >> 6), pc = (float)(t & 63);
        float cs = 1.f, sn = 0.f; if (lat) rope_cs((lane >> 5) ? pc : pr, lane & 31, 1.0f / 32.0f, cs, sn);
        float xk[2], yk[2], xd[8], yd[8];
        heads_load<2>(row + 1024, ia, xk, yk); heads_load<8>(row + 2560, ia, xd, yd);
        if (lat) {
            float xq[8], yq[8], xe[8], ye[8];
            heads_load<8>(row, ia, xq, yq); heads_load<8>(row + 1536, ia, xe, ye);
            heads_finish<8>(row, ia, xq, yq, cqn, true, cs, sn, lane); heads_finish<8>(row + 1536, ia, xe, ye, dqn, false, 1.f, 0.f, lane);
        }
        heads_finish<2>(row + 1024, ia, xk, yk, ckn, lat, cs, sn, lane); heads_finish<8>(row + 2560, ia, xd, yd, dkn, false, 1.f, 0.f, lane);
    }
}
constexpr float LOG2E = 1.4426950408889634f;
__device__ __forceinline__ void attn_phase_ab(const bf16* P0, const bf16* QB, const bf16* KVB, bf16* OB, char* lds, const int wave0) {
    const int c = blockIdx.x, G = gridDim.x;
    for (int id = c; id < 1024 + 32; id += G) {
        att::Args a{};
        int mixer, b, h, qrow0, NT;
        if (id < 1024) { const int rnd = id >> 8, cc = id & 255; mixer = rnd >> 1; b = rnd & 1; h = cc & 7; qrow0 = b * SEQ + (cc >> 3) * 256; NT = 132; }
        else { const int cc = id - 1024; mixer = cc >> 4; b = (cc >> 3) & 1; h = cc & 7; qrow0 = MLAT + b * NCTX; NT = 4; }
        a.NT = NT; a.nctx = 4; a.ctx_row0 = MLAT + b * NCTX; a.lat_row0 = b * SEQ; a.ldo = DM;
        if (mixer == 0) {
            a.Q = P0 + (size_t)qrow0 * N_IN0 + h * 128; a.ldq = N_IN0; a.K = P0 + 1024 + (h >> 2) * 128; a.ldk = N_IN0; a.K2 = nullptr; a.ldk2 = 0; a.V = P0 + 1280 + (h >> 2) * 128; a.ldv = N_IN0;
            a.O = OB + (size_t)qrow0 * DM + h * 128; const float scale = 0.08838834764831845f; a.C = scale * LOG2E; a.thr_raw = 8.0f / scale;

#ifndef DIS_A
            att::attn_unit<128, 0>(a, lds, wave0);
#endif

        } else {
            a.Q = QB + (size_t)qrow0 * N_UQ + h * 192; a.ldq = N_UQ; a.K = KVB + h * 256; a.ldk = N_UKV; a.K2 = P0 + 2560; a.ldk2 = N_IN0; a.V = KVB + h * 256 + 128; a.ldv = N_UKV;
            a.O = OB + (size_t)qrow0 * DM + 1024 + h * 128; const float scale = 0.07216878364870322f; a.C = scale * LOG2E; a.thr_raw = 8.0f / scale;

#ifndef DIS_B
            att::attn_unit<192, 0>(a, lds, wave0);
#endif

        }
    }
}
__device__ __forceinline__ void attn_phase_cd(const bf16* P1, bf16* OB, const float* sink, const float* rpb, char* lds, const int wave0) {
    const int c = blockIdx.x, G = gridDim.x;
    for (int id = c; id < 1024; id += G) {
        att::Args a{};
        const int rnd = id >> 8, cc = id & 255, mixer = rnd >> 1, b = rnd & 1, h = cc & 7, qb = cc >> 3, qrow0 = b * SEQ + qb * 256;
        a.nctx = 4; a.ctx_row0 = MLAT + b * NCTX; a.ldo = DM; a.ldq = a.ldk = a.ldv = N_IN1; a.K2 = nullptr; a.ldk2 = 0;
        const float scale = 0.08838834764831845f; a.C = scale * LOG2E; a.thr_raw = 8.0f / scale; a.inv_scale = 1.0f / scale;
        if (mixer == 0) {
            const int kbase = min(max(qb * 256 - 128, 0), SEQ - 512);
            a.NT = 12; a.lat_row0 = b * SEQ + kbase; a.qpos0 = qb * 256; a.kpos0 = kbase; a.sink_l2 = sink[h] * LOG2E;
            a.Q = P1 + (size_t)qrow0 * N_IN1 + h * 128; a.K = P1 + 1024 + (h >> 2) * 128; a.V = P1 + 1280 + (h >> 2) * 128; a.O = OB + (size_t)qrow0 * DM + h * 128;

#ifndef DIS_C
            att::attn_unit<128, 1>(a, lds, wave0);
#endif

        } else {
            const int r0 = qb * 4, klo = min(max(r0 - 4, 0), 116);
            a.NT = 16; a.lat_row0 = b * SEQ + klo * 64; a.r0 = r0; a.klo = klo; a.rpb = rpb + h * (15 * 31);
            a.Q = P1 + (size_t)qrow0 * N_IN1 + 1536 + h * 128; a.K = P1 + 2560 + h * 128; a.V = P1 + 3584 + h * 128; a.O = OB + (size_t)qrow0 * DM + 1024 + h * 128;

#ifndef DIS_D
            att::attn_unit<128, 2>(a, lds, wave0);
#endif

        }
    }
}

__global__ void __launch_bounds__(NTHR, 2) fwd_megakernel(KArgs args) {
    extern __shared__ __attribute__((aligned(16))) unsigned char lds[];
    cg::grid_group grid = cg::this_grid();
    LAS unsigned char* ldsl = (LAS unsigned char*)lds;
    const int wave0 = __builtin_amdgcn_readfirstlane(threadIdx.x >> 6);
    const int G = gridDim.x, NGW = G * NWAVES;
#define PHASE_IDS() const int tid = fresh_tid(wave0); const int lane = tid & 63, wave = __builtin_amdgcn_readfirstlane(tid >> 6), gw = blockIdx.x * NWAVES + wave; (void)wave; (void)gw; (void)lane
#define WSB (kargs()->ws)
#define x_ (kargs()->in[0])
#define ctx_ (kargs()->in[2])
#define out_ (kargs()->out)
#define hctx_ ((float*)(WSB + WS_HCTX))
#define MOD_ ((const float*)(WSB + WS_MOD))
#define UA_ ((bf16*)(WSB + WS_UO))
#define OB_ ((bf16*)(WSB + WS_OB))
#define FB_ ((bf16*)(WSB + WS_UO))
#define FP_ ((float*)(WSB + WS_UO + 64 * MiB))
#define OFB_ ((bf16*)(WSB + WS_BIG))
#define OFP_ ((float*)(WSB + WS_BIG + 128 * MiB))
#define PB_ ((bf16*)(WSB + WS_BIG))
#define OF_ ((float*)(WSB + WS_BIG))
#define ACT_ ((bf16*)(WSB + WS_BIG))
#define QB_ ((bf16*)(WSB + WS_QB))
#define KVB_ ((bf16*)(WSB + WS_KVB))
#define UB_ ((bf16*)(WSB + WS_UB))
#ifndef PROBE_G
#define PROBE_G 1
#endif
#ifndef PROBE_A
#define PROBE_A 1
#endif
#ifndef PROBE_S
#define PROBE_S 1
#endif
#define GSYNC() do { for (int s_ = 0; s_ < PROBE_S; ++s_) { xcd_barrier(bar); } } while (0)
    volatile LAS unsigned* MISC = (volatile LAS unsigned*)(ldsl + 131072 + 64);
    if (threadIdx.x < 2) MISC[threadIdx.x] = 0u;
    __syncthreads();
    grid.sync();
    XcdBarrier bar = xcd_barrier_post((unsigned*)(kargs()->ws + WS_BAR), MISC);

    for (int rep_ = 0; rep_ < PROBE_S; ++rep_) {
    { PHASE_IDS(); p0_mod(kargs(), ldsl, tid); }
    { PHASE_IDS(); p0_weights(kargs(), ldsl, gw, NGW, wave, lane); }
    }
    GSYNC();
    { PHASE_IDS(); pass_pre(x_, ctx_, kargs()->in[6], MOD_, 0, DM, UA_, MALL, gw, NGW, lane); }
    GSYNC();
    for (int L = 0; L < 2; ++L) {

        const int Mrows = L == 0 ? MALL : MLAT;
        { pg8::Gemm g = pg8::mk_gemm(L == 0 ? UA_ : UB_, (const bf16*)(WSB + (L == 0 ? WS_WIN0 : WS_WIN1)), MALL, L == 0 ? N_IN0 : N_IN1, DM, DM);
          pg8::StaticOrder S; S.init(g.M, g.N, G, (int)blockIdx.x); pg8::EpiBf16 E{PB_, g.N};
          for (int rep_ = 0; rep_ < PROBE_G; ++rep_) pg8::gemm_phase<pg8::EpiBf16, pg8::StaticOrder, true, true>(ldsl, g, S, E, wave0); }
        GSYNC();
        if (L == 0) {
            { PHASE_IDS(); prep_ab(PB_, kargs()->in[15], kargs()->in[16], kargs()->in[17], kargs()->in[18], gw, NGW, lane); }
            GSYNC();
            for (int q = 0; q < 2; ++q) {
                pg8::Gemm g = pg8::mk_gemm(PB_ + (q == 0 ? 1536 : 2048), (const bf16*)(WSB + (q == 0 ? WS_WUQ : WS_WUKV)), MALL, q == 0 ? N_UQ : N_UKV, 512, N_IN0);
                pg8::StaticOrder S; S.init(g.M, g.N, G, (int)blockIdx.x); pg8::EpiBf16 E{q == 0 ? QB_ : KVB_, g.N};
                for (int rep_ = 0; rep_ < PROBE_G; ++rep_) pg8::gemm_phase<pg8::EpiBf16, pg8::StaticOrder, true, true>(ldsl, g, S, E, wave0);
            }
            GSYNC();
            { PHASE_IDS(); prep_qb(QB_, gw, NGW, lane); }
            GSYNC();
            for (int rep_ = 0; rep_ < PROBE_A; ++rep_) attn_phase_ab(PB_, QB_, KVB_, OB_, (char*)lds, wave0);
        } else {
            { PHASE_IDS(); prep_cd(PB_, kargs()->in[23], kargs()->in[24], kargs()->in[26], kargs()->in[27], gw, NGW, lane); }
            GSYNC();
            for (int rep_ = 0; rep_ < PROBE_A; ++rep_) attn_phase_cd(PB_, OB_, kargs()->in[25], kargs()->in[28], (char*)lds, wave0);
        }
        GSYNC();
        { pg8::Gemm g = pg8::mk_gemm(OB_, (const bf16*)(WSB + (L == 0 ? WS_WOUT0 : WS_WOUT1)), MLAT, DM, DM, DM);
          pg8::StaticOrder S; S.init(g.M, g.N, G, (int)blockIdx.x); pg8::EpiBf16 E{OFB_, DM};
          for (int rep_ = 0; rep_ < PROBE_G; ++rep_) pg8::gemm_phase<pg8::EpiBf16, pg8::StaticOrder, true, true>(ldsl, g, S, E, wave0); }
        if (L == 0) { pg8::Gemm g = pg8::mk_gemm(OB_ + (size_t)MLAT * DM, (const bf16*)(WSB + WS_WOUT0), 2 * NCTX, 4 * DM, DM / 4, DM); g.ldb = DM; g.nNr = DM / 256;
          pg8::StaticOrder S; S.init(g.M, g.N, G, (int)blockIdx.x); pg8::EpiF32Split E{OFP_, DM, DM / 256, (size_t)2 * NCTX * DM};
          for (int rep_ = 0; rep_ < PROBE_G; ++rep_) pg8::gemm_phase<pg8::EpiF32Split, pg8::StaticOrder, true, true>(ldsl, g, S, E, wave0); }
        GSYNC();
        { PHASE_IDS(); pass_post(OFB_, OFP_, L == 0 ? x_ : out_, L == 0 ? ctx_ : hctx_, out_, hctx_, kargs()->in[7] + L * DM, MOD_ + (size_t)L * 3 * 12288, 2 * DM, kargs()->in[8] + L * DM, MOD_ + (size_t)L * 3 * 12288, 3 * DM, 4 * DM, UA_, Mrows, gw, NGW, lane); }
        GSYNC();
        { pg8::Gemm g = pg8::mk_gemm(UA_, (const bf16*)(WSB + WS_WGU + (size_t)L * 44 * MiB), Mrows, N_GU, DM, DM);
          pg8::StaticOrder S; S.init(g.M, g.N, G, (int)blockIdx.x); pg8::EpiSwiglu E{ACT_, DFF};
          for (int rep_ = 0; rep_ < PROBE_G; ++rep_) pg8::gemm_phase<pg8::EpiSwiglu, pg8::StaticOrder, true, true>(ldsl, g, S, E, wave0); }
        GSYNC();
        { pg8::Gemm g = pg8::mk_gemm(ACT_, (const bf16*)(WSB + WS_WD + (size_t)L * 22 * MiB), MLAT, DM, DFF, DFF);
          pg8::StaticOrder S; S.init(g.M, g.N, G, (int)blockIdx.x); pg8::EpiBf16 E{FB_, DM};
          for (int rep_ = 0; rep_ < PROBE_G; ++rep_) pg8::gemm_phase<pg8::EpiBf16, pg8::StaticOrder, true, true>(ldsl, g, S, E, wave0); }
        if (L == 0) { pg8::Gemm g = pg8::mk_gemm(ACT_ + (size_t)MLAT * DFF, (const bf16*)(WSB + WS_WD), 2 * NCTX, 4 * DM, DFF / 4, DFF); g.ldb = DFF; g.nNr = DM / 256;
          pg8::StaticOrder S; S.init(g.M, g.N, G, (int)blockIdx.x); pg8::EpiF32Split E{FP_, DM, DM / 256, (size_t)2 * NCTX * DM};
          for (int rep_ = 0; rep_ < PROBE_G; ++rep_) pg8::gemm_phase<pg8::EpiF32Split, pg8::StaticOrder, true, true>(ldsl, g, S, E, wave0); }
        GSYNC();
        { PHASE_IDS(); pass_post(FB_, FP_, out_, hctx_, out_, hctx_, kargs()->in[9] + L * DM, MOD_ + (size_t)L * 3 * 12288, 5 * DM, kargs()->in[6] + DM, MOD_ + (size_t)3 * 12288, 0, DM, L == 0 ? UB_ : nullptr, Mrows, gw, NGW, lane); }
        if (L == 0) GSYNC();
    }
#undef GSYNC
}

constexpr int LDS_BYTES = 131072 + 1024;
extern "C" void kernel_launch(void* const* d_in, const int* in_sizes, int n_in, void* d_out, int out_size, void* d_ws, size_t ws_size, hipStream_t stream) {
    static int grid = 0;
    if (grid == 0) {
        if (n_in != 29 || out_size != MLAT * DM || ws_size < WS_END) { fprintf(stderr, "kernel_launch: unexpected shapes: n_in %d out %d ws %zu (need %zu)\n", n_in, out_size, ws_size, (size_t)WS_END); grid = -1; return; }
        int dev = 0, cus = 0, per_cu = 0;
        hipGetDevice(&dev); hipDeviceGetAttribute(&cus, hipDeviceAttributeMultiprocessorCount, dev);
        if (hipFuncSetAttribute((const void*)fwd_megakernel, hipFuncAttributeMaxDynamicSharedMemorySize, LDS_BYTES) != hipSuccess) { fprintf(stderr, "kernel_launch: hipFuncSetAttribute failed\n"); grid = -1; return; }
        if (hipOccupancyMaxActiveBlocksPerMultiprocessor(&per_cu, (const void*)fwd_megakernel, NTHR, LDS_BYTES) != hipSuccess || per_cu < 1) { fprintf(stderr, "kernel_launch: occupancy query says %d\n", per_cu); per_cu = 1; }
        (void)hipGetLastError();
        grid = cus;
        fprintf(stderr, "kernel_launch: grid %d (per_cu %d)\n", grid, per_cu);
    }
    if (grid < 0) return;
    if (hipMemsetAsync((char*)d_ws + WS_BAR, 0, BAR_BYTES, stream) != hipSuccess) { fprintf(stderr, "kernel_launch: hipMemsetAsync failed\n"); return; }
    KArgs a{};
    for (int i = 0; i < 29; ++i) a.in[i] = (const float*)d_in[i];
    a.out = (float*)d_out; a.ws = (unsigned char*)d_ws;
    void* params[] = {&a};
    const hipError_t e = hipLaunchCooperativeKernel((const void*)fwd_megakernel, dim3(grid), dim3(NTHR), params, LDS_BYTES, stream);
    if (e != hipSuccess) fprintf(stderr, "kernel_launch: cooperative launch failed: %s (grid %d)\n", hipGetErrorString(e), grid);
}
```

```cpp
#include <hip/hip_runtime.h>
#include <hip/hip_cooperative_groups.h>
#include <cstdio>
#include <cstdint>
namespace cg = cooperative_groups;
__device__ __forceinline__ int fresh_tid(int wave0) { int l; asm volatile("v_mbcnt_lo_u32_b32 %0, -1, 0\n\tv_mbcnt_hi_u32_b32 %0, -1, %0" : "=v"(l)); return wave0 * 64 + l; }
namespace pg8 {
#define PG8_LAS __attribute__((address_space(3)))
typedef unsigned short bf16_t;
typedef short bf16x8 __attribute__((ext_vector_type(8)));
typedef float f32x4 __attribute__((ext_vector_type(4)));
typedef unsigned u32x4 __attribute__((ext_vector_type(4)));
constexpr int BM = 256, BK = 64, HALF = 128, HTB = HALF * BK * 2  , STAGE_BYTES = 8 * HTB, NXCD = 8, WGM = 8;

__host__ __device__ __forceinline__ int lds_byte(int r, int c) { const int st = (r >> 4) * 2 + (c >> 5), rr = r & 15, cc = c & 31, ob = rr * 64 + cc * 2; return st * 1024 + (ob ^ (((ob >> 9) & 1) << 5)); }
__host__ __device__ __forceinline__ void stage_rc(int b, int& R, int& C) { const int st = b / 1024, sb = b % 1024, swz = sb ^ (((sb >> 9) & 1) << 5); R = (st >> 1) * 16 + swz / 64; C = (st & 1) * 32 + (swz % 64) / 2; }
__host__ __device__ __forceinline__ int perm32(int rho) { const int n = rho >> 4, i = rho & 15; return 8 * (i >> 2) + 4 * n + (i & 3); }

struct Unit { int pm, pn; };
struct Gemm { const bf16_t* A; const bf16_t* Bt; int M, N, K, lda, ldb, nNr; };
__host__ __device__ __forceinline__ Gemm mk_gemm(const bf16_t* A, const bf16_t* Bt, int M, int N, int K, int lda) { Gemm g; g.A = A; g.Bt = Bt; g.M = M; g.N = N; g.K = K; g.lda = lda; g.ldb = K; g.nNr = N / BM; return g; }

struct StaticOrder {
    int nM, nN, nwg, G, c;
    __host__ __device__ void init(int M, int N, int G_, int c_) { nM = M / BM; nN = N / BM; nwg = nM * nN; G = G_; c = c_; }
    __host__ __device__ bool next(int i, Unit& u) const {
        const long L = (long)i * G + c; if (L >= nwg) return false;
        int wgid = (int)L; { const int q = nwg / NXCD, r = nwg % NXCD, xcd = wgid % NXCD, off = wgid / NXCD; wgid = (xcd < r ? xcd * (q + 1) : r * (q + 1) + (xcd - r) * q) + off; }
        const int nig = WGM * nN, gid = wgid / nig, fm = gid * WGM, gsz = (nM - fm) < WGM ? (nM - fm) : WGM;
        u.pm = fm + ((wgid % nig) % gsz); u.pn = (wgid % nig) / gsz; return true;
    }
    __device__ __forceinline__ void a_ready(const Unit&) const {}
    __device__ __forceinline__ void done(const Unit&) const {}
};


__device__ __forceinline__ unsigned cvt_pk_bf16(float lo, float hi) { unsigned r; asm volatile("v_cvt_pk_bf16_f32 %0, %1, %2" : "=v"(r) : "v"(lo), "v"(hi)); return r; }
struct EpiBf16 {
    static constexpr bool PERM = true, AFTER_DRAIN = false;
    bf16_t* O; int ldc;
    __device__ __forceinline__ void operator()(const f32x4 (&acc)[2][2][4][2], const Unit& u, int wr, int wc, int fr, int fq) const {
        const int row0 = u.pm * BM + wr * 64 + fr, col0 = u.pn * BM + wc * 32 + 8 * fq;
#pragma unroll
        for (int ai = 0; ai < 2; ++ai)
#pragma unroll
            for (int m = 0; m < 4; ++m) { bf16_t* rowp = O + (size_t)(row0 + ai * HALF + m * 16) * ldc + col0;
#pragma unroll
                for (int bj = 0; bj < 2; ++bj) { const f32x4 v0 = acc[ai][bj][m][0], v1 = acc[ai][bj][m][1];
                    u32x4 w; w.x = cvt_pk_bf16(v0[0], v0[1]); w.y = cvt_pk_bf16(v0[2], v0[3]); w.z = cvt_pk_bf16(v1[0], v1[1]); w.w = cvt_pk_bf16(v1[2], v1[3]);
                    *(u32x4*)(rowp + bj * HALF) = w; } }
    }
};
struct EpiF32 {
    static constexpr bool PERM = false, AFTER_DRAIN = false;
    float* O; int ldc;
    __device__ __forceinline__ void operator()(const f32x4 (&acc)[2][2][4][2], const Unit& u, int wr, int wc, int fr, int fq) const {
        const int row0 = u.pm * BM + wr * 64 + fr, col0 = u.pn * BM + wc * 32 + 4 * fq;
#pragma unroll
        for (int ai = 0; ai < 2; ++ai)
#pragma unroll
            for (int m = 0; m < 4; ++m) { float* rowp = O + (size_t)(row0 + ai * HALF + m * 16) * ldc + col0;
#pragma unroll
                for (int bj = 0; bj < 2; ++bj)
#pragma unroll
                    for (int n = 0; n < 2; ++n) *(f32x4*)(rowp + bj * HALF + n * 16) = acc[ai][bj][m][n]; }
    }
};
struct EpiF32Split {
    static constexpr bool PERM = false, AFTER_DRAIN = false;
    float* O; int ldc; int nNr; size_t sstride;
    __device__ __forceinline__ void operator()(const f32x4 (&acc)[2][2][4][2], const Unit& u, int wr, int wc, int fr, int fq) const {
        const int s = u.pn / nNr, pn = u.pn - s * nNr;
        const int row0 = u.pm * BM + wr * 64 + fr, col0 = pn * BM + wc * 32 + 4 * fq; float* Ob = O + (size_t)s * sstride;
#pragma unroll
        for (int ai = 0; ai < 2; ++ai)
#pragma unroll
            for (int m = 0; m < 4; ++m) { float* rowp = Ob + (size_t)(row0 + ai * HALF + m * 16) * ldc + col0;
#pragma unroll
                for (int bj = 0; bj < 2; ++bj)
#pragma unroll
                    for (int n = 0; n < 2; ++n) *(f32x4*)(rowp + bj * HALF + n * 16) = acc[ai][bj][m][n]; }
    }
};
__device__ __forceinline__ float silu_mul(float g, float u) { return g * __builtin_amdgcn_rcpf(1.0f + __builtin_amdgcn_exp2f(-1.4426950408889634f * g)) * u; }
struct EpiSwiglu {
    static constexpr bool PERM = true, AFTER_DRAIN = false;
    bf16_t* O; int ldc;
    __device__ __forceinline__ void operator()(const f32x4 (&acc)[2][2][4][2], const Unit& u, int wr, int wc, int fr, int fq) const {
        const int row0 = u.pm * BM + wr * 64 + fr, col0 = u.pn * HALF + wc * 32 + 8 * fq;
#pragma unroll
        for (int ai = 0; ai < 2; ++ai)
#pragma unroll
            for (int m = 0; m < 4; ++m) { bf16_t* rowp = O + (size_t)(row0 + ai * HALF + m * 16) * ldc + col0;
                const f32x4 g0 = acc[ai][0][m][0], g1 = acc[ai][0][m][1], u0 = acc[ai][1][m][0], u1 = acc[ai][1][m][1];
                u32x4 w; w.x = cvt_pk_bf16(silu_mul(g0[0], u0[0]), silu_mul(g0[1], u0[1])); w.y = cvt_pk_bf16(silu_mul(g0[2], u0[2]), silu_mul(g0[3], u0[3]));
                w.z = cvt_pk_bf16(silu_mul(g1[0], u1[0]), silu_mul(g1[1], u1[1])); w.w = cvt_pk_bf16(silu_mul(g1[2], u1[2]), silu_mul(g1[3], u1[3]));
                *(u32x4*)rowp = w; }
    }
};

template <class Epi, class Sched, bool ALIGN_EPI = false, bool SP2 = false>
__device__ __forceinline__ void gemm_phase(PG8_LAS unsigned char* lds, const Gemm g, const Sched& S, const Epi& E, const int wave0) {
    const int tid = fresh_tid(wave0), wid = __builtin_amdgcn_readfirstlane(tid >> 6), lane = tid & 63, wr = wid >> 2, wc = wid & 3, fr = lane & 15, fq = lane >> 4;
    const int K = g.K, nt = K / BK;
    unsigned voffA[2], voffB[2];
#pragma unroll
    for (int i = 0; i < 2; ++i) { int R, C; stage_rc(tid * 16 + i * 8192, R, C); const int Rb = Epi::PERM ? ((R & ~31) + perm32(R & 31)) : R;
        voffA[i] = (unsigned)(R * g.lda + C) * 2u; voffB[i] = (unsigned)(Rb * g.ldb + C) * 2u; }
    const size_t kstep = (size_t)(BK * 2);
    const size_t hstepA = (size_t)HALF * g.lda * 2, hstepB = (size_t)HALF * g.ldb * 2; const size_t ksb = (size_t)K * 2;
#define PG8_APTR(u) ((const char*)g.A + (size_t)(u).pm * tstepA + (size_t)((u).pn / g.nNr) * ksb)
#define PG8_BPTR(u) ((const char*)g.Bt + (size_t)((u).pn % g.nNr) * tstepB + (size_t)((u).pn / g.nNr) * ksb)
    const size_t tstepA = 2 * hstepA, tstepB = 2 * hstepB;
    const unsigned ldsw = (unsigned)wid * 1024u;
    const int aoff = lds_byte(wr * 64 + fr, fq * 8), boff = lds_byte(wc * 32 + fr, fq * 8);
#define PG8_SA(b, h) (((b) * 2 + (h)) * HTB)
#define PG8_SB(b, h) ((4 + (b) * 2 + (h)) * HTB)
#define PG8_STAGE(bufoff, gbase, voff) do { _Pragma("unroll") for (int _i = 0; _i < 2; ++_i) \
        __builtin_amdgcn_global_load_lds((const unsigned*)((const char*)(gbase) + (voff)[_i]), (PG8_LAS unsigned*)(lds + (bufoff) + ldsw + _i * 8192), 16, 0, 0); } while (0)
#define PG8_LDA(dst, b, h) do { _Pragma("unroll") for (int m = 0; m < 4; ++m) _Pragma("unroll") for (int k = 0; k < 2; ++k) dst[m][k] = *(const PG8_LAS bf16x8*)(lds + PG8_SA(b, h) + aoff + m * 2048 + k * 1024); } while (0)
#define PG8_LDB(dst, b, h) do { _Pragma("unroll") for (int n = 0; n < 2; ++n) _Pragma("unroll") for (int k = 0; k < 2; ++k) dst[n][k] = *(const PG8_LAS bf16x8*)(lds + PG8_SB(b, h) + boff + n * 2048 + k * 1024); } while (0)
#define PG8_MMA(ai, bj, At, Bt) do { __builtin_amdgcn_s_setprio(1); _Pragma("unroll") for (int m = 0; m < 4; ++m) _Pragma("unroll") for (int n = 0; n < 2; ++n) _Pragma("unroll") for (int k = 0; k < 2; ++k) \
        acc[ai][bj][m][n] = __builtin_amdgcn_mfma_f32_16x16x32_bf16(Bt[n][k], At[m][k], acc[ai][bj][m][n], 0, 0, 0); __builtin_amdgcn_s_setprio(0); } while (0)
#define PG8_WAIT_V(n) asm volatile("s_waitcnt vmcnt(" #n ")" ::: "memory")
#define PG8_WAIT_L(n) asm volatile("s_waitcnt lgkmcnt(" #n ")" ::: "memory")
#define PG8_BAR __builtin_amdgcn_s_barrier()
#define PG8_SCHED __builtin_amdgcn_sched_barrier(0)
    Unit cur, nxt; int ui = 0;
    if (!S.next(0, cur)) return;
    f32x4 acc[2][2][4][2];
#pragma unroll
    for (int a = 0; a < 2; ++a)
#pragma unroll
        for (int b = 0; b < 2; ++b)
#pragma unroll
            for (int m = 0; m < 4; ++m)
#pragma unroll
                for (int n = 0; n < 2; ++n) acc[a][b][m][n] = (f32x4){0.f, 0.f, 0.f, 0.f};
    bf16x8 At[4][2], B0[2][2], B1[2][2];
    const char* cA = PG8_APTR(cur); const char* cB = PG8_BPTR(cur);
    S.a_ready(cur);
    if constexpr (SP2) {
        PG8_STAGE(PG8_SB(0, 0), cB, voffB); PG8_STAGE(PG8_SB(0, 1), cB + hstepB, voffB); PG8_STAGE(PG8_SA(0, 0), cA, voffA); PG8_STAGE(PG8_SA(0, 1), cA + hstepA, voffA);
        if (wr == 1) PG8_BAR;
        PG8_WAIT_V(2); PG8_BAR;
        PG8_STAGE(PG8_SB(1, 0), cB + kstep, voffB); PG8_STAGE(PG8_SA(1, 0), cA + kstep, voffA); PG8_STAGE(PG8_SB(1, 1), cB + hstepB + kstep, voffB);
        PG8_WAIT_V(6); PG8_BAR;
    } else {
        PG8_STAGE(PG8_SB(0, 0), cB, voffB); PG8_STAGE(PG8_SA(0, 0), cA, voffA); PG8_STAGE(PG8_SB(0, 1), cB + hstepB, voffB); PG8_STAGE(PG8_SA(0, 1), cA + hstepA, voffA);
        if (wr == 1) PG8_BAR;
        PG8_WAIT_V(4); PG8_BAR;
        PG8_STAGE(PG8_SB(1, 0), cB + kstep, voffB); PG8_STAGE(PG8_SA(1, 0), cA + kstep, voffA); PG8_STAGE(PG8_SB(1, 1), cB + hstepB + kstep, voffB);
        PG8_WAIT_V(6); PG8_BAR;
    }
    for (;;) {
        const bool has_next = S.next(ui + 1, nxt);
        const char* nA = has_next ? PG8_APTR(nxt) : cA; const char* nB = has_next ? PG8_BPTR(nxt) : cB;
        for (int t = 0; t < nt; t += 2) {
            const bool last = (t == nt - 2);
            const char* a1 = cA + (size_t)(t + 1) * kstep;
            const char* a2 = last ? nA : cA + (size_t)(t + 2) * kstep; const char* b2 = last ? nB : cB + (size_t)(t + 2) * kstep;
            const char* a3 = a2 + kstep; const char* b3 = b2 + kstep;
            if (last && has_next) S.a_ready(nxt);
            if constexpr (SP2) {
            PG8_LDB(B0, 0, 0); PG8_LDB(B1, 0, 1); PG8_SCHED; PG8_LDA(At, 0, 0); PG8_STAGE(PG8_SA(1, 1), a1 + hstepA, voffA);
            PG8_WAIT_V(8); PG8_WAIT_L(0); PG8_BAR; PG8_MMA(0, 0, At, B0); PG8_MMA(0, 1, At, B1); PG8_BAR; PG8_SCHED;
            PG8_LDA(At, 0, 1); PG8_STAGE(PG8_SB(0, 0), b2, voffB); PG8_STAGE(PG8_SB(0, 1), b2 + hstepB, voffB); PG8_STAGE(PG8_SA(0, 0), a2, voffA);
            PG8_WAIT_V(8); PG8_WAIT_L(0); PG8_BAR; PG8_MMA(1, 0, At, B0); PG8_MMA(1, 1, At, B1); PG8_BAR; PG8_SCHED;
            PG8_LDB(B0, 1, 0); PG8_LDB(B1, 1, 1); PG8_SCHED; PG8_LDA(At, 1, 0); PG8_STAGE(PG8_SA(0, 1), a2 + hstepA, voffA);
            PG8_WAIT_V(8); PG8_WAIT_L(0); PG8_BAR; PG8_MMA(0, 0, At, B0); PG8_MMA(0, 1, At, B1); PG8_BAR; PG8_SCHED;
            PG8_LDA(At, 1, 1); PG8_STAGE(PG8_SB(1, 0), b3, voffB); PG8_STAGE(PG8_SB(1, 1), b3 + hstepB, voffB); PG8_STAGE(PG8_SA(1, 0), a3, voffA);
            PG8_WAIT_V(8); PG8_WAIT_L(0); PG8_BAR; PG8_MMA(1, 0, At, B0); PG8_MMA(1, 1, At, B1); PG8_BAR; PG8_SCHED;
            } else {
            PG8_LDB(B0, 0, 0); PG8_SCHED; PG8_LDA(At, 0, 0); PG8_STAGE(PG8_SA(1, 1), a1 + hstepA, voffA);
            PG8_WAIT_L(8); PG8_BAR; PG8_WAIT_L(0); PG8_MMA(0, 0, At, B0); PG8_BAR; PG8_SCHED;
            PG8_LDB(B1, 0, 1); PG8_STAGE(PG8_SB(0, 0), b2, voffB);
            PG8_BAR; PG8_WAIT_L(0); PG8_MMA(0, 1, At, B1); PG8_BAR;
            PG8_LDA(At, 0, 1); PG8_STAGE(PG8_SA(0, 0), a2, voffA);
            PG8_BAR; PG8_WAIT_L(0); PG8_MMA(1, 0, At, B0); PG8_BAR; PG8_SCHED;
            PG8_STAGE(PG8_SB(0, 1), b2 + hstepB, voffB);
            PG8_WAIT_V(6); PG8_BAR; PG8_MMA(1, 1, At, B1); PG8_BAR;
            PG8_LDB(B0, 1, 0); PG8_SCHED; PG8_LDA(At, 1, 0); PG8_STAGE(PG8_SA(0, 1), a2 + hstepA, voffA);
            PG8_WAIT_L(8); PG8_BAR; PG8_WAIT_L(0); PG8_MMA(0, 0, At, B0); PG8_BAR; PG8_SCHED;
            PG8_LDB(B1, 1, 1); PG8_STAGE(PG8_SB(1, 0), b3, voffB);
            PG8_BAR; PG8_WAIT_L(0); PG8_MMA(0, 1, At, B1); PG8_BAR;
            PG8_LDA(At, 1, 1); PG8_STAGE(PG8_SA(1, 0), a3, voffA);
            PG8_BAR; PG8_WAIT_L(0); PG8_MMA(1, 0, At, B0); PG8_BAR; PG8_SCHED;
            PG8_STAGE(PG8_SB(1, 1), b3 + hstepB, voffB);
            PG8_WAIT_V(6); PG8_BAR; PG8_MMA(1, 1, At, B1); PG8_BAR;
            }
        }
        if constexpr (ALIGN_EPI) { if (wr == 0) PG8_BAR; }
        if constexpr (!Epi::AFTER_DRAIN) { E(acc, cur, wr, wc, fr, fq); S.done(cur); }
        if (!has_next) break;
#pragma unroll
        for (int a = 0; a < 2; ++a)
#pragma unroll
            for (int b = 0; b < 2; ++b)
#pragma unroll
                for (int m = 0; m < 4; ++m)
#pragma unroll
                    for (int n = 0; n < 2; ++n) acc[a][b][m][n] = (f32x4){0.f, 0.f, 0.f, 0.f};
        cur = nxt; cA = nA; cB = nB; ++ui;
        if constexpr (ALIGN_EPI) { if (wr == 1) PG8_BAR; }
    }
    PG8_WAIT_V(0);
    if constexpr (!ALIGN_EPI) { if (wr == 0) PG8_BAR; }
    PG8_BAR;
    if constexpr (Epi::AFTER_DRAIN) { E.fused(acc, cur, wr, wc, fr, fq, lds, wid, lane); S.done(cur); }
#undef PG8_APTR
#undef PG8_BPTR
#undef PG8_SA
#undef PG8_SB
#undef PG8_STAGE
#undef PG8_LDA
#undef PG8_LDB
#undef PG8_MMA
#undef PG8_WAIT_V
#undef PG8_WAIT_L
#undef PG8_BAR
#undef PG8_SCHED
}
}
namespace att {
typedef unsigned short bf16;
typedef short bf16x8 __attribute__((ext_vector_type(8)));
typedef short s16x4 __attribute__((ext_vector_type(4)));
typedef float f32x16 __attribute__((ext_vector_type(16)));
typedef unsigned u32x4 __attribute__((ext_vector_type(4)));
constexpr int NW = 8, QBLK = 32, KVBLK = 64;
constexpr int SHM_V = KVBLK * 128 * 2;
#define SBAR() __builtin_amdgcn_sched_barrier(0)
__device__ __forceinline__ int crow(int r, int hi) { return (r & 3) + 8 * (r >> 2) + 4 * hi; }
__device__ __forceinline__ unsigned cvtpk(float lo, float hi) { unsigned r; asm volatile("v_cvt_pk_bf16_f32 %0, %1, %2" : "=v"(r) : "v"(lo), "v"(hi)); return r; }

struct Args {
  const bf16* Q; const bf16* K; const bf16* K2; const bf16* V; bf16* O;
  int ldq, ldk, ldk2, ldv, ldo;
  int NT, nctx, ctx_row0, lat_row0;
  float C, thr_raw;
  int qpos0, kpos0;
  float sink_l2;
  int r0, klo;
  const float* rpb; float inv_scale;
  int qrope_t0;
};

__device__ __forceinline__ void partialSM(f32x16& p0, f32x16& p1, float& m_reg, float& mn, float& alpha, const float C, const float thr_raw) {
  float pmax = p0[0];
#pragma unroll
  for (int r = 1; r < 16; ++r) pmax = fmaxf(pmax, p0[r]);
#pragma unroll
  for (int r = 0; r < 16; ++r) pmax = fmaxf(pmax, p1[r]);
  { auto rr = __builtin_amdgcn_permlane32_swap(__float_as_uint(pmax), __float_as_uint(pmax), false, false);
    pmax = fmaxf(__uint_as_float(rr[0]), __uint_as_float(rr[1])); }
  if (__builtin_expect(__all(pmax - m_reg <= thr_raw), 1)) { mn = m_reg; alpha = 1.f; }
  else { mn = fmaxf(m_reg, pmax); alpha = __builtin_amdgcn_exp2f((m_reg - mn) * C); m_reg = mn; }
  const float mnC = -mn * C;
#pragma unroll
  for (int r = 0; r < 16; ++r) p0[r] = fmaf(p0[r], C, mnC);
#pragma unroll
  for (int r = 0; r < 16; ++r) p1[r] = fmaf(p1[r], C, mnC);
#pragma unroll
  for (int r = 0; r < 16; ++r) p0[r] = __builtin_amdgcn_exp2f(p0[r]);
}
__device__ __forceinline__ void finishSM(f32x16& p0, f32x16& p1, float alpha, float& l_reg, bf16x8& pa0, bf16x8& pa1, bf16x8& pa2, bf16x8& pa3) {
#pragma unroll
  for (int r = 0; r < 16; ++r) p1[r] = __builtin_amdgcn_exp2f(p1[r]);
  float ps = 0;
#pragma unroll
  for (int r = 0; r < 16; ++r) ps += p0[r];
#pragma unroll
  for (int r = 0; r < 16; ++r) ps += p1[r];
  { auto rr = __builtin_amdgcn_permlane32_swap(__float_as_uint(ps), __float_as_uint(ps), false, false);
    ps = __uint_as_float(rr[0]) + __uint_as_float(rr[1]); }
  l_reg = l_reg * alpha + ps;
#define PK4(P, BASE, OUT) do { unsigned a0 = cvtpk(P[BASE + 0], P[BASE + 1]), a1 = cvtpk(P[BASE + 2], P[BASE + 3]);   \
    unsigned b0 = cvtpk(P[BASE + 4], P[BASE + 5]), b1 = cvtpk(P[BASE + 6], P[BASE + 7]);                              \
    auto r0 = __builtin_amdgcn_permlane32_swap(a0, b0, false, false); auto r1 = __builtin_amdgcn_permlane32_swap(a1, b1, false, false); \
    u32x4 w = {r0[0], r1[0], r0[1], r1[1]}; OUT = *reinterpret_cast<bf16x8*>(&w); } while (0)
  PK4(p0, 0, pa0); PK4(p0, 8, pa1); PK4(p1, 0, pa2); PK4(p1, 8, pa3);
#undef PK4
}
template <int DQ> __device__ __forceinline__ int kswz(int row, int colB) { return row * (DQ * 2) + (colB ^ ((row & 7) << 4)); }
typedef const __attribute__((address_space(3))) bf16x8* lds_b128_ptr;
template <int DQ> __device__ __forceinline__ void qkt(f32x16& p0, f32x16& p1, const int (&kx)[4], int koff, const bf16x8* qr) {
  p0 = f32x16{}; p1 = f32x16{};
  lds_b128_ptr k0 = (lds_b128_ptr)(unsigned)(kx[0] + koff), k1 = (lds_b128_ptr)(unsigned)(kx[1] + koff), k2 = (lds_b128_ptr)(unsigned)(kx[2] + koff), k3 = (lds_b128_ptr)(unsigned)(kx[3] + koff);
#pragma unroll
  for (int d0 = 0; d0 < DQ / 16; ++d0) { lds_b128_ptr kp = (d0 & 3) == 0 ? k0 : (d0 & 3) == 1 ? k1 : (d0 & 3) == 2 ? k2 : k3;
    const bf16x8 b0 = kp[(d0 >> 2) * 8];
    const bf16x8 b1 = kp[(d0 >> 2) * 8 + 32 * DQ * 2 / 16];
    p0 = __builtin_amdgcn_mfma_f32_32x32x16_bf16(b0, qr[d0], p0, 0, 0, 0);
    p1 = __builtin_amdgcn_mfma_f32_32x32x16_bf16(b1, qr[d0], p1, 0, 0, 0); }
}
__device__ __forceinline__ int v_st(int k, int c) { const int kk = (k & ~0xC) | ((k & 4) << 1) | ((k & 8) >> 1); return ((kk >> 3) * 4 + (c >> 5)) * 512 + ((kk & 7) * 32 + (c & 31)) * 2; }
__device__ __forceinline__ int v_rd_base(int lane) { return ((lane & 3) << 3) | (((lane >> 2) & 3) << 6) | (((lane >> 4) & 1) << 5) | (((lane >> 5) & 1) << 8); }
constexpr int v_rd_off(int d0, int ks, int half) { return d0 * 512 + ks * 4096 + half * 2048; }
template <int OFF> __device__ __forceinline__ s16x4 tr_read(int vb) {
  s16x4 r; asm volatile("ds_read_b64_tr_b16 %0, %1 offset:%2" : "=&v"(r) : "v"(vb), "i"(OFF) : "memory"); return r;
}
template <int D0> __device__ __forceinline__ void pv_one(f32x16& od, int vb, bf16x8 pa0, bf16x8 pa1, bf16x8 pa2, bf16x8 pa3) {
  const s16x4 l0 = tr_read<v_rd_off(D0, 0, 0)>(vb), h0 = tr_read<v_rd_off(D0, 0, 1)>(vb), l1 = tr_read<v_rd_off(D0, 1, 0)>(vb), h1 = tr_read<v_rd_off(D0, 1, 1)>(vb);
  const s16x4 l2 = tr_read<v_rd_off(D0, 2, 0)>(vb), h2 = tr_read<v_rd_off(D0, 2, 1)>(vb), l3 = tr_read<v_rd_off(D0, 3, 0)>(vb), h3 = tr_read<v_rd_off(D0, 3, 1)>(vb);
  asm volatile("s_waitcnt lgkmcnt(0)" ::: "memory"); SBAR();
#define PK(L, H) (bf16x8){L[0], L[1], L[2], L[3], H[0], H[1], H[2], H[3]}
  od = __builtin_amdgcn_mfma_f32_32x32x16_bf16(pa0, PK(l0, h0), od, 0, 0, 0);
  od = __builtin_amdgcn_mfma_f32_32x32x16_bf16(pa1, PK(l1, h1), od, 0, 0, 0);
  od = __builtin_amdgcn_mfma_f32_32x32x16_bf16(pa2, PK(l2, h2), od, 0, 0, 0);
  od = __builtin_amdgcn_mfma_f32_32x32x16_bf16(pa3, PK(l3, h3), od, 0, 0, 0);
#undef PK
}
__device__ __forceinline__ void pv_d0(f32x16* o, int vb, bf16x8 pa0, bf16x8 pa1, bf16x8 pa2, bf16x8 pa3) {
  pv_one<0>(o[0], vb, pa0, pa1, pa2, pa3); pv_one<1>(o[1], vb, pa0, pa1, pa2, pa3); pv_one<2>(o[2], vb, pa0, pa1, pa2, pa3); pv_one<3>(o[3], vb, pa0, pa1, pa2, pa3);
}
template <int MODE> __device__ __forceinline__ void maskf(f32x16& p0, f32x16& p1, int t, const Args& a, int wid, int r32, int hi, const float* bias_lds) {
  if constexpr (MODE == 0) { return; }
  else {
    if (t < a.nctx) return;
    if constexpr (MODE == 1) {
      const int kb = a.kpos0 + (t - a.nctx) * 64, qw = a.qpos0 + wid * 32;
      if (kb + 63 - qw <= 128 && qw + 31 - kb <= 128) return;
      const int q = qw + r32;
#pragma unroll
      for (int r = 0; r < 16; ++r) { const int d0 = kb + crow(r, hi) - q, d1 = d0 + 32;
        if (d0 > 128 || d0 < -128) p0[r] = -1e30f;
        if (d1 > 128 || d1 < -128) p1[r] = -1e30f; }
    } else {
      const int kr = a.klo + (t - a.nctx), rq = a.r0 + (wid >> 1);
      const int rs = min(max(rq - 4, 0), 120);
      if (kr < rs || kr >= rs + 8) {
#pragma unroll
        for (int r = 0; r < 16; ++r) { p0[r] = -1e30f; p1[r] = -1e30f; }
        return; }
      const int c = (wid & 1) * 32 + r32, cs = min(max(c - 8, 0), 48);
      int cb = 4 * hi - c + 63, vb = 4 * hi - cs;
      asm volatile("" : "+v"(cb), "+v"(vb));
      const float* bp = bias_lds + (kr - rq + 7) * 128 + cb;
#pragma unroll
      for (int r = 0; r < 16; ++r) { const int k0 = (r & 3) + 8 * (r >> 2), k1 = k0 + 32;
        const float b0 = bp[k0], b1 = bp[k1];
        p0[r] = ((unsigned)(k0 + vb) < 16u) ? fmaf(b0, a.inv_scale, p0[r]) : -1e30f;
        p1[r] = ((unsigned)(k1 + vb) < 16u) ? fmaf(b1, a.inv_scale, p1[r]) : -1e30f;
        if ((r & 3) == 3) SBAR(); }
    }
  }
}

template <int DQ, int MODE>
__device__ __forceinline__ void attn_unit(const Args& a, char* lds, const int wave0) {
  constexpr int SHM_K = KVBLK * DQ * 2, NQ = DQ / 16, OFF_K = 3 * SHM_V, OFF_WS = OFF_K + 2 * SHM_K;
  const int tid = fresh_tid(wave0), wid = tid >> 6, lane = tid & 63, r32 = lane & 31, hi = lane >> 5;
  char* V_lds = lds; char* K_lds = lds + OFF_K;
  float* ws = (float*)(lds + OFF_WS) + wid * 64; float* li_l = ws; float* al_l = ws + 32;
  float* bias_l = (float*)(lds + OFF_WS + 2048);
  if constexpr (MODE == 2) { if (tid < 465) bias_l[(tid / 31) * 128 + 48 + (tid % 31)] = a.rpb[tid]; }
  float m_reg = -1e30f, l_reg = 0; f32x16 o[4] = {}; bf16x8 qr[NQ];
  const float C = a.C, thr_raw = a.thr_raw;
  const bf16* Qw = a.Q + (long)(wid * QBLK + r32) * a.ldq + hi * 8;
#pragma unroll
  for (int d0 = 0; d0 < NQ; ++d0) qr[d0] = *reinterpret_cast<const bf16x8*>(Qw + d0 * 16);
  if constexpr (DQ == 192) {
    if (a.qrope_t0 >= 0) { const int t = a.qrope_t0 + wid * QBLK + r32; const float prow = (float)(t >> 6), pcol = (float)(t & 63);
#pragma unroll
      for (int half = 0; half < 2; ++half) { bf16x8 xa = qr[8 + 2 * half], xb = qr[9 + 2 * half]; const float pos = half ? pcol : prow;
#pragma unroll
        for (int e = 0; e < 8; ++e) { const int j = hi * 8 + e;
          const float inv_freq = __builtin_amdgcn_exp2f(-(float)j * (13.287712379549449f / 16.0f)); float rev = pos * inv_freq * 0.15915494309189535f; rev -= rintf(rev);
          const float sn = __builtin_amdgcn_sinf(rev), cs = __builtin_amdgcn_cosf(rev);
          const float x = __uint_as_float(((unsigned)(unsigned short)xa[e]) << 16), y = __uint_as_float(((unsigned)(unsigned short)xb[e]) << 16);
          const float nx = x * cs - y * sn, ny = y * cs + x * sn; unsigned ux = __float_as_uint(nx), uy = __float_as_uint(ny);
          ux = (ux + 0x7fffu + ((ux >> 16) & 1u)) >> 16; uy = (uy + 0x7fffu + ((uy >> 16) & 1u)) >> 16; xa[e] = (short)ux; xb[e] = (short)uy; }
        qr[8 + 2 * half] = xa; qr[9 + 2 * half] = xb; } } }
  const int sr = tid >> 4, sc = (tid & 15) * 8, vst0 = v_st(sr, sc), vst1 = v_st(32 + sr, sc);
  const int sr2 = tid >> 3, sc2 = (tid & 7) * 8;
  const int vb0 = (int)(uintptr_t)V_lds + v_rd_base(lane);
  int kx[4];
#pragma unroll
  for (int q = 0; q < 4; ++q) kx[q] = (int)(uintptr_t)K_lds + r32 * (DQ * 2) + ((q * 32 + hi * 16) ^ ((r32 & 7) << 4));
  bf16x8 s_vs0, s_vs1, s_ks0, s_ks1, s_ks2;
  const int vo0 = sr * a.ldv + sc, vo1 = (32 + sr) * a.ldv + sc, ko0 = sr * a.ldk + sc, ko1 = (32 + sr) * a.ldk + sc, ko2 = sr2 * a.ldk2 + sc2;
#define KROW(t) ((t) < a.nctx ? a.ctx_row0 + 64 * (t) : a.lat_row0 + 64 * ((t) - a.nctx))
#define SLOAD(t) do { const long kr_ = KROW(t); const bf16* vp_ = a.V + kr_ * a.ldv; const bf16* kp_ = a.K + kr_ * a.ldk; \
    s_vs0 = *reinterpret_cast<const bf16x8*>(vp_ + vo0); s_vs1 = *reinterpret_cast<const bf16x8*>(vp_ + vo1); \
    s_ks0 = *reinterpret_cast<const bf16x8*>(kp_ + ko0); s_ks1 = *reinterpret_cast<const bf16x8*>(kp_ + ko1); \
    if constexpr (DQ == 192) s_ks2 = *reinterpret_cast<const bf16x8*>(a.K2 + kr_ * a.ldk2 + ko2); } while (0)
#define SWRITE(t) do { char* vd_ = V_lds + ((t) % 3) * SHM_V; char* kd_ = K_lds + ((t) & 1) * SHM_K; \
    *(bf16x8*)(vd_ + vst0) = s_vs0; *(bf16x8*)(vd_ + vst1) = s_vs1; \
    *(bf16x8*)(kd_ + kswz<DQ>(sr, sc * 2)) = s_ks0; *(bf16x8*)(kd_ + kswz<DQ>(32 + sr, sc * 2)) = s_ks1; \
    if constexpr (DQ == 192) *(bf16x8*)(kd_ + kswz<DQ>(sr2, 256 + sc2 * 2)) = s_ks2; } while (0)
#define RESC(al) do { if (__any((al) < 1.f)) { if (hi == 0) al_l[r32] = (al); asm volatile("s_waitcnt lgkmcnt(0)" ::: "memory"); \
    _Pragma("unroll") for (int d = 0; d < 4; ++d) _Pragma("unroll") for (int r = 0; r < 16; ++r) o[d][r] *= al_l[crow(r, hi)]; } } while (0)
  f32x16 pA0, pA1, pB0, pB1; float mnA, mnB, alA, alB; bf16x8 pa0, pa1, pa2, pa3; const int NT = a.NT;
#define STEP(j, PN0, PN1, MNN, ALN, PP0, PP1, ALP) do { const int j_ = (j); \
    __syncthreads(); \
    if (j_ + 1 < NT) SWRITE(j_ + 1); \
    SBAR(); qkt<DQ>(PN0, PN1, kx, (j_ & 1) * SHM_K, qr); maskf<MODE>(PN0, PN1, j_, a, wid, r32, hi, bias_l); \
    finishSM(PP0, PP1, ALP, l_reg, pa0, pa1, pa2, pa3); SBAR(); \
    if (j_ + 2 < NT) SLOAD(j_ + 2); SBAR(); \
    pv_d0(o, vb0 + ((j_ - 1) % 3) * SHM_V, pa0, pa1, pa2, pa3); partialSM(PN0, PN1, m_reg, MNN, ALN, C, thr_raw); \
    RESC(ALN); } while (0)
  SLOAD(0); SWRITE(0); SLOAD(1); SWRITE(1); if (2 < NT) SLOAD(2);
  __syncthreads();
  qkt<DQ>(pA0, pA1, kx, 0, qr); maskf<MODE>(pA0, pA1, 0, a, wid, r32, hi, bias_l); partialSM(pA0, pA1, m_reg, mnA, alA, C, thr_raw);
  for (int j = 1; j + 1 < NT; j += 2) {
    STEP(j, pB0, pB1, mnB, alB, pA0, pA1, alA);
    STEP(j + 1, pA0, pA1, mnA, alA, pB0, pB1, alB);
  }
  STEP(NT - 1, pB0, pB1, mnB, alB, pA0, pA1, alA);
  finishSM(pB0, pB1, alB, l_reg, pa0, pa1, pa2, pa3); SBAR();
  pv_d0(o, vb0 + ((NT - 1) % 3) * SHM_V, pa0, pa1, pa2, pa3);
  if constexpr (MODE == 1) l_reg += __builtin_amdgcn_exp2f(a.sink_l2 - m_reg * C);
  if (hi == 0) li_l[r32] = l_reg; asm volatile("s_waitcnt lgkmcnt(0)" ::: "memory");
  float rli[16];
#pragma unroll
  for (int r = 0; r < 16; ++r) rli[r] = __builtin_amdgcn_rcpf(li_l[crow(r, hi)]);
  bf16* Ow = a.O + (long)(wid * QBLK) * a.ldo;
#pragma unroll
  for (int r = 0; r < 16; ++r) { const int orow = crow(r, hi);
#pragma unroll
    for (int d0 = 0; d0 < 4; ++d0) { const float v = o[d0][r] * rli[r]; unsigned u = __float_as_uint(v); u = (u + 0x7fffu + ((u >> 16) & 1u)) >> 16; Ow[(long)orow * a.ldo + d0 * 32 + r32] = (bf16)u; } }
  __syncthreads();
#undef KROW
#undef SLOAD
#undef SWRITE
#undef RESC
#undef STEP
}
#undef SBAR
}
#define LAS __attribute__((address_space(3)))
typedef unsigned short bf16;
typedef float f32x4 __attribute__((ext_vector_type(4)));
typedef unsigned v4u __attribute__((ext_vector_type(4)));
typedef unsigned v2u __attribute__((ext_vector_type(2)));
constexpr int NWAVES = 8, NTHR = 512;
constexpr int DM = 2048, SEQ = 8192, NCTX = 256, MLAT = 2 * SEQ, MALL = MLAT + 2 * NCTX, DFF = 5632;
constexpr int N_IN0 = 2816, N_IN1 = 4608, N_UQ = 1536, N_UKV = 2048, N_GU = 2 * DFF;
constexpr float EPS = 1e-6f;
constexpr size_t MiB = 1u << 20;
constexpr size_t WS_MOD = 0, WS_BAR = 512 * 1024, BAR_BYTES = 16384;
constexpr size_t WS_WIN0 = 1 * MiB, WS_WUQ = WS_WIN0 + 11 * MiB, WS_WUKV = WS_WUQ + 2 * MiB, WS_WOUT0 = WS_WUKV + 2 * MiB, WS_WIN1 = WS_WOUT0 + 8 * MiB, WS_WOUT1 = WS_WIN1 + 18 * MiB,
                 WS_WGU = WS_WOUT1 + 8 * MiB, WS_WD = WS_WGU + 88 * MiB, WS_HCTX = WS_WD + 44 * MiB;
constexpr size_t WS_UO = WS_HCTX + 4 * MiB;
constexpr size_t WS_OB = WS_UO + 66 * MiB;
constexpr size_t WS_BIG = WS_UO + 132 * MiB;
constexpr size_t WS_QB = WS_BIG + 91 * MiB, WS_KVB = WS_BIG + 141 * MiB, WS_UB = WS_BIG + 149 * MiB, WS_END = WS_BIG + 215 * MiB;
static_assert((size_t)MALL * DM * 2 == 66 * MiB && (size_t)MALL * N_IN0 * 2 <= 91 * MiB && (size_t)MALL * N_UQ * 2 <= 50 * MiB && (size_t)MALL * N_IN1 * 2 <= 149 * MiB && (size_t)MALL * DFF * 2 <= 215 * MiB, "ws map");

__device__ __forceinline__ unsigned f2bf(float f) { unsigned u = __builtin_bit_cast(unsigned, f); return (u + 0x7fffu + ((u >> 16) & 1u)) >> 16; }
__device__ __forceinline__ unsigned pk2(float lo, float hi) { return f2bf(lo) | (f2bf(hi) << 16); }
__device__ __forceinline__ float bf2f(bf16 v) { return __uint_as_float(((unsigned)v) << 16); }
__device__ __forceinline__ float wave_sum(float v, int lane) {
#pragma unroll
    for (int o = 1; o < 64; o <<= 1) v += __int_as_float(__builtin_amdgcn_ds_bpermute((lane ^ o) << 2, __float_as_int(v)));
    return v;
}
__device__ __forceinline__ float silu_f(float x) { return x / (1.0f + __expf(-x)); }

#define GAS __attribute__((address_space(1)))
#define XB_TMO      128
#define XB_XCNT(j)  (256  + 64 * (j))
#define XB_XSUB(j)  (1280 + 64 * (j))
#define XB_XGEN(j)  (2304 + 64 * (j))
#define XB_TOP      3328
#define XB_TOPGEN   3392
#define XCD_BAR_WORDS 3456
#define XB_SPIN_CAP (1u << 18)

__device__ __forceinline__ unsigned xb_ld(unsigned* p)              { return __hip_atomic_load(p, __ATOMIC_RELAXED, __HIP_MEMORY_SCOPE_AGENT); }
__device__ __forceinline__ unsigned xb_add(unsigned* p, unsigned v) { return __hip_atomic_fetch_add(p, v, __ATOMIC_RELAXED, __HIP_MEMORY_SCOPE_AGENT); }
__device__ __forceinline__ unsigned xb_xcc_id() { return (unsigned)__builtin_amdgcn_s_getreg((3 << 11) | 20) & 0xFu; }
#define XB_SPIN(cond, bar) do { unsigned _sp = 0; while (cond) { __builtin_amdgcn_s_sleep(1); \
    if ((++_sp & 255u) == 0u) { if (xb_ld(&(bar)[XB_TMO])) break; if (_sp > XB_SPIN_CAP) { atomicAdd(&(bar)[XB_TMO], 1u); break; } } } } while (0)

struct XcdBarrier {
    unsigned* bar; unsigned x;
    volatile LAS unsigned* st;
};

__device__ __forceinline__ XcdBarrier xcd_barrier_post(unsigned* bar, volatile LAS unsigned* st) {
    XcdBarrier b; b.bar = bar; b.x = xb_xcc_id(); b.st = st;
    if (threadIdx.x == 0) (void)xb_add(&bar[XB_XCNT(b.x)], 1u);
    return b;
}
__device__ __forceinline__ void xcd_barrier_complete(unsigned* bar, unsigned x, unsigned& nloc, unsigned& nx) {
    const unsigned G = gridDim.x * gridDim.y * gridDim.z;
    unsigned sum, cnt, mine, sp = 0u;
    for (;;) {
        sum = 0u; cnt = 0u; mine = 0u;
#pragma unroll
        for (unsigned j = 0; j < 16; ++j) { const unsigned c = xb_ld(&bar[XB_XCNT(j)]); sum += c; cnt += (c > 0u) ? 1u : 0u; mine = (j == x) ? c : mine; }
        if (sum == G) break;
        __builtin_amdgcn_s_sleep(1);
        if ((++sp & 255u) == 0u) { if (xb_ld(&bar[XB_TMO])) break; if (sp > XB_SPIN_CAP) { atomicAdd(&bar[XB_TMO], 1u); break; } }
    }
    nloc = mine > 0u ? mine : 1u; nx = cnt > 0u ? cnt : 1u;
}

__device__ __forceinline__ void xcd_barrier(const XcdBarrier& b) {
    asm volatile("s_waitcnt vmcnt(0)" ::: "memory");
    __syncthreads();
    if (threadIdx.x == 0) {
        unsigned* bar = b.bar;
        __builtin_amdgcn_s_waitcnt(0);
        unsigned nloc = b.st[0], nx = b.st[1];
        if (nloc == 0u) { xcd_barrier_complete(bar, b.x, nloc, nx); b.st[0] = nloc; b.st[1] = nx; }
        const unsigned old = xb_add(&bar[XB_XSUB(b.x)], 1u);
        const unsigned gen = old / nloc;
        if (old + 1u == (gen + 1u) * nloc) {
            __builtin_amdgcn_fence(__ATOMIC_RELEASE, "agent");
            asm volatile("s_waitcnt vmcnt(0)" ::: "memory");
            const unsigned og = xb_add(&bar[XB_TOP], 1u);
            const unsigned tg = og / nx;
            if (og + 1u == (tg + 1u) * nx) xb_add(&bar[XB_TOPGEN], 1u);
            else XB_SPIN(xb_ld(&bar[XB_TOPGEN]) == tg, bar);
            __builtin_amdgcn_fence(__ATOMIC_ACQUIRE, "agent");
            xb_add(&bar[XB_XGEN(b.x)], 1u);
            asm volatile("s_waitcnt vmcnt(0)" ::: "memory");
        } else {
            XB_SPIN(xb_ld(&bar[XB_XGEN(b.x)]) == gen, bar);
            __builtin_amdgcn_fence(__ATOMIC_ACQUIRE, "agent");
            asm volatile("s_waitcnt vmcnt(0)" ::: "memory");
        }
    }
    __syncthreads();
}

struct KArgs { const float* in[29]; float* out; unsigned char* ws; };
typedef const __attribute__((address_space(4))) KArgs* KAP;
__device__ __forceinline__ KAP kargs() { KAP p = (KAP)__builtin_amdgcn_kernarg_segment_ptr(); asm volatile("" : "+s"(p)); return p; }

__device__ __forceinline__ void transpose_item(const float* W, int K, int N, bf16* WT, int k0, int n0, int drow0, LAS float* scr, int lane) {
#pragma unroll 8
    for (int i = 0; i < 32; ++i) { const int kk = 2 * i + (lane >> 5); scr[kk * 33 + (lane & 31)] = W[(size_t)(k0 + kk) * N + n0 + (lane & 31)]; }
    asm volatile("s_waitcnt lgkmcnt(0)" ::: "memory");
    const int c = lane & 7;
#pragma unroll
    for (int j = 0; j < 4; ++j) { const int n = (lane >> 3) + 8 * j; const LAS float* s = scr + (8 * c) * 33 + n;
        v4u o; o.x = pk2(s[0 * 33], s[1 * 33]); o.y = pk2(s[2 * 33], s[3 * 33]); o.z = pk2(s[4 * 33], s[5 * 33]); o.w = pk2(s[6 * 33], s[7 * 33]);
        *(v4u*)(WT + (size_t)(drow0 + n) * K + k0 + 8 * c) = o; }
    asm volatile("s_waitcnt lgkmcnt(0)" ::: "memory");
}
__device__ __forceinline__ bool conv_matrix(int& it, const float* W, int K, int N, bf16* WT, int mode, LAS float* scr, int lane) {
    const int nblk = N / 32, items = (K / 64) * nblk;
    if (it >= items) { it -= items; return false; }
    const int kb = it / nblk, nb = it % nblk, n0 = 32 * nb;
    const int drow0 = mode == 0 ? n0 : ((n0 >> 7) * 256 + (mode == 2 ? 128 : 0) + (n0 & 127));
    transpose_item(W, K, N, WT, 64 * kb, n0, drow0, scr, lane);
    return true;
}
__device__ __forceinline__ void p0_weights(KAP a, LAS unsigned char* lds, int gw, int NGW, int wave, int lane) {
    LAS float* scr = (LAS float*)(lds + wave * 8704);
    unsigned char* ws = a->ws;
    constexpr int I_TOTAL = (2048 / 64) * (2624 / 32) + (512 / 64) * (1536 / 32) + (512 / 64) * (2048 / 32) + 2 * (2048 / 64) * (2048 / 32) + (2048 / 64) * (4608 / 32)
                          + 4 * (2048 / 64) * (DFF / 32) + 2 * (DFF / 64) * (2048 / 32);
    for (int item = gw; item < I_TOTAL; item += NGW) {
        int it = item;
        if (conv_matrix(it, a->in[13], 2048, 2624, (bf16*)(ws + WS_WIN0), 0, scr, lane)) continue;
        if (conv_matrix(it, a->in[19], 512, 1536, (bf16*)(ws + WS_WUQ), 0, scr, lane)) continue;
        if (conv_matrix(it, a->in[20], 512, 2048, (bf16*)(ws + WS_WUKV), 0, scr, lane)) continue;
        if (conv_matrix(it, a->in[14], 2048, 2048, (bf16*)(ws + WS_WOUT0), 0, scr, lane)) continue;
        if (conv_matrix(it, a->in[21], 2048, 4608, (bf16*)(ws + WS_WIN1), 0, scr, lane)) continue;
        if (conv_matrix(it, a->in[22], 2048, 2048, (bf16*)(ws + WS_WOUT1), 0, scr, lane)) continue;
        if (conv_matrix(it, a->in[10], 2048, DFF, (bf16*)(ws + WS_WGU), 1, scr, lane)) continue;
        if (conv_matrix(it, a->in[10] + (size_t)2048 * DFF, 2048, DFF, (bf16*)(ws + WS_WGU + 44 * MiB), 1, scr, lane)) continue;
        if (conv_matrix(it, a->in[11], 2048, DFF, (bf16*)(ws + WS_WGU), 2, scr, lane)) continue;
        if (conv_matrix(it, a->in[11] + (size_t)2048 * DFF, 2048, DFF, (bf16*)(ws + WS_WGU + 44 * MiB), 2, scr, lane)) continue;
        if (conv_matrix(it, a->in[12], DFF, 2048, (bf16*)(ws + WS_WD), 0, scr, lane)) continue;
        conv_matrix(it, a->in[12] + (size_t)2048 * DFF, DFF, 2048, (bf16*)(ws + WS_WD + 22 * MiB), 0, scr, lane);
    }
}
__device__ __forceinline__ void p0_mod(KAP a, LAS unsigned char* lds, int tid) {
    LAS float* sv = (LAS float*)lds;
    LAS float* red = (LAS float*)(lds + 24576);
    const int blk = blockIdx.x; if (blk >= 256) return;
    const int layer = blk >> 7, col0 = (blk & 127) * 96;
    for (int i = tid; i < 3 * 2048; i += NTHR) { const int v = i >> 11, k = i & 2047; const float x = v < 2 ? a->in[1][v * 2048 + k] : a->in[3][k]; sv[i] = silu_f(x); }
    __syncthreads();
    const int c4 = tid % 24, ks = tid / 24;
    if (ks < 21) {
        const float* W = a->in[4] + (size_t)layer * 2048 * 12288 + col0 + 4 * c4;
        f32x4 a0 = {0, 0, 0, 0}, a1 = a0, a2 = a0;
#pragma unroll 4
        for (int k = ks; k < 2048; k += 21) { const f32x4 w = *(const f32x4*)(W + (size_t)k * 12288); a0 += w * sv[k]; a1 += w * sv[2048 + k]; a2 += w * sv[4096 + k]; }
        LAS float* r = red + ks * 288 + 4 * c4;
        *(LAS f32x4*)(r) = a0; *(LAS f32x4*)(r + 96) = a1; *(LAS f32x4*)(r + 192) = a2;
    }
    __syncthreads();
    if (tid < 288) { float s = 0.f;
        for (int q = 0; q < 21; ++q) s += red[q * 288 + tid];
        const int v = tid / 96, j = tid % 96;
        ((float*)(a->ws + WS_MOD))[(size_t)(layer * 3 + v) * 12288 + col0 + j] = s + a->in[5][layer * 12288 + col0 + j]; }
    __syncthreads();
}
__device__ __forceinline__ void store_u(bf16* urow, int lane, const f32x4 (&v)[8], float rstd, const float* g, const float* sh, const float* sc) {
#pragma unroll
    for (int j = 0; j < 8; ++j) { const int ci = 256 * j + 4 * lane; const f32x4 g4 = *(const f32x4*)(g + ci), s4 = *(const f32x4*)(sc + ci), h4 = *(const f32x4*)(sh + ci);
        const f32x4 t = (v[j] * rstd * g4) * (1.0f + s4) + h4; v2u w; w.x = pk2(t[0], t[1]); w.y = pk2(t[2], t[3]); *(v2u*)(urow + ci) = w; }
}
__device__ __forceinline__ void pass_pre(const float* hlat, const float* hctx, const float* g, const float* mod, int sh_off, int sc_off, bf16* U, int nrows, int gw, int NGW, int lane) {
    for (int m0 = gw; m0 < nrows; m0 += 2 * NGW) {
        int mr[2]; mr[0] = m0; mr[1] = m0 + NGW; const bool two = mr[1] < nrows; if (!two) mr[1] = m0;
        f32x4 v[2][8]; float ss[2];
#pragma unroll
        for (int r = 0; r < 2; ++r) { const int m = mr[r]; const float* src = m < MLAT ? hlat + (size_t)m * DM : hctx + (size_t)(m - MLAT) * DM;
#pragma unroll
            for (int j = 0; j < 8; ++j) v[r][j] = *(const f32x4*)(src + 256 * j + 4 * lane); }
#pragma unroll
        for (int r = 0; r < 2; ++r) { ss[r] = 0.f;
#pragma unroll
            for (int j = 0; j < 8; ++j) ss[r] += (v[r][j][0] * v[r][j][0] + v[r][j][1] * v[r][j][1]) + (v[r][j][2] * v[r][j][2] + v[r][j][3] * v[r][j][3]); }
#pragma unroll
        for (int r = 0; r < 2; ++r) { if (r == 1 && !two) break; const int m = mr[r]; const float* mv = mod + (m < MLAT ? (m >> 13) : 2) * 12288;
            const float rstd = rsqrtf(wave_sum(ss[r], lane) * (1.0f / DM) + EPS);
            store_u(U + (size_t)m * DM, lane, v[r], rstd, g, mv + sh_off, mv + sc_off); }
    }
}
__device__ __forceinline__ void pass_post(const bf16* o16, const float* opart, const float* hlat, const float* hctx, float* olat, float* octx, const float* gpost, const float* mod, int gt_off,
                                          const float* gpre, const float* modu, int sh_off, int sc_off, bf16* U, int nrows, int gw, int NGW, int lane) {
    for (int m0 = gw; m0 < nrows; m0 += 2 * NGW) {
        int mr[2]; mr[0] = m0; mr[1] = m0 + NGW; const bool two = mr[1] < nrows; if (!two) mr[1] = m0;
        f32x4 v[2][8], hh[2][8]; float ss[2];
#pragma unroll
        for (int r = 0; r < 2; ++r) { const int m = mr[r]; ss[r] = 0.f;
            const float* hs = m < MLAT ? hlat + (size_t)m * DM : hctx + (size_t)(m - MLAT) * DM;
            if (m < MLAT) { const bf16* orow = o16 + (size_t)m * DM;
#pragma unroll
                for (int j = 0; j < 8; ++j) { const v2u raw = *(const v2u*)(orow + 256 * j + 4 * lane);
                    v[r][j] = (f32x4){__uint_as_float(raw.x << 16), __uint_as_float(raw.x & 0xffff0000u), __uint_as_float(raw.y << 16), __uint_as_float(raw.y & 0xffff0000u)}; }
            } else { const float* orow = opart + (size_t)(m - MLAT) * DM;
#pragma unroll
                for (int j = 0; j < 8; ++j) { const int ci = 256 * j + 4 * lane;
                    v[r][j] = (*(const f32x4*)(orow + ci) + *(const f32x4*)(orow + ci + (size_t)512 * DM)) + (*(const f32x4*)(orow + ci + (size_t)1024 * DM) + *(const f32x4*)(orow + ci + (size_t)1536 * DM)); } }
#pragma unroll
            for (int j = 0; j < 8; ++j) hh[r][j] = *(const f32x4*)(hs + 256 * j + 4 * lane);
        }
#pragma unroll
        for (int r = 0; r < 2; ++r)
#pragma unroll
            for (int j = 0; j < 8; ++j) ss[r] += (v[r][j][0] * v[r][j][0] + v[r][j][1] * v[r][j][1]) + (v[r][j][2] * v[r][j][2] + v[r][j][3] * v[r][j][3]);
#pragma unroll
        for (int r = 0; r < 2; ++r) { const int m = mr[r]; if (r == 1 && !two) break;
            float* hd = m < MLAT ? olat + (size_t)m * DM : octx + (size_t)(m - MLAT) * DM; const int vi = (m < MLAT ? (m >> 13) : 2); const float* mv = mod + vi * 12288;
            const float rstd = rsqrtf(wave_sum(ss[r], lane) * (1.0f / DM) + EPS); float s2 = 0.f;
#pragma unroll
            for (int j = 0; j < 8; ++j) { const int ci = 256 * j + 4 * lane; const f32x4 g4 = *(const f32x4*)(gpost + ci), t4 = *(const f32x4*)(mv + gt_off + ci);
                const f32x4 nv = hh[r][j] + t4 * (v[r][j] * rstd * g4); v[r][j] = nv; *(f32x4*)(hd + ci) = nv; s2 += (nv[0] * nv[0] + nv[1] * nv[1]) + (nv[2] * nv[2] + nv[3] * nv[3]); }
            if (U) { const float* mu = modu + vi * 12288; const float rstd2 = rsqrtf(wave_sum(s2, lane) * (1.0f / DM) + EPS); store_u(U + (size_t)m * DM, lane, v[r], rstd2, gpre, mu + sh_off, mu + sc_off); }
        }
    }
}
__device__ __forceinline__ void rope_cs(float pos, int j, float inv_nf, float& cs, float& sn) {
    const float inv_freq = __builtin_amdgcn_exp2f(-(float)j * inv_nf * 13.287712379549449f);
    float rev = pos * inv_freq * 0.15915494309189535f; rev -= rintf(rev);
    sn = __builtin_amdgcn_sinf(rev); cs = __builtin_amdgcn_cosf(rev);
}
template <int NH> __device__ __forceinline__ void heads_load(const bf16* base, int ia, float (&x)[NH], float (&y)[NH]) {
#pragma unroll
    for (int h = 0; h < NH; ++h) { x[h] = bf2f(base[h * 128 + ia]); y[h] = bf2f(base[h * 128 + ia + 32]); }
}
template <int NH> __device__ __forceinline__ void heads_finish(bf16* base, int ia, float (&x)[NH], float (&y)[NH], const float* gain, bool rope, float cs, float sn, int lane) {
    const float ga = gain[ia], gb = gain[ia + 32];
#pragma unroll
    for (int h = 0; h < NH; ++h) {
        const float rstd = rsqrtf(wave_sum(x[h] * x[h] + y[h] * y[h], lane) * (1.0f / 128.0f) + EPS);
        float a = x[h] * rstd * ga, b = y[h] * rstd * gb;
        if (rope) { const float na = a * cs - b * sn, nb = b * cs + a * sn; a = na; b = nb; }
        base[h * 128 + ia] = (bf16)f2bf(a); base[h * 128 + ia + 32] = (bf16)f2bf(b); }
}
__device__ __forceinline__ void unpack8(const v4u raw, float (&x)[8]) {
#pragma unroll
    for (int i = 0; i < 4; ++i) { x[2 * i] = __uint_as_float(raw[i] << 16); x[2 * i + 1] = __uint_as_float(raw[i] & 0xffff0000u); }
}
__device__ __forceinline__ void norm512_finish(bf16* p, const float (&x)[8], const float* gain, int lane) {
    float ss = 0.f;
#pragma unroll
    for (int i = 0; i < 8; ++i) ss += x[i] * x[i];
    const float rstd = rsqrtf(wave_sum(ss, lane) * (1.0f / 512.0f) + EPS);
    const f32x4 g0 = *(const f32x4*)(gain + 8 * lane), g1 = *(const f32x4*)(gain + 8 * lane + 4);
    v4u w; w.x = pk2(x[0] * rstd * g0[0], x[1] * rstd * g0[1]); w.y = pk2(x[2] * rstd * g0[2], x[3] * rstd * g0[3]); w.z = pk2(x[4] * rstd * g1[0], x[5] * rstd * g1[1]); w.w = pk2(x[6] * rstd * g1[2], x[7] * rstd * g1[3]);
    *(v4u*)(p + 8 * lane) = w;
}
__device__ __forceinline__ void rope64(bf16* p, float prow, float pcol, int l32) {
    const int j = l32 & 15, s = (l32 >> 4) & 1, ia = 32 * s + j, ib = ia + 16;
    const float x = bf2f(p[ia]), y = bf2f(p[ib]); float cs, sn; rope_cs(s ? pcol : prow, j, 1.0f / 16.0f, cs, sn);
    p[ia] = (bf16)f2bf(x * cs - y * sn); p[ib] = (bf16)f2bf(y * cs + x * sn);
}
__device__ __forceinline__ void prep_ab(bf16* P, const float* aqn, const float* akn, const float* bqn, const float* bkvn, int gw, int NGW, int lane) {
    const int ia = 64 * (lane >> 5) + (lane & 31);
    for (int m = gw; m < MALL; m += NGW) {
        bf16* row = P + (size_t)m * N_IN0; const bool lat = m < MLAT; const int t = m & (SEQ - 1); const float pr = (float)(t >> 6), pc = (float)(t & 63);
        float xq[8], yq[8], xk[2], yk[2], c1[8], c2[8];
        heads_load<8>(row, ia, xq, yq); heads_load<2>(row + 1024, ia, xk, yk);
        unpack8(*(const v4u*)(row + 1536 + 8 * lane), c1); unpack8(*(const v4u*)(row + 2048 + 8 * lane), c2);
        if (lat && lane < 32) rope64(row + 2560, pr, pc, lane);
        float cs = 1.f, sn = 0.f; if (lat) rope_cs((lane >> 5) ? pc : pr, lane & 31, 1.0f / 32.0f, cs, sn);
        heads_finish<8>(row, ia, xq, yq, aqn, lat, cs, sn, lane); heads_finish<2>(row + 1024, ia, xk, yk, akn, lat, cs, sn, lane);
        norm512_finish(row + 1536, c1, bqn, lane); norm512_finish(row + 2048, c2, bkvn, lane);
    }
}
__device__ __forceinline__ void prep_qb(bf16* QB, int gw, int NGW, int lane) {
    for (int m = gw; m < MLAT; m += NGW) {
        bf16* row = QB + (size_t)m * N_UQ; const int t = m & (SEQ - 1); const float pr = (float)(t >> 6), pc = (float)(t & 63);
#pragma unroll
        for (int i = 0; i < 4; ++i) rope64(row + (2 * i + (lane >> 5)) * 192 + 128, pr, pc, lane & 31);
    }
}
__device__ __forceinline__ void prep_cd(bf16* P, const float* cqn, const float* ckn, const float* dqn, const float* dkn, int gw, int NGW, int lane) {
    const int ia = 64 * (lane >> 5) + (lane & 31);
    for (int m = gw; m < MALL; m += NGW) {
        bf16* row = P + (size_t)m * N_IN1; const bool lat = m < MLAT; const int t = m & (SEQ - 1); const float pr = (float)(t >> 6), pc = (float)(t & 63);
        float cs = 1.f, sn = 0.f; if (lat) rope_cs((lane >> 5) ? pc : pr, lane & 31, 1.0f / 32.0f, cs, sn);
        float xk[2], yk[2], xd[8], yd[8];
        heads_load<2>(row + 1024, ia, xk, yk); heads_load<8>(row + 2560, ia, xd, yd);
        if (lat) {
            float xq[8], yq[8], xe[8], ye[8];
            heads_load<8>(row, ia, xq, yq); heads_load<8>(row + 1536, ia, xe, ye);
            heads_finish<8>(row, ia, xq, yq, cqn, true, cs, sn, lane); heads_finish<8>(row + 1536, ia, xe, ye, dqn, false, 1.f, 0.f, lane);
        }
        heads_finish<2>(row + 1024, ia, xk, yk, ckn, lat, cs, sn, lane); heads_finish<8>(row + 2560, ia, xd, yd, dkn, false, 1.f, 0.f, lane);
    }
}
constexpr float LOG2E = 1.4426950408889634f;
__device__ __forceinline__ void attn_phase_ab(const bf16* P0, const bf16* QB, const bf16* KVB, bf16* OB, char* lds, const int wave0) {
    const int c = blockIdx.x, G = gridDim.x;
    for (int id = c; id < 1024 + 32; id += G) {
        att::Args a{};
        int mixer, b, h, qrow0, NT;
        if (id < 1024) { const int rnd = id >> 8, cc = id & 255; mixer = rnd >> 1; b = rnd & 1; h = cc & 7; qrow0 = b * SEQ + (cc >> 3) * 256; NT = 132; }
        else { const int cc = id - 1024; mixer = cc >> 4; b = (cc >> 3) & 1; h = cc & 7; qrow0 = MLAT + b * NCTX; NT = 4; }
        a.NT = NT; a.nctx = 4; a.ctx_row0 = MLAT + b * NCTX; a.lat_row0 = b * SEQ; a.ldo = DM; a.qrope_t0 = (id < 1024) ? (qrow0 - b * SEQ) : -1;
        if (mixer == 0) {
            a.Q = P0 + (size_t)qrow0 * N_IN0 + h * 128; a.ldq = N_IN0; a.K = P0 + 1024 + (h >> 2) * 128; a.ldk = N_IN0; a.K2 = nullptr; a.ldk2 = 0; a.V = P0 + 1280 + (h >> 2) * 128; a.ldv = N_IN0;
            a.O = OB + (size_t)qrow0 * DM + h * 128; const float scale = 0.08838834764831845f; a.C = scale * LOG2E; a.thr_raw = 8.0f / scale;

#ifndef DIS_A
            att::attn_unit<128, 0>(a, lds, wave0);
#endif

        } else {
            a.Q = QB + (size_t)qrow0 * N_UQ + h * 192; a.ldq = N_UQ; a.K = KVB + h * 256; a.ldk = N_UKV; a.K2 = P0 + 2560; a.ldk2 = N_IN0; a.V = KVB + h * 256 + 128; a.ldv = N_UKV;
            a.O = OB + (size_t)qrow0 * DM + 1024 + h * 128; const float scale = 0.07216878364870322f; a.C = scale * LOG2E; a.thr_raw = 8.0f / scale;

#ifndef DIS_B
            att::attn_unit<192, 0>(a, lds, wave0);
#endif

        }
    }
}
__device__ __forceinline__ void attn_phase_cd(const bf16* P1, bf16* OB, const float* sink, const float* rpb, char* lds, const int wave0) {
    const int c = blockIdx.x, G = gridDim.x;
    for (int id = c; id < 1024; id += G) {
        att::Args a{};
        const int rnd = id >> 8, cc = id & 255, mixer = rnd >> 1, b = rnd & 1, h = cc & 7, qb = cc >> 3, qrow0 = b * SEQ + qb * 256;
        a.nctx = 4; a.ctx_row0 = MLAT + b * NCTX; a.ldo = DM; a.ldq = a.ldk = a.ldv = N_IN1; a.K2 = nullptr; a.ldk2 = 0;
        const float scale = 0.08838834764831845f; a.C = scale * LOG2E; a.thr_raw = 8.0f / scale; a.inv_scale = 1.0f / scale;
        if (mixer == 0) {
            const int kbase = min(max(qb * 256 - 128, 0), SEQ - 512);
            a.NT = 12; a.lat_row0 = b * SEQ + kbase; a.qpos0 = qb * 256; a.kpos0 = kbase; a.sink_l2 = sink[h] * LOG2E;
            a.Q = P1 + (size_t)qrow0 * N_IN1 + h * 128; a.K = P1 + 1024 + (h >> 2) * 128; a.V = P1 + 1280 + (h >> 2) * 128; a.O = OB + (size_t)qrow0 * DM + h * 128;

#ifndef DIS_C
            att::attn_unit<128, 1>(a, lds, wave0);
#endif

        } else {
            const int r0 = qb * 4, klo = min(max(r0 - 4, 0), 116);
            a.NT = 16; a.lat_row0 = b * SEQ + klo * 64; a.r0 = r0; a.klo = klo; a.rpb = rpb + h * (15 * 31);
            a.Q = P1 + (size_t)qrow0 * N_IN1 + 1536 + h * 128; a.K = P1 + 2560 + h * 128; a.V = P1 + 3584 + h * 128; a.O = OB + (size_t)qrow0 * DM + 1024 + h * 128;

#ifndef DIS_D
            att::attn_unit<128, 2>(a, lds, wave0);
#endif

        }
    }
}

__global__ void __launch_bounds__(NTHR, 2) fwd_megakernel(KArgs args) {
    extern __shared__ __attribute__((aligned(16))) unsigned char lds[];
    cg::grid_group grid = cg::this_grid();
    LAS unsigned char* ldsl = (LAS unsigned char*)lds;
    const int wave0 = __builtin_amdgcn_readfirstlane(threadIdx.x >> 6);
    const int G = gridDim.x, NGW = G * NWAVES;
#define PHASE_IDS() const int tid = fresh_tid(wave0); const int lane = tid & 63, wave = __builtin_amdgcn_readfirstlane(tid >> 6), gw = blockIdx.x * NWAVES + wave; (void)wave; (void)gw; (void)lane
#define WSB (kargs()->ws)
#define x_ (kargs()->in[0])
#define ctx_ (kargs()->in[2])
#define out_ (kargs()->out)
#define hctx_ ((float*)(WSB + WS_HCTX))
#define MOD_ ((const float*)(WSB + WS_MOD))
#define UA_ ((bf16*)(WSB + WS_UO))
#define OB_ ((bf16*)(WSB + WS_OB))
#define FB_ ((bf16*)(WSB + WS_UO))
#define FP_ ((float*)(WSB + WS_UO + 64 * MiB))
#define OFB_ ((bf16*)(WSB + WS_BIG))
#define OFP_ ((float*)(WSB + WS_BIG + 128 * MiB))
#define PB_ ((bf16*)(WSB + WS_BIG))
#define OF_ ((float*)(WSB + WS_BIG))
#define ACT_ ((bf16*)(WSB + WS_BIG))
#define QB_ ((bf16*)(WSB + WS_QB))
#define KVB_ ((bf16*)(WSB + WS_KVB))
#define UB_ ((bf16*)(WSB + WS_UB))
#ifndef PROBE_G
#define PROBE_G 1
#endif
#ifndef PROBE_A
#define PROBE_A 1
#endif
#ifndef PROBE_S
#define PROBE_S 1
#endif
#define GSYNC() do { for (int s_ = 0; s_ < PROBE_S; ++s_) { xcd_barrier(bar); } } while (0)
    volatile LAS unsigned* MISC = (volatile LAS unsigned*)(ldsl + 131072 + 64);
    if (threadIdx.x < 2) MISC[threadIdx.x] = 0u;
    __syncthreads();
    grid.sync();
    XcdBarrier bar = xcd_barrier_post((unsigned*)(kargs()->ws + WS_BAR), MISC);

    for (int rep_ = 0; rep_ < PROBE_S; ++rep_) {
    { PHASE_IDS(); p0_mod(kargs(), ldsl, tid); }
    { PHASE_IDS(); p0_weights(kargs(), ldsl, gw, NGW, wave, lane); }
    }
    GSYNC();
    { PHASE_IDS(); pass_pre(x_, ctx_, kargs()->in[6], MOD_, 0, DM, UA_, MALL, gw, NGW, lane); }
    GSYNC();
    for (int L = 0; L < 2; ++L) {

        const int Mrows = L == 0 ? MALL : MLAT;
        { pg8::Gemm g = pg8::mk_gemm(L == 0 ? UA_ : UB_, (const bf16*)(WSB + (L == 0 ? WS_WIN0 : WS_WIN1)), MALL, L == 0 ? N_IN0 : N_IN1, DM, DM);
          pg8::StaticOrder S; S.init(g.M, g.N, G, (int)blockIdx.x); pg8::EpiBf16 E{PB_, g.N};
          for (int rep_ = 0; rep_ < PROBE_G; ++rep_) pg8::gemm_phase<pg8::EpiBf16, pg8::StaticOrder, true, true>(ldsl, g, S, E, wave0); }
        GSYNC();
        if (L == 0) {
            { PHASE_IDS(); prep_ab(PB_, kargs()->in[15], kargs()->in[16], kargs()->in[17], kargs()->in[18], gw, NGW, lane); }
            GSYNC();
            for (int q = 0; q < 2; ++q) {
                pg8::Gemm g = pg8::mk_gemm(PB_ + (q == 0 ? 1536 : 2048), (const bf16*)(WSB + (q == 0 ? WS_WUQ : WS_WUKV)), MALL, q == 0 ? N_UQ : N_UKV, 512, N_IN0);
                pg8::StaticOrder S; S.init(g.M, g.N, G, (int)blockIdx.x); pg8::EpiBf16 E{q == 0 ? QB_ : KVB_, g.N};
                for (int rep_ = 0; rep_ < PROBE_G; ++rep_) pg8::gemm_phase<pg8::EpiBf16, pg8::StaticOrder, true, true>(ldsl, g, S, E, wave0);
            }
            GSYNC();
            for (int rep_ = 0; rep_ < PROBE_A; ++rep_) attn_phase_ab(PB_, QB_, KVB_, OB_, (char*)lds, wave0);
        } else {
            { PHASE_IDS(); prep_cd(PB_, kargs()->in[23], kargs()->in[24], kargs()->in[26], kargs()->in[27], gw, NGW, lane); }
            GSYNC();
            for (int rep_ = 0; rep_ < PROBE_A; ++rep_) attn_phase_cd(PB_, OB_, kargs()->in[25], kargs()->in[28], (char*)lds, wave0);
        }
        GSYNC();
        { pg8::Gemm g = pg8::mk_gemm(OB_, (const bf16*)(WSB + (L == 0 ? WS_WOUT0 : WS_WOUT1)), MLAT, DM, DM, DM);
          pg8::StaticOrder S; S.init(g.M, g.N, G, (int)blockIdx.x); pg8::EpiBf16 E{OFB_, DM};
          for (int rep_ = 0; rep_ < PROBE_G; ++rep_) pg8::gemm_phase<pg8::EpiBf16, pg8::StaticOrder, true, true>(ldsl, g, S, E, wave0); }
        if (L == 0) { pg8::Gemm g = pg8::mk_gemm(OB_ + (size_t)MLAT * DM, (const bf16*)(WSB + WS_WOUT0), 2 * NCTX, 4 * DM, DM / 4, DM); g.ldb = DM; g.nNr = DM / 256;
          pg8::StaticOrder S; S.init(g.M, g.N, G, (int)blockIdx.x); pg8::EpiF32Split E{OFP_, DM, DM / 256, (size_t)2 * NCTX * DM};
          for (int rep_ = 0; rep_ < PROBE_G; ++rep_) pg8::gemm_phase<pg8::EpiF32Split, pg8::StaticOrder, true, true>(ldsl, g, S, E, wave0); }
        GSYNC();
        { PHASE_IDS(); pass_post(OFB_, OFP_, L == 0 ? x_ : out_, L == 0 ? ctx_ : hctx_, out_, hctx_, kargs()->in[7] + L * DM, MOD_ + (size_t)L * 3 * 12288, 2 * DM, kargs()->in[8] + L * DM, MOD_ + (size_t)L * 3 * 12288, 3 * DM, 4 * DM, UA_, Mrows, gw, NGW, lane); }
        GSYNC();
        { pg8::Gemm g = pg8::mk_gemm(UA_, (const bf16*)(WSB + WS_WGU + (size_t)L * 44 * MiB), Mrows, N_GU, DM, DM);
          pg8::StaticOrder S; S.init(g.M, g.N, G, (int)blockIdx.x); pg8::EpiSwiglu E{ACT_, DFF};
          for (int rep_ = 0; rep_ < PROBE_G; ++rep_) pg8::gemm_phase<pg8::EpiSwiglu, pg8::StaticOrder, true, true>(ldsl, g, S, E, wave0); }
        GSYNC();
        { pg8::Gemm g = pg8::mk_gemm(ACT_, (const bf16*)(WSB + WS_WD + (size_t)L * 22 * MiB), MLAT, DM, DFF, DFF);
          pg8::StaticOrder S; S.init(g.M, g.N, G, (int)blockIdx.x); pg8::EpiBf16 E{FB_, DM};
          for (int rep_ = 0; rep_ < PROBE_G; ++rep_) pg8::gemm_phase<pg8::EpiBf16, pg8::StaticOrder, true, true>(ldsl, g, S, E, wave0); }
        if (L == 0) { pg8::Gemm g = pg8::mk_gemm(ACT_ + (size_t)MLAT * DFF, (const bf16*)(WSB + WS_WD), 2 * NCTX, 4 * DM, DFF / 4, DFF); g.ldb = DFF; g.nNr = DM / 256;
          pg8::StaticOrder S; S.init(g.M, g.N, G, (int)blockIdx.x); pg8::EpiF32Split E{FP_, DM, DM / 256, (size_t)2 * NCTX * DM};
          for (int rep_ = 0; rep_ < PROBE_G; ++rep_) pg8::gemm_phase<pg8::EpiF32Split, pg8::StaticOrder, true, true>(ldsl, g, S, E, wave0); }
        GSYNC();
        { PHASE_IDS(); pass_post(FB_, FP_, out_, hctx_, out_, hctx_, kargs()->in[9] + L * DM, MOD_ + (size_t)L * 3 * 12288, 5 * DM, kargs()->in[6] + DM, MOD_ + (size_t)3 * 12288, 0, DM, L == 0 ? UB_ : nullptr, Mrows, gw, NGW, lane); }
        if (L == 0) GSYNC();
    }
#undef GSYNC
}

constexpr int LDS_BYTES = 131072 + 1024;
extern "C" void kernel_launch(void* const* d_in, const int* in_sizes, int n_in, void* d_out, int out_size, void* d_ws, size_t ws_size, hipStream_t stream) {
    static int grid = 0;
    if (grid == 0) {
        if (n_in != 29 || out_size != MLAT * DM || ws_size < WS_END) { fprintf(stderr, "kernel_launch: unexpected shapes: n_in %d out %d ws %zu (need %zu)\n", n_in, out_size, ws_size, (size_t)WS_END); grid = -1; return; }
        int dev = 0, cus = 0, per_cu = 0;
        hipGetDevice(&dev); hipDeviceGetAttribute(&cus, hipDeviceAttributeMultiprocessorCount, dev);
        if (hipFuncSetAttribute((const void*)fwd_megakernel, hipFuncAttributeMaxDynamicSharedMemorySize, LDS_BYTES) != hipSuccess) { fprintf(stderr, "kernel_launch: hipFuncSetAttribute failed\n"); grid = -1; return; }
        if (hipOccupancyMaxActiveBlocksPerMultiprocessor(&per_cu, (const void*)fwd_megakernel, NTHR, LDS_BYTES) != hipSuccess || per_cu < 1) { fprintf(stderr, "kernel_launch: occupancy query says %d\n", per_cu); per_cu = 1; }
        (void)hipGetLastError();
        grid = cus;
        fprintf(stderr, "kernel_launch: grid %d (per_cu %d)\n", grid, per_cu);
    }
    if (grid < 0) return;
    if (hipMemsetAsync((char*)d_ws + WS_BAR, 0, BAR_BYTES, stream) != hipSuccess) { fprintf(stderr, "kernel_launch: hipMemsetAsync failed\n"); return; }
    KArgs a{};
    for (int i = 0; i < 29; ++i) a.in[i] = (const float*)d_in[i];
    a.out = (float*)d_out; a.ws = (unsigned char*)d_ws;
    void* params[] = {&a};
    const hipError_t e = hipLaunchCooperativeKernel((const void*)fwd_megakernel, dim3(grid), dim3(NTHR), params, LDS_BYTES, stream);
    if (e != hipSuccess) fprintf(stderr, "kernel_launch: cooperative launch failed: %s (grid %d)\n", hipGetErrorString(e), grid);
}
```

```cpp
#include <hip/hip_runtime.h>
#include <hip/hip_cooperative_groups.h>
#include <cstdio>
#include <cstdint>
namespace cg = cooperative_groups;
__device__ __forceinline__ int fresh_tid(int wave0) { int l; asm volatile("v_mbcnt_lo_u32_b32 %0, -1, 0\n\tv_mbcnt_hi_u32_b32 %0, -1, %0" : "=v"(l)); return wave0 * 64 + l; }
namespace pg8 {
#define PG8_LAS __attribute__((address_space(3)))
typedef unsigned short bf16_t;
typedef short bf16x8 __attribute__((ext_vector_type(8)));
typedef float f32x4 __attribute__((ext_vector_type(4)));
typedef unsigned u32x4 __attribute__((ext_vector_type(4)));
constexpr int BM = 256, BK = 64, HALF = 128, HTB = HALF * BK * 2  , STAGE_BYTES = 8 * HTB, NXCD = 8, WGM = 8;

__host__ __device__ __forceinline__ int lds_byte(int r, int c) { const int st = (r >> 4) * 2 + (c >> 5), rr = r & 15, cc = c & 31, ob = rr * 64 + cc * 2; return st * 1024 + (ob ^ (((ob >> 9) & 1) << 5)); }
__host__ __device__ __forceinline__ void stage_rc(int b, int& R, int& C) { const int st = b / 1024, sb = b % 1024, swz = sb ^ (((sb >> 9) & 1) << 5); R = (st >> 1) * 16 + swz / 64; C = (st & 1) * 32 + (swz % 64) / 2; }
__host__ __device__ __forceinline__ int perm32(int rho) { const int n = rho >> 4, i = rho & 15; return 8 * (i >> 2) + 4 * n + (i & 3); }

struct Unit { int pm, pn; };
struct Gemm { const bf16_t* A; const bf16_t* Bt; int M, N, K, lda, ldb, nNr; };
__host__ __device__ __forceinline__ Gemm mk_gemm(const bf16_t* A, const bf16_t* Bt, int M, int N, int K, int lda) { Gemm g; g.A = A; g.Bt = Bt; g.M = M; g.N = N; g.K = K; g.lda = lda; g.ldb = K; g.nNr = N / BM; return g; }

struct StaticOrder {
    int nM, nN, nwg, G, c;
    __host__ __device__ void init(int M, int N, int G_, int c_) { nM = M / BM; nN = N / BM; nwg = nM * nN; G = G_; c = c_; }
    __host__ __device__ bool next(int i, Unit& u) const {
        const long L = (long)i * G + c; if (L >= nwg) return false;
        int wgid = (int)L; { const int q = nwg / NXCD, r = nwg % NXCD, xcd = wgid % NXCD, off = wgid / NXCD; wgid = (xcd < r ? xcd * (q + 1) : r * (q + 1) + (xcd - r) * q) + off; }
        const int nig = WGM * nN, gid = wgid / nig, fm = gid * WGM, gsz = (nM - fm) < WGM ? (nM - fm) : WGM;
        u.pm = fm + ((wgid % nig) % gsz); u.pn = (wgid % nig) / gsz; return true;
    }
    __device__ __forceinline__ void a_ready(const Unit&) const {}
    __device__ __forceinline__ void done(const Unit&) const {}
};


__device__ __forceinline__ unsigned cvt_pk_bf16(float lo, float hi) { unsigned r; asm volatile("v_cvt_pk_bf16_f32 %0, %1, %2" : "=v"(r) : "v"(lo), "v"(hi)); return r; }
struct EpiBf16 {
    static constexpr bool PERM = true, AFTER_DRAIN = false;
    bf16_t* O; int ldc;
    __device__ __forceinline__ void operator()(const f32x4 (&acc)[2][2][4][2], const Unit& u, int wr, int wc, int fr, int fq) const {
        const int row0 = u.pm * BM + wr * 64 + fr, col0 = u.pn * BM + wc * 32 + 8 * fq;
#pragma unroll
        for (int ai = 0; ai < 2; ++ai)
#pragma unroll
            for (int m = 0; m < 4; ++m) { bf16_t* rowp = O + (size_t)(row0 + ai * HALF + m * 16) * ldc + col0;
#pragma unroll
                for (int bj = 0; bj < 2; ++bj) { const f32x4 v0 = acc[ai][bj][m][0], v1 = acc[ai][bj][m][1];
                    u32x4 w; w.x = cvt_pk_bf16(v0[0], v0[1]); w.y = cvt_pk_bf16(v0[2], v0[3]); w.z = cvt_pk_bf16(v1[0], v1[1]); w.w = cvt_pk_bf16(v1[2], v1[3]);
                    *(u32x4*)(rowp + bj * HALF) = w; } }
    }
};
struct EpiF32 {
    static constexpr bool PERM = false, AFTER_DRAIN = false;
    float* O; int ldc;
    __device__ __forceinline__ void operator()(const f32x4 (&acc)[2][2][4][2], const Unit& u, int wr, int wc, int fr, int fq) const {
        const int row0 = u.pm * BM + wr * 64 + fr, col0 = u.pn * BM + wc * 32 + 4 * fq;
#pragma unroll
        for (int ai = 0; ai < 2; ++ai)
#pragma unroll
            for (int m = 0; m < 4; ++m) { float* rowp = O + (size_t)(row0 + ai * HALF + m * 16) * ldc + col0;
#pragma unroll
                for (int bj = 0; bj < 2; ++bj)
#pragma unroll
                    for (int n = 0; n < 2; ++n) *(f32x4*)(rowp + bj * HALF + n * 16) = acc[ai][bj][m][n]; }
    }
};
struct EpiF32Split {
    static constexpr bool PERM = false, AFTER_DRAIN = false;
    float* O; int ldc; int nNr; size_t sstride;
    __device__ __forceinline__ void operator()(const f32x4 (&acc)[2][2][4][2], const Unit& u, int wr, int wc, int fr, int fq) const {
        const int s = u.pn / nNr, pn = u.pn - s * nNr;
        const int row0 = u.pm * BM + wr * 64 + fr, col0 = pn * BM + wc * 32 + 4 * fq; float* Ob = O + (size_t)s * sstride;
#pragma unroll
        for (int ai = 0; ai < 2; ++ai)
#pragma unroll
            for (int m = 0; m < 4; ++m) { float* rowp = Ob + (size_t)(row0 + ai * HALF + m * 16) * ldc + col0;
#pragma unroll
                for (int bj = 0; bj < 2; ++bj)
#pragma unroll
                    for (int n = 0; n < 2; ++n) *(f32x4*)(rowp + bj * HALF + n * 16) = acc[ai][bj][m][n]; }
    }
};
__device__ __forceinline__ float silu_mul(float g, float u) { return g * __builtin_amdgcn_rcpf(1.0f + __builtin_amdgcn_exp2f(-1.4426950408889634f * g)) * u; }
struct EpiSwiglu {
    static constexpr bool PERM = true, AFTER_DRAIN = false;
    bf16_t* O; int ldc;
    __device__ __forceinline__ void operator()(const f32x4 (&acc)[2][2][4][2], const Unit& u, int wr, int wc, int fr, int fq) const {
        const int row0 = u.pm * BM + wr * 64 + fr, col0 = u.pn * HALF + wc * 32 + 8 * fq;
#pragma unroll
        for (int ai = 0; ai < 2; ++ai)
#pragma unroll
            for (int m = 0; m < 4; ++m) { bf16_t* rowp = O + (size_t)(row0 + ai * HALF + m * 16) * ldc + col0;
                const f32x4 g0 = acc[ai][0][m][0], g1 = acc[ai][0][m][1], u0 = acc[ai][1][m][0], u1 = acc[ai][1][m][1];
                u32x4 w; w.x = cvt_pk_bf16(silu_mul(g0[0], u0[0]), silu_mul(g0[1], u0[1])); w.y = cvt_pk_bf16(silu_mul(g0[2], u0[2]), silu_mul(g0[3], u0[3]));
                w.z = cvt_pk_bf16(silu_mul(g1[0], u1[0]), silu_mul(g1[1], u1[1])); w.w = cvt_pk_bf16(silu_mul(g1[2], u1[2]), silu_mul(g1[3], u1[3]));
                *(u32x4*)rowp = w; }
    }
};

template <class Epi, class Sched, bool ALIGN_EPI = false, bool SP2 = false>
__device__ __forceinline__ void gemm_phase(PG8_LAS unsigned char* lds, const Gemm g, const Sched& S, const Epi& E, const int wave0) {
    const int tid = fresh_tid(wave0), wid = __builtin_amdgcn_readfirstlane(tid >> 6), lane = tid & 63, wr = wid >> 2, wc = wid & 3, fr = lane & 15, fq = lane >> 4;
    const int K = g.K, nt = K / BK;
    unsigned voffA[2], voffB[2];
#pragma unroll
    for (int i = 0; i < 2; ++i) { int R, C; stage_rc(tid * 16 + i * 8192, R, C); const int Rb = Epi::PERM ? ((R & ~31) + perm32(R & 31)) : R;
        voffA[i] = (unsigned)(R * g.lda + C) * 2u; voffB[i] = (unsigned)(Rb * g.ldb + C) * 2u; }
    const size_t kstep = (size_t)(BK * 2);
    const size_t hstepA = (size_t)HALF * g.lda * 2, hstepB = (size_t)HALF * g.ldb * 2; const size_t ksb = (size_t)K * 2;
#define PG8_APTR(u) ((const char*)g.A + (size_t)(u).pm * tstepA + (size_t)((u).pn / g.nNr) * ksb)
#define PG8_BPTR(u) ((const char*)g.Bt + (size_t)((u).pn % g.nNr) * tstepB + (size_t)((u).pn / g.nNr) * ksb)
    const size_t tstepA = 2 * hstepA, tstepB = 2 * hstepB;
    const unsigned ldsw = (unsigned)wid * 1024u;
    const int aoff = lds_byte(wr * 64 + fr, fq * 8), boff = lds_byte(wc * 32 + fr, fq * 8);
#define PG8_SA(b, h) (((b) * 2 + (h)) * HTB)
#define PG8_SB(b, h) ((4 + (b) * 2 + (h)) * HTB)
#define PG8_STAGE(bufoff, gbase, voff) do { _Pragma("unroll") for (int _i = 0; _i < 2; ++_i) \
        __builtin_amdgcn_global_load_lds((const unsigned*)((const char*)(gbase) + (voff)[_i]), (PG8_LAS unsigned*)(lds + (bufoff) + ldsw + _i * 8192), 16, 0, 0); } while (0)
#define PG8_LDA(dst, b, h) do { _Pragma("unroll") for (int m = 0; m < 4; ++m) _Pragma("unroll") for (int k = 0; k < 2; ++k) dst[m][k] = *(const PG8_LAS bf16x8*)(lds + PG8_SA(b, h) + aoff + m * 2048 + k * 1024); } while (0)
#define PG8_LDB(dst, b, h) do { _Pragma("unroll") for (int n = 0; n < 2; ++n) _Pragma("unroll") for (int k = 0; k < 2; ++k) dst[n][k] = *(const PG8_LAS bf16x8*)(lds + PG8_SB(b, h) + boff + n * 2048 + k * 1024); } while (0)
#define PG8_MMA(ai, bj, At, Bt) do { __builtin_amdgcn_s_setprio(1); _Pragma("unroll") for (int m = 0; m < 4; ++m) _Pragma("unroll") for (int n = 0; n < 2; ++n) _Pragma("unroll") for (int k = 0; k < 2; ++k) \
        acc[ai][bj][m][n] = __builtin_amdgcn_mfma_f32_16x16x32_bf16(Bt[n][k], At[m][k], acc[ai][bj][m][n], 0, 0, 0); __builtin_amdgcn_s_setprio(0); } while (0)
#define PG8_WAIT_V(n) asm volatile("s_waitcnt vmcnt(" #n ")" ::: "memory")
#define PG8_WAIT_L(n) asm volatile("s_waitcnt lgkmcnt(" #n ")" ::: "memory")
#define PG8_BAR __builtin_amdgcn_s_barrier()
#define PG8_SCHED __builtin_amdgcn_sched_barrier(0)
    Unit cur, nxt; int ui = 0;
    if (!S.next(0, cur)) return;
    f32x4 acc[2][2][4][2];
#pragma unroll
    for (int a = 0; a < 2; ++a)
#pragma unroll
        for (int b = 0; b < 2; ++b)
#pragma unroll
            for (int m = 0; m < 4; ++m)
#pragma unroll
                for (int n = 0; n < 2; ++n) acc[a][b][m][n] = (f32x4){0.f, 0.f, 0.f, 0.f};
    bf16x8 At[4][2], B0[2][2], B1[2][2];
    const char* cA = PG8_APTR(cur); const char* cB = PG8_BPTR(cur);
    S.a_ready(cur);
    if constexpr (SP2) {
        PG8_STAGE(PG8_SB(0, 0), cB, voffB); PG8_STAGE(PG8_SB(0, 1), cB + hstepB, voffB); PG8_STAGE(PG8_SA(0, 0), cA, voffA); PG8_STAGE(PG8_SA(0, 1), cA + hstepA, voffA);
        if (wr == 1) PG8_BAR;
        PG8_WAIT_V(2); PG8_BAR;
        PG8_STAGE(PG8_SB(1, 0), cB + kstep, voffB); PG8_STAGE(PG8_SA(1, 0), cA + kstep, voffA); PG8_STAGE(PG8_SB(1, 1), cB + hstepB + kstep, voffB);
        PG8_WAIT_V(6); PG8_BAR;
    } else {
        PG8_STAGE(PG8_SB(0, 0), cB, voffB); PG8_STAGE(PG8_SA(0, 0), cA, voffA); PG8_STAGE(PG8_SB(0, 1), cB + hstepB, voffB); PG8_STAGE(PG8_SA(0, 1), cA + hstepA, voffA);
        if (wr == 1) PG8_BAR;
        PG8_WAIT_V(4); PG8_BAR;
        PG8_STAGE(PG8_SB(1, 0), cB + kstep, voffB); PG8_STAGE(PG8_SA(1, 0), cA + kstep, voffA); PG8_STAGE(PG8_SB(1, 1), cB + hstepB + kstep, voffB);
        PG8_WAIT_V(6); PG8_BAR;
    }
    for (;;) {
        const bool has_next = S.next(ui + 1, nxt);
        const char* nA = has_next ? PG8_APTR(nxt) : cA; const char* nB = has_next ? PG8_BPTR(nxt) : cB;
        for (int t = 0; t < nt; t += 2) {
            const bool last = (t == nt - 2);
            const char* a1 = cA + (size_t)(t + 1) * kstep;
            const char* a2 = last ? nA : cA + (size_t)(t + 2) * kstep; const char* b2 = last ? nB : cB + (size_t)(t + 2) * kstep;
            const char* a3 = a2 + kstep; const char* b3 = b2 + kstep;
            if (last && has_next) S.a_ready(nxt);
            if constexpr (SP2) {
            PG8_LDB(B0, 0, 0); PG8_LDB(B1, 0, 1); PG8_SCHED; PG8_LDA(At, 0, 0); PG8_STAGE(PG8_SA(1, 1), a1 + hstepA, voffA);
            PG8_WAIT_V(8); PG8_WAIT_L(0); PG8_BAR; PG8_MMA(0, 0, At, B0); PG8_MMA(0, 1, At, B1); PG8_BAR; PG8_SCHED;
            PG8_LDA(At, 0, 1); PG8_STAGE(PG8_SB(0, 0), b2, voffB); PG8_STAGE(PG8_SB(0, 1), b2 + hstepB, voffB); PG8_STAGE(PG8_SA(0, 0), a2, voffA);
            PG8_WAIT_V(8); PG8_WAIT_L(0); PG8_BAR; PG8_MMA(1, 0, At, B0); PG8_MMA(1, 1, At, B1); PG8_BAR; PG8_SCHED;
            PG8_LDB(B0, 1, 0); PG8_LDB(B1, 1, 1); PG8_SCHED; PG8_LDA(At, 1, 0); PG8_STAGE(PG8_SA(0, 1), a2 + hstepA, voffA);
            PG8_WAIT_V(8); PG8_WAIT_L(0); PG8_BAR; PG8_MMA(0, 0, At, B0); PG8_MMA(0, 1, At, B1); PG8_BAR; PG8_SCHED;
            PG8_LDA(At, 1, 1); PG8_STAGE(PG8_SB(1, 0), b3, voffB); PG8_STAGE(PG8_SB(1, 1), b3 + hstepB, voffB); PG8_STAGE(PG8_SA(1, 0), a3, voffA);
            PG8_WAIT_V(8); PG8_WAIT_L(0); PG8_BAR; PG8_MMA(1, 0, At, B0); PG8_MMA(1, 1, At, B1); PG8_BAR; PG8_SCHED;
            } else {
            PG8_LDB(B0, 0, 0); PG8_SCHED; PG8_LDA(At, 0, 0); PG8_STAGE(PG8_SA(1, 1), a1 + hstepA, voffA);
            PG8_WAIT_L(8); PG8_BAR; PG8_WAIT_L(0); PG8_MMA(0, 0, At, B0); PG8_BAR; PG8_SCHED;
            PG8_LDB(B1, 0, 1); PG8_STAGE(PG8_SB(0, 0), b2, voffB);
            PG8_BAR; PG8_WAIT_L(0); PG8_MMA(0, 1, At, B1); PG8_BAR;
            PG8_LDA(At, 0, 1); PG8_STAGE(PG8_SA(0, 0), a2, voffA);
            PG8_BAR; PG8_WAIT_L(0); PG8_MMA(1, 0, At, B0); PG8_BAR; PG8_SCHED;
            PG8_STAGE(PG8_SB(0, 1), b2 + hstepB, voffB);
            PG8_WAIT_V(6); PG8_BAR; PG8_MMA(1, 1, At, B1); PG8_BAR;
            PG8_LDB(B0, 1, 0); PG8_SCHED; PG8_LDA(At, 1, 0); PG8_STAGE(PG8_SA(0, 1), a2 + hstepA, voffA);
            PG8_WAIT_L(8); PG8_BAR; PG8_WAIT_L(0); PG8_MMA(0, 0, At, B0); PG8_BAR; PG8_SCHED;
            PG8_LDB(B1, 1, 1); PG8_STAGE(PG8_SB(1, 0), b3, voffB);
            PG8_BAR; PG8_WAIT_L(0); PG8_MMA(0, 1, At, B1); PG8_BAR;
            PG8_LDA(At, 1, 1); PG8_STAGE(PG8_SA(1, 0), a3, voffA);
            PG8_BAR; PG8_WAIT_L(0); PG8_MMA(1, 0, At, B0); PG8_BAR; PG8_SCHED;
            PG8_STAGE(PG8_SB(1, 1), b3 + hstepB, voffB);
            PG8_WAIT_V(6); PG8_BAR; PG8_MMA(1, 1, At, B1); PG8_BAR;
            }
        }
        if constexpr (ALIGN_EPI) { if (wr == 0) PG8_BAR; }
        if constexpr (!Epi::AFTER_DRAIN) { E(acc, cur, wr, wc, fr, fq); S.done(cur); }
        if (!has_next) break;
#pragma unroll
        for (int a = 0; a < 2; ++a)
#pragma unroll
            for (int b = 0; b < 2; ++b)
#pragma unroll
                for (int m = 0; m < 4; ++m)
#pragma unroll
                    for (int n = 0; n < 2; ++n) acc[a][b][m][n] = (f32x4){0.f, 0.f, 0.f, 0.f};
        cur = nxt; cA = nA; cB = nB; ++ui;
        if constexpr (ALIGN_EPI) { if (wr == 1) PG8_BAR; }
    }
    PG8_WAIT_V(0);
    if constexpr (!ALIGN_EPI) { if (wr == 0) PG8_BAR; }
    PG8_BAR;
    if constexpr (Epi::AFTER_DRAIN) { E.fused(acc, cur, wr, wc, fr, fq, lds, wid, lane); S.done(cur); }
#undef PG8_APTR
#undef PG8_BPTR
#undef PG8_SA
#undef PG8_SB
#undef PG8_STAGE
#undef PG8_LDA
#undef PG8_LDB
#undef PG8_MMA
#undef PG8_WAIT_V
#undef PG8_WAIT_L
#undef PG8_BAR
#undef PG8_SCHED
}
}
namespace att {
typedef unsigned short bf16;
typedef short bf16x8 __attribute__((ext_vector_type(8)));
typedef short s16x4 __attribute__((ext_vector_type(4)));
typedef float f32x16 __attribute__((ext_vector_type(16)));
typedef unsigned u32x4 __attribute__((ext_vector_type(4)));
constexpr int NW = 8, QBLK = 32, KVBLK = 64;
constexpr int SHM_V = KVBLK * 128 * 2;
#define SBAR() __builtin_amdgcn_sched_barrier(0)
__device__ __forceinline__ int crow(int r, int hi) { return (r & 3) + 8 * (r >> 2) + 4 * hi; }
__device__ __forceinline__ unsigned cvtpk(float lo, float hi) { unsigned r; asm volatile("v_cvt_pk_bf16_f32 %0, %1, %2" : "=v"(r) : "v"(lo), "v"(hi)); return r; }

struct Args {
  const bf16* Q; const bf16* K; const bf16* K2; const bf16* V; bf16* O;
  int ldq, ldk, ldk2, ldv, ldo;
  int NT, nctx, ctx_row0, lat_row0;
  float C, thr_raw;
  int qpos0, kpos0;
  float sink_l2;
  int r0, klo;
  const float* rpb; float inv_scale;
  const float* qgain;
  int qrope_t0;
};

__device__ __forceinline__ void partialSM(f32x16& p0, f32x16& p1, float& m_reg, float& mn, float& alpha, const float C, const float thr_raw) {
  float pmax = p0[0];
#pragma unroll
  for (int r = 1; r < 16; ++r) pmax = fmaxf(pmax, p0[r]);
#pragma unroll
  for (int r = 0; r < 16; ++r) pmax = fmaxf(pmax, p1[r]);
  { auto rr = __builtin_amdgcn_permlane32_swap(__float_as_uint(pmax), __float_as_uint(pmax), false, false);
    pmax = fmaxf(__uint_as_float(rr[0]), __uint_as_float(rr[1])); }
  if (__builtin_expect(__all(pmax - m_reg <= thr_raw), 1)) { mn = m_reg; alpha = 1.f; }
  else { mn = fmaxf(m_reg, pmax); alpha = __builtin_amdgcn_exp2f((m_reg - mn) * C); m_reg = mn; }
  const float mnC = -mn * C;
#pragma unroll
  for (int r = 0; r < 16; ++r) p0[r] = fmaf(p0[r], C, mnC);
#pragma unroll
  for (int r = 0; r < 16; ++r) p1[r] = fmaf(p1[r], C, mnC);
#pragma unroll
  for (int r = 0; r < 16; ++r) p0[r] = __builtin_amdgcn_exp2f(p0[r]);
}
__device__ __forceinline__ void finishSM(f32x16& p0, f32x16& p1, float alpha, float& l_reg, bf16x8& pa0, bf16x8& pa1, bf16x8& pa2, bf16x8& pa3) {
#pragma unroll
  for (int r = 0; r < 16; ++r) p1[r] = __builtin_amdgcn_exp2f(p1[r]);
  float ps = 0;
#pragma unroll
  for (int r = 0; r < 16; ++r) ps += p0[r];
#pragma unroll
  for (int r = 0; r < 16; ++r) ps += p1[r];
  { auto rr = __builtin_amdgcn_permlane32_swap(__float_as_uint(ps), __float_as_uint(ps), false, false);
    ps = __uint_as_float(rr[0]) + __uint_as_float(rr[1]); }
  l_reg = l_reg * alpha + ps;
#define PK4(P, BASE, OUT) do { unsigned a0 = cvtpk(P[BASE + 0], P[BASE + 1]), a1 = cvtpk(P[BASE + 2], P[BASE + 3]);   \
    unsigned b0 = cvtpk(P[BASE + 4], P[BASE + 5]), b1 = cvtpk(P[BASE + 6], P[BASE + 7]);                              \
    auto r0 = __builtin_amdgcn_permlane32_swap(a0, b0, false, false); auto r1 = __builtin_amdgcn_permlane32_swap(a1, b1, false, false); \
    u32x4 w = {r0[0], r1[0], r0[1], r1[1]}; OUT = *reinterpret_cast<bf16x8*>(&w); } while (0)
  PK4(p0, 0, pa0); PK4(p0, 8, pa1); PK4(p1, 0, pa2); PK4(p1, 8, pa3);
#undef PK4
}
template <int DQ> __device__ __forceinline__ int kswz(int row, int colB) { return row * (DQ * 2) + (colB ^ ((row & 7) << 4)); }
typedef const __attribute__((address_space(3))) bf16x8* lds_b128_ptr;
template <int DQ> __device__ __forceinline__ void qkt(f32x16& p0, f32x16& p1, const int (&kx)[4], int koff, const bf16x8* qr) {
  p0 = f32x16{}; p1 = f32x16{};
  lds_b128_ptr k0 = (lds_b128_ptr)(unsigned)(kx[0] + koff), k1 = (lds_b128_ptr)(unsigned)(kx[1] + koff), k2 = (lds_b128_ptr)(unsigned)(kx[2] + koff), k3 = (lds_b128_ptr)(unsigned)(kx[3] + koff);
#pragma unroll
  for (int d0 = 0; d0 < DQ / 16; ++d0) { lds_b128_ptr kp = (d0 & 3) == 0 ? k0 : (d0 & 3) == 1 ? k1 : (d0 & 3) == 2 ? k2 : k3;
    const bf16x8 b0 = kp[(d0 >> 2) * 8];
    const bf16x8 b1 = kp[(d0 >> 2) * 8 + 32 * DQ * 2 / 16];
    p0 = __builtin_amdgcn_mfma_f32_32x32x16_bf16(b0, qr[d0], p0, 0, 0, 0);
    p1 = __builtin_amdgcn_mfma_f32_32x32x16_bf16(b1, qr[d0], p1, 0, 0, 0); }
}
__device__ __forceinline__ int v_st(int k, int c) { const int kk = (k & ~0xC) | ((k & 4) << 1) | ((k & 8) >> 1); return ((kk >> 3) * 4 + (c >> 5)) * 512 + ((kk & 7) * 32 + (c & 31)) * 2; }
__device__ __forceinline__ int v_rd_base(int lane) { return ((lane & 3) << 3) | (((lane >> 2) & 3) << 6) | (((lane >> 4) & 1) << 5) | (((lane >> 5) & 1) << 8); }
constexpr int v_rd_off(int d0, int ks, int half) { return d0 * 512 + ks * 4096 + half * 2048; }
template <int OFF> __device__ __forceinline__ s16x4 tr_read(int vb) {
  s16x4 r; asm volatile("ds_read_b64_tr_b16 %0, %1 offset:%2" : "=&v"(r) : "v"(vb), "i"(OFF) : "memory"); return r;
}
template <int D0> __device__ __forceinline__ void pv_one(f32x16& od, int vb, bf16x8 pa0, bf16x8 pa1, bf16x8 pa2, bf16x8 pa3) {
  const s16x4 l0 = tr_read<v_rd_off(D0, 0, 0)>(vb), h0 = tr_read<v_rd_off(D0, 0, 1)>(vb), l1 = tr_read<v_rd_off(D0, 1, 0)>(vb), h1 = tr_read<v_rd_off(D0, 1, 1)>(vb);
  const s16x4 l2 = tr_read<v_rd_off(D0, 2, 0)>(vb), h2 = tr_read<v_rd_off(D0, 2, 1)>(vb), l3 = tr_read<v_rd_off(D0, 3, 0)>(vb), h3 = tr_read<v_rd_off(D0, 3, 1)>(vb);
  asm volatile("s_waitcnt lgkmcnt(0)" ::: "memory"); SBAR();
#define PK(L, H) (bf16x8){L[0], L[1], L[2], L[3], H[0], H[1], H[2], H[3]}
  od = __builtin_amdgcn_mfma_f32_32x32x16_bf16(pa0, PK(l0, h0), od, 0, 0, 0);
  od = __builtin_amdgcn_mfma_f32_32x32x16_bf16(pa1, PK(l1, h1), od, 0, 0, 0);
  od = __builtin_amdgcn_mfma_f32_32x32x16_bf16(pa2, PK(l2, h2), od, 0, 0, 0);
  od = __builtin_amdgcn_mfma_f32_32x32x16_bf16(pa3, PK(l3, h3), od, 0, 0, 0);
#undef PK
}
__device__ __forceinline__ void pv_d0(f32x16* o, int vb, bf16x8 pa0, bf16x8 pa1, bf16x8 pa2, bf16x8 pa3) {
  pv_one<0>(o[0], vb, pa0, pa1, pa2, pa3); pv_one<1>(o[1], vb, pa0, pa1, pa2, pa3); pv_one<2>(o[2], vb, pa0, pa1, pa2, pa3); pv_one<3>(o[3], vb, pa0, pa1, pa2, pa3);
}
template <int MODE> __device__ __forceinline__ void maskf(f32x16& p0, f32x16& p1, int t, const Args& a, int wid, int r32, int hi, const float* bias_lds) {
  if constexpr (MODE == 0) { return; }
  else {
    if (t < a.nctx) return;
    if constexpr (MODE == 1) {
      const int kb = a.kpos0 + (t - a.nctx) * 64, qw = a.qpos0 + wid * 32;
      if (kb + 63 - qw <= 128 && qw + 31 - kb <= 128) return;
      const int q = qw + r32;
#pragma unroll
      for (int r = 0; r < 16; ++r) { const int d0 = kb + crow(r, hi) - q, d1 = d0 + 32;
        if (d0 > 128 || d0 < -128) p0[r] = -1e30f;
        if (d1 > 128 || d1 < -128) p1[r] = -1e30f; }
    } else {
      const int kr = a.klo + (t - a.nctx), rq = a.r0 + (wid >> 1);
      const int rs = min(max(rq - 4, 0), 120);
      if (kr < rs || kr >= rs + 8) {
#pragma unroll
        for (int r = 0; r < 16; ++r) { p0[r] = -1e30f; p1[r] = -1e30f; }
        return; }
      const int c = (wid & 1) * 32 + r32, cs = min(max(c - 8, 0), 48);
      int cb = 4 * hi - c + 63, vb = 4 * hi - cs;
      asm volatile("" : "+v"(cb), "+v"(vb));
      const float* bp = bias_lds + (kr - rq + 7) * 128 + cb;
#pragma unroll
      for (int r = 0; r < 16; ++r) { const int k0 = (r & 3) + 8 * (r >> 2), k1 = k0 + 32;
        const float b0 = bp[k0], b1 = bp[k1];
        p0[r] = ((unsigned)(k0 + vb) < 16u) ? fmaf(b0, a.inv_scale, p0[r]) : -1e30f;
        p1[r] = ((unsigned)(k1 + vb) < 16u) ? fmaf(b1, a.inv_scale, p1[r]) : -1e30f;
        if ((r & 3) == 3) SBAR(); }
    }
  }
}

template <int DQ, int MODE>
__device__ __forceinline__ void attn_unit(const Args& a, char* lds, const int wave0) {
  constexpr int SHM_K = KVBLK * DQ * 2, NQ = DQ / 16, OFF_K = 3 * SHM_V, OFF_WS = OFF_K + 2 * SHM_K;
  const int tid = fresh_tid(wave0), wid = tid >> 6, lane = tid & 63, r32 = lane & 31, hi = lane >> 5;
  char* V_lds = lds; char* K_lds = lds + OFF_K;
  float* ws = (float*)(lds + OFF_WS) + wid * 64; float* li_l = ws; float* al_l = ws + 32;
  float* bias_l = (float*)(lds + OFF_WS + 2048);
  if constexpr (MODE == 2) { if (tid < 465) bias_l[(tid / 31) * 128 + 48 + (tid % 31)] = a.rpb[tid]; }
  float m_reg = -1e30f, l_reg = 0; f32x16 o[4] = {}; bf16x8 qr[NQ];
  const float C = a.C, thr_raw = a.thr_raw;
  const bf16* Qw = a.Q + (long)(wid * QBLK + r32) * a.ldq + hi * 8;
#pragma unroll
  for (int d0 = 0; d0 < NQ; ++d0) qr[d0] = *reinterpret_cast<const bf16x8*>(Qw + d0 * 16);
  if constexpr (DQ == 128) {
    if (a.qgain) { float xf[8][8]; float ss = 0.f;
#pragma unroll
      for (int d0 = 0; d0 < 8; ++d0)
#pragma unroll
        for (int e = 0; e < 8; ++e) { xf[d0][e] = __uint_as_float(((unsigned)(unsigned short)qr[d0][e]) << 16); ss += xf[d0][e] * xf[d0][e]; }
      { auto rr = __builtin_amdgcn_permlane32_swap(__float_as_uint(ss), __float_as_uint(ss), false, false); ss = __uint_as_float(rr[0]) + __uint_as_float(rr[1]); }
      const float rstd = rsqrtf(ss * (1.0f / 128.0f) + 1e-6f);
#pragma unroll
      for (int d0 = 0; d0 < 8; ++d0) { const float* gp = a.qgain + d0 * 16 + hi * 8;
#pragma unroll
        for (int e = 0; e < 8; ++e) xf[d0][e] = xf[d0][e] * rstd * gp[e]; }
      if (a.qrope_t0 >= 0) { const int t = a.qrope_t0 + wid * QBLK + r32; const float prow = (float)(t >> 6), pcol = (float)(t & 63);
#pragma unroll
        for (int half = 0; half < 2; ++half)
#pragma unroll
          for (int blk = 0; blk < 2; ++blk)
#pragma unroll
            for (int e = 0; e < 8; ++e) { const int j = blk * 16 + hi * 8 + e, da = 4 * half + blk, db = da + 2;
              const float inv_freq = __builtin_amdgcn_exp2f(-(float)j * (13.287712379549449f / 32.0f)); float rev = (half ? pcol : prow) * inv_freq * 0.15915494309189535f; rev -= rintf(rev);
              const float sn = __builtin_amdgcn_sinf(rev), cs = __builtin_amdgcn_cosf(rev);
              const float x = xf[da][e], y = xf[db][e]; xf[da][e] = x * cs - y * sn; xf[db][e] = y * cs + x * sn; } }
#pragma unroll
      for (int d0 = 0; d0 < 8; ++d0) { bf16x8 w;
#pragma unroll
        for (int e = 0; e < 8; ++e) { unsigned u = __float_as_uint(xf[d0][e]); u = (u + 0x7fffu + ((u >> 16) & 1u)) >> 16; w[e] = (short)u; }
        qr[d0] = w; } } }
  if constexpr (DQ == 192) {
    if (a.qrope_t0 >= 0) { const int t = a.qrope_t0 + wid * QBLK + r32; const float prow = (float)(t >> 6), pcol = (float)(t & 63);
#pragma unroll
      for (int half = 0; half < 2; ++half) { bf16x8 xa = qr[8 + 2 * half], xb = qr[9 + 2 * half]; const float pos = half ? pcol : prow;
#pragma unroll
        for (int e = 0; e < 8; ++e) { const int j = hi * 8 + e;
          const float inv_freq = __builtin_amdgcn_exp2f(-(float)j * (13.287712379549449f / 16.0f)); float rev = pos * inv_freq * 0.15915494309189535f; rev -= rintf(rev);
          const float sn = __builtin_amdgcn_sinf(rev), cs = __builtin_amdgcn_cosf(rev);
          const float x = __uint_as_float(((unsigned)(unsigned short)xa[e]) << 16), y = __uint_as_float(((unsigned)(unsigned short)xb[e]) << 16);
          const float nx = x * cs - y * sn, ny = y * cs + x * sn; unsigned ux = __float_as_uint(nx), uy = __float_as_uint(ny);
          ux = (ux + 0x7fffu + ((ux >> 16) & 1u)) >> 16; uy = (uy + 0x7fffu + ((uy >> 16) & 1u)) >> 16; xa[e] = (short)ux; xb[e] = (short)uy; }
        qr[8 + 2 * half] = xa; qr[9 + 2 * half] = xb; } } }
  const int sr = tid >> 4, sc = (tid & 15) * 8, vst0 = v_st(sr, sc), vst1 = v_st(32 + sr, sc);
  const int sr2 = tid >> 3, sc2 = (tid & 7) * 8;
  const int vb0 = (int)(uintptr_t)V_lds + v_rd_base(lane);
  int kx[4];
#pragma unroll
  for (int q = 0; q < 4; ++q) kx[q] = (int)(uintptr_t)K_lds + r32 * (DQ * 2) + ((q * 32 + hi * 16) ^ ((r32 & 7) << 4));
  bf16x8 s_vs0, s_vs1, s_ks0, s_ks1, s_ks2;
  const int vo0 = sr * a.ldv + sc, vo1 = (32 + sr) * a.ldv + sc, ko0 = sr * a.ldk + sc, ko1 = (32 + sr) * a.ldk + sc, ko2 = sr2 * a.ldk2 + sc2;
#define KROW(t) ((t) < a.nctx ? a.ctx_row0 + 64 * (t) : a.lat_row0 + 64 * ((t) - a.nctx))
#define SLOAD(t) do { const long kr_ = KROW(t); const bf16* vp_ = a.V + kr_ * a.ldv; const bf16* kp_ = a.K + kr_ * a.ldk; \
    s_vs0 = *reinterpret_cast<const bf16x8*>(vp_ + vo0); s_vs1 = *reinterpret_cast<const bf16x8*>(vp_ + vo1); \
    s_ks0 = *reinterpret_cast<const bf16x8*>(kp_ + ko0); s_ks1 = *reinterpret_cast<const bf16x8*>(kp_ + ko1); \
    if constexpr (DQ == 192) s_ks2 = *reinterpret_cast<const bf16x8*>(a.K2 + kr_ * a.ldk2 + ko2); } while (0)
#define SWRITE(t) do { char* vd_ = V_lds + ((t) % 3) * SHM_V; char* kd_ = K_lds + ((t) & 1) * SHM_K; \
    *(bf16x8*)(vd_ + vst0) = s_vs0; *(bf16x8*)(vd_ + vst1) = s_vs1; \
    *(bf16x8*)(kd_ + kswz<DQ>(sr, sc * 2)) = s_ks0; *(bf16x8*)(kd_ + kswz<DQ>(32 + sr, sc * 2)) = s_ks1; \
    if constexpr (DQ == 192) *(bf16x8*)(kd_ + kswz<DQ>(sr2, 256 + sc2 * 2)) = s_ks2; } while (0)
#define RESC(al) do { if (__any((al) < 1.f)) { if (hi == 0) al_l[r32] = (al); asm volatile("s_waitcnt lgkmcnt(0)" ::: "memory"); \
    _Pragma("unroll") for (int d = 0; d < 4; ++d) _Pragma("unroll") for (int r = 0; r < 16; ++r) o[d][r] *= al_l[crow(r, hi)]; } } while (0)
  f32x16 pA0, pA1, pB0, pB1; float mnA, mnB, alA, alB; bf16x8 pa0, pa1, pa2, pa3; const int NT = a.NT;
#define STEP(j, PN0, PN1, MNN, ALN, PP0, PP1, ALP) do { const int j_ = (j); \
    __syncthreads(); \
    if (j_ + 1 < NT) SWRITE(j_ + 1); \
    SBAR(); qkt<DQ>(PN0, PN1, kx, (j_ & 1) * SHM_K, qr); maskf<MODE>(PN0, PN1, j_, a, wid, r32, hi, bias_l); \
    finishSM(PP0, PP1, ALP, l_reg, pa0, pa1, pa2, pa3); SBAR(); \
    if (j_ + 2 < NT) SLOAD(j_ + 2); SBAR(); \
    pv_d0(o, vb0 + ((j_ - 1) % 3) * SHM_V, pa0, pa1, pa2, pa3); partialSM(PN0, PN1, m_reg, MNN, ALN, C, thr_raw); \
    RESC(ALN); } while (0)
  SLOAD(0); SWRITE(0); SLOAD(1); SWRITE(1); if (2 < NT) SLOAD(2);
  __syncthreads();
  qkt<DQ>(pA0, pA1, kx, 0, qr); maskf<MODE>(pA0, pA1, 0, a, wid, r32, hi, bias_l); partialSM(pA0, pA1, m_reg, mnA, alA, C, thr_raw);
  for (int j = 1; j + 1 < NT; j += 2) {
    STEP(j, pB0, pB1, mnB, alB, pA0, pA1, alA);
    STEP(j + 1, pA0, pA1, mnA, alA, pB0, pB1, alB);
  }
  STEP(NT - 1, pB0, pB1, mnB, alB, pA0, pA1, alA);
  finishSM(pB0, pB1, alB, l_reg, pa0, pa1, pa2, pa3); SBAR();
  pv_d0(o, vb0 + ((NT - 1) % 3) * SHM_V, pa0, pa1, pa2, pa3);
  if constexpr (MODE == 1) l_reg += __builtin_amdgcn_exp2f(a.sink_l2 - m_reg * C);
  if (hi == 0) li_l[r32] = l_reg; asm volatile("s_waitcnt lgkmcnt(0)" ::: "memory");
  float rli[16];
#pragma unroll
  for (int r = 0; r < 16; ++r) rli[r] = __builtin_amdgcn_rcpf(li_l[crow(r, hi)]);
  bf16* Ow = a.O + (long)(wid * QBLK) * a.ldo;
#pragma unroll
  for (int r = 0; r < 16; ++r) { const int orow = crow(r, hi);
#pragma unroll
    for (int d0 = 0; d0 < 4; ++d0) { const float v = o[d0][r] * rli[r]; unsigned u = __float_as_uint(v); u = (u + 0x7fffu + ((u >> 16) & 1u)) >> 16; Ow[(long)orow * a.ldo + d0 * 32 + r32] = (bf16)u; } }
  __syncthreads();
#undef KROW
#undef SLOAD
#undef SWRITE
#undef RESC
#undef STEP
}
#undef SBAR
}
#define LAS __attribute__((address_space(3)))
typedef unsigned short bf16;
typedef float f32x4 __attribute__((ext_vector_type(4)));
typedef unsigned v4u __attribute__((ext_vector_type(4)));
typedef unsigned v2u __attribute__((ext_vector_type(2)));
constexpr int NWAVES = 8, NTHR = 512;
constexpr int DM = 2048, SEQ = 8192, NCTX = 256, MLAT = 2 * SEQ, MALL = MLAT + 2 * NCTX, DFF = 5632;
constexpr int N_IN0 = 2816, N_IN1 = 4608, N_UQ = 1536, N_UKV = 2048, N_GU = 2 * DFF;
constexpr float EPS = 1e-6f;
constexpr size_t MiB = 1u << 20;
constexpr size_t WS_MOD = 0, WS_BAR = 512 * 1024, BAR_BYTES = 16384;
constexpr size_t WS_WIN0 = 1 * MiB, WS_WUQ = WS_WIN0 + 11 * MiB, WS_WUKV = WS_WUQ + 2 * MiB, WS_WOUT0 = WS_WUKV + 2 * MiB, WS_WIN1 = WS_WOUT0 + 8 * MiB, WS_WOUT1 = WS_WIN1 + 18 * MiB,
                 WS_WGU = WS_WOUT1 + 8 * MiB, WS_WD = WS_WGU + 88 * MiB, WS_HCTX = WS_WD + 44 * MiB;
constexpr size_t WS_UO = WS_HCTX + 4 * MiB;
constexpr size_t WS_OB = WS_UO + 66 * MiB;
constexpr size_t WS_BIG = WS_UO + 132 * MiB;
constexpr size_t WS_QB = WS_BIG + 91 * MiB, WS_KVB = WS_BIG + 141 * MiB, WS_UB = WS_BIG + 149 * MiB, WS_END = WS_BIG + 215 * MiB;
static_assert((size_t)MALL * DM * 2 == 66 * MiB && (size_t)MALL * N_IN0 * 2 <= 91 * MiB && (size_t)MALL * N_UQ * 2 <= 50 * MiB && (size_t)MALL * N_IN1 * 2 <= 149 * MiB && (size_t)MALL * DFF * 2 <= 215 * MiB, "ws map");

__device__ __forceinline__ unsigned f2bf(float f) { unsigned u = __builtin_bit_cast(unsigned, f); return (u + 0x7fffu + ((u >> 16) & 1u)) >> 16; }
__device__ __forceinline__ unsigned pk2(float lo, float hi) { return f2bf(lo) | (f2bf(hi) << 16); }
__device__ __forceinline__ float bf2f(bf16 v) { return __uint_as_float(((unsigned)v) << 16); }
__device__ __forceinline__ float wave_sum(float v, int lane) {
#pragma unroll
    for (int o = 1; o < 64; o <<= 1) v += __int_as_float(__builtin_amdgcn_ds_bpermute((lane ^ o) << 2, __float_as_int(v)));
    return v;
}
__device__ __forceinline__ float silu_f(float x) { return x / (1.0f + __expf(-x)); }

#define GAS __attribute__((address_space(1)))
#define XB_TMO      128
#define XB_XCNT(j)  (256  + 64 * (j))
#define XB_XSUB(j)  (1280 + 64 * (j))
#define XB_XGEN(j)  (2304 + 64 * (j))
#define XB_TOP      3328
#define XB_TOPGEN   3392
#define XCD_BAR_WORDS 3456
#define XB_SPIN_CAP (1u << 18)

__device__ __forceinline__ unsigned xb_ld(unsigned* p)              { return __hip_atomic_load(p, __ATOMIC_RELAXED, __HIP_MEMORY_SCOPE_AGENT); }
__device__ __forceinline__ unsigned xb_add(unsigned* p, unsigned v) { return __hip_atomic_fetch_add(p, v, __ATOMIC_RELAXED, __HIP_MEMORY_SCOPE_AGENT); }
__device__ __forceinline__ unsigned xb_xcc_id() { return (unsigned)__builtin_amdgcn_s_getreg((3 << 11) | 20) & 0xFu; }
#define XB_SPIN(cond, bar) do { unsigned _sp = 0; while (cond) { __builtin_amdgcn_s_sleep(1); \
    if ((++_sp & 255u) == 0u) { if (xb_ld(&(bar)[XB_TMO])) break; if (_sp > XB_SPIN_CAP) { atomicAdd(&(bar)[XB_TMO], 1u); break; } } } } while (0)

struct XcdBarrier {
    unsigned* bar; unsigned x;
    volatile LAS unsigned* st;
};

__device__ __forceinline__ XcdBarrier xcd_barrier_post(unsigned* bar, volatile LAS unsigned* st) {
    XcdBarrier b; b.bar = bar; b.x = xb_xcc_id(); b.st = st;
    if (threadIdx.x == 0) (void)xb_add(&bar[XB_XCNT(b.x)], 1u);
    return b;
}
__device__ __forceinline__ void xcd_barrier_complete(unsigned* bar, unsigned x, unsigned& nloc, unsigned& nx) {
    const unsigned G = gridDim.x * gridDim.y * gridDim.z;
    unsigned sum, cnt, mine, sp = 0u;
    for (;;) {
        sum = 0u; cnt = 0u; mine = 0u;
#pragma unroll
        for (unsigned j = 0; j < 16; ++j) { const unsigned c = xb_ld(&bar[XB_XCNT(j)]); sum += c; cnt += (c > 0u) ? 1u : 0u; mine = (j == x) ? c : mine; }
        if (sum == G) break;
        __builtin_amdgcn_s_sleep(1);
        if ((++sp & 255u) == 0u) { if (xb_ld(&bar[XB_TMO])) break; if (sp > XB_SPIN_CAP) { atomicAdd(&bar[XB_TMO], 1u); break; } }
    }
    nloc = mine > 0u ? mine : 1u; nx = cnt > 0u ? cnt : 1u;
}

__device__ __forceinline__ void xcd_barrier(const XcdBarrier& b) {
    asm volatile("s_waitcnt vmcnt(0)" ::: "memory");
    __syncthreads();
    if (threadIdx.x == 0) {
        unsigned* bar = b.bar;
        __builtin_amdgcn_s_waitcnt(0);
        unsigned nloc = b.st[0], nx = b.st[1];
        if (nloc == 0u) { xcd_barrier_complete(bar, b.x, nloc, nx); b.st[0] = nloc; b.st[1] = nx; }
        const unsigned old = xb_add(&bar[XB_XSUB(b.x)], 1u);
        const unsigned gen = old / nloc;
        if (old + 1u == (gen + 1u) * nloc) {
            __builtin_amdgcn_fence(__ATOMIC_RELEASE, "agent");
            asm volatile("s_waitcnt vmcnt(0)" ::: "memory");
            const unsigned og = xb_add(&bar[XB_TOP], 1u);
            const unsigned tg = og / nx;
            if (og + 1u == (tg + 1u) * nx) xb_add(&bar[XB_TOPGEN], 1u);
            else XB_SPIN(xb_ld(&bar[XB_TOPGEN]) == tg, bar);
            __builtin_amdgcn_fence(__ATOMIC_ACQUIRE, "agent");
            xb_add(&bar[XB_XGEN(b.x)], 1u);
            asm volatile("s_waitcnt vmcnt(0)" ::: "memory");
        } else {
            XB_SPIN(xb_ld(&bar[XB_XGEN(b.x)]) == gen, bar);
            __builtin_amdgcn_fence(__ATOMIC_ACQUIRE, "agent");
            asm volatile("s_waitcnt vmcnt(0)" ::: "memory");
        }
    }
    __syncthreads();
}

struct KArgs { const float* in[29]; float* out; unsigned char* ws; };
typedef const __attribute__((address_space(4))) KArgs* KAP;
__device__ __forceinline__ KAP kargs() { KAP p = (KAP)__builtin_amdgcn_kernarg_segment_ptr(); asm volatile("" : "+s"(p)); return p; }

__device__ __forceinline__ void transpose_item(const float* W, int K, int N, bf16* WT, int k0, int n0, int drow0, LAS float* scr, int lane) {
#pragma unroll 8
    for (int i = 0; i < 32; ++i) { const int kk = 2 * i + (lane >> 5); scr[kk * 33 + (lane & 31)] = W[(size_t)(k0 + kk) * N + n0 + (lane & 31)]; }
    asm volatile("s_waitcnt lgkmcnt(0)" ::: "memory");
    const int c = lane & 7;
#pragma unroll
    for (int j = 0; j < 4; ++j) { const int n = (lane >> 3) + 8 * j; const LAS float* s = scr + (8 * c) * 33 + n;
        v4u o; o.x = pk2(s[0 * 33], s[1 * 33]); o.y = pk2(s[2 * 33], s[3 * 33]); o.z = pk2(s[4 * 33], s[5 * 33]); o.w = pk2(s[6 * 33], s[7 * 33]);
        *(v4u*)(WT + (size_t)(drow0 + n) * K + k0 + 8 * c) = o; }
    asm volatile("s_waitcnt lgkmcnt(0)" ::: "memory");
}
__device__ __forceinline__ bool conv_matrix(int& it, const float* W, int K, int N, bf16* WT, int mode, LAS float* scr, int lane) {
    const int nblk = N / 32, items = (K / 64) * nblk;
    if (it >= items) { it -= items; return false; }
    const int kb = it / nblk, nb = it % nblk, n0 = 32 * nb;
    const int drow0 = mode == 0 ? n0 : ((n0 >> 7) * 256 + (mode == 2 ? 128 : 0) + (n0 & 127));
    transpose_item(W, K, N, WT, 64 * kb, n0, drow0, scr, lane);
    return true;
}
__device__ __forceinline__ void p0_weights(KAP a, LAS unsigned char* lds, int gw, int NGW, int wave, int lane) {
    LAS float* scr = (LAS float*)(lds + wave * 8704);
    unsigned char* ws = a->ws;
    constexpr int I_TOTAL = (2048 / 64) * (2624 / 32) + (512 / 64) * (1536 / 32) + (512 / 64) * (2048 / 32) + 2 * (2048 / 64) * (2048 / 32) + (2048 / 64) * (4608 / 32)
                          + 4 * (2048 / 64) * (DFF / 32) + 2 * (DFF / 64) * (2048 / 32);
    for (int item = gw; item < I_TOTAL; item += NGW) {
        int it = item;
        if (conv_matrix(it, a->in[13], 2048, 2624, (bf16*)(ws + WS_WIN0), 0, scr, lane)) continue;
        if (conv_matrix(it, a->in[19], 512, 1536, (bf16*)(ws + WS_WUQ), 0, scr, lane)) continue;
        if (conv_matrix(it, a->in[20], 512, 2048, (bf16*)(ws + WS_WUKV), 0, scr, lane)) continue;
        if (conv_matrix(it, a->in[14], 2048, 2048, (bf16*)(ws + WS_WOUT0), 0, scr, lane)) continue;
        if (conv_matrix(it, a->in[21], 2048, 4608, (bf16*)(ws + WS_WIN1), 0, scr, lane)) continue;
        if (conv_matrix(it, a->in[22], 2048, 2048, (bf16*)(ws + WS_WOUT1), 0, scr, lane)) continue;
        if (conv_matrix(it, a->in[10], 2048, DFF, (bf16*)(ws + WS_WGU), 1, scr, lane)) continue;
        if (conv_matrix(it, a->in[10] + (size_t)2048 * DFF, 2048, DFF, (bf16*)(ws + WS_WGU + 44 * MiB), 1, scr, lane)) continue;
        if (conv_matrix(it, a->in[11], 2048, DFF, (bf16*)(ws + WS_WGU), 2, scr, lane)) continue;
        if (conv_matrix(it, a->in[11] + (size_t)2048 * DFF, 2048, DFF, (bf16*)(ws + WS_WGU + 44 * MiB), 2, scr, lane)) continue;
        if (conv_matrix(it, a->in[12], DFF, 2048, (bf16*)(ws + WS_WD), 0, scr, lane)) continue;
        conv_matrix(it, a->in[12] + (size_t)2048 * DFF, DFF, 2048, (bf16*)(ws + WS_WD + 22 * MiB), 0, scr, lane);
    }
}
__device__ __forceinline__ void p0_mod(KAP a, LAS unsigned char* lds, int tid) {
    LAS float* sv = (LAS float*)lds;
    LAS float* red = (LAS float*)(lds + 24576);
    const int blk = blockIdx.x; if (blk >= 256) return;
    const int layer = blk >> 7, col0 = (blk & 127) * 96;
    for (int i = tid; i < 3 * 2048; i += NTHR) { const int v = i >> 11, k = i & 2047; const float x = v < 2 ? a->in[1][v * 2048 + k] : a->in[3][k]; sv[i] = silu_f(x); }
    __syncthreads();
    const int c4 = tid % 24, ks = tid / 24;
    if (ks < 21) {
        const float* W = a->in[4] + (size_t)layer * 2048 * 12288 + col0 + 4 * c4;
        f32x4 a0 = {0, 0, 0, 0}, a1 = a0, a2 = a0;
#pragma unroll 4
        for (int k = ks; k < 2048; k += 21) { const f32x4 w = *(const f32x4*)(W + (size_t)k * 12288); a0 += w * sv[k]; a1 += w * sv[2048 + k]; a2 += w * sv[4096 + k]; }
        LAS float* r = red + ks * 288 + 4 * c4;
        *(LAS f32x4*)(r) = a0; *(LAS f32x4*)(r + 96) = a1; *(LAS f32x4*)(r + 192) = a2;
    }
    __syncthreads();
    if (tid < 288) { float s = 0.f;
        for (int q = 0; q < 21; ++q) s += red[q * 288 + tid];
        const int v = tid / 96, j = tid % 96;
        ((float*)(a->ws + WS_MOD))[(size_t)(layer * 3 + v) * 12288 + col0 + j] = s + a->in[5][layer * 12288 + col0 + j]; }
    __syncthreads();
}
__device__ __forceinline__ void store_u(bf16* urow, int lane, const f32x4 (&v)[8], float rstd, const float* g, const float* sh, const float* sc) {
#pragma unroll
    for (int j = 0; j < 8; ++j) { const int ci = 256 * j + 4 * lane; const f32x4 g4 = *(const f32x4*)(g + ci), s4 = *(const f32x4*)(sc + ci), h4 = *(const f32x4*)(sh + ci);
        const f32x4 t = (v[j] * rstd * g4) * (1.0f + s4) + h4; v2u w; w.x = pk2(t[0], t[1]); w.y = pk2(t[2], t[3]); *(v2u*)(urow + ci) = w; }
}
__device__ __forceinline__ void pass_pre(const float* hlat, const float* hctx, const float* g, const float* mod, int sh_off, int sc_off, bf16* U, int nrows, int gw, int NGW, int lane) {
    for (int m0 = gw; m0 < nrows; m0 += 2 * NGW) {
        int mr[2]; mr[0] = m0; mr[1] = m0 + NGW; const bool two = mr[1] < nrows; if (!two) mr[1] = m0;
        f32x4 v[2][8]; float ss[2];
#pragma unroll
        for (int r = 0; r < 2; ++r) { const int m = mr[r]; const float* src = m < MLAT ? hlat + (size_t)m * DM : hctx + (size_t)(m - MLAT) * DM;
#pragma unroll
            for (int j = 0; j < 8; ++j) v[r][j] = *(const f32x4*)(src + 256 * j + 4 * lane); }
#pragma unroll
        for (int r = 0; r < 2; ++r) { ss[r] = 0.f;
#pragma unroll
            for (int j = 0; j < 8; ++j) ss[r] += (v[r][j][0] * v[r][j][0] + v[r][j][1] * v[r][j][1]) + (v[r][j][2] * v[r][j][2] + v[r][j][3] * v[r][j][3]); }
#pragma unroll
        for (int r = 0; r < 2; ++r) { if (r == 1 && !two) break; const int m = mr[r]; const float* mv = mod + (m < MLAT ? (m >> 13) : 2) * 12288;
            const float rstd = rsqrtf(wave_sum(ss[r], lane) * (1.0f / DM) + EPS);
            store_u(U + (size_t)m * DM, lane, v[r], rstd, g, mv + sh_off, mv + sc_off); }
    }
}
__device__ __forceinline__ void pass_post(const bf16* o16, const float* opart, const float* hlat, const float* hctx, float* olat, float* octx, const float* gpost, const float* mod, int gt_off,
                                          const float* gpre, const float* modu, int sh_off, int sc_off, bf16* U, int nrows, int gw, int NGW, int lane) {
    for (int m0 = gw; m0 < nrows; m0 += 2 * NGW) {
        int mr[2]; mr[0] = m0; mr[1] = m0 + NGW; const bool two = mr[1] < nrows; if (!two) mr[1] = m0;
        f32x4 v[2][8], hh[2][8]; float ss[2];
#pragma unroll
        for (int r = 0; r < 2; ++r) { const int m = mr[r]; ss[r] = 0.f;
            const float* hs = m < MLAT ? hlat + (size_t)m * DM : hctx + (size_t)(m - MLAT) * DM;
            if (m < MLAT) { const bf16* orow = o16 + (size_t)m * DM;
#pragma unroll
                for (int j = 0; j < 8; ++j) { const v2u raw = *(const v2u*)(orow + 256 * j + 4 * lane);
                    v[r][j] = (f32x4){__uint_as_float(raw.x << 16), __uint_as_float(raw.x & 0xffff0000u), __uint_as_float(raw.y << 16), __uint_as_float(raw.y & 0xffff0000u)}; }
            } else { const float* orow = opart + (size_t)(m - MLAT) * DM;
#pragma unroll
                for (int j = 0; j < 8; ++j) { const int ci = 256 * j + 4 * lane;
                    v[r][j] = (*(const f32x4*)(orow + ci) + *(const f32x4*)(orow + ci + (size_t)512 * DM)) + (*(const f32x4*)(orow + ci + (size_t)1024 * DM) + *(const f32x4*)(orow + ci + (size_t)1536 * DM)); } }
#pragma unroll
            for (int j = 0; j < 8; ++j) hh[r][j] = *(const f32x4*)(hs + 256 * j + 4 * lane);
        }
#pragma unroll
        for (int r = 0; r < 2; ++r)
#pragma unroll
            for (int j = 0; j < 8; ++j) ss[r] += (v[r][j][0] * v[r][j][0] + v[r][j][1] * v[r][j][1]) + (v[r][j][2] * v[r][j][2] + v[r][j][3] * v[r][j][3]);
#pragma unroll
        for (int r = 0; r < 2; ++r) { const int m = mr[r]; if (r == 1 && !two) break;
            float* hd = m < MLAT ? olat + (size_t)m * DM : octx + (size_t)(m - MLAT) * DM; const int vi = (m < MLAT ? (m >> 13) : 2); const float* mv = mod + vi * 12288;
            const float rstd = rsqrtf(wave_sum(ss[r], lane) * (1.0f / DM) + EPS); float s2 = 0.f;
#pragma unroll
            for (int j = 0; j < 8; ++j) { const int ci = 256 * j + 4 * lane; const f32x4 g4 = *(const f32x4*)(gpost + ci), t4 = *(const f32x4*)(mv + gt_off + ci);
                const f32x4 nv = hh[r][j] + t4 * (v[r][j] * rstd * g4); v[r][j] = nv; *(f32x4*)(hd + ci) = nv; s2 += (nv[0] * nv[0] + nv[1] * nv[1]) + (nv[2] * nv[2] + nv[3] * nv[3]); }
            if (U) { const float* mu = modu + vi * 12288; const float rstd2 = rsqrtf(wave_sum(s2, lane) * (1.0f / DM) + EPS); store_u(U + (size_t)m * DM, lane, v[r], rstd2, gpre, mu + sh_off, mu + sc_off); }
        }
    }
}
__device__ __forceinline__ void rope_cs(float pos, int j, float inv_nf, float& cs, float& sn) {
    const float inv_freq = __builtin_amdgcn_exp2f(-(float)j * inv_nf * 13.287712379549449f);
    float rev = pos * inv_freq * 0.15915494309189535f; rev -= rintf(rev);
    sn = __builtin_amdgcn_sinf(rev); cs = __builtin_amdgcn_cosf(rev);
}
template <int NH> __device__ __forceinline__ void heads_load(const bf16* base, int ia, float (&x)[NH], float (&y)[NH]) {
#pragma unroll
    for (int h = 0; h < NH; ++h) { x[h] = bf2f(base[h * 128 + ia]); y[h] = bf2f(base[h * 128 + ia + 32]); }
}
template <int NH> __device__ __forceinline__ void heads_finish(bf16* base, int ia, float (&x)[NH], float (&y)[NH], const float* gain, bool rope, float cs, float sn, int lane) {
    const float ga = gain[ia], gb = gain[ia + 32];
#pragma unroll
    for (int h = 0; h < NH; ++h) {
        const float rstd = rsqrtf(wave_sum(x[h] * x[h] + y[h] * y[h], lane) * (1.0f / 128.0f) + EPS);
        float a = x[h] * rstd * ga, b = y[h] * rstd * gb;
        if (rope) { const float na = a * cs - b * sn, nb = b * cs + a * sn; a = na; b = nb; }
        base[h * 128 + ia] = (bf16)f2bf(a); base[h * 128 + ia + 32] = (bf16)f2bf(b); }
}
__device__ __forceinline__ void unpack8(const v4u raw, float (&x)[8]) {
#pragma unroll
    for (int i = 0; i < 4; ++i) { x[2 * i] = __uint_as_float(raw[i] << 16); x[2 * i + 1] = __uint_as_float(raw[i] & 0xffff0000u); }
}
__device__ __forceinline__ void norm512_finish(bf16* p, const float (&x)[8], const float* gain, int lane) {
    float ss = 0.f;
#pragma unroll
    for (int i = 0; i < 8; ++i) ss += x[i] * x[i];
    const float rstd = rsqrtf(wave_sum(ss, lane) * (1.0f / 512.0f) + EPS);
    const f32x4 g0 = *(const f32x4*)(gain + 8 * lane), g1 = *(const f32x4*)(gain + 8 * lane + 4);
    v4u w; w.x = pk2(x[0] * rstd * g0[0], x[1] * rstd * g0[1]); w.y = pk2(x[2] * rstd * g0[2], x[3] * rstd * g0[3]); w.z = pk2(x[4] * rstd * g1[0], x[5] * rstd * g1[1]); w.w = pk2(x[6] * rstd * g1[2], x[7] * rstd * g1[3]);
    *(v4u*)(p + 8 * lane) = w;
}
__device__ __forceinline__ void rope64(bf16* p, float prow, float pcol, int l32) {
    const int j = l32 & 15, s = (l32 >> 4) & 1, ia = 32 * s + j, ib = ia + 16;
    const float x = bf2f(p[ia]), y = bf2f(p[ib]); float cs, sn; rope_cs(s ? pcol : prow, j, 1.0f / 16.0f, cs, sn);
    p[ia] = (bf16)f2bf(x * cs - y * sn); p[ib] = (bf16)f2bf(y * cs + x * sn);
}
__device__ __forceinline__ void prep_ab(bf16* P, const float* aqn, const float* akn, const float* bqn, const float* bkvn, int gw, int NGW, int lane) {
    const int ia = 64 * (lane >> 5) + (lane & 31);
    for (int m = gw; m < MALL; m += NGW) {
        bf16* row = P + (size_t)m * N_IN0; const bool lat = m < MLAT; const int t = m & (SEQ - 1); const float pr = (float)(t >> 6), pc = (float)(t & 63);
        float xk[2], yk[2], c1[8], c2[8];
        heads_load<2>(row + 1024, ia, xk, yk);
        unpack8(*(const v4u*)(row + 1536 + 8 * lane), c1); unpack8(*(const v4u*)(row + 2048 + 8 * lane), c2);
        if (lat && lane < 32) rope64(row + 2560, pr, pc, lane);
        float cs = 1.f, sn = 0.f; if (lat) rope_cs((lane >> 5) ? pc : pr, lane & 31, 1.0f / 32.0f, cs, sn);
        heads_finish<2>(row + 1024, ia, xk, yk, akn, lat, cs, sn, lane);
        norm512_finish(row + 1536, c1, bqn, lane); norm512_finish(row + 2048, c2, bkvn, lane);
    }
}
__device__ __forceinline__ void prep_qb(bf16* QB, int gw, int NGW, int lane) {
    for (int m = gw; m < MLAT; m += NGW) {
        bf16* row = QB + (size_t)m * N_UQ; const int t = m & (SEQ - 1); const float pr = (float)(t >> 6), pc = (float)(t & 63);
#pragma unroll
        for (int i = 0; i < 4; ++i) rope64(row + (2 * i + (lane >> 5)) * 192 + 128, pr, pc, lane & 31);
    }
}
__device__ __forceinline__ void prep_cd(bf16* P, const float* cqn, const float* ckn, const float* dqn, const float* dkn, int gw, int NGW, int lane) {
    const int ia = 64 * (lane >> 5) + (lane & 31);
    for (int m = gw; m < MALL; m += NGW) {
        bf16* row = P + (size_t)m * N_IN1; const bool lat = m < MLAT; const int t = m & (SEQ - 1); const float pr = (float)(t >> 6), pc = (float)(t & 63);
        float cs = 1.f, sn = 0.f; if (lat) rope_cs((lane >> 5) ? pc : pr, lane & 31, 1.0f / 32.0f, cs, sn);
        float xk[2], yk[2], xd[8], yd[8];
        heads_load<2>(row + 1024, ia, xk, yk); heads_load<8>(row + 2560, ia, xd, yd);
        heads_finish<2>(row + 1024, ia, xk, yk, ckn, lat, cs, sn, lane); heads_finish<8>(row + 2560, ia, xd, yd, dkn, false, 1.f, 0.f, lane);
    }
}
constexpr float LOG2E = 1.4426950408889634f;
__device__ __forceinline__ void attn_phase_ab(const bf16* P0, const bf16* QB, const bf16* KVB, bf16* OB, const float* aqn, char* lds, const int wave0) {
    const int c = blockIdx.x, G = gridDim.x;
    for (int id = c; id < 1024 + 32; id += G) {
        att::Args a{};
        int mixer, b, h, qrow0, NT;
        if (id < 1024) { const int rnd = id >> 8, cc = id & 255; mixer = rnd >> 1; b = rnd & 1; h = cc & 7; qrow0 = b * SEQ + (cc >> 3) * 256; NT = 132; }
        else { const int cc = id - 1024; mixer = cc >> 4; b = (cc >> 3) & 1; h = cc & 7; qrow0 = MLAT + b * NCTX; NT = 4; }
        a.NT = NT; a.nctx = 4; a.ctx_row0 = MLAT + b * NCTX; a.lat_row0 = b * SEQ; a.ldo = DM; a.qrope_t0 = (id < 1024) ? (qrow0 - b * SEQ) : -1;
        if (mixer == 0) {
            a.Q = P0 + (size_t)qrow0 * N_IN0 + h * 128; a.ldq = N_IN0; a.K = P0 + 1024 + (h >> 2) * 128; a.ldk = N_IN0; a.K2 = nullptr; a.ldk2 = 0; a.V = P0 + 1280 + (h >> 2) * 128; a.ldv = N_IN0;
            a.O = OB + (size_t)qrow0 * DM + h * 128; const float scale = 0.08838834764831845f; a.C = scale * LOG2E; a.thr_raw = 8.0f / scale; a.qgain = aqn;

#ifndef DIS_A
            att::attn_unit<128, 0>(a, lds, wave0);
#endif

        } else {
            a.Q = QB + (size_t)qrow0 * N_UQ + h * 192; a.ldq = N_UQ; a.K = KVB + h * 256; a.ldk = N_UKV; a.K2 = P0 + 2560; a.ldk2 = N_IN0; a.V = KVB + h * 256 + 128; a.ldv = N_UKV;
            a.O = OB + (size_t)qrow0 * DM + 1024 + h * 128; const float scale = 0.07216878364870322f; a.C = scale * LOG2E; a.thr_raw = 8.0f / scale;

#ifndef DIS_B
            att::attn_unit<192, 0>(a, lds, wave0);
#endif

        }
    }
}
__device__ __forceinline__ void attn_phase_cd(const bf16* P1, bf16* OB, const float* sink, const float* rpb, const float* cqn, const float* dqn, char* lds, const int wave0) {
    const int c = blockIdx.x, G = gridDim.x;
    for (int id = c; id < 1024; id += G) {
        att::Args a{};
        const int rnd = id >> 8, cc = id & 255, mixer = rnd >> 1, b = rnd & 1, h = cc & 7, qb = cc >> 3, qrow0 = b * SEQ + qb * 256;
        a.nctx = 4; a.ctx_row0 = MLAT + b * NCTX; a.ldo = DM; a.ldq = a.ldk = a.ldv = N_IN1; a.K2 = nullptr; a.ldk2 = 0;
        const float scale = 0.08838834764831845f; a.C = scale * LOG2E; a.thr_raw = 8.0f / scale; a.inv_scale = 1.0f / scale;
        if (mixer == 0) {
            const int kbase = min(max(qb * 256 - 128, 0), SEQ - 512);
            a.NT = 12; a.lat_row0 = b * SEQ + kbase; a.qpos0 = qb * 256; a.kpos0 = kbase; a.sink_l2 = sink[h] * LOG2E;
            a.qgain = cqn; a.qrope_t0 = qb * 256; a.Q = P1 + (size_t)qrow0 * N_IN1 + h * 128; a.K = P1 + 1024 + (h >> 2) * 128; a.V = P1 + 1280 + (h >> 2) * 128; a.O = OB + (size_t)qrow0 * DM + h * 128;

#ifndef DIS_C
            att::attn_unit<128, 1>(a, lds, wave0);
#endif

        } else {
            const int r0 = qb * 4, klo = min(max(r0 - 4, 0), 116);
            a.NT = 16; a.lat_row0 = b * SEQ + klo * 64; a.r0 = r0; a.klo = klo; a.rpb = rpb + h * (15 * 31);
            a.qgain = dqn; a.qrope_t0 = -1; a.Q = P1 + (size_t)qrow0 * N_IN1 + 1536 + h * 128; a.K = P1 + 2560 + h * 128; a.V = P1 + 3584 + h * 128; a.O = OB + (size_t)qrow0 * DM + 1024 + h * 128;

#ifndef DIS_D
            att::attn_unit<128, 2>(a, lds, wave0);
#endif

        }
    }
}

__global__ void __launch_bounds__(NTHR, 2) fwd_megakernel(KArgs args) {
    extern __shared__ __attribute__((aligned(16))) unsigned char lds[];
    cg::grid_group grid = cg::this_grid();
    LAS unsigned char* ldsl = (LAS unsigned char*)lds;
    const int wave0 = __builtin_amdgcn_readfirstlane(threadIdx.x >> 6);
    const int G = gridDim.x, NGW = G * NWAVES;
#define PHASE_IDS() const int tid = fresh_tid(wave0); const int lane = tid & 63, wave = __builtin_amdgcn_readfirstlane(tid >> 6), gw = blockIdx.x * NWAVES + wave; (void)wave; (void)gw; (void)lane
#define WSB (kargs()->ws)
#define x_ (kargs()->in[0])
#define ctx_ (kargs()->in[2])
#define out_ (kargs()->out)
#define hctx_ ((float*)(WSB + WS_HCTX))
#define MOD_ ((const float*)(WSB + WS_MOD))
#define UA_ ((bf16*)(WSB + WS_UO))
#define OB_ ((bf16*)(WSB + WS_OB))
#define FB_ ((bf16*)(WSB + WS_UO))
#define FP_ ((float*)(WSB + WS_UO + 64 * MiB))
#define OFB_ ((bf16*)(WSB + WS_BIG))
#define OFP_ ((float*)(WSB + WS_BIG + 128 * MiB))
#define PB_ ((bf16*)(WSB + WS_BIG))
#define OF_ ((float*)(WSB + WS_BIG))
#define ACT_ ((bf16*)(WSB + WS_BIG))
#define QB_ ((bf16*)(WSB + WS_QB))
#define KVB_ ((bf16*)(WSB + WS_KVB))
#define UB_ ((bf16*)(WSB + WS_UB))
#ifndef PROBE_G
#define PROBE_G 1
#endif
#ifndef PROBE_A
#define PROBE_A 1
#endif
#ifndef PROBE_S
#define PROBE_S 1
#endif
#define GSYNC() do { for (int s_ = 0; s_ < PROBE_S; ++s_) { xcd_barrier(bar); } } while (0)
    volatile LAS unsigned* MISC = (volatile LAS unsigned*)(ldsl + 131072 + 64);
    if (threadIdx.x < 2) MISC[threadIdx.x] = 0u;
    __syncthreads();
    grid.sync();
    XcdBarrier bar = xcd_barrier_post((unsigned*)(kargs()->ws + WS_BAR), MISC);

    for (int rep_ = 0; rep_ < PROBE_S; ++rep_) {
    { PHASE_IDS(); p0_mod(kargs(), ldsl, tid); }
    { PHASE_IDS(); p0_weights(kargs(), ldsl, gw, NGW, wave, lane); }
    }
    GSYNC();
    { PHASE_IDS(); pass_pre(x_, ctx_, kargs()->in[6], MOD_, 0, DM, UA_, MALL, gw, NGW, lane); }
    GSYNC();
    for (int L = 0; L < 2; ++L) {

        const int Mrows = L == 0 ? MALL : MLAT;
        { pg8::Gemm g = pg8::mk_gemm(L == 0 ? UA_ : UB_, (const bf16*)(WSB + (L == 0 ? WS_WIN0 : WS_WIN1)), MALL, L == 0 ? N_IN0 : N_IN1, DM, DM);
          pg8::StaticOrder S; S.init(g.M, g.N, G, (int)blockIdx.x); pg8::EpiBf16 E{PB_, g.N};
          for (int rep_ = 0; rep_ < PROBE_G; ++rep_) pg8::gemm_phase<pg8::EpiBf16, pg8::StaticOrder, true, true>(ldsl, g, S, E, wave0); }
        GSYNC();
        if (L == 0) {
            { PHASE_IDS(); prep_ab(PB_, kargs()->in[15], kargs()->in[16], kargs()->in[17], kargs()->in[18], gw, NGW, lane); }
            GSYNC();
            for (int q = 0; q < 2; ++q) {
                pg8::Gemm g = pg8::mk_gemm(PB_ + (q == 0 ? 1536 : 2048), (const bf16*)(WSB + (q == 0 ? WS_WUQ : WS_WUKV)), MALL, q == 0 ? N_UQ : N_UKV, 512, N_IN0);
                pg8::StaticOrder S; S.init(g.M, g.N, G, (int)blockIdx.x); pg8::EpiBf16 E{q == 0 ? QB_ : KVB_, g.N};
                for (int rep_ = 0; rep_ < PROBE_G; ++rep_) pg8::gemm_phase<pg8::EpiBf16, pg8::StaticOrder, true, true>(ldsl, g, S, E, wave0);
            }
            GSYNC();
            for (int rep_ = 0; rep_ < PROBE_A; ++rep_) attn_phase_ab(PB_, QB_, KVB_, OB_, kargs()->in[15], (char*)lds, wave0);
        } else {
            { PHASE_IDS(); prep_cd(PB_, kargs()->in[23], kargs()->in[24], kargs()->in[26], kargs()->in[27], gw, NGW, lane); }
            GSYNC();
            for (int rep_ = 0; rep_ < PROBE_A; ++rep_) attn_phase_cd(PB_, OB_, kargs()->in[25], kargs()->in[28], kargs()->in[23], kargs()->in[26], (char*)lds, wave0);
        }
        GSYNC();
        { pg8::Gemm g = pg8::mk_gemm(OB_, (const bf16*)(WSB + (L == 0 ? WS_WOUT0 : WS_WOUT1)), MLAT, DM, DM, DM);
          pg8::StaticOrder S; S.init(g.M, g.N, G, (int)blockIdx.x); pg8::EpiBf16 E{OFB_, DM};
          for (int rep_ = 0; rep_ < PROBE_G; ++rep_) pg8::gemm_phase<pg8::EpiBf16, pg8::StaticOrder, true, true>(ldsl, g, S, E, wave0); }
        if (L == 0) { pg8::Gemm g = pg8::mk_gemm(OB_ + (size_t)MLAT * DM, (const bf16*)(WSB + WS_WOUT0), 2 * NCTX, 4 * DM, DM / 4, DM); g.ldb = DM; g.nNr = DM / 256;
          pg8::StaticOrder S; S.init(g.M, g.N, G, (int)blockIdx.x); pg8::EpiF32Split E{OFP_, DM, DM / 256, (size_t)2 * NCTX * DM};
          for (int rep_ = 0; rep_ < PROBE_G; ++rep_) pg8::gemm_phase<pg8::EpiF32Split, pg8::StaticOrder, true, true>(ldsl, g, S, E, wave0); }
        GSYNC();
        { PHASE_IDS(); pass_post(OFB_, OFP_, L == 0 ? x_ : out_, L == 0 ? ctx_ : hctx_, out_, hctx_, kargs()->in[7] + L * DM, MOD_ + (size_t)L * 3 * 12288, 2 * DM, kargs()->in[8] + L * DM, MOD_ + (size_t)L * 3 * 12288, 3 * DM, 4 * DM, UA_, Mrows, gw, NGW, lane); }
        GSYNC();
        { pg8::Gemm g = pg8::mk_gemm(UA_, (const bf16*)(WSB + WS_WGU + (size_t)L * 44 * MiB), Mrows, N_GU, DM, DM);
          pg8::StaticOrder S; S.init(g.M, g.N, G, (int)blockIdx.x); pg8::EpiSwiglu E{ACT_, DFF};
          for (int rep_ = 0; rep_ < PROBE_G; ++rep_) pg8::gemm_phase<pg8::EpiSwiglu, pg8::StaticOrder, true, true>(ldsl, g, S, E, wave0); }
        GSYNC();
        { pg8::Gemm g = pg8::mk_gemm(ACT_, (const bf16*)(WSB + WS_WD + (size_t)L * 22 * MiB), MLAT, DM, DFF, DFF);
          pg8::StaticOrder S; S.init(g.M, g.N, G, (int)blockIdx.x); pg8::EpiBf16 E{FB_, DM};
          for (int rep_ = 0; rep_ < PROBE_G; ++rep_) pg8::gemm_phase<pg8::EpiBf16, pg8::StaticOrder, true, true>(ldsl, g, S, E, wave0); }
        if (L == 0) { pg8::Gemm g = pg8::mk_gemm(ACT_ + (size_t)MLAT * DFF, (const bf16*)(WSB + WS_WD), 2 * NCTX, 4 * DM, DFF / 4, DFF); g.ldb = DFF; g.nNr = DM / 256;
          pg8::StaticOrder S; S.init(g.M, g.N, G, (int)blockIdx.x); pg8::EpiF32Split E{FP_, DM, DM / 256, (size_t)2 * NCTX * DM};
          for (int rep_ = 0; rep_ < PROBE_G; ++rep_) pg8::gemm_phase<pg8::EpiF32Split, pg8::StaticOrder, true, true>(ldsl, g, S, E, wave0); }
        GSYNC();
        { PHASE_IDS(); pass_post(FB_, FP_, out_, hctx_, out_, hctx_, kargs()->in[9] + L * DM, MOD_ + (size_t)L * 3 * 12288, 5 * DM, kargs()->in[6] + DM, MOD_ + (size_t)3 * 12288, 0, DM, L == 0 ? UB_ : nullptr, Mrows, gw, NGW, lane); }
        if (L == 0) GSYNC();
    }
#undef GSYNC
}

constexpr int LDS_BYTES = 131072 + 1024;
extern "C" void kernel_launch(void* const* d_in, const int* in_sizes, int n_in, void* d_out, int out_size, void* d_ws, size_t ws_size, hipStream_t stream) {
    static int grid = 0;
    if (grid == 0) {
        if (n_in != 29 || out_size != MLAT * DM || ws_size < WS_END) { fprintf(stderr, "kernel_launch: unexpected shapes: n_in %d out %d ws %zu (need %zu)\n", n_in, out_size, ws_size, (size_t)WS_END); grid = -1; return; }
        int dev = 0, cus = 0, per_cu = 0;
        hipGetDevice(&dev); hipDeviceGetAttribute(&cus, hipDeviceAttributeMultiprocessorCount, dev);
        if (hipFuncSetAttribute((const void*)fwd_megakernel, hipFuncAttributeMaxDynamicSharedMemorySize, LDS_BYTES) != hipSuccess) { fprintf(stderr, "kernel_launch: hipFuncSetAttribute failed\n"); grid = -1; return; }
        if (hipOccupancyMaxActiveBlocksPerMultiprocessor(&per_cu, (const void*)fwd_megakernel, NTHR, LDS_BYTES) != hipSuccess || per_cu < 1) { fprintf(stderr, "kernel_launch: occupancy query says %d\n", per_cu); per_cu = 1; }
        (void)hipGetLastError();
        grid = cus;
        fprintf(stderr, "kernel_launch: grid %d (per_cu %d)\n", grid, per_cu);
    }
    if (grid < 0) return;
    if (hipMemsetAsync((char*)d_ws + WS_BAR, 0, BAR_BYTES, stream) != hipSuccess) { fprintf(stderr, "kernel_launch: hipMemsetAsync failed\n"); return; }
    KArgs a{};
    for (int i = 0; i < 29; ++i) a.in[i] = (const float*)d_in[i];
    a.out = (float*)d_out; a.ws = (unsigned char*)d_ws;
    void* params[] = {&a};
    const hipError_t e = hipLaunchCooperativeKernel((const void*)fwd_megakernel, dim3(grid), dim3(NTHR), params, LDS_BYTES, stream);
    if (e != hipSuccess) fprintf(stderr, "kernel_launch: cooperative launch failed: %s (grid %d)\n", hipGetErrorString(e), grid);
}
```

```cpp
#include <hip/hip_runtime.h>
#include <hip/hip_cooperative_groups.h>
#include <cstdio>
#include <cstdint>
namespace cg = cooperative_groups;
__device__ __forceinline__ int fresh_tid(int wave0) { int l; asm volatile("v_mbcnt_lo_u32_b32 %0, -1, 0\n\tv_mbcnt_hi_u32_b32 %0, -1, %0" : "=v"(l)); return wave0 * 64 + l; }
namespace pg8 {
#define PG8_LAS __attribute__((address_space(3)))
typedef unsigned short bf16_t;
typedef short bf16x8 __attribute__((ext_vector_type(8)));
typedef float f32x4 __attribute__((ext_vector_type(4)));
typedef unsigned u32x4 __attribute__((ext_vector_type(4)));
constexpr int BM = 256, BK = 64, HALF = 128, HTB = HALF * BK * 2  , STAGE_BYTES = 8 * HTB, NXCD = 8, WGM = 8;

__host__ __device__ __forceinline__ int lds_byte(int r, int c) { const int st = (r >> 4) * 2 + (c >> 5), rr = r & 15, cc = c & 31, ob = rr * 64 + cc * 2; return st * 1024 + (ob ^ (((ob >> 9) & 1) << 5)); }
__host__ __device__ __forceinline__ void stage_rc(int b, int& R, int& C) { const int st = b / 1024, sb = b % 1024, swz = sb ^ (((sb >> 9) & 1) << 5); R = (st >> 1) * 16 + swz / 64; C = (st & 1) * 32 + (swz % 64) / 2; }
__host__ __device__ __forceinline__ int perm32(int rho) { const int n = rho >> 4, i = rho & 15; return 8 * (i >> 2) + 4 * n + (i & 3); }

struct Unit { int pm, pn; };
struct Gemm { const bf16_t* A; const bf16_t* Bt; int M, N, K, lda, ldb, nNr; };
__host__ __device__ __forceinline__ Gemm mk_gemm(const bf16_t* A, const bf16_t* Bt, int M, int N, int K, int lda) { Gemm g; g.A = A; g.Bt = Bt; g.M = M; g.N = N; g.K = K; g.lda = lda; g.ldb = K; g.nNr = N / BM; return g; }

struct StaticOrder {
    int nM, nN, nwg, G, c;
    __host__ __device__ void init(int M, int N, int G_, int c_) { nM = M / BM; nN = N / BM; nwg = nM * nN; G = G_; c = c_; }
    __host__ __device__ bool next(int i, Unit& u) const {
        const long L = (long)i * G + c; if (L >= nwg) return false;
        int wgid = (int)L; { const int q = nwg / NXCD, r = nwg % NXCD, xcd = wgid % NXCD, off = wgid / NXCD; wgid = (xcd < r ? xcd * (q + 1) : r * (q + 1) + (xcd - r) * q) + off; }
        const int nig = WGM * nN, gid = wgid / nig, fm = gid * WGM, gsz = (nM - fm) < WGM ? (nM - fm) : WGM;
        u.pm = fm + ((wgid % nig) % gsz); u.pn = (wgid % nig) / gsz; return true;
    }
    __device__ __forceinline__ void a_ready(const Unit&) const {}
    __device__ __forceinline__ void done(const Unit&) const {}
};


__device__ __forceinline__ unsigned cvt_pk_bf16(float lo, float hi) { unsigned r; asm volatile("v_cvt_pk_bf16_f32 %0, %1, %2" : "=v"(r) : "v"(lo), "v"(hi)); return r; }
struct EpiBf16 {
    static constexpr bool PERM = true, AFTER_DRAIN = false;
    bf16_t* O; int ldc;
    __device__ __forceinline__ void operator()(const f32x4 (&acc)[2][2][4][2], const Unit& u, int wr, int wc, int fr, int fq) const {
        const int row0 = u.pm * BM + wr * 64 + fr, col0 = u.pn * BM + wc * 32 + 8 * fq;
#pragma unroll
        for (int ai = 0; ai < 2; ++ai)
#pragma unroll
            for (int m = 0; m < 4; ++m) { bf16_t* rowp = O + (size_t)(row0 + ai * HALF + m * 16) * ldc + col0;
#pragma unroll
                for (int bj = 0; bj < 2; ++bj) { const f32x4 v0 = acc[ai][bj][m][0], v1 = acc[ai][bj][m][1];
                    u32x4 w; w.x = cvt_pk_bf16(v0[0], v0[1]); w.y = cvt_pk_bf16(v0[2], v0[3]); w.z = cvt_pk_bf16(v1[0], v1[1]); w.w = cvt_pk_bf16(v1[2], v1[3]);
                    *(u32x4*)(rowp + bj * HALF) = w; } }
    }
};
struct EpiF32 {
    static constexpr bool PERM = false, AFTER_DRAIN = false;
    float* O; int ldc;
    __device__ __forceinline__ void operator()(const f32x4 (&acc)[2][2][4][2], const Unit& u, int wr, int wc, int fr, int fq) const {
        const int row0 = u.pm * BM + wr * 64 + fr, col0 = u.pn * BM + wc * 32 + 4 * fq;
#pragma unroll
        for (int ai = 0; ai < 2; ++ai)
#pragma unroll
            for (int m = 0; m < 4; ++m) { float* rowp = O + (size_t)(row0 + ai * HALF + m * 16) * ldc + col0;
#pragma unroll
                for (int bj = 0; bj < 2; ++bj)
#pragma unroll
                    for (int n = 0; n < 2; ++n) *(f32x4*)(rowp + bj * HALF + n * 16) = acc[ai][bj][m][n]; }
    }
};
struct EpiF32Split {
    static constexpr bool PERM = false, AFTER_DRAIN = false;
    float* O; int ldc; int nNr; size_t sstride;
    __device__ __forceinline__ void operator()(const f32x4 (&acc)[2][2][4][2], const Unit& u, int wr, int wc, int fr, int fq) const {
        const int s = u.pn / nNr, pn = u.pn - s * nNr;
        const int row0 = u.pm * BM + wr * 64 + fr, col0 = pn * BM + wc * 32 + 4 * fq; float* Ob = O + (size_t)s * sstride;
#pragma unroll
        for (int ai = 0; ai < 2; ++ai)
#pragma unroll
            for (int m = 0; m < 4; ++m) { float* rowp = Ob + (size_t)(row0 + ai * HALF + m * 16) * ldc + col0;
#pragma unroll
                for (int bj = 0; bj < 2; ++bj)
#pragma unroll
                    for (int n = 0; n < 2; ++n) *(f32x4*)(rowp + bj * HALF + n * 16) = acc[ai][bj][m][n]; }
    }
};
__device__ __forceinline__ float silu_mul(float g, float u) { return g * __builtin_amdgcn_rcpf(1.0f + __builtin_amdgcn_exp2f(-1.4426950408889634f * g)) * u; }
struct EpiSwiglu {
    static constexpr bool PERM = true, AFTER_DRAIN = false;
    bf16_t* O; int ldc;
    __device__ __forceinline__ void operator()(const f32x4 (&acc)[2][2][4][2], const Unit& u, int wr, int wc, int fr, int fq) const {
        const int row0 = u.pm * BM + wr * 64 + fr, col0 = u.pn * HALF + wc * 32 + 8 * fq;
#pragma unroll
        for (int ai = 0; ai < 2; ++ai)
#pragma unroll
            for (int m = 0; m < 4; ++m) { bf16_t* rowp = O + (size_t)(row0 + ai * HALF + m * 16) * ldc + col0;
                const f32x4 g0 = acc[ai][0][m][0], g1 = acc[ai][0][m][1], u0 = acc[ai][1][m][0], u1 = acc[ai][1][m][1];
                u32x4 w; w.x = cvt_pk_bf16(silu_mul(g0[0], u0[0]), silu_mul(g0[1], u0[1])); w.y = cvt_pk_bf16(silu_mul(g0[2], u0[2]), silu_mul(g0[3], u0[3]));
                w.z = cvt_pk_bf16(silu_mul(g1[0], u1[0]), silu_mul(g1[1], u1[1])); w.w = cvt_pk_bf16(silu_mul(g1[2], u1[2]), silu_mul(g1[3], u1[3]));
                *(u32x4*)rowp = w; }
    }
};

template <class Epi, class Sched, bool ALIGN_EPI = false, bool SP2 = false>
__device__ __forceinline__ void gemm_phase(PG8_LAS unsigned char* lds, const Gemm g, const Sched& S, const Epi& E, const int wave0) {
    const int tid = fresh_tid(wave0), wid = __builtin_amdgcn_readfirstlane(tid >> 6), lane = tid & 63, wr = wid >> 2, wc = wid & 3, fr = lane & 15, fq = lane >> 4;
    const int K = g.K, nt = K / BK;
    unsigned voffA[2], voffB[2];
#pragma unroll
    for (int i = 0; i < 2; ++i) { int R, C; stage_rc(tid * 16 + i * 8192, R, C); const int Rb = Epi::PERM ? ((R & ~31) + perm32(R & 31)) : R;
        voffA[i] = (unsigned)(R * g.lda + C) * 2u; voffB[i] = (unsigned)(Rb * g.ldb + C) * 2u; }
    const size_t kstep = (size_t)(BK * 2);
    const size_t hstepA = (size_t)HALF * g.lda * 2, hstepB = (size_t)HALF * g.ldb * 2; const size_t ksb = (size_t)K * 2;
#define PG8_APTR(u) ((const char*)g.A + (size_t)(u).pm * tstepA + (size_t)((u).pn / g.nNr) * ksb)
#define PG8_BPTR(u) ((const char*)g.Bt + (size_t)((u).pn % g.nNr) * tstepB + (size_t)((u).pn / g.nNr) * ksb)
    const size_t tstepA = 2 * hstepA, tstepB = 2 * hstepB;
    const unsigned ldsw = (unsigned)wid * 1024u;
    const int aoff = lds_byte(wr * 64 + fr, fq * 8), boff = lds_byte(wc * 32 + fr, fq * 8);
#define PG8_SA(b, h) (((b) * 2 + (h)) * HTB)
#define PG8_SB(b, h) ((4 + (b) * 2 + (h)) * HTB)
#define PG8_STAGE(bufoff, gbase, voff) do { _Pragma("unroll") for (int _i = 0; _i < 2; ++_i) \
        __builtin_amdgcn_global_load_lds((const unsigned*)((const char*)(gbase) + (voff)[_i]), (PG8_LAS unsigned*)(lds + (bufoff) + ldsw + _i * 8192), 16, 0, 0); } while (0)
#define PG8_LDA(dst, b, h) do { _Pragma("unroll") for (int m = 0; m < 4; ++m) _Pragma("unroll") for (int k = 0; k < 2; ++k) dst[m][k] = *(const PG8_LAS bf16x8*)(lds + PG8_SA(b, h) + aoff + m * 2048 + k * 1024); } while (0)
#define PG8_LDB(dst, b, h) do { _Pragma("unroll") for (int n = 0; n < 2; ++n) _Pragma("unroll") for (int k = 0; k < 2; ++k) dst[n][k] = *(const PG8_LAS bf16x8*)(lds + PG8_SB(b, h) + boff + n * 2048 + k * 1024); } while (0)
#define PG8_MMA(ai, bj, At, Bt) do { __builtin_amdgcn_s_setprio(1); _Pragma("unroll") for (int m = 0; m < 4; ++m) _Pragma("unroll") for (int n = 0; n < 2; ++n) _Pragma("unroll") for (int k = 0; k < 2; ++k) \
        acc[ai][bj][m][n] = __builtin_amdgcn_mfma_f32_16x16x32_bf16(Bt[n][k], At[m][k], acc[ai][bj][m][n], 0, 0, 0); __builtin_amdgcn_s_setprio(0); } while (0)
#define PG8_WAIT_V(n) asm volatile("s_waitcnt vmcnt(" #n ")" ::: "memory")
#define PG8_WAIT_L(n) asm volatile("s_waitcnt lgkmcnt(" #n ")" ::: "memory")
#define PG8_BAR __builtin_amdgcn_s_barrier()
#define PG8_SCHED __builtin_amdgcn_sched_barrier(0)
    Unit cur, nxt; int ui = 0;
    if (!S.next(0, cur)) return;
    f32x4 acc[2][2][4][2];
#pragma unroll
    for (int a = 0; a < 2; ++a)
#pragma unroll
        for (int b = 0; b < 2; ++b)
#pragma unroll
            for (int m = 0; m < 4; ++m)
#pragma unroll
                for (int n = 0; n < 2; ++n) acc[a][b][m][n] = (f32x4){0.f, 0.f, 0.f, 0.f};
    bf16x8 At[4][2], B0[2][2], B1[2][2];
    const char* cA = PG8_APTR(cur); const char* cB = PG8_BPTR(cur);
    S.a_ready(cur);
    if constexpr (SP2) {
        PG8_STAGE(PG8_SB(0, 0), cB, voffB); PG8_STAGE(PG8_SB(0, 1), cB + hstepB, voffB); PG8_STAGE(PG8_SA(0, 0), cA, voffA); PG8_STAGE(PG8_SA(0, 1), cA + hstepA, voffA);
        if (wr == 1) PG8_BAR;
        PG8_WAIT_V(2); PG8_BAR;
        PG8_STAGE(PG8_SB(1, 0), cB + kstep, voffB); PG8_STAGE(PG8_SA(1, 0), cA + kstep, voffA); PG8_STAGE(PG8_SB(1, 1), cB + hstepB + kstep, voffB);
        PG8_WAIT_V(6); PG8_BAR;
    } else {
        PG8_STAGE(PG8_SB(0, 0), cB, voffB); PG8_STAGE(PG8_SA(0, 0), cA, voffA); PG8_STAGE(PG8_SB(0, 1), cB + hstepB, voffB); PG8_STAGE(PG8_SA(0, 1), cA + hstepA, voffA);
        if (wr == 1) PG8_BAR;
        PG8_WAIT_V(4); PG8_BAR;
        PG8_STAGE(PG8_SB(1, 0), cB + kstep, voffB); PG8_STAGE(PG8_SA(1, 0), cA + kstep, voffA); PG8_STAGE(PG8_SB(1, 1), cB + hstepB + kstep, voffB);
        PG8_WAIT_V(6); PG8_BAR;
    }
    for (;;) {
        const bool has_next = S.next(ui + 1, nxt);
        const char* nA = has_next ? PG8_APTR(nxt) : cA; const char* nB = has_next ? PG8_BPTR(nxt) : cB;
        for (int t = 0; t < nt; t += 2) {
            const bool last = (t == nt - 2);
            const char* a1 = cA + (size_t)(t + 1) * kstep;
            const char* a2 = last ? nA : cA + (size_t)(t + 2) * kstep; const char* b2 = last ? nB : cB + (size_t)(t + 2) * kstep;
            const char* a3 = a2 + kstep; const char* b3 = b2 + kstep;
            if (last && has_next) S.a_ready(nxt);
            if constexpr (SP2) {
            PG8_LDB(B0, 0, 0); PG8_LDB(B1, 0, 1); PG8_SCHED; PG8_LDA(At, 0, 0); PG8_STAGE(PG8_SA(1, 1), a1 + hstepA, voffA);
            PG8_WAIT_V(8); PG8_WAIT_L(0); PG8_BAR; PG8_MMA(0, 0, At, B0); PG8_MMA(0, 1, At, B1); PG8_BAR; PG8_SCHED;
            PG8_LDA(At, 0, 1); PG8_STAGE(PG8_SB(0, 0), b2, voffB); PG8_STAGE(PG8_SB(0, 1), b2 + hstepB, voffB); PG8_STAGE(PG8_SA(0, 0), a2, voffA);
            PG8_WAIT_V(8); PG8_WAIT_L(0); PG8_BAR; PG8_MMA(1, 0, At, B0); PG8_MMA(1, 1, At, B1); PG8_BAR; PG8_SCHED;
            PG8_LDB(B0, 1, 0); PG8_LDB(B1, 1, 1); PG8_SCHED; PG8_LDA(At, 1, 0); PG8_STAGE(PG8_SA(0, 1), a2 + hstepA, voffA);
            PG8_WAIT_V(8); PG8_WAIT_L(0); PG8_BAR; PG8_MMA(0, 0, At, B0); PG8_MMA(0, 1, At, B1); PG8_BAR; PG8_SCHED;
            PG8_LDA(At, 1, 1); PG8_STAGE(PG8_SB(1, 0), b3, voffB); PG8_STAGE(PG8_SB(1, 1), b3 + hstepB, voffB); PG8_STAGE(PG8_SA(1, 0), a3, voffA);
            PG8_WAIT_V(8); PG8_WAIT_L(0); PG8_BAR; PG8_MMA(1, 0, At, B0); PG8_MMA(1, 1, At, B1); PG8_BAR; PG8_SCHED;
            } else {
            PG8_LDB(B0, 0, 0); PG8_SCHED; PG8_LDA(At, 0, 0); PG8_STAGE(PG8_SA(1, 1), a1 + hstepA, voffA);
            PG8_WAIT_L(8); PG8_BAR; PG8_WAIT_L(0); PG8_MMA(0, 0, At, B0); PG8_BAR; PG8_SCHED;
            PG8_LDB(B1, 0, 1); PG8_STAGE(PG8_SB(0, 0), b2, voffB);
            PG8_BAR; PG8_WAIT_L(0); PG8_MMA(0, 1, At, B1); PG8_BAR;
            PG8_LDA(At, 0, 1); PG8_STAGE(PG8_SA(0, 0), a2, voffA);
            PG8_BAR; PG8_WAIT_L(0); PG8_MMA(1, 0, At, B0); PG8_BAR; PG8_SCHED;
            PG8_STAGE(PG8_SB(0, 1), b2 + hstepB, voffB);
            PG8_WAIT_V(6); PG8_BAR; PG8_MMA(1, 1, At, B1); PG8_BAR;
            PG8_LDB(B0, 1, 0); PG8_SCHED; PG8_LDA(At, 1, 0); PG8_STAGE(PG8_SA(0, 1), a2 + hstepA, voffA);
            PG8_WAIT_L(8); PG8_BAR; PG8_WAIT_L(0); PG8_MMA(0, 0, At, B0); PG8_BAR; PG8_SCHED;
            PG8_LDB(B1, 1, 1); PG8_STAGE(PG8_SB(1, 0), b3, voffB);
            PG8_BAR; PG8_WAIT_L(0); PG8_MMA(0, 1, At, B1); PG8_BAR;
            PG8_LDA(At, 1, 1); PG8_STAGE(PG8_SA(1, 0), a3, voffA);
            PG8_BAR; PG8_WAIT_L(0); PG8_MMA(1, 0, At, B0); PG8_BAR; PG8_SCHED;
            PG8_STAGE(PG8_SB(1, 1), b3 + hstepB, voffB);
            PG8_WAIT_V(6); PG8_BAR; PG8_MMA(1, 1, At, B1); PG8_BAR;
            }
        }
        if constexpr (ALIGN_EPI) { if (wr == 0) PG8_BAR; }
        if constexpr (!Epi::AFTER_DRAIN) { E(acc, cur, wr, wc, fr, fq); S.done(cur); }
        if (!has_next) break;
#pragma unroll
        for (int a = 0; a < 2; ++a)
#pragma unroll
            for (int b = 0; b < 2; ++b)
#pragma unroll
                for (int m = 0; m < 4; ++m)
#pragma unroll
                    for (int n = 0; n < 2; ++n) acc[a][b][m][n] = (f32x4){0.f, 0.f, 0.f, 0.f};
        cur = nxt; cA = nA; cB = nB; ++ui;
        if constexpr (ALIGN_EPI) { if (wr == 1) PG8_BAR; }
    }
    PG8_WAIT_V(0);
    if constexpr (!ALIGN_EPI) { if (wr == 0) PG8_BAR; }
    PG8_BAR;
    if constexpr (Epi::AFTER_DRAIN) { E.fused(acc, cur, wr, wc, fr, fq, lds, wid, lane); S.done(cur); }
#undef PG8_APTR
#undef PG8_BPTR
#undef PG8_SA
#undef PG8_SB
#undef PG8_STAGE
#undef PG8_LDA
#undef PG8_LDB
#undef PG8_MMA
#undef PG8_WAIT_V
#undef PG8_WAIT_L
#undef PG8_BAR
#undef PG8_SCHED
}
}
namespace att {
typedef unsigned short bf16;
typedef short bf16x8 __attribute__((ext_vector_type(8)));
typedef short s16x4 __attribute__((ext_vector_type(4)));
typedef float f32x16 __attribute__((ext_vector_type(16)));
typedef unsigned u32x4 __attribute__((ext_vector_type(4)));
constexpr int NW = 8, QBLK = 32, KVBLK = 64;
constexpr int SHM_V = KVBLK * 128 * 2;
#define SBAR() __builtin_amdgcn_sched_barrier(0)
__device__ __forceinline__ int crow(int r, int hi) { return (r & 3) + 8 * (r >> 2) + 4 * hi; }
__device__ __forceinline__ unsigned cvtpk(float lo, float hi) { unsigned r; asm volatile("v_cvt_pk_bf16_f32 %0, %1, %2" : "=v"(r) : "v"(lo), "v"(hi)); return r; }

struct Args {
  const bf16* Q; const bf16* K; const bf16* K2; const bf16* V; bf16* O;
  int ldq, ldk, ldk2, ldv, ldo;
  int NT, nctx, ctx_row0, lat_row0;
  float C, thr_raw;
  int qpos0, kpos0;
  float sink_l2;
  int r0, klo;
  const float* rpb; float inv_scale;
  const float* qgain;
  int qrope_t0;
};

__device__ __forceinline__ void partialSM(f32x16& p0, f32x16& p1, float& m_reg, float& mn, float& alpha, const float C, const float thr_raw) {
  float pmax = p0[0];
#pragma unroll
  for (int r = 1; r < 16; ++r) pmax = fmaxf(pmax, p0[r]);
#pragma unroll
  for (int r = 0; r < 16; ++r) pmax = fmaxf(pmax, p1[r]);
  { auto rr = __builtin_amdgcn_permlane32_swap(__float_as_uint(pmax), __float_as_uint(pmax), false, false);
    pmax = fmaxf(__uint_as_float(rr[0]), __uint_as_float(rr[1])); }
  if (__builtin_expect(__all(pmax - m_reg <= thr_raw), 1)) { mn = m_reg; alpha = 1.f; }
  else { mn = fmaxf(m_reg, pmax); alpha = __builtin_amdgcn_exp2f((m_reg - mn) * C); m_reg = mn; }
  const float mnC = -mn * C;
#pragma unroll
  for (int r = 0; r < 16; ++r) p0[r] = fmaf(p0[r], C, mnC);
#pragma unroll
  for (int r = 0; r < 16; ++r) p1[r] = fmaf(p1[r], C, mnC);
#pragma unroll
  for (int r = 0; r < 16; ++r) p0[r] = __builtin_amdgcn_exp2f(p0[r]);
}
__device__ __forceinline__ void finishSM(f32x16& p0, f32x16& p1, float alpha, float& l_reg, bf16x8& pa0, bf16x8& pa1, bf16x8& pa2, bf16x8& pa3) {
#pragma unroll
  for (int r = 0; r < 16; ++r) p1[r] = __builtin_amdgcn_exp2f(p1[r]);
  float ps = 0;
#pragma unroll
  for (int r = 0; r < 16; ++r) ps += p0[r];
#pragma unroll
  for (int r = 0; r < 16; ++r) ps += p1[r];
  { auto rr = __builtin_amdgcn_permlane32_swap(__float_as_uint(ps), __float_as_uint(ps), false, false);
    ps = __uint_as_float(rr[0]) + __uint_as_float(rr[1]); }
  l_reg = l_reg * alpha + ps;
#define PK4(P, BASE, OUT) do { unsigned a0 = cvtpk(P[BASE + 0], P[BASE + 1]), a1 = cvtpk(P[BASE + 2], P[BASE + 3]);   \
    unsigned b0 = cvtpk(P[BASE + 4], P[BASE + 5]), b1 = cvtpk(P[BASE + 6], P[BASE + 7]);                              \
    auto r0 = __builtin_amdgcn_permlane32_swap(a0, b0, false, false); auto r1 = __builtin_amdgcn_permlane32_swap(a1, b1, false, false); \
    u32x4 w = {r0[0], r1[0], r0[1], r1[1]}; OUT = *reinterpret_cast<bf16x8*>(&w); } while (0)
  PK4(p0, 0, pa0); PK4(p0, 8, pa1); PK4(p1, 0, pa2); PK4(p1, 8, pa3);
#undef PK4
}
template <int DQ> __device__ __forceinline__ int kswz(int row, int colB) { return row * (DQ * 2) + (colB ^ ((row & 7) << 4)); }
typedef const __attribute__((address_space(3))) bf16x8* lds_b128_ptr;
template <int DQ> __device__ __forceinline__ void qkt(f32x16& p0, f32x16& p1, const int (&kx)[4], int koff, const bf16x8* qr) {
  p0 = f32x16{}; p1 = f32x16{};
  lds_b128_ptr k0 = (lds_b128_ptr)(unsigned)(kx[0] + koff), k1 = (lds_b128_ptr)(unsigned)(kx[1] + koff), k2 = (lds_b128_ptr)(unsigned)(kx[2] + koff), k3 = (lds_b128_ptr)(unsigned)(kx[3] + koff);
#pragma unroll
  for (int d0 = 0; d0 < DQ / 16; ++d0) { lds_b128_ptr kp = (d0 & 3) == 0 ? k0 : (d0 & 3) == 1 ? k1 : (d0 & 3) == 2 ? k2 : k3;
    const bf16x8 b0 = kp[(d0 >> 2) * 8];
    const bf16x8 b1 = kp[(d0 >> 2) * 8 + 32 * DQ * 2 / 16];
    p0 = __builtin_amdgcn_mfma_f32_32x32x16_bf16(b0, qr[d0], p0, 0, 0, 0);
    p1 = __builtin_amdgcn_mfma_f32_32x32x16_bf16(b1, qr[d0], p1, 0, 0, 0); }
}
__device__ __forceinline__ int v_st(int k, int c) { const int kk = (k & ~0xC) | ((k & 4) << 1) | ((k & 8) >> 1); return ((kk >> 3) * 4 + (c >> 5)) * 512 + ((kk & 7) * 32 + (c & 31)) * 2; }
__device__ __forceinline__ int v_rd_base(int lane) { return ((lane & 3) << 3) | (((lane >> 2) & 3) << 6) | (((lane >> 4) & 1) << 5) | (((lane >> 5) & 1) << 8); }
constexpr int v_rd_off(int d0, int ks, int half) { return d0 * 512 + ks * 4096 + half * 2048; }
template <int OFF> __device__ __forceinline__ s16x4 tr_read(int vb) {
  s16x4 r; asm volatile("ds_read_b64_tr_b16 %0, %1 offset:%2" : "=&v"(r) : "v"(vb), "i"(OFF) : "memory"); return r;
}
template <int D0> __device__ __forceinline__ void pv_one(f32x16& od, int vb, bf16x8 pa0, bf16x8 pa1, bf16x8 pa2, bf16x8 pa3) {
  const s16x4 l0 = tr_read<v_rd_off(D0, 0, 0)>(vb), h0 = tr_read<v_rd_off(D0, 0, 1)>(vb), l1 = tr_read<v_rd_off(D0, 1, 0)>(vb), h1 = tr_read<v_rd_off(D0, 1, 1)>(vb);
  const s16x4 l2 = tr_read<v_rd_off(D0, 2, 0)>(vb), h2 = tr_read<v_rd_off(D0, 2, 1)>(vb), l3 = tr_read<v_rd_off(D0, 3, 0)>(vb), h3 = tr_read<v_rd_off(D0, 3, 1)>(vb);
  asm volatile("s_waitcnt lgkmcnt(0)" ::: "memory"); SBAR();
#define PK(L, H) (bf16x8){L[0], L[1], L[2], L[3], H[0], H[1], H[2], H[3]}
  od = __builtin_amdgcn_mfma_f32_32x32x16_bf16(pa0, PK(l0, h0), od, 0, 0, 0);
  od = __builtin_amdgcn_mfma_f32_32x32x16_bf16(pa1, PK(l1, h1), od, 0, 0, 0);
  od = __builtin_amdgcn_mfma_f32_32x32x16_bf16(pa2, PK(l2, h2), od, 0, 0, 0);
  od = __builtin_amdgcn_mfma_f32_32x32x16_bf16(pa3, PK(l3, h3), od, 0, 0, 0);
#undef PK
}
__device__ __forceinline__ void pv_d0(f32x16* o, int vb, bf16x8 pa0, bf16x8 pa1, bf16x8 pa2, bf16x8 pa3) {
  pv_one<0>(o[0], vb, pa0, pa1, pa2, pa3); pv_one<1>(o[1], vb, pa0, pa1, pa2, pa3); pv_one<2>(o[2], vb, pa0, pa1, pa2, pa3); pv_one<3>(o[3], vb, pa0, pa1, pa2, pa3);
}
template <int MODE> __device__ __forceinline__ void maskf(f32x16& p0, f32x16& p1, int t, const Args& a, int wid, int r32, int hi, const float* bias_lds) {
  if constexpr (MODE == 0) { return; }
  else {
    if (t < a.nctx) return;
    if constexpr (MODE == 1) {
      const int kb = a.kpos0 + (t - a.nctx) * 64, qw = a.qpos0 + wid * 32;
      if (kb + 63 - qw <= 128 && qw + 31 - kb <= 128) return;
      const int q = qw + r32;
#pragma unroll
      for (int r = 0; r < 16; ++r) { const int d0 = kb + crow(r, hi) - q, d1 = d0 + 32;
        if (d0 > 128 || d0 < -128) p0[r] = -1e30f;
        if (d1 > 128 || d1 < -128) p1[r] = -1e30f; }
    } else {
      const int kr = a.klo + (t - a.nctx), rq = a.r0 + (wid >> 1);
      const int rs = min(max(rq - 4, 0), 120);
      if (kr < rs || kr >= rs + 8) {
#pragma unroll
        for (int r = 0; r < 16; ++r) { p0[r] = -1e30f; p1[r] = -1e30f; }
        return; }
      const int c = (wid & 1) * 32 + r32, cs = min(max(c - 8, 0), 48);
      int cb = 4 * hi - c + 63, vb = 4 * hi - cs;
      asm volatile("" : "+v"(cb), "+v"(vb));
      const float* bp = bias_lds + (kr - rq + 7) * 128 + cb;
#pragma unroll
      for (int r = 0; r < 16; ++r) { const int k0 = (r & 3) + 8 * (r >> 2), k1 = k0 + 32;
        const float b0 = bp[k0], b1 = bp[k1];
        p0[r] = ((unsigned)(k0 + vb) < 16u) ? fmaf(b0, a.inv_scale, p0[r]) : -1e30f;
        p1[r] = ((unsigned)(k1 + vb) < 16u) ? fmaf(b1, a.inv_scale, p1[r]) : -1e30f;
        if ((r & 3) == 3) SBAR(); }
    }
  }
}

template <int DQ, int MODE>
__device__ __forceinline__ void attn_unit(const Args& a, char* lds, const int wave0) {
  constexpr int SHM_K = KVBLK * DQ * 2, NQ = DQ / 16, OFF_K = 3 * SHM_V, OFF_WS = OFF_K + 2 * SHM_K;
  const int tid = fresh_tid(wave0), wid = tid >> 6, lane = tid & 63, r32 = lane & 31, hi = lane >> 5;
  char* V_lds = lds; char* K_lds = lds + OFF_K;
  float* ws = (float*)(lds + OFF_WS) + wid * 64; float* li_l = ws; float* al_l = ws + 32;
  float* bias_l = (float*)(lds + OFF_WS + 2048);
  if constexpr (MODE == 2) { if (tid < 465) bias_l[(tid / 31) * 128 + 48 + (tid % 31)] = a.rpb[tid]; }
  float m_reg = -1e30f, l_reg = 0; f32x16 o[4] = {}; bf16x8 qr[NQ];
  const float C = a.C, thr_raw = a.thr_raw;
  const bf16* Qw = a.Q + (long)(wid * QBLK + r32) * a.ldq + hi * 8;
#pragma unroll
  for (int d0 = 0; d0 < NQ; ++d0) qr[d0] = *reinterpret_cast<const bf16x8*>(Qw + d0 * 16);
  if constexpr (DQ == 128) {
    if (a.qgain) { float xf[8][8]; float ss = 0.f;
#pragma unroll
      for (int d0 = 0; d0 < 8; ++d0)
#pragma unroll
        for (int e = 0; e < 8; ++e) { xf[d0][e] = __uint_as_float(((unsigned)(unsigned short)qr[d0][e]) << 16); ss += xf[d0][e] * xf[d0][e]; }
      { auto rr = __builtin_amdgcn_permlane32_swap(__float_as_uint(ss), __float_as_uint(ss), false, false); ss = __uint_as_float(rr[0]) + __uint_as_float(rr[1]); }
      const float rstd = rsqrtf(ss * (1.0f / 128.0f) + 1e-6f);
#pragma unroll
      for (int d0 = 0; d0 < 8; ++d0) { const float* gp = a.qgain + d0 * 16 + hi * 8;
#pragma unroll
        for (int e = 0; e < 8; ++e) xf[d0][e] = xf[d0][e] * rstd * gp[e]; }
      if (a.qrope_t0 >= 0) { const int t = a.qrope_t0 + wid * QBLK + r32; const float prow = (float)(t >> 6), pcol = (float)(t & 63);
#pragma unroll
        for (int half = 0; half < 2; ++half)
#pragma unroll
          for (int blk = 0; blk < 2; ++blk)
#pragma unroll
            for (int e = 0; e < 8; ++e) { const int j = blk * 16 + hi * 8 + e, da = 4 * half + blk, db = da + 2;
              const float inv_freq = __builtin_amdgcn_exp2f(-(float)j * (13.287712379549449f / 32.0f)); float rev = (half ? pcol : prow) * inv_freq * 0.15915494309189535f; rev -= rintf(rev);
              const float sn = __builtin_amdgcn_sinf(rev), cs = __builtin_amdgcn_cosf(rev);
              const float x = xf[da][e], y = xf[db][e]; xf[da][e] = x * cs - y * sn; xf[db][e] = y * cs + x * sn; } }
#pragma unroll
      for (int d0 = 0; d0 < 8; ++d0) { bf16x8 w;
#pragma unroll
        for (int e = 0; e < 8; ++e) { unsigned u = __float_as_uint(xf[d0][e]); u = (u + 0x7fffu + ((u >> 16) & 1u)) >> 16; w[e] = (short)u; }
        qr[d0] = w; } } }
  if constexpr (DQ == 192) {
    if (a.qrope_t0 >= 0) { const int t = a.qrope_t0 + wid * QBLK + r32; const float prow = (float)(t >> 6), pcol = (float)(t & 63);
#pragma unroll
      for (int half = 0; half < 2; ++half) { bf16x8 xa = qr[8 + 2 * half], xb = qr[9 + 2 * half]; const float pos = half ? pcol : prow;
#pragma unroll
        for (int e = 0; e < 8; ++e) { const int j = hi * 8 + e;
          const float inv_freq = __builtin_amdgcn_exp2f(-(float)j * (13.287712379549449f / 16.0f)); float rev = pos * inv_freq * 0.15915494309189535f; rev -= rintf(rev);
          const float sn = __builtin_amdgcn_sinf(rev), cs = __builtin_amdgcn_cosf(rev);
          const float x = __uint_as_float(((unsigned)(unsigned short)xa[e]) << 16), y = __uint_as_float(((unsigned)(unsigned short)xb[e]) << 16);
          const float nx = x * cs - y * sn, ny = y * cs + x * sn; unsigned ux = __float_as_uint(nx), uy = __float_as_uint(ny);
          ux = (ux + 0x7fffu + ((ux >> 16) & 1u)) >> 16; uy = (uy + 0x7fffu + ((uy >> 16) & 1u)) >> 16; xa[e] = (short)ux; xb[e] = (short)uy; }
        qr[8 + 2 * half] = xa; qr[9 + 2 * half] = xb; } } }
  const int vb0 = (int)(uintptr_t)V_lds + v_rd_base(lane);
  int kx[4];
#pragma unroll
  for (int q = 0; q < 4; ++q) kx[q] = (int)(uintptr_t)K_lds + r32 * (DQ * 2) + ((q * 32 + hi * 16) ^ ((r32 & 7) << 4));
  constexpr int KP = DQ / 64;
  int koff[KP]; bool kk2[KP]; int voff[2];
#pragma unroll
  for (int i = 0; i < KP; ++i) { const int q = (wid * KP + i) * 64 + lane, row = q / (DQ / 8), cs = q % (DQ / 8), c = cs ^ (row & 7);
    kk2[i] = (DQ == 192) && c >= 16; koff[i] = kk2[i] ? row * a.ldk2 + (c - 16) * 8 : row * a.ldk + c * 8; }
#pragma unroll
  for (int i = 0; i < 2; ++i) { const int q = (wid * 2 + i) * 64 + lane, sub = q >> 5, within = q & 31, kk = (sub >> 2) * 8 + (within >> 2), c = (sub & 3) * 32 + (within & 3) * 8;
    const int k = (kk & ~0xC) | ((kk & 4) << 1) | ((kk & 8) >> 1); voff[i] = k * a.ldv + c; }
  const unsigned kdst0 = (unsigned)(uintptr_t)K_lds + (unsigned)(wid * KP) * 1024u, vdst0 = (unsigned)(uintptr_t)V_lds + (unsigned)(wid * 2) * 1024u;
#define KROW(t) ((t) < a.nctx ? a.ctx_row0 + 64 * (t) : a.lat_row0 + 64 * ((t) - a.nctx))
#define GLDS16(gsrc, ldst) do { unsigned keep_; asm volatile("s_mov_b32 %0, m0\n\ts_mov_b32 m0, %2\n\ts_nop 0\n\tglobal_load_lds_dwordx4 %1, off\n\ts_mov_b32 m0, %0" : "=&s"(keep_) : "v"(gsrc), "s"(ldst) : "memory"); } while (0)
#define DMA(t) do { const long kr_ = KROW(t); const unsigned kd_ = (unsigned)__builtin_amdgcn_readfirstlane((int)(kdst0 + (unsigned)(((t) & 1) * SHM_K))), vd_ = (unsigned)__builtin_amdgcn_readfirstlane((int)(vdst0 + (unsigned)(((t) % 3) * SHM_V))); \
    const bf16* vp_ = a.V + kr_ * a.ldv; const bf16* kp_ = a.K + kr_ * a.ldk; const bf16* kp2_ = (DQ == 192) ? a.K2 + kr_ * a.ldk2 : kp_; \
    _Pragma("unroll") for (int i_ = 0; i_ < KP; ++i_) { const bf16* g_ = ((DQ == 192) && kk2[i_] ? kp2_ : kp_) + koff[i_]; GLDS16(g_, kd_ + (unsigned)i_ * 1024u); } \
    _Pragma("unroll") for (int i_ = 0; i_ < 2; ++i_) GLDS16(vp_ + voff[i_], vd_ + (unsigned)i_ * 1024u); } while (0)
#define WAIT_BAR() asm volatile("s_waitcnt vmcnt(0) lgkmcnt(0)\n\ts_barrier" ::: "memory")
#define RESC(al) do { if (__any((al) < 1.f)) { if (hi == 0) al_l[r32] = (al); asm volatile("s_waitcnt lgkmcnt(0)" ::: "memory"); \
    _Pragma("unroll") for (int d = 0; d < 4; ++d) _Pragma("unroll") for (int r = 0; r < 16; ++r) o[d][r] *= al_l[crow(r, hi)]; } } while (0)
  f32x16 pA0, pA1, pB0, pB1; float mnA, mnB, alA, alB; bf16x8 pa0, pa1, pa2, pa3; const int NT = a.NT;
#define STEP(j, PN0, PN1, MNN, ALN, PP0, PP1, ALP) do { const int j_ = (j); \
    WAIT_BAR();                            \
    if (j_ + 1 < NT) DMA(j_ + 1);          \
    SBAR(); qkt<DQ>(PN0, PN1, kx, (j_ & 1) * SHM_K, qr); maskf<MODE>(PN0, PN1, j_, a, wid, r32, hi, bias_l); \
    finishSM(PP0, PP1, ALP, l_reg, pa0, pa1, pa2, pa3); SBAR(); \
    pv_d0(o, vb0 + ((j_ - 1) % 3) * SHM_V, pa0, pa1, pa2, pa3); partialSM(PN0, PN1, m_reg, MNN, ALN, C, thr_raw); \
    RESC(ALN); } while (0)
  DMA(0); DMA(1);
  WAIT_BAR();
  qkt<DQ>(pA0, pA1, kx, 0, qr); maskf<MODE>(pA0, pA1, 0, a, wid, r32, hi, bias_l); partialSM(pA0, pA1, m_reg, mnA, alA, C, thr_raw);
  for (int j = 1; j + 1 < NT; j += 2) {
    STEP(j, pB0, pB1, mnB, alB, pA0, pA1, alA);
    STEP(j + 1, pA0, pA1, mnA, alA, pB0, pB1, alB);
  }
  STEP(NT - 1, pB0, pB1, mnB, alB, pA0, pA1, alA);
  finishSM(pB0, pB1, alB, l_reg, pa0, pa1, pa2, pa3); SBAR();
  pv_d0(o, vb0 + ((NT - 1) % 3) * SHM_V, pa0, pa1, pa2, pa3);
  if constexpr (MODE == 1) l_reg += __builtin_amdgcn_exp2f(a.sink_l2 - m_reg * C);
  if (hi == 0) li_l[r32] = l_reg; asm volatile("s_waitcnt lgkmcnt(0)" ::: "memory");
  float rli[16];
#pragma unroll
  for (int r = 0; r < 16; ++r) rli[r] = __builtin_amdgcn_rcpf(li_l[crow(r, hi)]);
  bf16* Ow = a.O + (long)(wid * QBLK) * a.ldo;
#pragma unroll
  for (int r = 0; r < 16; ++r) { const int orow = crow(r, hi);
#pragma unroll
    for (int d0 = 0; d0 < 4; ++d0) { const float v = o[d0][r] * rli[r]; unsigned u = __float_as_uint(v); u = (u + 0x7fffu + ((u >> 16) & 1u)) >> 16; Ow[(long)orow * a.ldo + d0 * 32 + r32] = (bf16)u; } }
  asm volatile("s_waitcnt lgkmcnt(0)\n\ts_barrier" ::: "memory");
#undef KROW
#undef GLDS16
#undef DMA
#undef WAIT_BAR
#undef RESC
#undef STEP
}
#undef SBAR
}
#define LAS __attribute__((address_space(3)))
typedef unsigned short bf16;
typedef float f32x4 __attribute__((ext_vector_type(4)));
typedef unsigned v4u __attribute__((ext_vector_type(4)));
typedef unsigned v2u __attribute__((ext_vector_type(2)));
constexpr int NWAVES = 8, NTHR = 512;
constexpr int DM = 2048, SEQ = 8192, NCTX = 256, MLAT = 2 * SEQ, MALL = MLAT + 2 * NCTX, DFF = 5632;
constexpr int N_IN0 = 2816, N_IN1 = 4608, N_UQ = 1536, N_UKV = 2048, N_GU = 2 * DFF;
constexpr float EPS = 1e-6f;
constexpr size_t MiB = 1u << 20;
constexpr size_t WS_MOD = 0, WS_BAR = 512 * 1024, BAR_BYTES = 16384;
constexpr size_t WS_WIN0 = 1 * MiB, WS_WUQ = WS_WIN0 + 11 * MiB, WS_WUKV = WS_WUQ + 2 * MiB, WS_WOUT0 = WS_WUKV + 2 * MiB, WS_WIN1 = WS_WOUT0 + 8 * MiB, WS_WOUT1 = WS_WIN1 + 18 * MiB,
                 WS_WGU = WS_WOUT1 + 8 * MiB, WS_WD = WS_WGU + 88 * MiB, WS_HCTX = WS_WD + 44 * MiB;
constexpr size_t WS_UO = WS_HCTX + 4 * MiB;
constexpr size_t WS_OB = WS_UO + 66 * MiB;
constexpr size_t WS_BIG = WS_UO + 132 * MiB;
constexpr size_t WS_QB = WS_BIG + 91 * MiB, WS_KVB = WS_BIG + 141 * MiB, WS_UB = WS_BIG + 149 * MiB, WS_END = WS_BIG + 215 * MiB;
static_assert((size_t)MALL * DM * 2 == 66 * MiB && (size_t)MALL * N_IN0 * 2 <= 91 * MiB && (size_t)MALL * N_UQ * 2 <= 50 * MiB && (size_t)MALL * N_IN1 * 2 <= 149 * MiB && (size_t)MALL * DFF * 2 <= 215 * MiB, "ws map");

__device__ __forceinline__ unsigned f2bf(float f) { unsigned u = __builtin_bit_cast(unsigned, f); return (u + 0x7fffu + ((u >> 16) & 1u)) >> 16; }
__device__ __forceinline__ unsigned pk2(float lo, float hi) { return f2bf(lo) | (f2bf(hi) << 16); }
__device__ __forceinline__ float bf2f(bf16 v) { return __uint_as_float(((unsigned)v) << 16); }
__device__ __forceinline__ float wave_sum(float v, int lane) {
#pragma unroll
    for (int o = 1; o < 64; o <<= 1) v += __int_as_float(__builtin_amdgcn_ds_bpermute((lane ^ o) << 2, __float_as_int(v)));
    return v;
}
__device__ __forceinline__ float silu_f(float x) { return x / (1.0f + __expf(-x)); }

#define GAS __attribute__((address_space(1)))
#define XB_TMO      128
#define XB_XCNT(j)  (256  + 64 * (j))
#define XB_XSUB(j)  (1280 + 64 * (j))
#define XB_XGEN(j)  (2304 + 64 * (j))
#define XB_TOP      3328
#define XB_TOPGEN   3392
#define XCD_BAR_WORDS 3456
#define XB_SPIN_CAP (1u << 18)

__device__ __forceinline__ unsigned xb_ld(unsigned* p)              { return __hip_atomic_load(p, __ATOMIC_RELAXED, __HIP_MEMORY_SCOPE_AGENT); }
__device__ __forceinline__ unsigned xb_add(unsigned* p, unsigned v) { return __hip_atomic_fetch_add(p, v, __ATOMIC_RELAXED, __HIP_MEMORY_SCOPE_AGENT); }
__device__ __forceinline__ unsigned xb_xcc_id() { return (unsigned)__builtin_amdgcn_s_getreg((3 << 11) | 20) & 0xFu; }
#define XB_SPIN(cond, bar) do { unsigned _sp = 0; while (cond) { __builtin_amdgcn_s_sleep(1); \
    if ((++_sp & 255u) == 0u) { if (xb_ld(&(bar)[XB_TMO])) break; if (_sp > XB_SPIN_CAP) { atomicAdd(&(bar)[XB_TMO], 1u); break; } } } } while (0)

struct XcdBarrier {
    unsigned* bar; unsigned x;
    volatile LAS unsigned* st;
};

__device__ __forceinline__ XcdBarrier xcd_barrier_post(unsigned* bar, volatile LAS unsigned* st) {
    XcdBarrier b; b.bar = bar; b.x = xb_xcc_id(); b.st = st;
    if (threadIdx.x == 0) (void)xb_add(&bar[XB_XCNT(b.x)], 1u);
    return b;
}
__device__ __forceinline__ void xcd_barrier_complete(unsigned* bar, unsigned x, unsigned& nloc, unsigned& nx) {
    const unsigned G = gridDim.x * gridDim.y * gridDim.z;
    unsigned sum, cnt, mine, sp = 0u;
    for (;;) {
        sum = 0u; cnt = 0u; mine = 0u;
#pragma unroll
        for (unsigned j = 0; j < 16; ++j) { const unsigned c = xb_ld(&bar[XB_XCNT(j)]); sum += c; cnt += (c > 0u) ? 1u : 0u; mine = (j == x) ? c : mine; }
        if (sum == G) break;
        __builtin_amdgcn_s_sleep(1);
        if ((++sp & 255u) == 0u) { if (xb_ld(&bar[XB_TMO])) break; if (sp > XB_SPIN_CAP) { atomicAdd(&bar[XB_TMO], 1u); break; } }
    }
    nloc = mine > 0u ? mine : 1u; nx = cnt > 0u ? cnt : 1u;
}

__device__ __forceinline__ void xcd_barrier(const XcdBarrier& b) {
    asm volatile("s_waitcnt vmcnt(0)" ::: "memory");
    __syncthreads();
    if (threadIdx.x == 0) {
        unsigned* bar = b.bar;
        __builtin_amdgcn_s_waitcnt(0);
        unsigned nloc = b.st[0], nx = b.st[1];
        if (nloc == 0u) { xcd_barrier_complete(bar, b.x, nloc, nx); b.st[0] = nloc; b.st[1] = nx; }
        const unsigned old = xb_add(&bar[XB_XSUB(b.x)], 1u);
        const unsigned gen = old / nloc;
        if (old + 1u == (gen + 1u) * nloc) {
            __builtin_amdgcn_fence(__ATOMIC_RELEASE, "agent");
            asm volatile("s_waitcnt vmcnt(0)" ::: "memory");
            const unsigned og = xb_add(&bar[XB_TOP], 1u);
            const unsigned tg = og / nx;
            if (og + 1u == (tg + 1u) * nx) xb_add(&bar[XB_TOPGEN], 1u);
            else XB_SPIN(xb_ld(&bar[XB_TOPGEN]) == tg, bar);
            __builtin_amdgcn_fence(__ATOMIC_ACQUIRE, "agent");
            xb_add(&bar[XB_XGEN(b.x)], 1u);
            asm volatile("s_waitcnt vmcnt(0)" ::: "memory");
        } else {
            XB_SPIN(xb_ld(&bar[XB_XGEN(b.x)]) == gen, bar);
            __builtin_amdgcn_fence(__ATOMIC_ACQUIRE, "agent");
            asm volatile("s_waitcnt vmcnt(0)" ::: "memory");
        }
    }
    __syncthreads();
}

struct KArgs { const float* in[29]; float* out; unsigned char* ws; };
typedef const __attribute__((address_space(4))) KArgs* KAP;
__device__ __forceinline__ KAP kargs() { KAP p = (KAP)__builtin_amdgcn_kernarg_segment_ptr(); asm volatile("" : "+s"(p)); return p; }

__device__ __forceinline__ void transpose_item(const float* W, int K, int N, bf16* WT, int k0, int n0, int drow0, LAS float* scr, int lane) {
#pragma unroll 8
    for (int i = 0; i < 32; ++i) { const int kk = 2 * i + (lane >> 5); scr[kk * 33 + (lane & 31)] = __builtin_nontemporal_load(W + (size_t)(k0 + kk) * N + n0 + (lane & 31)); }
    asm volatile("s_waitcnt lgkmcnt(0)" ::: "memory");
    const int c = lane & 7;
#pragma unroll
    for (int j = 0; j < 4; ++j) { const int n = (lane >> 3) + 8 * j; const LAS float* s = scr + (8 * c) * 33 + n;
        v4u o; o.x = pk2(s[0 * 33], s[1 * 33]); o.y = pk2(s[2 * 33], s[3 * 33]); o.z = pk2(s[4 * 33], s[5 * 33]); o.w = pk2(s[6 * 33], s[7 * 33]);
        *(v4u*)(WT + (size_t)(drow0 + n) * K + k0 + 8 * c) = o; }
    asm volatile("s_waitcnt lgkmcnt(0)" ::: "memory");
}
__device__ __forceinline__ bool conv_matrix(int& it, const float* W, int K, int N, bf16* WT, int mode, LAS float* scr, int lane) {
    const int nblk = N / 32, items = (K / 64) * nblk;
    if (it >= items) { it -= items; return false; }
    const int kb = it / nblk, nb = it % nblk, n0 = 32 * nb;
    const int drow0 = mode == 0 ? n0 : ((n0 >> 7) * 256 + (mode == 2 ? 128 : 0) + (n0 & 127));
    transpose_item(W, K, N, WT, 64 * kb, n0, drow0, scr, lane);
    return true;
}
__device__ __forceinline__ void p0_weights(KAP a, LAS unsigned char* lds, int gw, int NGW, int wave, int lane) {
    LAS float* scr = (LAS float*)(lds + wave * 8704);
    unsigned char* ws = a->ws;
    constexpr int I_TOTAL = (2048 / 64) * (2624 / 32) + (512 / 64) * (1536 / 32) + (512 / 64) * (2048 / 32) + 2 * (2048 / 64) * (2048 / 32) + (2048 / 64) * (4608 / 32)
                          + 4 * (2048 / 64) * (DFF / 32) + 2 * (DFF / 64) * (2048 / 32);
    for (int item = gw; item < I_TOTAL; item += NGW) {
        int it = item;
        if (conv_matrix(it, a->in[13], 2048, 2624, (bf16*)(ws + WS_WIN0), 0, scr, lane)) continue;
        if (conv_matrix(it, a->in[19], 512, 1536, (bf16*)(ws + WS_WUQ), 0, scr, lane)) continue;
        if (conv_matrix(it, a->in[20], 512, 2048, (bf16*)(ws + WS_WUKV), 0, scr, lane)) continue;
        if (conv_matrix(it, a->in[14], 2048, 2048, (bf16*)(ws + WS_WOUT0), 0, scr, lane)) continue;
        if (conv_matrix(it, a->in[21], 2048, 4608, (bf16*)(ws + WS_WIN1), 0, scr, lane)) continue;
        if (conv_matrix(it, a->in[22], 2048, 2048, (bf16*)(ws + WS_WOUT1), 0, scr, lane)) continue;
        if (conv_matrix(it, a->in[10], 2048, DFF, (bf16*)(ws + WS_WGU), 1, scr, lane)) continue;
        if (conv_matrix(it, a->in[10] + (size_t)2048 * DFF, 2048, DFF, (bf16*)(ws + WS_WGU + 44 * MiB), 1, scr, lane)) continue;
        if (conv_matrix(it, a->in[11], 2048, DFF, (bf16*)(ws + WS_WGU), 2, scr, lane)) continue;
        if (conv_matrix(it, a->in[11] + (size_t)2048 * DFF, 2048, DFF, (bf16*)(ws + WS_WGU + 44 * MiB), 2, scr, lane)) continue;
        if (conv_matrix(it, a->in[12], DFF, 2048, (bf16*)(ws + WS_WD), 0, scr, lane)) continue;
        conv_matrix(it, a->in[12] + (size_t)2048 * DFF, DFF, 2048, (bf16*)(ws + WS_WD + 22 * MiB), 0, scr, lane);
    }
}
__device__ __forceinline__ void p0_mod(KAP a, LAS unsigned char* lds, int tid) {
    LAS float* sv = (LAS float*)lds;
    LAS float* red = (LAS float*)(lds + 24576);
    const int blk = blockIdx.x; if (blk >= 256) return;
    const int layer = blk >> 7, col0 = (blk & 127) * 96;
    for (int i = tid; i < 3 * 2048; i += NTHR) { const int v = i >> 11, k = i & 2047; const float x = v < 2 ? a->in[1][v * 2048 + k] : a->in[3][k]; sv[i] = silu_f(x); }
    __syncthreads();
    const int c4 = tid % 24, ks = tid / 24;
    if (ks < 21) {
        const float* W = a->in[4] + (size_t)layer * 2048 * 12288 + col0 + 4 * c4;
        f32x4 a0 = {0, 0, 0, 0}, a1 = a0, a2 = a0;
#pragma unroll 8
        for (int k = ks; k < 2048; k += 21) { const f32x4 w = __builtin_nontemporal_load((const f32x4*)(W + (size_t)k * 12288)); a0 += w * sv[k]; a1 += w * sv[2048 + k]; a2 += w * sv[4096 + k]; }
        LAS float* r = red + ks * 288 + 4 * c4;
        *(LAS f32x4*)(r) = a0; *(LAS f32x4*)(r + 96) = a1; *(LAS f32x4*)(r + 192) = a2;
    }
    __syncthreads();
    if (tid < 288) { float s = 0.f;
        for (int q = 0; q < 21; ++q) s += red[q * 288 + tid];
        const int v = tid / 96, j = tid % 96;
        ((float*)(a->ws + WS_MOD))[(size_t)(layer * 3 + v) * 12288 + col0 + j] = s + a->in[5][layer * 12288 + col0 + j]; }
    __syncthreads();
}
__device__ __forceinline__ void store_u(bf16* urow, int lane, const f32x4 (&v)[8], float rstd, const float* g, const float* sh, const float* sc) {
#pragma unroll
    for (int j = 0; j < 8; ++j) { const int ci = 256 * j + 4 * lane; const f32x4 g4 = *(const f32x4*)(g + ci), s4 = *(const f32x4*)(sc + ci), h4 = *(const f32x4*)(sh + ci);
        const f32x4 t = (v[j] * rstd * g4) * (1.0f + s4) + h4; v2u w; w.x = pk2(t[0], t[1]); w.y = pk2(t[2], t[3]); *(v2u*)(urow + ci) = w; }
}
__device__ __forceinline__ void pass_pre(const float* hlat, const float* hctx, const float* g, const float* mod, int sh_off, int sc_off, bf16* U, int nrows, int gw, int NGW, int lane) {
    for (int m0 = gw; m0 < nrows; m0 += 2 * NGW) {
        int mr[2]; mr[0] = m0; mr[1] = m0 + NGW; const bool two = mr[1] < nrows; if (!two) mr[1] = m0;
        f32x4 v[2][8]; float ss[2];
#pragma unroll
        for (int r = 0; r < 2; ++r) { const int m = mr[r]; const float* src = m < MLAT ? hlat + (size_t)m * DM : hctx + (size_t)(m - MLAT) * DM;
#pragma unroll
            for (int j = 0; j < 8; ++j) v[r][j] = *(const f32x4*)(src + 256 * j + 4 * lane); }
#pragma unroll
        for (int r = 0; r < 2; ++r) { ss[r] = 0.f;
#pragma unroll
            for (int j = 0; j < 8; ++j) ss[r] += (v[r][j][0] * v[r][j][0] + v[r][j][1] * v[r][j][1]) + (v[r][j][2] * v[r][j][2] + v[r][j][3] * v[r][j][3]); }
#pragma unroll
        for (int r = 0; r < 2; ++r) { if (r == 1 && !two) break; const int m = mr[r]; const float* mv = mod + (m < MLAT ? (m >> 13) : 2) * 12288;
            const float rstd = rsqrtf(wave_sum(ss[r], lane) * (1.0f / DM) + EPS);
            store_u(U + (size_t)m * DM, lane, v[r], rstd, g, mv + sh_off, mv + sc_off); }
    }
}
__device__ __forceinline__ void pass_post(const bf16* o16, const float* opart, const float* hlat, const float* hctx, float* olat, float* octx, const float* gpost, const float* mod, int gt_off,
                                          const float* gpre, const float* modu, int sh_off, int sc_off, bf16* U, int nrows, int gw, int NGW, int lane) {
    for (int m0 = gw; m0 < nrows; m0 += 2 * NGW) {
        int mr[2]; mr[0] = m0; mr[1] = m0 + NGW; const bool two = mr[1] < nrows; if (!two) mr[1] = m0;
        f32x4 v[2][8], hh[2][8]; float ss[2];
#pragma unroll
        for (int r = 0; r < 2; ++r) { const int m = mr[r]; ss[r] = 0.f;
            const float* hs = m < MLAT ? hlat + (size_t)m * DM : hctx + (size_t)(m - MLAT) * DM;
            if (m < MLAT) { const bf16* orow = o16 + (size_t)m * DM;
#pragma unroll
                for (int j = 0; j < 8; ++j) { const v2u raw = *(const v2u*)(orow + 256 * j + 4 * lane);
                    v[r][j] = (f32x4){__uint_as_float(raw.x << 16), __uint_as_float(raw.x & 0xffff0000u), __uint_as_float(raw.y << 16), __uint_as_float(raw.y & 0xffff0000u)}; }
            } else { const float* orow = opart + (size_t)(m - MLAT) * DM;
#pragma unroll
                for (int j = 0; j < 8; ++j) { const int ci = 256 * j + 4 * lane;
                    v[r][j] = (*(const f32x4*)(orow + ci) + *(const f32x4*)(orow + ci + (size_t)512 * DM)) + (*(const f32x4*)(orow + ci + (size_t)1024 * DM) + *(const f32x4*)(orow + ci + (size_t)1536 * DM)); } }
#pragma unroll
            for (int j = 0; j < 8; ++j) hh[r][j] = *(const f32x4*)(hs + 256 * j + 4 * lane);
        }
#pragma unroll
        for (int r = 0; r < 2; ++r)
#pragma unroll
            for (int j = 0; j < 8; ++j) ss[r] += (v[r][j][0] * v[r][j][0] + v[r][j][1] * v[r][j][1]) + (v[r][j][2] * v[r][j][2] + v[r][j][3] * v[r][j][3]);
#pragma unroll
        for (int r = 0; r < 2; ++r) { const int m = mr[r]; if (r == 1 && !two) break;
            float* hd = m < MLAT ? olat + (size_t)m * DM : octx + (size_t)(m - MLAT) * DM; const int vi = (m < MLAT ? (m >> 13) : 2); const float* mv = mod + vi * 12288;
            const float rstd = rsqrtf(wave_sum(ss[r], lane) * (1.0f / DM) + EPS); float s2 = 0.f;
#pragma unroll
            for (int j = 0; j < 8; ++j) { const int ci = 256 * j + 4 * lane; const f32x4 g4 = *(const f32x4*)(gpost + ci), t4 = *(const f32x4*)(mv + gt_off + ci);
                const f32x4 nv = hh[r][j] + t4 * (v[r][j] * rstd * g4); v[r][j] = nv; *(f32x4*)(hd + ci) = nv; s2 += (nv[0] * nv[0] + nv[1] * nv[1]) + (nv[2] * nv[2] + nv[3] * nv[3]); }
            if (U) { const float* mu = modu + vi * 12288; const float rstd2 = rsqrtf(wave_sum(s2, lane) * (1.0f / DM) + EPS); store_u(U + (size_t)m * DM, lane, v[r], rstd2, gpre, mu + sh_off, mu + sc_off); }
        }
    }
}
__device__ __forceinline__ void rope_cs(float pos, int j, float inv_nf, float& cs, float& sn) {
    const float inv_freq = __builtin_amdgcn_exp2f(-(float)j * inv_nf * 13.287712379549449f);
    float rev = pos * inv_freq * 0.15915494309189535f; rev -= rintf(rev);
    sn = __builtin_amdgcn_sinf(rev); cs = __builtin_amdgcn_cosf(rev);
}
template <int NH> __device__ __forceinline__ void heads_load(const bf16* base, int ia, float (&x)[NH], float (&y)[NH]) {
#pragma unroll
    for (int h = 0; h < NH; ++h) { x[h] = bf2f(base[h * 128 + ia]); y[h] = bf2f(base[h * 128 + ia + 32]); }
}
template <int NH> __device__ __forceinline__ void heads_finish(bf16* base, int ia, float (&x)[NH], float (&y)[NH], const float* gain, bool rope, float cs, float sn, int lane) {
    const float ga = gain[ia], gb = gain[ia + 32];
#pragma unroll
    for (int h = 0; h < NH; ++h) {
        const float rstd = rsqrtf(wave_sum(x[h] * x[h] + y[h] * y[h], lane) * (1.0f / 128.0f) + EPS);
        float a = x[h] * rstd * ga, b = y[h] * rstd * gb;
        if (rope) { const float na = a * cs - b * sn, nb = b * cs + a * sn; a = na; b = nb; }
        base[h * 128 + ia] = (bf16)f2bf(a); base[h * 128 + ia + 32] = (bf16)f2bf(b); }
}
__device__ __forceinline__ void unpack8(const v4u raw, float (&x)[8]) {
#pragma unroll
    for (int i = 0; i < 4; ++i) { x[2 * i] = __uint_as_float(raw[i] << 16); x[2 * i + 1] = __uint_as_float(raw[i] & 0xffff0000u); }
}
__device__ __forceinline__ void norm512_finish(bf16* p, const float (&x)[8], const float* gain, int lane) {
    float ss = 0.f;
#pragma unroll
    for (int i = 0; i < 8; ++i) ss += x[i] * x[i];
    const float rstd = rsqrtf(wave_sum(ss, lane) * (1.0f / 512.0f) + EPS);
    const f32x4 g0 = *(const f32x4*)(gain + 8 * lane), g1 = *(const f32x4*)(gain + 8 * lane + 4);
    v4u w; w.x = pk2(x[0] * rstd * g0[0], x[1] * rstd * g0[1]); w.y = pk2(x[2] * rstd * g0[2], x[3] * rstd * g0[3]); w.z = pk2(x[4] * rstd * g1[0], x[5] * rstd * g1[1]); w.w = pk2(x[6] * rstd * g1[2], x[7] * rstd * g1[3]);
    *(v4u*)(p + 8 * lane) = w;
}
__device__ __forceinline__ void rope64(bf16* p, float prow, float pcol, int l32) {
    const int j = l32 & 15, s = (l32 >> 4) & 1, ia = 32 * s + j, ib = ia + 16;
    const float x = bf2f(p[ia]), y = bf2f(p[ib]); float cs, sn; rope_cs(s ? pcol : prow, j, 1.0f / 16.0f, cs, sn);
    p[ia] = (bf16)f2bf(x * cs - y * sn); p[ib] = (bf16)f2bf(y * cs + x * sn);
}
__device__ __forceinline__ void prep_ab(bf16* P, const float* aqn, const float* akn, const float* bqn, const float* bkvn, int gw, int NGW, int lane) {
    const int ia = 64 * (lane >> 5) + (lane & 31);
    for (int m = gw; m < MALL; m += NGW) {
        bf16* row = P + (size_t)m * N_IN0; const bool lat = m < MLAT; const int t = m & (SEQ - 1); const float pr = (float)(t >> 6), pc = (float)(t & 63);
        float xk[2], yk[2], c1[8], c2[8];
        heads_load<2>(row + 1024, ia, xk, yk);
        unpack8(*(const v4u*)(row + 1536 + 8 * lane), c1); unpack8(*(const v4u*)(row + 2048 + 8 * lane), c2);
        if (lat && lane < 32) rope64(row + 2560, pr, pc, lane);
        float cs = 1.f, sn = 0.f; if (lat) rope_cs((lane >> 5) ? pc : pr, lane & 31, 1.0f / 32.0f, cs, sn);
        heads_finish<2>(row + 1024, ia, xk, yk, akn, lat, cs, sn, lane);
        norm512_finish(row + 1536, c1, bqn, lane); norm512_finish(row + 2048, c2, bkvn, lane);
    }
}
__device__ __forceinline__ void prep_qb(bf16* QB, int gw, int NGW, int lane) {
    for (int m = gw; m < MLAT; m += NGW) {
        bf16* row = QB + (size_t)m * N_UQ; const int t = m & (SEQ - 1); const float pr = (float)(t >> 6), pc = (float)(t & 63);
#pragma unroll
        for (int i = 0; i < 4; ++i) rope64(row + (2 * i + (lane >> 5)) * 192 + 128, pr, pc, lane & 31);
    }
}
__device__ __forceinline__ void prep_cd(bf16* P, const float* cqn, const float* ckn, const float* dqn, const float* dkn, int gw, int NGW, int lane) {
    const int ia = 64 * (lane >> 5) + (lane & 31);
    for (int m = gw; m < MALL; m += NGW) {
        bf16* row = P + (size_t)m * N_IN1; const bool lat = m < MLAT; const int t = m & (SEQ - 1); const float pr = (float)(t >> 6), pc = (float)(t & 63);
        float cs = 1.f, sn = 0.f; if (lat) rope_cs((lane >> 5) ? pc : pr, lane & 31, 1.0f / 32.0f, cs, sn);
        float xk[2], yk[2], xd[8], yd[8];
        heads_load<2>(row + 1024, ia, xk, yk); heads_load<8>(row + 2560, ia, xd, yd);
        heads_finish<2>(row + 1024, ia, xk, yk, ckn, lat, cs, sn, lane); heads_finish<8>(row + 2560, ia, xd, yd, dkn, false, 1.f, 0.f, lane);
    }
}
constexpr float LOG2E = 1.4426950408889634f;
__device__ __forceinline__ void attn_phase_ab(const bf16* P0, const bf16* QB, const bf16* KVB, bf16* OB, const float* aqn, char* lds, const int wave0) {
    const int c = blockIdx.x, G = gridDim.x;
    for (int id = c; id < 1024 + 32; id += G) {
        att::Args a{};
        int mixer, b, h, qrow0, NT;
        if (id < 1024) { const int rnd = id >> 8, cc = id & 255; mixer = rnd >> 1; b = rnd & 1; h = cc & 7; qrow0 = b * SEQ + (cc >> 3) * 256; NT = 132; }
        else { const int cc = id - 1024; mixer = cc >> 4; b = (cc >> 3) & 1; h = cc & 7; qrow0 = MLAT + b * NCTX; NT = 4; }
        a.NT = NT; a.nctx = 4; a.ctx_row0 = MLAT + b * NCTX; a.lat_row0 = b * SEQ; a.ldo = DM; a.qrope_t0 = (id < 1024) ? (qrow0 - b * SEQ) : -1;
        if (mixer == 0) {
            a.Q = P0 + (size_t)qrow0 * N_IN0 + h * 128; a.ldq = N_IN0; a.K = P0 + 1024 + (h >> 2) * 128; a.ldk = N_IN0; a.K2 = nullptr; a.ldk2 = 0; a.V = P0 + 1280 + (h >> 2) * 128; a.ldv = N_IN0;
            a.O = OB + (size_t)qrow0 * DM + h * 128; const float scale = 0.08838834764831845f; a.C = scale * LOG2E; a.thr_raw = 8.0f / scale; a.qgain = aqn;

#ifndef DIS_A
            att::attn_unit<128, 0>(a, lds, wave0);
#endif

        } else {
            a.Q = QB + (size_t)qrow0 * N_UQ + h * 192; a.ldq = N_UQ; a.K = KVB + h * 256; a.ldk = N_UKV; a.K2 = P0 + 2560; a.ldk2 = N_IN0; a.V = KVB + h * 256 + 128; a.ldv = N_UKV;
            a.O = OB + (size_t)qrow0 * DM + 1024 + h * 128; const float scale = 0.07216878364870322f; a.C = scale * LOG2E; a.thr_raw = 8.0f / scale;

#ifndef DIS_B
            att::attn_unit<192, 0>(a, lds, wave0);
#endif

        }
    }
}
__device__ __forceinline__ void attn_phase_cd(const bf16* P1, bf16* OB, const float* sink, const float* rpb, const float* cqn, const float* dqn, char* lds, const int wave0) {
    const int c = blockIdx.x, G = gridDim.x;
    for (int id = c; id < 1024; id += G) {
        att::Args a{};
        const int rnd = id >> 8, cc = id & 255, mixer = rnd >> 1, b = rnd & 1, h = cc & 7, qb = cc >> 3, qrow0 = b * SEQ + qb * 256;
        a.nctx = 4; a.ctx_row0 = MLAT + b * NCTX; a.ldo = DM; a.ldq = a.ldk = a.ldv = N_IN1; a.K2 = nullptr; a.ldk2 = 0;
        const float scale = 0.08838834764831845f; a.C = scale * LOG2E; a.thr_raw = 8.0f / scale; a.inv_scale = 1.0f / scale;
        if (mixer == 0) {
            const int kbase = min(max(qb * 256 - 128, 0), SEQ - 512);
            a.NT = 12; a.lat_row0 = b * SEQ + kbase; a.qpos0 = qb * 256; a.kpos0 = kbase; a.sink_l2 = __uint_as_float((unsigned)__builtin_amdgcn_readfirstlane((int)__float_as_uint(sink[h]))) * LOG2E;
            a.qgain = cqn; a.qrope_t0 = qb * 256; a.Q = P1 + (size_t)qrow0 * N_IN1 + h * 128; a.K = P1 + 1024 + (h >> 2) * 128; a.V = P1 + 1280 + (h >> 2) * 128; a.O = OB + (size_t)qrow0 * DM + h * 128;

#ifndef DIS_C
            att::attn_unit<128, 1>(a, lds, wave0);
#endif

        } else {
            const int r0 = qb * 4, klo = min(max(r0 - 4, 0), 116);
            a.NT = 16; a.lat_row0 = b * SEQ + klo * 64; a.r0 = r0; a.klo = klo; a.rpb = rpb + h * (15 * 31);
            a.qgain = dqn; a.qrope_t0 = -1; a.Q = P1 + (size_t)qrow0 * N_IN1 + 1536 + h * 128; a.K = P1 + 2560 + h * 128; a.V = P1 + 3584 + h * 128; a.O = OB + (size_t)qrow0 * DM + 1024 + h * 128;

#ifndef DIS_D
            att::attn_unit<128, 2>(a, lds, wave0);
#endif

        }
    }
}

__global__ void __launch_bounds__(NTHR, 2) fwd_megakernel(KArgs args) {
    extern __shared__ __attribute__((aligned(16))) unsigned char lds[];
    cg::grid_group grid = cg::this_grid();
    LAS unsigned char* ldsl = (LAS unsigned char*)lds;
    const int wave0 = __builtin_amdgcn_readfirstlane(threadIdx.x >> 6);
    const int G = gridDim.x, NGW = G * NWAVES;
#define PHASE_IDS() const int tid = fresh_tid(wave0); const int lane = tid & 63, wave = __builtin_amdgcn_readfirstlane(tid >> 6), gw = blockIdx.x * NWAVES + wave; (void)wave; (void)gw; (void)lane
#define WSB (kargs()->ws)
#define x_ (kargs()->in[0])
#define ctx_ (kargs()->in[2])
#define out_ (kargs()->out)
#define hctx_ ((float*)(WSB + WS_HCTX))
#define MOD_ ((const float*)(WSB + WS_MOD))
#define UA_ ((bf16*)(WSB + WS_UO))
#define OB_ ((bf16*)(WSB + WS_OB))
#define FB_ ((bf16*)(WSB + WS_UO))
#define FP_ ((float*)(WSB + WS_UO + 64 * MiB))
#define OFB_ ((bf16*)(WSB + WS_BIG))
#define OFP_ ((float*)(WSB + WS_BIG + 128 * MiB))
#define PB_ ((bf16*)(WSB + WS_BIG))
#define OF_ ((float*)(WSB + WS_BIG))
#define ACT_ ((bf16*)(WSB + WS_BIG))
#define QB_ ((bf16*)(WSB + WS_QB))
#define KVB_ ((bf16*)(WSB + WS_KVB))
#define UB_ ((bf16*)(WSB + WS_UB))
#ifndef PROBE_G
#define PROBE_G 1
#endif
#ifndef PROBE_A
#define PROBE_A 1
#endif
#ifndef PROBE_S
#define PROBE_S 1
#endif
#define GSYNC() do { for (int s_ = 0; s_ < PROBE_S; ++s_) { xcd_barrier(bar); } } while (0)
    volatile LAS unsigned* MISC = (volatile LAS unsigned*)(ldsl + 131072 + 64);
    if (threadIdx.x < 2) MISC[threadIdx.x] = 0u;
    __syncthreads();
    grid.sync();
    XcdBarrier bar = xcd_barrier_post((unsigned*)(kargs()->ws + WS_BAR), MISC);

    for (int rep_ = 0; rep_ < PROBE_S; ++rep_) {
    { PHASE_IDS(); p0_mod(kargs(), ldsl, tid); }
    { PHASE_IDS(); p0_weights(kargs(), ldsl, gw, NGW, wave, lane); }
    }
    GSYNC();
    { PHASE_IDS(); pass_pre(x_, ctx_, kargs()->in[6], MOD_, 0, DM, UA_, MALL, gw, NGW, lane); }
    GSYNC();
    for (int L = 0; L < 2; ++L) {

        const int Mrows = L == 0 ? MALL : MLAT;
        { pg8::Gemm g = pg8::mk_gemm(L == 0 ? UA_ : UB_, (const bf16*)(WSB + (L == 0 ? WS_WIN0 : WS_WIN1)), MALL, L == 0 ? N_IN0 : N_IN1, DM, DM);
          pg8::StaticOrder S; S.init(g.M, g.N, G, (int)blockIdx.x); pg8::EpiBf16 E{PB_, g.N};
          for (int rep_ = 0; rep_ < PROBE_G; ++rep_) pg8::gemm_phase<pg8::EpiBf16, pg8::StaticOrder, true, true>(ldsl, g, S, E, wave0); }
        GSYNC();
        if (L == 0) {
            { PHASE_IDS(); prep_ab(PB_, kargs()->in[15], kargs()->in[16], kargs()->in[17], kargs()->in[18], gw, NGW, lane); }
            GSYNC();
            for (int q = 0; q < 2; ++q) {
                pg8::Gemm g = pg8::mk_gemm(PB_ + (q == 0 ? 1536 : 2048), (const bf16*)(WSB + (q == 0 ? WS_WUQ : WS_WUKV)), MALL, q == 0 ? N_UQ : N_UKV, 512, N_IN0);
                pg8::StaticOrder S; S.init(g.M, g.N, G, (int)blockIdx.x); pg8::EpiBf16 E{q == 0 ? QB_ : KVB_, g.N};
                for (int rep_ = 0; rep_ < PROBE_G; ++rep_) pg8::gemm_phase<pg8::EpiBf16, pg8::StaticOrder, true, true>(ldsl, g, S, E, wave0);
            }
            GSYNC();
            for (int rep_ = 0; rep_ < PROBE_A; ++rep_) attn_phase_ab(PB_, QB_, KVB_, OB_, kargs()->in[15], (char*)lds, wave0);
        } else {
            { PHASE_IDS(); prep_cd(PB_, kargs()->in[23], kargs()->in[24], kargs()->in[26], kargs()->in[27], gw, NGW, lane); }
            GSYNC();
            for (int rep_ = 0; rep_ < PROBE_A; ++rep_) attn_phase_cd(PB_, OB_, kargs()->in[25], kargs()->in[28], kargs()->in[23], kargs()->in[26], (char*)lds, wave0);
        }
        GSYNC();
        { pg8::Gemm g = pg8::mk_gemm(OB_, (const bf16*)(WSB + (L == 0 ? WS_WOUT0 : WS_WOUT1)), MLAT, DM, DM, DM);
          pg8::StaticOrder S; S.init(g.M, g.N, G, (int)blockIdx.x); pg8::EpiBf16 E{OFB_, DM};
          for (int rep_ = 0; rep_ < PROBE_G; ++rep_) pg8::gemm_phase<pg8::EpiBf16, pg8::StaticOrder, true, true>(ldsl, g, S, E, wave0); }
        if (L == 0) { pg8::Gemm g = pg8::mk_gemm(OB_ + (size_t)MLAT * DM, (const bf16*)(WSB + WS_WOUT0), 2 * NCTX, 4 * DM, DM / 4, DM); g.ldb = DM; g.nNr = DM / 256;
          pg8::StaticOrder S; S.init(g.M, g.N, G, (int)blockIdx.x); pg8::EpiF32Split E{OFP_, DM, DM / 256, (size_t)2 * NCTX * DM};
          for (int rep_ = 0; rep_ < PROBE_G; ++rep_) pg8::gemm_phase<pg8::EpiF32Split, pg8::StaticOrder, true, true>(ldsl, g, S, E, wave0); }
        GSYNC();
        { PHASE_IDS(); pass_post(OFB_, OFP_, L == 0 ? x_ : out_, L == 0 ? ctx_ : hctx_, out_, hctx_, kargs()->in[7] + L * DM, MOD_ + (size_t)L * 3 * 12288, 2 * DM, kargs()->in[8] + L * DM, MOD_ + (size_t)L * 3 * 12288, 3 * DM, 4 * DM, UA_, Mrows, gw, NGW, lane); }
        GSYNC();
        { pg8::Gemm g = pg8::mk_gemm(UA_, (const bf16*)(WSB + WS_WGU + (size_t)L * 44 * MiB), Mrows, N_GU, DM, DM);
          pg8::StaticOrder S; S.init(g.M, g.N, G, (int)blockIdx.x); pg8::EpiSwiglu E{ACT_, DFF};
          for (int rep_ = 0; rep_ < PROBE_G; ++rep_) pg8::gemm_phase<pg8::EpiSwiglu, pg8::StaticOrder, true, true>(ldsl, g, S, E, wave0); }
        GSYNC();
        { pg8::Gemm g = pg8::mk_gemm(ACT_, (const bf16*)(WSB + WS_WD + (size_t)L * 22 * MiB), MLAT, DM, DFF, DFF);
          pg8::StaticOrder S; S.init(g.M, g.N, G, (int)blockIdx.x); pg8::EpiBf16 E{FB_, DM};
          for (int rep_ = 0; rep_ < PROBE_G; ++rep_) pg8::gemm_phase<pg8::EpiBf16, pg8::StaticOrder, true, true>(ldsl, g, S, E, wave0); }
        if (L == 0) { pg8::Gemm g = pg8::mk_gemm(ACT_ + (size_t)MLAT * DFF, (const bf16*)(WSB + WS_WD), 2 * NCTX, 4 * DM, DFF / 4, DFF); g.ldb = DFF; g.nNr = DM / 256;
          pg8::StaticOrder S; S.init(g.M, g.N, G, (int)blockIdx.x); pg8::EpiF32Split E{FP_, DM, DM / 256, (size_t)2 * NCTX * DM};
          for (int rep_ = 0; rep_ < PROBE_G; ++rep_) pg8::gemm_phase<pg8::EpiF32Split, pg8::StaticOrder, true, true>(ldsl, g, S, E, wave0); }
        GSYNC();
        { PHASE_IDS(); pass_post(FB_, FP_, out_, hctx_, out_, hctx_, kargs()->in[9] + L * DM, MOD_ + (size_t)L * 3 * 12288, 5 * DM, kargs()->in[6] + DM, MOD_ + (size_t)3 * 12288, 0, DM, L == 0 ? UB_ : nullptr, Mrows, gw, NGW, lane); }
        if (L == 0) GSYNC();
    }
#undef GSYNC
}

constexpr int LDS_BYTES = 131072 + 1024;
extern "C" void kernel_launch(void* const* d_in, const int* in_sizes, int n_in, void* d_out, int out_size, void* d_ws, size_t ws_size, hipStream_t stream) {
    static int grid = 0;
    if (grid == 0) {
        if (n_in != 29 || out_size != MLAT * DM || ws_size < WS_END) { fprintf(stderr, "kernel_launch: unexpected shapes: n_in %d out %d ws %zu (need %zu)\n", n_in, out_size, ws_size, (size_t)WS_END); grid = -1; return; }
        int dev = 0, cus = 0, per_cu = 0;
        hipGetDevice(&dev); hipDeviceGetAttribute(&cus, hipDeviceAttributeMultiprocessorCount, dev);
        if (hipFuncSetAttribute((const void*)fwd_megakernel, hipFuncAttributeMaxDynamicSharedMemorySize, LDS_BYTES) != hipSuccess) { fprintf(stderr, "kernel_launch: hipFuncSetAttribute failed\n"); grid = -1; return; }
        if (hipOccupancyMaxActiveBlocksPerMultiprocessor(&per_cu, (const void*)fwd_megakernel, NTHR, LDS_BYTES) != hipSuccess || per_cu < 1) { fprintf(stderr, "kernel_launch: occupancy query says %d\n", per_cu); per_cu = 1; }
        (void)hipGetLastError();
        grid = cus;
        fprintf(stderr, "kernel_launch: grid %d (per_cu %d)\n", grid, per_cu);
    }
    if (grid < 0) return;
    if (hipMemsetAsync((char*)d_ws + WS_BAR, 0, BAR_BYTES, stream) != hipSuccess) { fprintf(stderr, "kernel_launch: hipMemsetAsync failed\n"); return; }
    KArgs a{};
    for (int i = 0; i < 29; ++i) a.in[i] = (const float*)d_in[i];
    a.out = (float*)d_out; a.ws = (unsigned char*)d_ws;
    void* params[] = {&a};
    const hipError_t e = hipLaunchCooperativeKernel((const void*)fwd_megakernel, dim3(grid), dim3(NTHR), params, LDS_BYTES, stream);
    if (e != hipSuccess) fprintf(stderr, "kernel_launch: cooperative launch failed: %s (grid %d)\n", hipGetErrorString(e), grid);
}
```

```cpp
#include <hip/hip_runtime.h>
#include <hip/hip_cooperative_groups.h>
#include <cstdio>
#include <cstdint>
namespace cg = cooperative_groups;
__device__ __forceinline__ int fresh_tid(int wave0) { int l; asm volatile("v_mbcnt_lo_u32_b32 %0, -1, 0\n\tv_mbcnt_hi_u32_b32 %0, -1, %0" : "=v"(l)); return wave0 * 64 + l; }
namespace pg8 {
#define PG8_LAS __attribute__((address_space(3)))
typedef unsigned short bf16_t;
typedef short bf16x8 __attribute__((ext_vector_type(8)));
typedef float f32x4 __attribute__((ext_vector_type(4)));
typedef unsigned u32x4 __attribute__((ext_vector_type(4)));
constexpr int BM = 256, BK = 64, HALF = 128, HTB = HALF * BK * 2  , STAGE_BYTES = 8 * HTB, NXCD = 8, WGM = 8;

__host__ __device__ __forceinline__ int lds_byte(int r, int c) { const int st = (r >> 4) * 2 + (c >> 5), rr = r & 15, cc = c & 31, ob = rr * 64 + cc * 2; return st * 1024 + (ob ^ (((ob >> 9) & 1) << 5)); }
__host__ __device__ __forceinline__ void stage_rc(int b, int& R, int& C) { const int st = b / 1024, sb = b % 1024, swz = sb ^ (((sb >> 9) & 1) << 5); R = (st >> 1) * 16 + swz / 64; C = (st & 1) * 32 + (swz % 64) / 2; }
__host__ __device__ __forceinline__ int perm32(int rho) { const int n = rho >> 4, i = rho & 15; return 8 * (i >> 2) + 4 * n + (i & 3); }

struct Unit { int pm, pn; };
struct Gemm { const bf16_t* A; const bf16_t* Bt; int M, N, K, lda, ldb, nNr; };
__host__ __device__ __forceinline__ Gemm mk_gemm(const bf16_t* A, const bf16_t* Bt, int M, int N, int K, int lda) { Gemm g; g.A = A; g.Bt = Bt; g.M = M; g.N = N; g.K = K; g.lda = lda; g.ldb = K; g.nNr = N / BM; return g; }

struct StaticOrder {
    int nM, nN, nwg, G, c;
    __host__ __device__ void init(int M, int N, int G_, int c_) { nM = M / BM; nN = N / BM; nwg = nM * nN; G = G_; c = c_; }
    __host__ __device__ bool next(int i, Unit& u) const {
        const long L = (long)i * G + c; if (L >= nwg) return false;
        int wgid = (int)L; { const int q = nwg / NXCD, r = nwg % NXCD, xcd = wgid % NXCD, off = wgid / NXCD; wgid = (xcd < r ? xcd * (q + 1) : r * (q + 1) + (xcd - r) * q) + off; }
        const int nig = WGM * nN, gid = wgid / nig, fm = gid * WGM, gsz = (nM - fm) < WGM ? (nM - fm) : WGM;
        u.pm = fm + ((wgid % nig) % gsz); u.pn = (wgid % nig) / gsz; return true;
    }
    __device__ __forceinline__ void a_ready(const Unit&) const {}
    __device__ __forceinline__ void done(const Unit&) const {}
};


__device__ __forceinline__ unsigned cvt_pk_bf16(float lo, float hi) { unsigned r; asm volatile("v_cvt_pk_bf16_f32 %0, %1, %2" : "=v"(r) : "v"(lo), "v"(hi)); return r; }
struct EpiBf16 {
    static constexpr bool PERM = true, AFTER_DRAIN = false;
    bf16_t* O; int ldc;
    __device__ __forceinline__ void operator()(const f32x4 (&acc)[2][2][4][2], const Unit& u, int wr, int wc, int fr, int fq) const {
        const int row0 = u.pm * BM + wr * 64 + fr, col0 = u.pn * BM + wc * 32 + 8 * fq;
#pragma unroll
        for (int ai = 0; ai < 2; ++ai)
#pragma unroll
            for (int m = 0; m < 4; ++m) { bf16_t* rowp = O + (size_t)(row0 + ai * HALF + m * 16) * ldc + col0;
#pragma unroll
                for (int bj = 0; bj < 2; ++bj) { const f32x4 v0 = acc[ai][bj][m][0], v1 = acc[ai][bj][m][1];
                    u32x4 w; w.x = cvt_pk_bf16(v0[0], v0[1]); w.y = cvt_pk_bf16(v0[2], v0[3]); w.z = cvt_pk_bf16(v1[0], v1[1]); w.w = cvt_pk_bf16(v1[2], v1[3]);
                    *(u32x4*)(rowp + bj * HALF) = w; } }
    }
};
struct EpiF32 {
    static constexpr bool PERM = false, AFTER_DRAIN = false;
    float* O; int ldc;
    __device__ __forceinline__ void operator()(const f32x4 (&acc)[2][2][4][2], const Unit& u, int wr, int wc, int fr, int fq) const {
        const int row0 = u.pm * BM + wr * 64 + fr, col0 = u.pn * BM + wc * 32 + 4 * fq;
#pragma unroll
        for (int ai = 0; ai < 2; ++ai)
#pragma unroll
            for (int m = 0; m < 4; ++m) { float* rowp = O + (size_t)(row0 + ai * HALF + m * 16) * ldc + col0;
#pragma unroll
                for (int bj = 0; bj < 2; ++bj)
#pragma unroll
                    for (int n = 0; n < 2; ++n) *(f32x4*)(rowp + bj * HALF + n * 16) = acc[ai][bj][m][n]; }
    }
};
struct EpiF32Split {
    static constexpr bool PERM = false, AFTER_DRAIN = false;
    float* O; int ldc; int nNr; size_t sstride;
    __device__ __forceinline__ void operator()(const f32x4 (&acc)[2][2][4][2], const Unit& u, int wr, int wc, int fr, int fq) const {
        const int s = u.pn / nNr, pn = u.pn - s * nNr;
        const int row0 = u.pm * BM + wr * 64 + fr, col0 = pn * BM + wc * 32 + 4 * fq; float* Ob = O + (size_t)s * sstride;
#pragma unroll
        for (int ai = 0; ai < 2; ++ai)
#pragma unroll
            for (int m = 0; m < 4; ++m) { float* rowp = Ob + (size_t)(row0 + ai * HALF + m * 16) * ldc + col0;
#pragma unroll
                for (int bj = 0; bj < 2; ++bj)
#pragma unroll
                    for (int n = 0; n < 2; ++n) *(f32x4*)(rowp + bj * HALF + n * 16) = acc[ai][bj][m][n]; }
    }
};
__device__ __forceinline__ float silu_mul(float g, float u) { return g * __builtin_amdgcn_rcpf(1.0f + __builtin_amdgcn_exp2f(-1.4426950408889634f * g)) * u; }
struct EpiSwiglu {
    static constexpr bool PERM = true, AFTER_DRAIN = false;
    bf16_t* O; int ldc;
    __device__ __forceinline__ void operator()(const f32x4 (&acc)[2][2][4][2], const Unit& u, int wr, int wc, int fr, int fq) const {
        const int row0 = u.pm * BM + wr * 64 + fr, col0 = u.pn * HALF + wc * 32 + 8 * fq;
#pragma unroll
        for (int ai = 0; ai < 2; ++ai)
#pragma unroll
            for (int m = 0; m < 4; ++m) { bf16_t* rowp = O + (size_t)(row0 + ai * HALF + m * 16) * ldc + col0;
                const f32x4 g0 = acc[ai][0][m][0], g1 = acc[ai][0][m][1], u0 = acc[ai][1][m][0], u1 = acc[ai][1][m][1];
                u32x4 w; w.x = cvt_pk_bf16(silu_mul(g0[0], u0[0]), silu_mul(g0[1], u0[1])); w.y = cvt_pk_bf16(silu_mul(g0[2], u0[2]), silu_mul(g0[3], u0[3]));
                w.z = cvt_pk_bf16(silu_mul(g1[0], u1[0]), silu_mul(g1[1], u1[1])); w.w = cvt_pk_bf16(silu_mul(g1[2], u1[2]), silu_mul(g1[3], u1[3]));
                *(u32x4*)rowp = w; }
    }
};

template <class Epi, class Sched, bool ALIGN_EPI = false, bool SP2 = false>
__device__ __forceinline__ void gemm_phase(PG8_LAS unsigned char* lds, const Gemm g, const Sched& S, const Epi& E, const int wave0) {
    const int tid = fresh_tid(wave0), wid = __builtin_amdgcn_readfirstlane(tid >> 6), lane = tid & 63, wr = wid >> 2, wc = wid & 3, fr = lane & 15, fq = lane >> 4;
    const int K = g.K, nt = K / BK;
    unsigned voffA[2], voffB[2];
#pragma unroll
    for (int i = 0; i < 2; ++i) { int R, C; stage_rc(tid * 16 + i * 8192, R, C); const int Rb = Epi::PERM ? ((R & ~31) + perm32(R & 31)) : R;
        voffA[i] = (unsigned)(R * g.lda + C) * 2u; voffB[i] = (unsigned)(Rb * g.ldb + C) * 2u; }
    const size_t kstep = (size_t)(BK * 2);
    const size_t hstepA = (size_t)HALF * g.lda * 2, hstepB = (size_t)HALF * g.ldb * 2; const size_t ksb = (size_t)K * 2;
#define PG8_APTR(u) ((const char*)g.A + (size_t)(u).pm * tstepA + (size_t)((u).pn / g.nNr) * ksb)
#define PG8_BPTR(u) ((const char*)g.Bt + (size_t)((u).pn % g.nNr) * tstepB + (size_t)((u).pn / g.nNr) * ksb)
    const size_t tstepA = 2 * hstepA, tstepB = 2 * hstepB;
    const unsigned ldsw = (unsigned)wid * 1024u;
    const int aoff = lds_byte(wr * 64 + fr, fq * 8), boff = lds_byte(wc * 32 + fr, fq * 8);
#define PG8_SA(b, h) (((b) * 2 + (h)) * HTB)
#define PG8_SB(b, h) ((4 + (b) * 2 + (h)) * HTB)
#define PG8_STAGE(bufoff, gbase, voff) do { _Pragma("unroll") for (int _i = 0; _i < 2; ++_i) \
        __builtin_amdgcn_global_load_lds((const unsigned*)((const char*)(gbase) + (voff)[_i]), (PG8_LAS unsigned*)(lds + (bufoff) + ldsw + _i * 8192), 16, 0, 0); } while (0)
#define PG8_LDA(dst, b, h) do { _Pragma("unroll") for (int m = 0; m < 4; ++m) _Pragma("unroll") for (int k = 0; k < 2; ++k) dst[m][k] = *(const PG8_LAS bf16x8*)(lds + PG8_SA(b, h) + aoff + m * 2048 + k * 1024); } while (0)
#define PG8_LDB(dst, b, h) do { _Pragma("unroll") for (int n = 0; n < 2; ++n) _Pragma("unroll") for (int k = 0; k < 2; ++k) dst[n][k] = *(const PG8_LAS bf16x8*)(lds + PG8_SB(b, h) + boff + n * 2048 + k * 1024); } while (0)
#define PG8_MMA(ai, bj, At, Bt) do { __builtin_amdgcn_s_setprio(1); _Pragma("unroll") for (int m = 0; m < 4; ++m) _Pragma("unroll") for (int n = 0; n < 2; ++n) _Pragma("unroll") for (int k = 0; k < 2; ++k) \
        acc[ai][bj][m][n] = __builtin_amdgcn_mfma_f32_16x16x32_bf16(Bt[n][k], At[m][k], acc[ai][bj][m][n], 0, 0, 0); __builtin_amdgcn_s_setprio(0); } while (0)
#define PG8_WAIT_V(n) asm volatile("s_waitcnt vmcnt(" #n ")" ::: "memory")
#define PG8_WAIT_L(n) asm volatile("s_waitcnt lgkmcnt(" #n ")" ::: "memory")
#define PG8_BAR __builtin_amdgcn_s_barrier()
#define PG8_SCHED __builtin_amdgcn_sched_barrier(0)
    Unit cur, nxt; int ui = 0;
    if (!S.next(0, cur)) return;
    f32x4 acc[2][2][4][2];
#pragma unroll
    for (int a = 0; a < 2; ++a)
#pragma unroll
        for (int b = 0; b < 2; ++b)
#pragma unroll
            for (int m = 0; m < 4; ++m)
#pragma unroll
                for (int n = 0; n < 2; ++n) acc[a][b][m][n] = (f32x4){0.f, 0.f, 0.f, 0.f};
    bf16x8 At[4][2], B0[2][2], B1[2][2];
    const char* cA = PG8_APTR(cur); const char* cB = PG8_BPTR(cur);
    S.a_ready(cur);
    if constexpr (SP2) {
        PG8_STAGE(PG8_SB(0, 0), cB, voffB); PG8_STAGE(PG8_SB(0, 1), cB + hstepB, voffB); PG8_STAGE(PG8_SA(0, 0), cA, voffA); PG8_STAGE(PG8_SA(0, 1), cA + hstepA, voffA);
        if (wr == 1) PG8_BAR;
        PG8_WAIT_V(2); PG8_BAR;
        PG8_STAGE(PG8_SB(1, 0), cB + kstep, voffB); PG8_STAGE(PG8_SA(1, 0), cA + kstep, voffA); PG8_STAGE(PG8_SB(1, 1), cB + hstepB + kstep, voffB);
        PG8_WAIT_V(6); PG8_BAR;
    } else {
        PG8_STAGE(PG8_SB(0, 0), cB, voffB); PG8_STAGE(PG8_SA(0, 0), cA, voffA); PG8_STAGE(PG8_SB(0, 1), cB + hstepB, voffB); PG8_STAGE(PG8_SA(0, 1), cA + hstepA, voffA);
        if (wr == 1) PG8_BAR;
        PG8_WAIT_V(4); PG8_BAR;
        PG8_STAGE(PG8_SB(1, 0), cB + kstep, voffB); PG8_STAGE(PG8_SA(1, 0), cA + kstep, voffA); PG8_STAGE(PG8_SB(1, 1), cB + hstepB + kstep, voffB);
        PG8_WAIT_V(6); PG8_BAR;
    }
    for (;;) {
        const bool has_next = S.next(ui + 1, nxt);
        const char* nA = has_next ? PG8_APTR(nxt) : cA; const char* nB = has_next ? PG8_BPTR(nxt) : cB;
        for (int t = 0; t < nt; t += 2) {
            const bool last = (t == nt - 2);
            const char* a1 = cA + (size_t)(t + 1) * kstep;
            const char* a2 = last ? nA : cA + (size_t)(t + 2) * kstep; const char* b2 = last ? nB : cB + (size_t)(t + 2) * kstep;
            const char* a3 = a2 + kstep; const char* b3 = b2 + kstep;
            if (last && has_next) S.a_ready(nxt);
            if constexpr (SP2) {
            PG8_LDB(B0, 0, 0); PG8_LDB(B1, 0, 1); PG8_SCHED; PG8_LDA(At, 0, 0); PG8_STAGE(PG8_SA(1, 1), a1 + hstepA, voffA);
            PG8_WAIT_V(8); PG8_WAIT_L(0); PG8_BAR; PG8_MMA(0, 0, At, B0); PG8_MMA(0, 1, At, B1); PG8_BAR; PG8_SCHED;
            PG8_LDA(At, 0, 1); PG8_STAGE(PG8_SB(0, 0), b2, voffB); PG8_STAGE(PG8_SB(0, 1), b2 + hstepB, voffB); PG8_STAGE(PG8_SA(0, 0), a2, voffA);
            PG8_WAIT_V(8); PG8_WAIT_L(0); PG8_BAR; PG8_MMA(1, 0, At, B0); PG8_MMA(1, 1, At, B1); PG8_BAR; PG8_SCHED;
            PG8_LDB(B0, 1, 0); PG8_LDB(B1, 1, 1); PG8_SCHED; PG8_LDA(At, 1, 0); PG8_STAGE(PG8_SA(0, 1), a2 + hstepA, voffA);
            PG8_WAIT_V(8); PG8_WAIT_L(0); PG8_BAR; PG8_MMA(0, 0, At, B0); PG8_MMA(0, 1, At, B1); PG8_BAR; PG8_SCHED;
            PG8_LDA(At, 1, 1); PG8_STAGE(PG8_SB(1, 0), b3, voffB); PG8_STAGE(PG8_SB(1, 1), b3 + hstepB, voffB); PG8_STAGE(PG8_SA(1, 0), a3, voffA);
            PG8_WAIT_V(8); PG8_WAIT_L(0); PG8_BAR; PG8_MMA(1, 0, At, B0); PG8_MMA(1, 1, At, B1); PG8_BAR; PG8_SCHED;
            } else {
            PG8_LDB(B0, 0, 0); PG8_SCHED; PG8_LDA(At, 0, 0); PG8_STAGE(PG8_SA(1, 1), a1 + hstepA, voffA);
            PG8_WAIT_L(8); PG8_BAR; PG8_WAIT_L(0); PG8_MMA(0, 0, At, B0); PG8_BAR; PG8_SCHED;
            PG8_LDB(B1, 0, 1); PG8_STAGE(PG8_SB(0, 0), b2, voffB);
            PG8_BAR; PG8_WAIT_L(0); PG8_MMA(0, 1, At, B1); PG8_BAR;
            PG8_LDA(At, 0, 1); PG8_STAGE(PG8_SA(0, 0), a2, voffA);
            PG8_BAR; PG8_WAIT_L(0); PG8_MMA(1, 0, At, B0); PG8_BAR; PG8_SCHED;
            PG8_STAGE(PG8_SB(0, 1), b2 + hstepB, voffB);
            PG8_WAIT_V(6); PG8_BAR; PG8_MMA(1, 1, At, B1); PG8_BAR;
            PG8_LDB(B0, 1, 0); PG8_SCHED; PG8_LDA(At, 1, 0); PG8_STAGE(PG8_SA(0, 1), a2 + hstepA, voffA);
            PG8_WAIT_L(8); PG8_BAR; PG8_WAIT_L(0); PG8_MMA(0, 0, At, B0); PG8_BAR; PG8_SCHED;
            PG8_LDB(B1, 1, 1); PG8_STAGE(PG8_SB(1, 0), b3, voffB);
            PG8_BAR; PG8_WAIT_L(0); PG8_MMA(0, 1, At, B1); PG8_BAR;
            PG8_LDA(At, 1, 1); PG8_STAGE(PG8_SA(1, 0), a3, voffA);
            PG8_BAR; PG8_WAIT_L(0); PG8_MMA(1, 0, At, B0); PG8_BAR; PG8_SCHED;
            PG8_STAGE(PG8_SB(1, 1), b3 + hstepB, voffB);
            PG8_WAIT_V(6); PG8_BAR; PG8_MMA(1, 1, At, B1); PG8_BAR;
            }
        }
        if constexpr (ALIGN_EPI) { if (wr == 0) PG8_BAR; }
        if constexpr (!Epi::AFTER_DRAIN) { E(acc, cur, wr, wc, fr, fq); S.done(cur); }
        if (!has_next) break;
#pragma unroll
        for (int a = 0; a < 2; ++a)
#pragma unroll
            for (int b = 0; b < 2; ++b)
#pragma unroll
                for (int m = 0; m < 4; ++m)
#pragma unroll
                    for (int n = 0; n < 2; ++n) acc[a][b][m][n] = (f32x4){0.f, 0.f, 0.f, 0.f};
        cur = nxt; cA = nA; cB = nB; ++ui;
        if constexpr (ALIGN_EPI) { if (wr == 1) PG8_BAR; }
    }
    PG8_WAIT_V(0);
    if constexpr (!ALIGN_EPI) { if (wr == 0) PG8_BAR; }
    PG8_BAR;
    if constexpr (Epi::AFTER_DRAIN) { E.fused(acc, cur, wr, wc, fr, fq, lds, wid, lane); S.done(cur); }
#undef PG8_APTR
#undef PG8_BPTR
#undef PG8_SA
#undef PG8_SB
#undef PG8_STAGE
#undef PG8_LDA
#undef PG8_LDB
#undef PG8_MMA
#undef PG8_WAIT_V
#undef PG8_WAIT_L
#undef PG8_BAR
#undef PG8_SCHED
}
}
namespace att {
typedef unsigned short bf16;
typedef short bf16x8 __attribute__((ext_vector_type(8)));
typedef short s16x4 __attribute__((ext_vector_type(4)));
typedef float f32x16 __attribute__((ext_vector_type(16)));
typedef unsigned u32x4 __attribute__((ext_vector_type(4)));
constexpr int NW = 8, QBLK = 32, KVBLK = 64;
constexpr int SHM_V = KVBLK * 128 * 2;
#define SBAR() __builtin_amdgcn_sched_barrier(0)
__device__ __forceinline__ int crow(int r, int hi) { return (r & 3) + 8 * (r >> 2) + 4 * hi; }
__device__ __forceinline__ unsigned cvtpk(float lo, float hi) { unsigned r; asm volatile("v_cvt_pk_bf16_f32 %0, %1, %2" : "=v"(r) : "v"(lo), "v"(hi)); return r; }

struct Args {
  const bf16* Q; const bf16* K; const bf16* K2; const bf16* V; bf16* O;
  int ldq, ldk, ldk2, ldv, ldo;
  int NT, nctx, ctx_row0, lat_row0;
  float C, thr_raw;
  int qpos0, kpos0;
  float sink_l2;
  int r0, klo;
  const float* rpb; float inv_scale;
  const float* qgain;
  int qrope_t0;
};

__device__ __forceinline__ void partialSM(f32x16& p0, f32x16& p1, float& m_reg, float& mn, float& alpha, const float C, const float thr_raw) {
  float pmax = p0[0];
#pragma unroll
  for (int r = 1; r < 16; ++r) pmax = fmaxf(pmax, p0[r]);
#pragma unroll
  for (int r = 0; r < 16; ++r) pmax = fmaxf(pmax, p1[r]);
  { auto rr = __builtin_amdgcn_permlane32_swap(__float_as_uint(pmax), __float_as_uint(pmax), false, false);
    pmax = fmaxf(__uint_as_float(rr[0]), __uint_as_float(rr[1])); }
  if (__builtin_expect(__all(pmax - m_reg <= thr_raw), 1)) { mn = m_reg; alpha = 1.f; }
  else { mn = fmaxf(m_reg, pmax); alpha = __builtin_amdgcn_exp2f((m_reg - mn) * C); m_reg = mn; }
  const float mnC = -mn * C;
#pragma unroll
  for (int r = 0; r < 16; ++r) p0[r] = fmaf(p0[r], C, mnC);
#pragma unroll
  for (int r = 0; r < 16; ++r) p1[r] = fmaf(p1[r], C, mnC);
#pragma unroll
  for (int r = 0; r < 16; ++r) p0[r] = __builtin_amdgcn_exp2f(p0[r]);
}
__device__ __forceinline__ void finishSM(f32x16& p0, f32x16& p1, float alpha, float& l_reg, bf16x8& pa0, bf16x8& pa1, bf16x8& pa2, bf16x8& pa3) {
#pragma unroll
  for (int r = 0; r < 16; ++r) p1[r] = __builtin_amdgcn_exp2f(p1[r]);
  float ps = 0;
#pragma unroll
  for (int r = 0; r < 16; ++r) ps += p0[r];
#pragma unroll
  for (int r = 0; r < 16; ++r) ps += p1[r];
  { auto rr = __builtin_amdgcn_permlane32_swap(__float_as_uint(ps), __float_as_uint(ps), false, false);
    ps = __uint_as_float(rr[0]) + __uint_as_float(rr[1]); }
  l_reg = l_reg * alpha + ps;
#define PK4(P, BASE, OUT) do { unsigned a0 = cvtpk(P[BASE + 0], P[BASE + 1]), a1 = cvtpk(P[BASE + 2], P[BASE + 3]);   \
    unsigned b0 = cvtpk(P[BASE + 4], P[BASE + 5]), b1 = cvtpk(P[BASE + 6], P[BASE + 7]);                              \
    auto r0 = __builtin_amdgcn_permlane32_swap(a0, b0, false, false); auto r1 = __builtin_amdgcn_permlane32_swap(a1, b1, false, false); \
    u32x4 w = {r0[0], r1[0], r0[1], r1[1]}; OUT = *reinterpret_cast<bf16x8*>(&w); } while (0)
  PK4(p0, 0, pa0); PK4(p0, 8, pa1); PK4(p1, 0, pa2); PK4(p1, 8, pa3);
#undef PK4
}
template <int DQ> __device__ __forceinline__ int kswz(int row, int colB) { return row * (DQ * 2) + (colB ^ ((row & 7) << 4)); }
typedef const __attribute__((address_space(3))) bf16x8* lds_b128_ptr;
template <int DQ> __device__ __forceinline__ void qkt(f32x16& p0, f32x16& p1, const int (&kx)[4], int koff, const bf16x8* qr) {
  p0 = f32x16{}; p1 = f32x16{};
  lds_b128_ptr k0 = (lds_b128_ptr)(unsigned)(kx[0] + koff), k1 = (lds_b128_ptr)(unsigned)(kx[1] + koff), k2 = (lds_b128_ptr)(unsigned)(kx[2] + koff), k3 = (lds_b128_ptr)(unsigned)(kx[3] + koff);
#pragma unroll
  for (int d0 = 0; d0 < DQ / 16; ++d0) { lds_b128_ptr kp = (d0 & 3) == 0 ? k0 : (d0 & 3) == 1 ? k1 : (d0 & 3) == 2 ? k2 : k3;
    const bf16x8 b0 = kp[(d0 >> 2) * 8];
    const bf16x8 b1 = kp[(d0 >> 2) * 8 + 32 * DQ * 2 / 16];
    p0 = __builtin_amdgcn_mfma_f32_32x32x16_bf16(b0, qr[d0], p0, 0, 0, 0);
    p1 = __builtin_amdgcn_mfma_f32_32x32x16_bf16(b1, qr[d0], p1, 0, 0, 0); }
}
__device__ __forceinline__ int v_st(int k, int c) { const int kk = (k & ~0xC) | ((k & 4) << 1) | ((k & 8) >> 1); return ((kk >> 3) * 4 + (c >> 5)) * 512 + ((kk & 7) * 32 + (c & 31)) * 2; }
__device__ __forceinline__ int v_rd_base(int lane) { return ((lane & 3) << 3) | (((lane >> 2) & 3) << 6) | (((lane >> 4) & 1) << 5) | (((lane >> 5) & 1) << 8); }
constexpr int v_rd_off(int d0, int ks, int half) { return d0 * 512 + ks * 4096 + half * 2048; }
template <int OFF> __device__ __forceinline__ s16x4 tr_read(int vb) {
  s16x4 r; asm volatile("ds_read_b64_tr_b16 %0, %1 offset:%2" : "=&v"(r) : "v"(vb), "i"(OFF) : "memory"); return r;
}
template <int D0> __device__ __forceinline__ void pv_one(f32x16& od, int vb, bf16x8 pa0, bf16x8 pa1, bf16x8 pa2, bf16x8 pa3) {
  const s16x4 l0 = tr_read<v_rd_off(D0, 0, 0)>(vb), h0 = tr_read<v_rd_off(D0, 0, 1)>(vb), l1 = tr_read<v_rd_off(D0, 1, 0)>(vb), h1 = tr_read<v_rd_off(D0, 1, 1)>(vb);
  const s16x4 l2 = tr_read<v_rd_off(D0, 2, 0)>(vb), h2 = tr_read<v_rd_off(D0, 2, 1)>(vb), l3 = tr_read<v_rd_off(D0, 3, 0)>(vb), h3 = tr_read<v_rd_off(D0, 3, 1)>(vb);
  asm volatile("s_waitcnt lgkmcnt(0)" ::: "memory"); SBAR();
#define PK(L, H) (bf16x8){L[0], L[1], L[2], L[3], H[0], H[1], H[2], H[3]}
  od = __builtin_amdgcn_mfma_f32_32x32x16_bf16(pa0, PK(l0, h0), od, 0, 0, 0);
  od = __builtin_amdgcn_mfma_f32_32x32x16_bf16(pa1, PK(l1, h1), od, 0, 0, 0);
  od = __builtin_amdgcn_mfma_f32_32x32x16_bf16(pa2, PK(l2, h2), od, 0, 0, 0);
  od = __builtin_amdgcn_mfma_f32_32x32x16_bf16(pa3, PK(l3, h3), od, 0, 0, 0);
#undef PK
}
__device__ __forceinline__ void pv_d0(f32x16* o, int vb, bf16x8 pa0, bf16x8 pa1, bf16x8 pa2, bf16x8 pa3) {
  pv_one<0>(o[0], vb, pa0, pa1, pa2, pa3); pv_one<1>(o[1], vb, pa0, pa1, pa2, pa3); pv_one<2>(o[2], vb, pa0, pa1, pa2, pa3); pv_one<3>(o[3], vb, pa0, pa1, pa2, pa3);
}
template <int MODE> __device__ __forceinline__ void maskf(f32x16& p0, f32x16& p1, int t, const Args& a, int wid, int r32, int hi, const float* bias_lds) {
  if constexpr (MODE == 0) { return; }
  else {
    if (t < a.nctx) return;
    if constexpr (MODE == 1) {
      const int kb = a.kpos0 + (t - a.nctx) * 64, qw = a.qpos0 + wid * 32;
      if (kb + 63 - qw <= 128 && qw + 31 - kb <= 128) return;
      const int q = qw + r32;
#pragma unroll
      for (int r = 0; r < 16; ++r) { const int d0 = kb + crow(r, hi) - q, d1 = d0 + 32;
        if (d0 > 128 || d0 < -128) p0[r] = -1e30f;
        if (d1 > 128 || d1 < -128) p1[r] = -1e30f; }
    } else {
      const int kr = a.klo + (t - a.nctx), rq = a.r0 + (wid >> 1);
      const int rs = min(max(rq - 4, 0), 120);
      if (kr < rs || kr >= rs + 8) {
#pragma unroll
        for (int r = 0; r < 16; ++r) { p0[r] = -1e30f; p1[r] = -1e30f; }
        return; }
      const int c = (wid & 1) * 32 + r32, cs = min(max(c - 8, 0), 48);
      int cb = 4 * hi - c + 63, vb = 4 * hi - cs;
      asm volatile("" : "+v"(cb), "+v"(vb));
      const float* bp = bias_lds + (kr - rq + 7) * 128 + cb;
#pragma unroll
      for (int r = 0; r < 16; ++r) { const int k0 = (r & 3) + 8 * (r >> 2), k1 = k0 + 32;
        const float b0 = bp[k0], b1 = bp[k1];
        p0[r] = ((unsigned)(k0 + vb) < 16u) ? fmaf(b0, a.inv_scale, p0[r]) : -1e30f;
        p1[r] = ((unsigned)(k1 + vb) < 16u) ? fmaf(b1, a.inv_scale, p1[r]) : -1e30f;
        if ((r & 3) == 3) SBAR(); }
    }
  }
}

template <int DQ, int MODE>
__device__ __forceinline__ void attn_unit(const Args& a, char* lds, const int wave0) {
  constexpr int SHM_K = KVBLK * DQ * 2, NQ = DQ / 16, OFF_K = 3 * SHM_V, OFF_WS = OFF_K + 2 * SHM_K;
  const int tid = fresh_tid(wave0), wid = tid >> 6, lane = tid & 63, r32 = lane & 31, hi = lane >> 5;
  char* V_lds = lds; char* K_lds = lds + OFF_K;
  float* ws = (float*)(lds + OFF_WS) + wid * 64; float* li_l = ws; float* al_l = ws + 32;
  float* bias_l = (float*)(lds + OFF_WS + 2048);
  if constexpr (MODE == 2) { if (tid < 465) bias_l[(tid / 31) * 128 + 48 + (tid % 31)] = a.rpb[tid]; }
  float m_reg = -1e30f, l_reg = 0; f32x16 o[4] = {}; bf16x8 qr[NQ];
  const float C = a.C, thr_raw = a.thr_raw;
  const bf16* Qw = a.Q + (long)(wid * QBLK + r32) * a.ldq + hi * 8;
#pragma unroll
  for (int d0 = 0; d0 < NQ; ++d0) qr[d0] = *reinterpret_cast<const bf16x8*>(Qw + d0 * 16);
  if constexpr (DQ == 128) {
    if (a.qgain) { float xf[8][8]; float ss = 0.f;
#pragma unroll
      for (int d0 = 0; d0 < 8; ++d0)
#pragma unroll
        for (int e = 0; e < 8; ++e) { xf[d0][e] = __uint_as_float(((unsigned)(unsigned short)qr[d0][e]) << 16); ss += xf[d0][e] * xf[d0][e]; }
      { auto rr = __builtin_amdgcn_permlane32_swap(__float_as_uint(ss), __float_as_uint(ss), false, false); ss = __uint_as_float(rr[0]) + __uint_as_float(rr[1]); }
      const float rstd = rsqrtf(ss * (1.0f / 128.0f) + 1e-6f);
#pragma unroll
      for (int d0 = 0; d0 < 8; ++d0) { const float* gp = a.qgain + d0 * 16 + hi * 8;
#pragma unroll
        for (int e = 0; e < 8; ++e) xf[d0][e] = xf[d0][e] * rstd * gp[e]; }
      if (a.qrope_t0 >= 0) { const int t = a.qrope_t0 + wid * QBLK + r32; const float prow = (float)(t >> 6), pcol = (float)(t & 63);
#pragma unroll
        for (int half = 0; half < 2; ++half)
#pragma unroll
          for (int blk = 0; blk < 2; ++blk)
#pragma unroll
            for (int e = 0; e < 8; ++e) { const int j = blk * 16 + hi * 8 + e, da = 4 * half + blk, db = da + 2;
              const float inv_freq = __builtin_amdgcn_exp2f(-(float)j * (13.287712379549449f / 32.0f)); float rev = (half ? pcol : prow) * inv_freq * 0.15915494309189535f; rev -= rintf(rev);
              const float sn = __builtin_amdgcn_sinf(rev), cs = __builtin_amdgcn_cosf(rev);
              const float x = xf[da][e], y = xf[db][e]; xf[da][e] = x * cs - y * sn; xf[db][e] = y * cs + x * sn; } }
#pragma unroll
      for (int d0 = 0; d0 < 8; ++d0) { bf16x8 w;
#pragma unroll
        for (int e = 0; e < 8; ++e) { unsigned u = __float_as_uint(xf[d0][e]); u = (u + 0x7fffu + ((u >> 16) & 1u)) >> 16; w[e] = (short)u; }
        qr[d0] = w; } } }
  if constexpr (DQ == 192) {
    if (a.qrope_t0 >= 0) { const int t = a.qrope_t0 + wid * QBLK + r32; const float prow = (float)(t >> 6), pcol = (float)(t & 63);
#pragma unroll
      for (int half = 0; half < 2; ++half) { bf16x8 xa = qr[8 + 2 * half], xb = qr[9 + 2 * half]; const float pos = half ? pcol : prow;
#pragma unroll
        for (int e = 0; e < 8; ++e) { const int j = hi * 8 + e;
          const float inv_freq = __builtin_amdgcn_exp2f(-(float)j * (13.287712379549449f / 16.0f)); float rev = pos * inv_freq * 0.15915494309189535f; rev -= rintf(rev);
          const float sn = __builtin_amdgcn_sinf(rev), cs = __builtin_amdgcn_cosf(rev);
          const float x = __uint_as_float(((unsigned)(unsigned short)xa[e]) << 16), y = __uint_as_float(((unsigned)(unsigned short)xb[e]) << 16);
          const float nx = x * cs - y * sn, ny = y * cs + x * sn; unsigned ux = __float_as_uint(nx), uy = __float_as_uint(ny);
          ux = (ux + 0x7fffu + ((ux >> 16) & 1u)) >> 16; uy = (uy + 0x7fffu + ((uy >> 16) & 1u)) >> 16; xa[e] = (short)ux; xb[e] = (short)uy; }
        qr[8 + 2 * half] = xa; qr[9 + 2 * half] = xb; } } }
  const int vb0 = (int)(uintptr_t)V_lds + v_rd_base(lane);
  int kx[4];
#pragma unroll
  for (int q = 0; q < 4; ++q) kx[q] = (int)(uintptr_t)K_lds + r32 * (DQ * 2) + ((q * 32 + hi * 16) ^ ((r32 & 7) << 4));
  constexpr int KP = DQ / 64;
  int koff[KP]; bool kk2[KP]; int voff[2];
#pragma unroll
  for (int i = 0; i < KP; ++i) { const int q = (wid * KP + i) * 64 + lane, row = q / (DQ / 8), cs = q % (DQ / 8), c = cs ^ (row & 7);
    kk2[i] = (DQ == 192) && c >= 16; koff[i] = kk2[i] ? row * a.ldk2 + (c - 16) * 8 : row * a.ldk + c * 8; }
#pragma unroll
  for (int i = 0; i < 2; ++i) { const int q = (wid * 2 + i) * 64 + lane, sub = q >> 5, within = q & 31, kk = (sub >> 2) * 8 + (within >> 2), c = (sub & 3) * 32 + (within & 3) * 8;
    const int k = (kk & ~0xC) | ((kk & 4) << 1) | ((kk & 8) >> 1); voff[i] = k * a.ldv + c; }
  const unsigned kdst0 = (unsigned)(uintptr_t)K_lds + (unsigned)(wid * KP) * 1024u, vdst0 = (unsigned)(uintptr_t)V_lds + (unsigned)(wid * 2) * 1024u;
#define KROW(t) ((t) < a.nctx ? a.ctx_row0 + 64 * (t) : a.lat_row0 + 64 * ((t) - a.nctx))
#define GLDS16(gsrc, ldst) do { unsigned keep_; asm volatile("s_mov_b32 %0, m0\n\ts_mov_b32 m0, %2\n\ts_nop 0\n\tglobal_load_lds_dwordx4 %1, off\n\ts_mov_b32 m0, %0" : "=&s"(keep_) : "v"(gsrc), "s"(ldst) : "memory"); } while (0)
#define DMA(t) do { const long kr_ = KROW(t); const unsigned kd_ = (unsigned)__builtin_amdgcn_readfirstlane((int)(kdst0 + (unsigned)(((t) & 1) * SHM_K))), vd_ = (unsigned)__builtin_amdgcn_readfirstlane((int)(vdst0 + (unsigned)(((t) % 3) * SHM_V))); \
    const bf16* vp_ = a.V + kr_ * a.ldv; const bf16* kp_ = a.K + kr_ * a.ldk; const bf16* kp2_ = (DQ == 192) ? a.K2 + kr_ * a.ldk2 : kp_; \
    _Pragma("unroll") for (int i_ = 0; i_ < KP; ++i_) { const bf16* g_ = ((DQ == 192) && kk2[i_] ? kp2_ : kp_) + koff[i_]; GLDS16(g_, kd_ + (unsigned)i_ * 1024u); } \
    _Pragma("unroll") for (int i_ = 0; i_ < 2; ++i_) GLDS16(vp_ + voff[i_], vd_ + (unsigned)i_ * 1024u); } while (0)
#define WAIT_BAR() asm volatile("s_waitcnt vmcnt(0) lgkmcnt(0)\n\ts_barrier" ::: "memory")
#define RESC(al) do { if (__any((al) < 1.f)) { if (hi == 0) al_l[r32] = (al); asm volatile("s_waitcnt lgkmcnt(0)" ::: "memory"); \
    _Pragma("unroll") for (int d = 0; d < 4; ++d) _Pragma("unroll") for (int r = 0; r < 16; ++r) o[d][r] *= al_l[crow(r, hi)]; } } while (0)
  f32x16 pA0, pA1, pB0, pB1; float mnA, mnB, alA, alB; bf16x8 pa0, pa1, pa2, pa3; const int NT = a.NT;
#define STEP(j, PN0, PN1, MNN, ALN, PP0, PP1, ALP) do { const int j_ = (j); \
    WAIT_BAR();                            \
    if (j_ + 1 < NT) DMA(j_ + 1);          \
    SBAR(); qkt<DQ>(PN0, PN1, kx, (j_ & 1) * SHM_K, qr); maskf<MODE>(PN0, PN1, j_, a, wid, r32, hi, bias_l); \
    finishSM(PP0, PP1, ALP, l_reg, pa0, pa1, pa2, pa3); SBAR(); \
    pv_d0(o, vb0 + ((j_ - 1) % 3) * SHM_V, pa0, pa1, pa2, pa3); partialSM(PN0, PN1, m_reg, MNN, ALN, C, thr_raw); \
    RESC(ALN); } while (0)
  DMA(0); DMA(1);
  WAIT_BAR();
  qkt<DQ>(pA0, pA1, kx, 0, qr); maskf<MODE>(pA0, pA1, 0, a, wid, r32, hi, bias_l); partialSM(pA0, pA1, m_reg, mnA, alA, C, thr_raw);
  for (int j = 1; j + 1 < NT; j += 2) {
    STEP(j, pB0, pB1, mnB, alB, pA0, pA1, alA);
    STEP(j + 1, pA0, pA1, mnA, alA, pB0, pB1, alB);
  }
  STEP(NT - 1, pB0, pB1, mnB, alB, pA0, pA1, alA);
  finishSM(pB0, pB1, alB, l_reg, pa0, pa1, pa2, pa3); SBAR();
  pv_d0(o, vb0 + ((NT - 1) % 3) * SHM_V, pa0, pa1, pa2, pa3);
  if constexpr (MODE == 1) l_reg += __builtin_amdgcn_exp2f(a.sink_l2 - m_reg * C);
  if (hi == 0) li_l[r32] = l_reg; asm volatile("s_waitcnt lgkmcnt(0)" ::: "memory");
  float rli[16];
#pragma unroll
  for (int r = 0; r < 16; ++r) rli[r] = __builtin_amdgcn_rcpf(li_l[crow(r, hi)]);
  asm volatile("s_waitcnt lgkmcnt(0)\n\ts_barrier" ::: "memory");
  { bf16* stg = (bf16*)(lds + wid * 8704);
#pragma unroll
    for (int r = 0; r < 16; ++r) { const int orow = crow(r, hi);
#pragma unroll
      for (int d0 = 0; d0 < 4; ++d0) { const float v = o[d0][r] * rli[r]; unsigned u = __float_as_uint(v); u = (u + 0x7fffu + ((u >> 16) & 1u)) >> 16; stg[orow * 136 + d0 * 32 + r32] = (bf16)u; } }
    asm volatile("s_waitcnt lgkmcnt(0)" ::: "memory");
    bf16* Ow = a.O + (long)(wid * QBLK) * a.ldo;
#pragma unroll
    for (int i = 0; i < 8; ++i) { const int row = i * 4 + (lane >> 4), ch = lane & 15; const u32x4 v = *(const u32x4*)(stg + row * 136 + ch * 8); *(u32x4*)(Ow + (long)row * a.ldo + ch * 8) = v; } }
  asm volatile("s_waitcnt lgkmcnt(0)\n\ts_barrier" ::: "memory");
#undef KROW
#undef GLDS16
#undef DMA
#undef WAIT_BAR
#undef RESC
#undef STEP
}
#undef SBAR
}
#define LAS __attribute__((address_space(3)))
typedef unsigned short bf16;
typedef float f32x4 __attribute__((ext_vector_type(4)));
typedef unsigned v4u __attribute__((ext_vector_type(4)));
typedef unsigned v2u __attribute__((ext_vector_type(2)));
constexpr int NWAVES = 8, NTHR = 512;
constexpr int DM = 2048, SEQ = 8192, NCTX = 256, MLAT = 2 * SEQ, MALL = MLAT + 2 * NCTX, DFF = 5632;
constexpr int N_IN0 = 2816, N_IN1 = 4608, N_UQ = 1536, N_UKV = 2048, N_GU = 2 * DFF;
constexpr float EPS = 1e-6f;
constexpr size_t MiB = 1u << 20;
constexpr size_t WS_MOD = 0, WS_BAR = 512 * 1024, BAR_BYTES = 16384;
constexpr size_t WS_WIN0 = 1 * MiB, WS_WUQ = WS_WIN0 + 11 * MiB, WS_WUKV = WS_WUQ + 2 * MiB, WS_WOUT0 = WS_WUKV + 2 * MiB, WS_WIN1 = WS_WOUT0 + 8 * MiB, WS_WOUT1 = WS_WIN1 + 18 * MiB,
                 WS_WGU = WS_WOUT1 + 8 * MiB, WS_WD = WS_WGU + 88 * MiB, WS_HCTX = WS_WD + 44 * MiB;
constexpr size_t WS_UO = WS_HCTX + 4 * MiB;
constexpr size_t WS_OB = WS_UO + 66 * MiB;
constexpr size_t WS_BIG = WS_UO + 132 * MiB;
constexpr size_t WS_QB = WS_BIG + 91 * MiB, WS_KVB = WS_BIG + 141 * MiB, WS_UB = WS_BIG + 149 * MiB, WS_END = WS_BIG + 215 * MiB;
static_assert((size_t)MALL * DM * 2 == 66 * MiB && (size_t)MALL * N_IN0 * 2 <= 91 * MiB && (size_t)MALL * N_UQ * 2 <= 50 * MiB && (size_t)MALL * N_IN1 * 2 <= 149 * MiB && (size_t)MALL * DFF * 2 <= 215 * MiB, "ws map");

__device__ __forceinline__ unsigned f2bf(float f) { unsigned u = __builtin_bit_cast(unsigned, f); return (u + 0x7fffu + ((u >> 16) & 1u)) >> 16; }
__device__ __forceinline__ unsigned pk2(float lo, float hi) { return f2bf(lo) | (f2bf(hi) << 16); }
__device__ __forceinline__ float bf2f(bf16 v) { return __uint_as_float(((unsigned)v) << 16); }
__device__ __forceinline__ float wave_sum(float v, int lane) {
#pragma unroll
    for (int o = 1; o < 64; o <<= 1) v += __int_as_float(__builtin_amdgcn_ds_bpermute((lane ^ o) << 2, __float_as_int(v)));
    return v;
}
__device__ __forceinline__ float silu_f(float x) { return x / (1.0f + __expf(-x)); }

#define GAS __attribute__((address_space(1)))
#define XB_TMO      128
#define XB_XCNT(j)  (256  + 64 * (j))
#define XB_XSUB(j)  (1280 + 64 * (j))
#define XB_XGEN(j)  (2304 + 64 * (j))
#define XB_TOP      3328
#define XB_TOPGEN   3392
#define XCD_BAR_WORDS 3456
#define XB_SPIN_CAP (1u << 18)

__device__ __forceinline__ unsigned xb_ld(unsigned* p)              { return __hip_atomic_load(p, __ATOMIC_RELAXED, __HIP_MEMORY_SCOPE_AGENT); }
__device__ __forceinline__ unsigned xb_add(unsigned* p, unsigned v) { return __hip_atomic_fetch_add(p, v, __ATOMIC_RELAXED, __HIP_MEMORY_SCOPE_AGENT); }
__device__ __forceinline__ unsigned xb_xcc_id() { return (unsigned)__builtin_amdgcn_s_getreg((3 << 11) | 20) & 0xFu; }
#define XB_SPIN(cond, bar) do { unsigned _sp = 0; while (cond) { __builtin_amdgcn_s_sleep(1); \
    if ((++_sp & 255u) == 0u) { if (xb_ld(&(bar)[XB_TMO])) break; if (_sp > XB_SPIN_CAP) { atomicAdd(&(bar)[XB_TMO], 1u); break; } } } } while (0)

struct XcdBarrier {
    unsigned* bar; unsigned x;
    volatile LAS unsigned* st;
};

__device__ __forceinline__ XcdBarrier xcd_barrier_post(unsigned* bar, volatile LAS unsigned* st) {
    XcdBarrier b; b.bar = bar; b.x = xb_xcc_id(); b.st = st;
    if (threadIdx.x == 0) (void)xb_add(&bar[XB_XCNT(b.x)], 1u);
    return b;
}
__device__ __forceinline__ void xcd_barrier_complete(unsigned* bar, unsigned x, unsigned& nloc, unsigned& nx) {
    const unsigned G = gridDim.x * gridDim.y * gridDim.z;
    unsigned sum, cnt, mine, sp = 0u;
    for (;;) {
        sum = 0u; cnt = 0u; mine = 0u;
#pragma unroll
        for (unsigned j = 0; j < 16; ++j) { const unsigned c = xb_ld(&bar[XB_XCNT(j)]); sum += c; cnt += (c > 0u) ? 1u : 0u; mine = (j == x) ? c : mine; }
        if (sum == G) break;
        __builtin_amdgcn_s_sleep(1);
        if ((++sp & 255u) == 0u) { if (xb_ld(&bar[XB_TMO])) break; if (sp > XB_SPIN_CAP) { atomicAdd(&bar[XB_TMO], 1u); break; } }
    }
    nloc = mine > 0u ? mine : 1u; nx = cnt > 0u ? cnt : 1u;
}

__device__ __forceinline__ void xcd_barrier(const XcdBarrier& b) {
    asm volatile("s_waitcnt vmcnt(0)" ::: "memory");
    __syncthreads();
    if (threadIdx.x == 0) {
        unsigned* bar = b.bar;
        __builtin_amdgcn_s_waitcnt(0);
        unsigned nloc = b.st[0], nx = b.st[1];
        if (nloc == 0u) { xcd_barrier_complete(bar, b.x, nloc, nx); b.st[0] = nloc; b.st[1] = nx; }
        const unsigned old = xb_add(&bar[XB_XSUB(b.x)], 1u);
        const unsigned gen = old / nloc;
        if (old + 1u == (gen + 1u) * nloc) {
            __builtin_amdgcn_fence(__ATOMIC_RELEASE, "agent");
            asm volatile("s_waitcnt vmcnt(0)" ::: "memory");
            const unsigned og = xb_add(&bar[XB_TOP], 1u);
            const unsigned tg = og / nx;
            if (og + 1u == (tg + 1u) * nx) xb_add(&bar[XB_TOPGEN], 1u);
            else XB_SPIN(xb_ld(&bar[XB_TOPGEN]) == tg, bar);
            __builtin_amdgcn_fence(__ATOMIC_ACQUIRE, "agent");
            xb_add(&bar[XB_XGEN(b.x)], 1u);
            asm volatile("s_waitcnt vmcnt(0)" ::: "memory");
        } else {
            XB_SPIN(xb_ld(&bar[XB_XGEN(b.x)]) == gen, bar);
            __builtin_amdgcn_fence(__ATOMIC_ACQUIRE, "agent");
            asm volatile("s_waitcnt vmcnt(0)" ::: "memory");
        }
    }
    __syncthreads();
}

struct KArgs { const float* in[29]; float* out; unsigned char* ws; };
typedef const __attribute__((address_space(4))) KArgs* KAP;
__device__ __forceinline__ KAP kargs() { KAP p = (KAP)__builtin_amdgcn_kernarg_segment_ptr(); asm volatile("" : "+s"(p)); return p; }

__device__ __forceinline__ void transpose_item(const float* W, int K, int N, bf16* WT, int k0, int n0, int drow0, LAS float* scr, int lane) {
#pragma unroll 8
    for (int i = 0; i < 32; ++i) { const int kk = 2 * i + (lane >> 5); scr[kk * 33 + (lane & 31)] = __builtin_nontemporal_load(W + (size_t)(k0 + kk) * N + n0 + (lane & 31)); }
    asm volatile("s_waitcnt lgkmcnt(0)" ::: "memory");
    const int c = lane & 7;
#pragma unroll
    for (int j = 0; j < 4; ++j) { const int n = (lane >> 3) + 8 * j; const LAS float* s = scr + (8 * c) * 33 + n;
        v4u o; o.x = pk2(s[0 * 33], s[1 * 33]); o.y = pk2(s[2 * 33], s[3 * 33]); o.z = pk2(s[4 * 33], s[5 * 33]); o.w = pk2(s[6 * 33], s[7 * 33]);
        *(v4u*)(WT + (size_t)(drow0 + n) * K + k0 + 8 * c) = o; }
    asm volatile("s_waitcnt lgkmcnt(0)" ::: "memory");
}
__device__ __forceinline__ bool conv_matrix(int& it, const float* W, int K, int N, bf16* WT, int mode, LAS float* scr, int lane) {
    const int nblk = N / 32, items = (K / 64) * nblk;
    if (it >= items) { it -= items; return false; }
    const int kb = it / nblk, nb = it % nblk, n0 = 32 * nb;
    const int drow0 = mode == 0 ? n0 : ((n0 >> 7) * 256 + (mode == 2 ? 128 : 0) + (n0 & 127));
    transpose_item(W, K, N, WT, 64 * kb, n0, drow0, scr, lane);
    return true;
}
__device__ __forceinline__ void p0_weights(KAP a, LAS unsigned char* lds, int gw, int NGW, int wave, int lane) {
    LAS float* scr = (LAS float*)(lds + wave * 8704);
    unsigned char* ws = a->ws;
    constexpr int I_TOTAL = (2048 / 64) * (2624 / 32) + (512 / 64) * (1536 / 32) + (512 / 64) * (2048 / 32) + 2 * (2048 / 64) * (2048 / 32) + (2048 / 64) * (4608 / 32)
                          + 4 * (2048 / 64) * (DFF / 32) + 2 * (DFF / 64) * (2048 / 32);
    for (int item = gw; item < I_TOTAL; item += NGW) {
        int it = item;
        if (conv_matrix(it, a->in[13], 2048, 2624, (bf16*)(ws + WS_WIN0), 0, scr, lane)) continue;
        if (conv_matrix(it, a->in[19], 512, 1536, (bf16*)(ws + WS_WUQ), 0, scr, lane)) continue;
        if (conv_matrix(it, a->in[20], 512, 2048, (bf16*)(ws + WS_WUKV), 0, scr, lane)) continue;
        if (conv_matrix(it, a->in[14], 2048, 2048, (bf16*)(ws + WS_WOUT0), 0, scr, lane)) continue;
        if (conv_matrix(it, a->in[21], 2048, 4608, (bf16*)(ws + WS_WIN1), 0, scr, lane)) continue;
        if (conv_matrix(it, a->in[22], 2048, 2048, (bf16*)(ws + WS_WOUT1), 0, scr, lane)) continue;
        if (conv_matrix(it, a->in[10], 2048, DFF, (bf16*)(ws + WS_WGU), 1, scr, lane)) continue;
        if (conv_matrix(it, a->in[10] + (size_t)2048 * DFF, 2048, DFF, (bf16*)(ws + WS_WGU + 44 * MiB), 1, scr, lane)) continue;
        if (conv_matrix(it, a->in[11], 2048, DFF, (bf16*)(ws + WS_WGU), 2, scr, lane)) continue;
        if (conv_matrix(it, a->in[11] + (size_t)2048 * DFF, 2048, DFF, (bf16*)(ws + WS_WGU + 44 * MiB), 2, scr, lane)) continue;
        if (conv_matrix(it, a->in[12], DFF, 2048, (bf16*)(ws + WS_WD), 0, scr, lane)) continue;
        conv_matrix(it, a->in[12] + (size_t)2048 * DFF, DFF, 2048, (bf16*)(ws + WS_WD + 22 * MiB), 0, scr, lane);
    }
}
__device__ __forceinline__ void p0_mod(KAP a, LAS unsigned char* lds, int tid) {
    LAS float* sv = (LAS float*)lds;
    LAS float* red = (LAS float*)(lds + 24576);
    const int blk = blockIdx.x; if (blk >= 256) return;
    const int layer = blk >> 7, col0 = (blk & 127) * 96;
    for (int i = tid; i < 3 * 2048; i += NTHR) { const int v = i >> 11, k = i & 2047; const float x = v < 2 ? a->in[1][v * 2048 + k] : a->in[3][k]; sv[i] = silu_f(x); }
    __syncthreads();
    const int c4 = tid % 24, ks = tid / 24;
    if (ks < 21) {
        const float* W = a->in[4] + (size_t)layer * 2048 * 12288 + col0 + 4 * c4;
        f32x4 a0 = {0, 0, 0, 0}, a1 = a0, a2 = a0;
#pragma unroll 8
        for (int k = ks; k < 2048; k += 21) { const f32x4 w = __builtin_nontemporal_load((const f32x4*)(W + (size_t)k * 12288)); a0 += w * sv[k]; a1 += w * sv[2048 + k]; a2 += w * sv[4096 + k]; }
        LAS float* r = red + ks * 288 + 4 * c4;
        *(LAS f32x4*)(r) = a0; *(LAS f32x4*)(r + 96) = a1; *(LAS f32x4*)(r + 192) = a2;
    }
    __syncthreads();
    if (tid < 288) { float s = 0.f;
        for (int q = 0; q < 21; ++q) s += red[q * 288 + tid];
        const int v = tid / 96, j = tid % 96;
        ((float*)(a->ws + WS_MOD))[(size_t)(layer * 3 + v) * 12288 + col0 + j] = s + a->in[5][layer * 12288 + col0 + j]; }
    __syncthreads();
}
__device__ __forceinline__ void store_u(bf16* urow, int lane, const f32x4 (&v)[8], float rstd, const float* g, const float* sh, const float* sc) {
#pragma unroll
    for (int j = 0; j < 8; ++j) { const int ci = 256 * j + 4 * lane; const f32x4 g4 = *(const f32x4*)(g + ci), s4 = *(const f32x4*)(sc + ci), h4 = *(const f32x4*)(sh + ci);
        const f32x4 t = (v[j] * rstd * g4) * (1.0f + s4) + h4; v2u w; w.x = pk2(t[0], t[1]); w.y = pk2(t[2], t[3]); *(v2u*)(urow + ci) = w; }
}
__device__ __forceinline__ void pass_pre(const float* hlat, const float* hctx, const float* g, const float* mod, int sh_off, int sc_off, bf16* U, int nrows, int gw, int NGW, int lane) {
    for (int m0 = gw; m0 < nrows; m0 += 2 * NGW) {
        int mr[2]; mr[0] = m0; mr[1] = m0 + NGW; const bool two = mr[1] < nrows; if (!two) mr[1] = m0;
        f32x4 v[2][8]; float ss[2];
#pragma unroll
        for (int r = 0; r < 2; ++r) { const int m = mr[r]; const float* src = m < MLAT ? hlat + (size_t)m * DM : hctx + (size_t)(m - MLAT) * DM;
#pragma unroll
            for (int j = 0; j < 8; ++j) v[r][j] = *(const f32x4*)(src + 256 * j + 4 * lane); }
#pragma unroll
        for (int r = 0; r < 2; ++r) { ss[r] = 0.f;
#pragma unroll
            for (int j = 0; j < 8; ++j) ss[r] += (v[r][j][0] * v[r][j][0] + v[r][j][1] * v[r][j][1]) + (v[r][j][2] * v[r][j][2] + v[r][j][3] * v[r][j][3]); }
#pragma unroll
        for (int r = 0; r < 2; ++r) { if (r == 1 && !two) break; const int m = mr[r]; const float* mv = mod + (m < MLAT ? (m >> 13) : 2) * 12288;
            const float rstd = rsqrtf(wave_sum(ss[r], lane) * (1.0f / DM) + EPS);
            store_u(U + (size_t)m * DM, lane, v[r], rstd, g, mv + sh_off, mv + sc_off); }
    }
}
__device__ __forceinline__ void pass_post(const bf16* o16, const float* opart, const float* hlat, const float* hctx, float* olat, float* octx, const float* gpost, const float* mod, int gt_off,
                                          const float* gpre, const float* modu, int sh_off, int sc_off, bf16* U, int nrows, int gw, int NGW, int lane) {
    for (int m0 = gw; m0 < nrows; m0 += 2 * NGW) {
        int mr[2]; mr[0] = m0; mr[1] = m0 + NGW; const bool two = mr[1] < nrows; if (!two) mr[1] = m0;
        f32x4 v[2][8], hh[2][8]; float ss[2];
#pragma unroll
        for (int r = 0; r < 2; ++r) { const int m = mr[r]; ss[r] = 0.f;
            const float* hs = m < MLAT ? hlat + (size_t)m * DM : hctx + (size_t)(m - MLAT) * DM;
            if (m < MLAT) { const bf16* orow = o16 + (size_t)m * DM;
#pragma unroll
                for (int j = 0; j < 8; ++j) { const v2u raw = *(const v2u*)(orow + 256 * j + 4 * lane);
                    v[r][j] = (f32x4){__uint_as_float(raw.x << 16), __uint_as_float(raw.x & 0xffff0000u), __uint_as_float(raw.y << 16), __uint_as_float(raw.y & 0xffff0000u)}; }
            } else { const float* orow = opart + (size_t)(m - MLAT) * DM;
#pragma unroll
                for (int j = 0; j < 8; ++j) { const int ci = 256 * j + 4 * lane;
                    v[r][j] = (*(const f32x4*)(orow + ci) + *(const f32x4*)(orow + ci + (size_t)512 * DM)) + (*(const f32x4*)(orow + ci + (size_t)1024 * DM) + *(const f32x4*)(orow + ci + (size_t)1536 * DM)); } }
#pragma unroll
            for (int j = 0; j < 8; ++j) hh[r][j] = *(const f32x4*)(hs + 256 * j + 4 * lane);
        }
#pragma unroll
        for (int r = 0; r < 2; ++r)
#pragma unroll
            for (int j = 0; j < 8; ++j) ss[r] += (v[r][j][0] * v[r][j][0] + v[r][j][1] * v[r][j][1]) + (v[r][j][2] * v[r][j][2] + v[r][j][3] * v[r][j][3]);
#pragma unroll
        for (int r = 0; r < 2; ++r) { const int m = mr[r]; if (r == 1 && !two) break;
            float* hd = m < MLAT ? olat + (size_t)m * DM : octx + (size_t)(m - MLAT) * DM; const int vi = (m < MLAT ? (m >> 13) : 2); const float* mv = mod + vi * 12288;
            const float rstd = rsqrtf(wave_sum(ss[r], lane) * (1.0f / DM) + EPS); float s2 = 0.f;
#pragma unroll
            for (int j = 0; j < 8; ++j) { const int ci = 256 * j + 4 * lane; const f32x4 g4 = *(const f32x4*)(gpost + ci), t4 = *(const f32x4*)(mv + gt_off + ci);
                const f32x4 nv = hh[r][j] + t4 * (v[r][j] * rstd * g4); v[r][j] = nv; *(f32x4*)(hd + ci) = nv; s2 += (nv[0] * nv[0] + nv[1] * nv[1]) + (nv[2] * nv[2] + nv[3] * nv[3]); }
            if (U) { const float* mu = modu + vi * 12288; const float rstd2 = rsqrtf(wave_sum(s2, lane) * (1.0f / DM) + EPS); store_u(U + (size_t)m * DM, lane, v[r], rstd2, gpre, mu + sh_off, mu + sc_off); }
        }
    }
}
__device__ __forceinline__ void rope_cs(float pos, int j, float inv_nf, float& cs, float& sn) {
    const float inv_freq = __builtin_amdgcn_exp2f(-(float)j * inv_nf * 13.287712379549449f);
    float rev = pos * inv_freq * 0.15915494309189535f; rev -= rintf(rev);
    sn = __builtin_amdgcn_sinf(rev); cs = __builtin_amdgcn_cosf(rev);
}
template <int NH> __device__ __forceinline__ void heads_load(const bf16* base, int ia, float (&x)[NH], float (&y)[NH]) {
#pragma unroll
    for (int h = 0; h < NH; ++h) { x[h] = bf2f(base[h * 128 + ia]); y[h] = bf2f(base[h * 128 + ia + 32]); }
}
template <int NH> __device__ __forceinline__ void heads_finish(bf16* base, int ia, float (&x)[NH], float (&y)[NH], const float* gain, bool rope, float cs, float sn, int lane) {
    const float ga = gain[ia], gb = gain[ia + 32];
#pragma unroll
    for (int h = 0; h < NH; ++h) {
        const float rstd = rsqrtf(wave_sum(x[h] * x[h] + y[h] * y[h], lane) * (1.0f / 128.0f) + EPS);
        float a = x[h] * rstd * ga, b = y[h] * rstd * gb;
        if (rope) { const float na = a * cs - b * sn, nb = b * cs + a * sn; a = na; b = nb; }
        base[h * 128 + ia] = (bf16)f2bf(a); base[h * 128 + ia + 32] = (bf16)f2bf(b); }
}
__device__ __forceinline__ void unpack8(const v4u raw, float (&x)[8]) {
#pragma unroll
    for (int i = 0; i < 4; ++i) { x[2 * i] = __uint_as_float(raw[i] << 16); x[2 * i + 1] = __uint_as_float(raw[i] & 0xffff0000u); }
}
__device__ __forceinline__ void norm512_finish(bf16* p, const float (&x)[8], const float* gain, int lane) {
    float ss = 0.f;
#pragma unroll
    for (int i = 0; i < 8; ++i) ss += x[i] * x[i];
    const float rstd = rsqrtf(wave_sum(ss, lane) * (1.0f / 512.0f) + EPS);
    const f32x4 g0 = *(const f32x4*)(gain + 8 * lane), g1 = *(const f32x4*)(gain + 8 * lane + 4);
    v4u w; w.x = pk2(x[0] * rstd * g0[0], x[1] * rstd * g0[1]); w.y = pk2(x[2] * rstd * g0[2], x[3] * rstd * g0[3]); w.z = pk2(x[4] * rstd * g1[0], x[5] * rstd * g1[1]); w.w = pk2(x[6] * rstd * g1[2], x[7] * rstd * g1[3]);
    *(v4u*)(p + 8 * lane) = w;
}
__device__ __forceinline__ void rope64(bf16* p, float prow, float pcol, int l32) {
    const int j = l32 & 15, s = (l32 >> 4) & 1, ia = 32 * s + j, ib = ia + 16;
    const float x = bf2f(p[ia]), y = bf2f(p[ib]); float cs, sn; rope_cs(s ? pcol : prow, j, 1.0f / 16.0f, cs, sn);
    p[ia] = (bf16)f2bf(x * cs - y * sn); p[ib] = (bf16)f2bf(y * cs + x * sn);
}
__device__ __forceinline__ void prep_ab(bf16* P, const float* aqn, const float* akn, const float* bqn, const float* bkvn, int gw, int NGW, int lane) {
    const int ia = 64 * (lane >> 5) + (lane & 31);
    for (int m = gw; m < MALL; m += NGW) {
        bf16* row = P + (size_t)m * N_IN0; const bool lat = m < MLAT; const int t = m & (SEQ - 1); const float pr = (float)(t >> 6), pc = (float)(t & 63);
        float xk[2], yk[2], c1[8], c2[8];
        heads_load<2>(row + 1024, ia, xk, yk);
        unpack8(*(const v4u*)(row + 1536 + 8 * lane), c1); unpack8(*(const v4u*)(row + 2048 + 8 * lane), c2);
        if (lat && lane < 32) rope64(row + 2560, pr, pc, lane);
        float cs = 1.f, sn = 0.f; if (lat) rope_cs((lane >> 5) ? pc : pr, lane & 31, 1.0f / 32.0f, cs, sn);
        heads_finish<2>(row + 1024, ia, xk, yk, akn, lat, cs, sn, lane);
        norm512_finish(row + 1536, c1, bqn, lane); norm512_finish(row + 2048, c2, bkvn, lane);
    }
}
__device__ __forceinline__ void prep_qb(bf16* QB, int gw, int NGW, int lane) {
    for (int m = gw; m < MLAT; m += NGW) {
        bf16* row = QB + (size_t)m * N_UQ; const int t = m & (SEQ - 1); const float pr = (float)(t >> 6), pc = (float)(t & 63);
#pragma unroll
        for (int i = 0; i < 4; ++i) rope64(row + (2 * i + (lane >> 5)) * 192 + 128, pr, pc, lane & 31);
    }
}
__device__ __forceinline__ void prep_cd(bf16* P, const float* cqn, const float* ckn, const float* dqn, const float* dkn, int gw, int NGW, int lane) {
    const int ia = 64 * (lane >> 5) + (lane & 31);
    for (int m = gw; m < MALL; m += NGW) {
        bf16* row = P + (size_t)m * N_IN1; const bool lat = m < MLAT; const int t = m & (SEQ - 1); const float pr = (float)(t >> 6), pc = (float)(t & 63);
        float cs = 1.f, sn = 0.f; if (lat) rope_cs((lane >> 5) ? pc : pr, lane & 31, 1.0f / 32.0f, cs, sn);
        float xk[2], yk[2], xd[8], yd[8];
        heads_load<2>(row + 1024, ia, xk, yk); heads_load<8>(row + 2560, ia, xd, yd);
        heads_finish<2>(row + 1024, ia, xk, yk, ckn, lat, cs, sn, lane); heads_finish<8>(row + 2560, ia, xd, yd, dkn, false, 1.f, 0.f, lane);
    }
}
constexpr float LOG2E = 1.4426950408889634f;
__device__ __forceinline__ void attn_phase_ab(const bf16* P0, const bf16* QB, const bf16* KVB, bf16* OB, const float* aqn, char* lds, const int wave0) {
    const int c = blockIdx.x, G = gridDim.x;
    for (int id = c; id < 1024 + 32; id += G) {
        att::Args a{};
        int mixer, b, h, qrow0, NT;
        if (id < 1024) { const int rnd = id >> 8, cc = id & 255; mixer = rnd >> 1; b = rnd & 1; h = cc & 7; qrow0 = b * SEQ + (cc >> 3) * 256; NT = 132; }
        else { const int cc = id - 1024; mixer = cc >> 4; b = (cc >> 3) & 1; h = cc & 7; qrow0 = MLAT + b * NCTX; NT = 4; }
        a.NT = NT; a.nctx = 4; a.ctx_row0 = MLAT + b * NCTX; a.lat_row0 = b * SEQ; a.ldo = DM; a.qrope_t0 = (id < 1024) ? (qrow0 - b * SEQ) : -1;
        if (mixer == 0) {
            a.Q = P0 + (size_t)qrow0 * N_IN0 + h * 128; a.ldq = N_IN0; a.K = P0 + 1024 + (h >> 2) * 128; a.ldk = N_IN0; a.K2 = nullptr; a.ldk2 = 0; a.V = P0 + 1280 + (h >> 2) * 128; a.ldv = N_IN0;
            a.O = OB + (size_t)qrow0 * DM + h * 128; const float scale = 0.08838834764831845f; a.C = scale * LOG2E; a.thr_raw = 8.0f / scale; a.qgain = aqn;

#ifndef DIS_A
            att::attn_unit<128, 0>(a, lds, wave0);
#endif

        } else {
            a.Q = QB + (size_t)qrow0 * N_UQ + h * 192; a.ldq = N_UQ; a.K = KVB + h * 256; a.ldk = N_UKV; a.K2 = P0 + 2560; a.ldk2 = N_IN0; a.V = KVB + h * 256 + 128; a.ldv = N_UKV;
            a.O = OB + (size_t)qrow0 * DM + 1024 + h * 128; const float scale = 0.07216878364870322f; a.C = scale * LOG2E; a.thr_raw = 8.0f / scale;

#ifndef DIS_B
            att::attn_unit<192, 0>(a, lds, wave0);
#endif

        }
    }
}
__device__ __forceinline__ void attn_phase_cd(const bf16* P1, bf16* OB, const float* sink, const float* rpb, const float* cqn, const float* dqn, char* lds, const int wave0) {
    const int c = blockIdx.x, G = gridDim.x;
    for (int id = c; id < 1024; id += G) {
        att::Args a{};
        const int rnd = id >> 8, cc = id & 255, mixer = rnd >> 1, b = rnd & 1, h = cc & 7, qb = cc >> 3, qrow0 = b * SEQ + qb * 256;
        a.nctx = 4; a.ctx_row0 = MLAT + b * NCTX; a.ldo = DM; a.ldq = a.ldk = a.ldv = N_IN1; a.K2 = nullptr; a.ldk2 = 0;
        const float scale = 0.08838834764831845f; a.C = scale * LOG2E; a.thr_raw = 8.0f / scale; a.inv_scale = 1.0f / scale;
        if (mixer == 0) {
            const int kbase = min(max(qb * 256 - 128, 0), SEQ - 512);
            a.NT = 12; a.lat_row0 = b * SEQ + kbase; a.qpos0 = qb * 256; a.kpos0 = kbase; a.sink_l2 = __uint_as_float((unsigned)__builtin_amdgcn_readfirstlane((int)__float_as_uint(sink[h]))) * LOG2E;
            a.qgain = cqn; a.qrope_t0 = qb * 256; a.Q = P1 + (size_t)qrow0 * N_IN1 + h * 128; a.K = P1 + 1024 + (h >> 2) * 128; a.V = P1 + 1280 + (h >> 2) * 128; a.O = OB + (size_t)qrow0 * DM + h * 128;

#ifndef DIS_C
            att::attn_unit<128, 1>(a, lds, wave0);
#endif

        } else {
            const int r0 = qb * 4, klo = min(max(r0 - 4, 0), 116);
            a.NT = 16; a.lat_row0 = b * SEQ + klo * 64; a.r0 = r0; a.klo = klo; a.rpb = rpb + h * (15 * 31);
            a.qgain = dqn; a.qrope_t0 = -1; a.Q = P1 + (size_t)qrow0 * N_IN1 + 1536 + h * 128; a.K = P1 + 2560 + h * 128; a.V = P1 + 3584 + h * 128; a.O = OB + (size_t)qrow0 * DM + 1024 + h * 128;

#ifndef DIS_D
            att::attn_unit<128, 2>(a, lds, wave0);
#endif

        }
    }
}

__global__ void __launch_bounds__(NTHR, 2) fwd_megakernel(KArgs args) {
    extern __shared__ __attribute__((aligned(16))) unsigned char lds[];
    cg::grid_group grid = cg::this_grid();
    LAS unsigned char* ldsl = (LAS unsigned char*)lds;
    const int wave0 = __builtin_amdgcn_readfirstlane(threadIdx.x >> 6);
    const int G = gridDim.x, NGW = G * NWAVES;
#define PHASE_IDS() const int tid = fresh_tid(wave0); const int lane = tid & 63, wave = __builtin_amdgcn_readfirstlane(tid >> 6), gw = blockIdx.x * NWAVES + wave; (void)wave; (void)gw; (void)lane
#define WSB (kargs()->ws)
#define x_ (kargs()->in[0])
#define ctx_ (kargs()->in[2])
#define out_ (kargs()->out)
#define hctx_ ((float*)(WSB + WS_HCTX))
#define MOD_ ((const float*)(WSB + WS_MOD))
#define UA_ ((bf16*)(WSB + WS_UO))
#define OB_ ((bf16*)(WSB + WS_OB))
#define FB_ ((bf16*)(WSB + WS_UO))
#define FP_ ((float*)(WSB + WS_UO + 64 * MiB))
#define OFB_ ((bf16*)(WSB + WS_BIG))
#define OFP_ ((float*)(WSB + WS_BIG + 128 * MiB))
#define PB_ ((bf16*)(WSB + WS_BIG))
#define OF_ ((float*)(WSB + WS_BIG))
#define ACT_ ((bf16*)(WSB + WS_BIG))
#define QB_ ((bf16*)(WSB + WS_QB))
#define KVB_ ((bf16*)(WSB + WS_KVB))
#define UB_ ((bf16*)(WSB + WS_UB))
#ifndef PROBE_G
#define PROBE_G 1
#endif
#ifndef PROBE_A
#define PROBE_A 1
#endif
#ifndef PROBE_S
#define PROBE_S 1
#endif
#define GSYNC() do { for (int s_ = 0; s_ < PROBE_S; ++s_) { xcd_barrier(bar); } } while (0)
    volatile LAS unsigned* MISC = (volatile LAS unsigned*)(ldsl + 131072 + 64);
    if (threadIdx.x < 2) MISC[threadIdx.x] = 0u;
    __syncthreads();
    grid.sync();
    XcdBarrier bar = xcd_barrier_post((unsigned*)(kargs()->ws + WS_BAR), MISC);

    for (int rep_ = 0; rep_ < PROBE_S; ++rep_) {
    { PHASE_IDS(); p0_mod(kargs(), ldsl, tid); }
    { PHASE_IDS(); p0_weights(kargs(), ldsl, gw, NGW, wave, lane); }
    }
    GSYNC();
    { PHASE_IDS(); pass_pre(x_, ctx_, kargs()->in[6], MOD_, 0, DM, UA_, MALL, gw, NGW, lane); }
    GSYNC();
    for (int L = 0; L < 2; ++L) {

        const int Mrows = L == 0 ? MALL : MLAT;
        { pg8::Gemm g = pg8::mk_gemm(L == 0 ? UA_ : UB_, (const bf16*)(WSB + (L == 0 ? WS_WIN0 : WS_WIN1)), MALL, L == 0 ? N_IN0 : N_IN1, DM, DM);
          pg8::StaticOrder S; S.init(g.M, g.N, G, (int)blockIdx.x); pg8::EpiBf16 E{PB_, g.N};
          for (int rep_ = 0; rep_ < PROBE_G; ++rep_) pg8::gemm_phase<pg8::EpiBf16, pg8::StaticOrder, true, true>(ldsl, g, S, E, wave0); }
        GSYNC();
        if (L == 0) {
            { PHASE_IDS(); prep_ab(PB_, kargs()->in[15], kargs()->in[16], kargs()->in[17], kargs()->in[18], gw, NGW, lane); }
            GSYNC();
            for (int q = 0; q < 2; ++q) {
                pg8::Gemm g = pg8::mk_gemm(PB_ + (q == 0 ? 1536 : 2048), (const bf16*)(WSB + (q == 0 ? WS_WUQ : WS_WUKV)), MALL, q == 0 ? N_UQ : N_UKV, 512, N_IN0);
                pg8::StaticOrder S; S.init(g.M, g.N, G, (int)blockIdx.x); pg8::EpiBf16 E{q == 0 ? QB_ : KVB_, g.N};
                for (int rep_ = 0; rep_ < PROBE_G; ++rep_) pg8::gemm_phase<pg8::EpiBf16, pg8::StaticOrder, true, true>(ldsl, g, S, E, wave0);
            }
            GSYNC();
            for (int rep_ = 0; rep_ < PROBE_A; ++rep_) attn_phase_ab(PB_, QB_, KVB_, OB_, kargs()->in[15], (char*)lds, wave0);
        } else {
            { PHASE_IDS(); prep_cd(PB_, kargs()->in[23], kargs()->in[24], kargs()->in[26], kargs()->in[27], gw, NGW, lane); }
            GSYNC();
            for (int rep_ = 0; rep_ < PROBE_A; ++rep_) attn_phase_cd(PB_, OB_, kargs()->in[25], kargs()->in[28], kargs()->in[23], kargs()->in[26], (char*)lds, wave0);
        }
        GSYNC();
        { pg8::Gemm g = pg8::mk_gemm(OB_, (const bf16*)(WSB + (L == 0 ? WS_WOUT0 : WS_WOUT1)), MLAT, DM, DM, DM);
          pg8::StaticOrder S; S.init(g.M, g.N, G, (int)blockIdx.x); pg8::EpiBf16 E{OFB_, DM};
          for (int rep_ = 0; rep_ < PROBE_G; ++rep_) pg8::gemm_phase<pg8::EpiBf16, pg8::StaticOrder, true, true>(ldsl, g, S, E, wave0); }
        if (L == 0) { pg8::Gemm g = pg8::mk_gemm(OB_ + (size_t)MLAT * DM, (const bf16*)(WSB + WS_WOUT0), 2 * NCTX, 4 * DM, DM / 4, DM); g.ldb = DM; g.nNr = DM / 256;
          pg8::StaticOrder S; S.init(g.M, g.N, G, (int)blockIdx.x); pg8::EpiF32Split E{OFP_, DM, DM / 256, (size_t)2 * NCTX * DM};
          for (int rep_ = 0; rep_ < PROBE_G; ++rep_) pg8::gemm_phase<pg8::EpiF32Split, pg8::StaticOrder, true, true>(ldsl, g, S, E, wave0); }
        GSYNC();
        { PHASE_IDS(); pass_post(OFB_, OFP_, L == 0 ? x_ : out_, L == 0 ? ctx_ : hctx_, out_, hctx_, kargs()->in[7] + L * DM, MOD_ + (size_t)L * 3 * 12288, 2 * DM, kargs()->in[8] + L * DM, MOD_ + (size_t)L * 3 * 12288, 3 * DM, 4 * DM, UA_, Mrows, gw, NGW, lane); }
        GSYNC();
        { pg8::Gemm g = pg8::mk_gemm(UA_, (const bf16*)(WSB + WS_WGU + (size_t)L * 44 * MiB), Mrows, N_GU, DM, DM);
          pg8::StaticOrder S; S.init(g.M, g.N, G, (int)blockIdx.x); pg8::EpiSwiglu E{ACT_, DFF};
          for (int rep_ = 0; rep_ < PROBE_G; ++rep_) pg8::gemm_phase<pg8::EpiSwiglu, pg8::StaticOrder, true, true>(ldsl, g, S, E, wave0); }
        GSYNC();
        { pg8::Gemm g = pg8::mk_gemm(ACT_, (const bf16*)(WSB + WS_WD + (size_t)L * 22 * MiB), MLAT, DM, DFF, DFF);
          pg8::StaticOrder S; S.init(g.M, g.N, G, (int)blockIdx.x); pg8::EpiBf16 E{FB_, DM};
          for (int rep_ = 0; rep_ < PROBE_G; ++rep_) pg8::gemm_phase<pg8::EpiBf16, pg8::StaticOrder, true, true>(ldsl, g, S, E, wave0); }
        if (L == 0) { pg8::Gemm g = pg8::mk_gemm(ACT_ + (size_t)MLAT * DFF, (const bf16*)(WSB + WS_WD), 2 * NCTX, 4 * DM, DFF / 4, DFF); g.ldb = DFF; g.nNr = DM / 256;
          pg8::StaticOrder S; S.init(g.M, g.N, G, (int)blockIdx.x); pg8::EpiF32Split E{FP_, DM, DM / 256, (size_t)2 * NCTX * DM};
          for (int rep_ = 0; rep_ < PROBE_G; ++rep_) pg8::gemm_phase<pg8::EpiF32Split, pg8::StaticOrder, true, true>(ldsl, g, S, E, wave0); }
        GSYNC();
        { PHASE_IDS(); pass_post(FB_, FP_, out_, hctx_, out_, hctx_, kargs()->in[9] + L * DM, MOD_ + (size_t)L * 3 * 12288, 5 * DM, kargs()->in[6] + DM, MOD_ + (size_t)3 * 12288, 0, DM, L == 0 ? UB_ : nullptr, Mrows, gw, NGW, lane); }
        if (L == 0) GSYNC();
    }
#undef GSYNC
}

constexpr int LDS_BYTES = 131072 + 1024;
extern "C" void kernel_launch(void* const* d_in, const int* in_sizes, int n_in, void* d_out, int out_size, void* d_ws, size_t ws_size, hipStream_t stream) {
    static int grid = 0;
    if (grid == 0) {
        if (n_in != 29 || out_size != MLAT * DM || ws_size < WS_END) { fprintf(stderr, "kernel_launch: unexpected shapes: n_in %d out %d ws %zu (need %zu)\n", n_in, out_size, ws_size, (size_t)WS_END); grid = -1; return; }
        int dev = 0, cus = 0, per_cu = 0;
        hipGetDevice(&dev); hipDeviceGetAttribute(&cus, hipDeviceAttributeMultiprocessorCount, dev);
        if (hipFuncSetAttribute((const void*)fwd_megakernel, hipFuncAttributeMaxDynamicSharedMemorySize, LDS_BYTES) != hipSuccess) { fprintf(stderr, "kernel_launch: hipFuncSetAttribute failed\n"); grid = -1; return; }
        if (hipOccupancyMaxActiveBlocksPerMultiprocessor(&per_cu, (const void*)fwd_megakernel, NTHR, LDS_BYTES) != hipSuccess || per_cu < 1) { fprintf(stderr, "kernel_launch: occupancy query says %d\n", per_cu); per_cu = 1; }
        (void)hipGetLastError();
        grid = cus;
        fprintf(stderr, "kernel_launch: grid %d (per_cu %d)\n", grid, per_cu);
    }
    if (grid < 0) return;
    if (hipMemsetAsync((char*)d_ws + WS_BAR, 0, BAR_BYTES, stream) != hipSuccess) { fprintf(stderr, "kernel_launch: hipMemsetAsync failed\n"); return; }
    KArgs a{};
    for (int i = 0; i < 29; ++i) a.in[i] = (const float*)d_in[i];
    a.out = (float*)d_out; a.ws = (unsigned char*)d_ws;
    void* params[] = {&a};
    const hipError_t e = hipLaunchCooperativeKernel((const void*)fwd_megakernel, dim3(grid), dim3(NTHR), params, LDS_BYTES, stream);
    if (e != hipSuccess) fprintf(stderr, "kernel_launch: cooperative launch failed: %s (grid %d)\n", hipGetErrorString(e), grid);
}
```

```cpp
#include <hip/hip_runtime.h>
#include <hip/hip_cooperative_groups.h>
#include <cstdio>
#include <cstdint>
namespace cg = cooperative_groups;
__device__ __forceinline__ int fresh_tid(int wave0) { int l; asm volatile("v_mbcnt_lo_u32_b32 %0, -1, 0\n\tv_mbcnt_hi_u32_b32 %0, -1, %0" : "=v"(l)); return wave0 * 64 + l; }
namespace pg8 {
#define PG8_LAS __attribute__((address_space(3)))
typedef unsigned short bf16_t;
typedef short bf16x8 __attribute__((ext_vector_type(8)));
typedef float f32x4 __attribute__((ext_vector_type(4)));
typedef unsigned u32x4 __attribute__((ext_vector_type(4)));
constexpr int BM = 256, BK = 64, HALF = 128, HTB = HALF * BK * 2  , STAGE_BYTES = 8 * HTB, NXCD = 8, WGM = 8;

__host__ __device__ __forceinline__ int lds_byte(int r, int c) { const int st = (r >> 4) * 2 + (c >> 5), rr = r & 15, cc = c & 31, ob = rr * 64 + cc * 2; return st * 1024 + (ob ^ (((ob >> 9) & 1) << 5)); }
__host__ __device__ __forceinline__ void stage_rc(int b, int& R, int& C) { const int st = b / 1024, sb = b % 1024, swz = sb ^ (((sb >> 9) & 1) << 5); R = (st >> 1) * 16 + swz / 64; C = (st & 1) * 32 + (swz % 64) / 2; }
__host__ __device__ __forceinline__ int perm32(int rho) { const int n = rho >> 4, i = rho & 15; return 8 * (i >> 2) + 4 * n + (i & 3); }

struct Unit { int pm, pn; };
struct Gemm { const bf16_t* A; const bf16_t* Bt; int M, N, K, lda, ldb, nNr; };
__host__ __device__ __forceinline__ Gemm mk_gemm(const bf16_t* A, const bf16_t* Bt, int M, int N, int K, int lda) { Gemm g; g.A = A; g.Bt = Bt; g.M = M; g.N = N; g.K = K; g.lda = lda; g.ldb = K; g.nNr = N / BM; return g; }

struct StaticOrder {
    int nM, nN, nwg, G, c;
    __host__ __device__ void init(int M, int N, int G_, int c_) { nM = M / BM; nN = N / BM; nwg = nM * nN; G = G_; c = c_; }
    __host__ __device__ bool next(int i, Unit& u) const {
        const long L = (long)i * G + c; if (L >= nwg) return false;
        int wgid = (int)L; { const int q = nwg / NXCD, r = nwg % NXCD, xcd = wgid % NXCD, off = wgid / NXCD; wgid = (xcd < r ? xcd * (q + 1) : r * (q + 1) + (xcd - r) * q) + off; }
        const int nig = WGM * nN, gid = wgid / nig, fm = gid * WGM, gsz = (nM - fm) < WGM ? (nM - fm) : WGM;
        u.pm = fm + ((wgid % nig) % gsz); u.pn = (wgid % nig) / gsz; return true;
    }
    __device__ __forceinline__ void a_ready(const Unit&) const {}
    __device__ __forceinline__ void done(const Unit&) const {}
};


__device__ __forceinline__ unsigned cvt_pk_bf16(float lo, float hi) { unsigned r; asm volatile("v_cvt_pk_bf16_f32 %0, %1, %2" : "=v"(r) : "v"(lo), "v"(hi)); return r; }
struct EpiBf16 {
    static constexpr bool PERM = true, AFTER_DRAIN = false;
    bf16_t* O; int ldc;
    __device__ __forceinline__ void operator()(const f32x4 (&acc)[2][2][4][2], const Unit& u, int wr, int wc, int fr, int fq) const {
        const int row0 = u.pm * BM + wr * 64 + fr, col0 = u.pn * BM + wc * 32 + 8 * fq;
#pragma unroll
        for (int ai = 0; ai < 2; ++ai)
#pragma unroll
            for (int m = 0; m < 4; ++m) { bf16_t* rowp = O + (size_t)(row0 + ai * HALF + m * 16) * ldc + col0;
#pragma unroll
                for (int bj = 0; bj < 2; ++bj) { const f32x4 v0 = acc[ai][bj][m][0], v1 = acc[ai][bj][m][1];
                    u32x4 w; w.x = cvt_pk_bf16(v0[0], v0[1]); w.y = cvt_pk_bf16(v0[2], v0[3]); w.z = cvt_pk_bf16(v1[0], v1[1]); w.w = cvt_pk_bf16(v1[2], v1[3]);
                    *(u32x4*)(rowp + bj * HALF) = w; } }
    }
};
struct EpiF32 {
    static constexpr bool PERM = false, AFTER_DRAIN = false;
    float* O; int ldc;
    __device__ __forceinline__ void operator()(const f32x4 (&acc)[2][2][4][2], const Unit& u, int wr, int wc, int fr, int fq) const {
        const int row0 = u.pm * BM + wr * 64 + fr, col0 = u.pn * BM + wc * 32 + 4 * fq;
#pragma unroll
        for (int ai = 0; ai < 2; ++ai)
#pragma unroll
            for (int m = 0; m < 4; ++m) { float* rowp = O + (size_t)(row0 + ai * HALF + m * 16) * ldc + col0;
#pragma unroll
                for (int bj = 0; bj < 2; ++bj)
#pragma unroll
                    for (int n = 0; n < 2; ++n) *(f32x4*)(rowp + bj * HALF + n * 16) = acc[ai][bj][m][n]; }
    }
};
struct EpiF32Split {
    static constexpr bool PERM = false, AFTER_DRAIN = false;
    float* O; int ldc; int nNr; size_t sstride;
    __device__ __forceinline__ void operator()(const f32x4 (&acc)[2][2][4][2], const Unit& u, int wr, int wc, int fr, int fq) const {
        const int s = u.pn / nNr, pn = u.pn - s * nNr;
        const int row0 = u.pm * BM + wr * 64 + fr, col0 = pn * BM + wc * 32 + 4 * fq; float* Ob = O + (size_t)s * sstride;
#pragma unroll
        for (int ai = 0; ai < 2; ++ai)
#pragma unroll
            for (int m = 0; m < 4; ++m) { float* rowp = Ob + (size_t)(row0 + ai * HALF + m * 16) * ldc + col0;
#pragma unroll
                for (int bj = 0; bj < 2; ++bj)
#pragma unroll
                    for (int n = 0; n < 2; ++n) *(f32x4*)(rowp + bj * HALF + n * 16) = acc[ai][bj][m][n]; }
    }
};
__device__ __forceinline__ float silu_mul(float g, float u) { return g * __builtin_amdgcn_rcpf(1.0f + __builtin_amdgcn_exp2f(-1.4426950408889634f * g)) * u; }
struct EpiSwiglu {
    static constexpr bool PERM = true, AFTER_DRAIN = false;
    bf16_t* O; int ldc;
    __device__ __forceinline__ void operator()(const f32x4 (&acc)[2][2][4][2], const Unit& u, int wr, int wc, int fr, int fq) const {
        const int row0 = u.pm * BM + wr * 64 + fr, col0 = u.pn * HALF + wc * 32 + 8 * fq;
#pragma unroll
        for (int ai = 0; ai < 2; ++ai)
#pragma unroll
            for (int m = 0; m < 4; ++m) { bf16_t* rowp = O + (size_t)(row0 + ai * HALF + m * 16) * ldc + col0;
                const f32x4 g0 = acc[ai][0][m][0], g1 = acc[ai][0][m][1], u0 = acc[ai][1][m][0], u1 = acc[ai][1][m][1];
                u32x4 w; w.x = cvt_pk_bf16(silu_mul(g0[0], u0[0]), silu_mul(g0[1], u0[1])); w.y = cvt_pk_bf16(silu_mul(g0[2], u0[2]), silu_mul(g0[3], u0[3]));
                w.z = cvt_pk_bf16(silu_mul(g1[0], u1[0]), silu_mul(g1[1], u1[1])); w.w = cvt_pk_bf16(silu_mul(g1[2], u1[2]), silu_mul(g1[3], u1[3]));
                *(u32x4*)rowp = w; }
    }
};

template <class Epi, class Sched, bool ALIGN_EPI = false, bool SP2 = false>
__device__ __forceinline__ void gemm_phase(PG8_LAS unsigned char* lds, const Gemm g, const Sched& S, const Epi& E, const int wave0) {
    const int tid = fresh_tid(wave0), wid = __builtin_amdgcn_readfirstlane(tid >> 6), lane = tid & 63, wr = wid >> 2, wc = wid & 3, fr = lane & 15, fq = lane >> 4;
    const int K = g.K, nt = K / BK;
    unsigned voffA[2], voffB[2];
#pragma unroll
    for (int i = 0; i < 2; ++i) { int R, C; stage_rc(tid * 16 + i * 8192, R, C); const int Rb = Epi::PERM ? ((R & ~31) + perm32(R & 31)) : R;
        voffA[i] = (unsigned)(R * g.lda + C) * 2u; voffB[i] = (unsigned)(Rb * g.ldb + C) * 2u; }
    const size_t kstep = (size_t)(BK * 2);
    const size_t hstepA = (size_t)HALF * g.lda * 2, hstepB = (size_t)HALF * g.ldb * 2; const size_t ksb = (size_t)K * 2;
#define PG8_APTR(u) ((const char*)g.A + (size_t)(u).pm * tstepA + (size_t)((u).pn / g.nNr) * ksb)
#define PG8_BPTR(u) ((const char*)g.Bt + (size_t)((u).pn % g.nNr) * tstepB + (size_t)((u).pn / g.nNr) * ksb)
    const size_t tstepA = 2 * hstepA, tstepB = 2 * hstepB;
    const unsigned ldsw = (unsigned)wid * 1024u;
    const int aoff = lds_byte(wr * 64 + fr, fq * 8), boff = lds_byte(wc * 32 + fr, fq * 8);
#define PG8_SA(b, h) (((b) * 2 + (h)) * HTB)
#define PG8_SB(b, h) ((4 + (b) * 2 + (h)) * HTB)
#define PG8_STAGE(bufoff, gbase, voff) do { _Pragma("unroll") for (int _i = 0; _i < 2; ++_i) \
        __builtin_amdgcn_global_load_lds((const unsigned*)((const char*)(gbase) + (voff)[_i]), (PG8_LAS unsigned*)(lds + (bufoff) + ldsw + _i * 8192), 16, 0, 0); } while (0)
#define PG8_LDA(dst, b, h) do { _Pragma("unroll") for (int m = 0; m < 4; ++m) _Pragma("unroll") for (int k = 0; k < 2; ++k) dst[m][k] = *(const PG8_LAS bf16x8*)(lds + PG8_SA(b, h) + aoff + m * 2048 + k * 1024); } while (0)
#define PG8_LDB(dst, b, h) do { _Pragma("unroll") for (int n = 0; n < 2; ++n) _Pragma("unroll") for (int k = 0; k < 2; ++k) dst[n][k] = *(const PG8_LAS bf16x8*)(lds + PG8_SB(b, h) + boff + n * 2048 + k * 1024); } while (0)
#define PG8_MMA(ai, bj, At, Bt) do { __builtin_amdgcn_s_setprio(1); _Pragma("unroll") for (int m = 0; m < 4; ++m) _Pragma("unroll") for (int n = 0; n < 2; ++n) _Pragma("unroll") for (int k = 0; k < 2; ++k) \
        acc[ai][bj][m][n] = __builtin_amdgcn_mfma_f32_16x16x32_bf16(Bt[n][k], At[m][k], acc[ai][bj][m][n], 0, 0, 0); __builtin_amdgcn_s_setprio(0); } while (0)
#define PG8_WAIT_V(n) asm volatile("s_waitcnt vmcnt(" #n ")" ::: "memory")
#define PG8_WAIT_L(n) asm volatile("s_waitcnt lgkmcnt(" #n ")" ::: "memory")
#define PG8_BAR __builtin_amdgcn_s_barrier()
#define PG8_SCHED __builtin_amdgcn_sched_barrier(0)
    Unit cur, nxt; int ui = 0;
    if (!S.next(0, cur)) return;
    f32x4 acc[2][2][4][2];
#pragma unroll
    for (int a = 0; a < 2; ++a)
#pragma unroll
        for (int b = 0; b < 2; ++b)
#pragma unroll
            for (int m = 0; m < 4; ++m)
#pragma unroll
                for (int n = 0; n < 2; ++n) acc[a][b][m][n] = (f32x4){0.f, 0.f, 0.f, 0.f};
    bf16x8 At[4][2], B0[2][2], B1[2][2];
    const char* cA = PG8_APTR(cur); const char* cB = PG8_BPTR(cur);
    S.a_ready(cur);
    if constexpr (SP2) {
        PG8_STAGE(PG8_SB(0, 0), cB, voffB); PG8_STAGE(PG8_SB(0, 1), cB + hstepB, voffB); PG8_STAGE(PG8_SA(0, 0), cA, voffA); PG8_STAGE(PG8_SA(0, 1), cA + hstepA, voffA);
        if (wr == 1) PG8_BAR;
        PG8_WAIT_V(2); PG8_BAR;
        PG8_STAGE(PG8_SB(1, 0), cB + kstep, voffB); PG8_STAGE(PG8_SA(1, 0), cA + kstep, voffA); PG8_STAGE(PG8_SB(1, 1), cB + hstepB + kstep, voffB);
        PG8_WAIT_V(6); PG8_BAR;
    } else {
        PG8_STAGE(PG8_SB(0, 0), cB, voffB); PG8_STAGE(PG8_SA(0, 0), cA, voffA); PG8_STAGE(PG8_SB(0, 1), cB + hstepB, voffB); PG8_STAGE(PG8_SA(0, 1), cA + hstepA, voffA);
        if (wr == 1) PG8_BAR;
        PG8_WAIT_V(4); PG8_BAR;
        PG8_STAGE(PG8_SB(1, 0), cB + kstep, voffB); PG8_STAGE(PG8_SA(1, 0), cA + kstep, voffA); PG8_STAGE(PG8_SB(1, 1), cB + hstepB + kstep, voffB);
        PG8_WAIT_V(6); PG8_BAR;
    }
    for (;;) {
        const bool has_next = S.next(ui + 1, nxt);
        const char* nA = has_next ? PG8_APTR(nxt) : cA; const char* nB = has_next ? PG8_BPTR(nxt) : cB;
        for (int t = 0; t < nt; t += 2) {
            const bool last = (t == nt - 2);
            const char* a1 = cA + (size_t)(t + 1) * kstep;
            const char* a2 = last ? nA : cA + (size_t)(t + 2) * kstep; const char* b2 = last ? nB : cB + (size_t)(t + 2) * kstep;
            const char* a3 = a2 + kstep; const char* b3 = b2 + kstep;
            if (last && has_next) S.a_ready(nxt);
            if constexpr (SP2) {
            PG8_LDB(B0, 0, 0); PG8_LDB(B1, 0, 1); PG8_SCHED; PG8_LDA(At, 0, 0); PG8_STAGE(PG8_SA(1, 1), a1 + hstepA, voffA);
            PG8_WAIT_V(8); PG8_WAIT_L(0); PG8_BAR; PG8_MMA(0, 0, At, B0); PG8_MMA(0, 1, At, B1); PG8_BAR; PG8_SCHED;
            PG8_LDA(At, 0, 1); PG8_STAGE(PG8_SB(0, 0), b2, voffB); PG8_STAGE(PG8_SB(0, 1), b2 + hstepB, voffB); PG8_STAGE(PG8_SA(0, 0), a2, voffA);
            PG8_WAIT_V(8); PG8_WAIT_L(0); PG8_BAR; PG8_MMA(1, 0, At, B0); PG8_MMA(1, 1, At, B1); PG8_BAR; PG8_SCHED;
            PG8_LDB(B0, 1, 0); PG8_LDB(B1, 1, 1); PG8_SCHED; PG8_LDA(At, 1, 0); PG8_STAGE(PG8_SA(0, 1), a2 + hstepA, voffA);
            PG8_WAIT_V(8); PG8_WAIT_L(0); PG8_BAR; PG8_MMA(0, 0, At, B0); PG8_MMA(0, 1, At, B1); PG8_BAR; PG8_SCHED;
            PG8_LDA(At, 1, 1); PG8_STAGE(PG8_SB(1, 0), b3, voffB); PG8_STAGE(PG8_SB(1, 1), b3 + hstepB, voffB); PG8_STAGE(PG8_SA(1, 0), a3, voffA);
            PG8_WAIT_V(8); PG8_WAIT_L(0); PG8_BAR; PG8_MMA(1, 0, At, B0); PG8_MMA(1, 1, At, B1); PG8_BAR; PG8_SCHED;
            } else {
            PG8_LDB(B0, 0, 0); PG8_SCHED; PG8_LDA(At, 0, 0); PG8_STAGE(PG8_SA(1, 1), a1 + hstepA, voffA);
            PG8_WAIT_L(8); PG8_BAR; PG8_WAIT_L(0); PG8_MMA(0, 0, At, B0); PG8_BAR; PG8_SCHED;
            PG8_LDB(B1, 0, 1); PG8_STAGE(PG8_SB(0, 0), b2, voffB);
            PG8_BAR; PG8_WAIT_L(0); PG8_MMA(0, 1, At, B1); PG8_BAR;
            PG8_LDA(At, 0, 1); PG8_STAGE(PG8_SA(0, 0), a2, voffA);
            PG8_BAR; PG8_WAIT_L(0); PG8_MMA(1, 0, At, B0); PG8_BAR; PG8_SCHED;
            PG8_STAGE(PG8_SB(0, 1), b2 + hstepB, voffB);
            PG8_WAIT_V(6); PG8_BAR; PG8_MMA(1, 1, At, B1); PG8_BAR;
            PG8_LDB(B0, 1, 0); PG8_SCHED; PG8_LDA(At, 1, 0); PG8_STAGE(PG8_SA(0, 1), a2 + hstepA, voffA);
            PG8_WAIT_L(8); PG8_BAR; PG8_WAIT_L(0); PG8_MMA(0, 0, At, B0); PG8_BAR; PG8_SCHED;
            PG8_LDB(B1, 1, 1); PG8_STAGE(PG8_SB(1, 0), b3, voffB);
            PG8_BAR; PG8_WAIT_L(0); PG8_MMA(0, 1, At, B1); PG8_BAR;
            PG8_LDA(At, 1, 1); PG8_STAGE(PG8_SA(1, 0), a3, voffA);
            PG8_BAR; PG8_WAIT_L(0); PG8_MMA(1, 0, At, B0); PG8_BAR; PG8_SCHED;
            PG8_STAGE(PG8_SB(1, 1), b3 + hstepB, voffB);
            PG8_WAIT_V(6); PG8_BAR; PG8_MMA(1, 1, At, B1); PG8_BAR;
            }
        }
        if constexpr (ALIGN_EPI) { if (wr == 0) PG8_BAR; }
        if constexpr (!Epi::AFTER_DRAIN) { E(acc, cur, wr, wc, fr, fq); S.done(cur); }
        if (!has_next) break;
#pragma unroll
        for (int a = 0; a < 2; ++a)
#pragma unroll
            for (int b = 0; b < 2; ++b)
#pragma unroll
                for (int m = 0; m < 4; ++m)
#pragma unroll
                    for (int n = 0; n < 2; ++n) acc[a][b][m][n] = (f32x4){0.f, 0.f, 0.f, 0.f};
        cur = nxt; cA = nA; cB = nB; ++ui;
        if constexpr (ALIGN_EPI) { if (wr == 1) PG8_BAR; }
    }
    PG8_WAIT_V(0);
    if constexpr (!ALIGN_EPI) { if (wr == 0) PG8_BAR; }
    PG8_BAR;
    if constexpr (Epi::AFTER_DRAIN) { E.fused(acc, cur, wr, wc, fr, fq, lds, wid, lane); S.done(cur); }
#undef PG8_APTR
#undef PG8_BPTR
#undef PG8_SA
#undef PG8_SB
#undef PG8_STAGE
#undef PG8_LDA
#undef PG8_LDB
#undef PG8_MMA
#undef PG8_WAIT_V
#undef PG8_WAIT_L
#undef PG8_BAR
#undef PG8_SCHED
}
}
namespace att {
typedef unsigned short bf16;
typedef short bf16x8 __attribute__((ext_vector_type(8)));
typedef short s16x4 __attribute__((ext_vector_type(4)));
typedef float f32x16 __attribute__((ext_vector_type(16)));
typedef unsigned u32x4 __attribute__((ext_vector_type(4)));
constexpr int NW = 8, QBLK = 32, KVBLK = 64;
constexpr int SHM_V = KVBLK * 128 * 2;
#define SBAR() __builtin_amdgcn_sched_barrier(0)
__device__ __forceinline__ int crow(int r, int hi) { return (r & 3) + 8 * (r >> 2) + 4 * hi; }
__device__ __forceinline__ unsigned cvtpk(float lo, float hi) { unsigned r; asm volatile("v_cvt_pk_bf16_f32 %0, %1, %2" : "=v"(r) : "v"(lo), "v"(hi)); return r; }

struct Args {
  const bf16* Q; const bf16* K; const bf16* K2; const bf16* V; bf16* O;
  int ldq, ldk, ldk2, ldv, ldo;
  int NT, nctx, ctx_row0, lat_row0;
  float C, thr_raw;
  int qpos0, kpos0;
  float sink_l2;
  int r0, klo;
  const float* rpb; float inv_scale;
  const float* qgain;
  int qrope_t0;
};

template <bool FIRST> __device__ __forceinline__ void partialSM(f32x16& p0, f32x16& p1, float& m_reg, float& alpha, f32x16& negm, const float thr) {
  float pmax = p0[0];
#pragma unroll
  for (int r = 1; r < 16; ++r) pmax = fmaxf(pmax, p0[r]);
#pragma unroll
  for (int r = 0; r < 16; ++r) pmax = fmaxf(pmax, p1[r]);
  { auto rr = __builtin_amdgcn_permlane32_swap(__float_as_uint(pmax), __float_as_uint(pmax), false, false);
    pmax = fmaxf(__uint_as_float(rr[0]), __uint_as_float(rr[1])); }
  alpha = 1.f;
  if (FIRST || !__builtin_expect(__all(pmax <= thr), 1)) {
    const float delta = FIRST ? pmax : fmaxf(pmax, 0.f);
    m_reg += delta; if (!FIRST) alpha = __builtin_amdgcn_exp2f(-delta);
#pragma unroll
    for (int r = 0; r < 16; ++r) { p0[r] -= delta; p1[r] -= delta; }
    const float nm = -m_reg;
#pragma unroll
    for (int r = 0; r < 16; ++r) negm[r] = nm;
    asm volatile("" : "+v"(negm));
  }
#pragma unroll
  for (int r = 0; r < 16; ++r) p0[r] = __builtin_amdgcn_exp2f(p0[r]);
}
__device__ __forceinline__ void finishSM(f32x16& p0, f32x16& p1, float alpha, float& l_reg, bf16x8& pa0, bf16x8& pa1, bf16x8& pa2, bf16x8& pa3) {
#pragma unroll
  for (int r = 0; r < 16; ++r) p1[r] = __builtin_amdgcn_exp2f(p1[r]);
  float ps = 0;
#pragma unroll
  for (int r = 0; r < 16; ++r) ps += p0[r];
#pragma unroll
  for (int r = 0; r < 16; ++r) ps += p1[r];
  { auto rr = __builtin_amdgcn_permlane32_swap(__float_as_uint(ps), __float_as_uint(ps), false, false);
    ps = __uint_as_float(rr[0]) + __uint_as_float(rr[1]); }
  l_reg = l_reg * alpha + ps;
#define PK4(P, BASE, OUT) do { unsigned a0 = cvtpk(P[BASE + 0], P[BASE + 1]), a1 = cvtpk(P[BASE + 2], P[BASE + 3]);   \
    unsigned b0 = cvtpk(P[BASE + 4], P[BASE + 5]), b1 = cvtpk(P[BASE + 6], P[BASE + 7]);                              \
    auto r0 = __builtin_amdgcn_permlane32_swap(a0, b0, false, false); auto r1 = __builtin_amdgcn_permlane32_swap(a1, b1, false, false); \
    u32x4 w = {r0[0], r1[0], r0[1], r1[1]}; OUT = *reinterpret_cast<bf16x8*>(&w); } while (0)
  PK4(p0, 0, pa0); PK4(p0, 8, pa1); PK4(p1, 0, pa2); PK4(p1, 8, pa3);
#undef PK4
}
template <int DQ> __device__ __forceinline__ int kswz(int row, int colB) { return row * (DQ * 2) + (colB ^ ((row & 7) << 4)); }
typedef const __attribute__((address_space(3))) bf16x8* lds_b128_ptr;
template <int DQ> __device__ __forceinline__ void qkt(f32x16& p0, f32x16& p1, const int (&kx)[4], int koff, const bf16x8* qr, const f32x16& negm) {
  lds_b128_ptr k0 = (lds_b128_ptr)(unsigned)(kx[0] + koff), k1 = (lds_b128_ptr)(unsigned)(kx[1] + koff), k2 = (lds_b128_ptr)(unsigned)(kx[2] + koff), k3 = (lds_b128_ptr)(unsigned)(kx[3] + koff);
#pragma unroll
  for (int d0 = 0; d0 < DQ / 16; ++d0) { lds_b128_ptr kp = (d0 & 3) == 0 ? k0 : (d0 & 3) == 1 ? k1 : (d0 & 3) == 2 ? k2 : k3;
    const bf16x8 b0 = kp[(d0 >> 2) * 8];
    const bf16x8 b1 = kp[(d0 >> 2) * 8 + 32 * DQ * 2 / 16];
    if (d0 == 0) { p0 = __builtin_amdgcn_mfma_f32_32x32x16_bf16(b0, qr[0], negm, 0, 0, 0); p1 = __builtin_amdgcn_mfma_f32_32x32x16_bf16(b1, qr[0], negm, 0, 0, 0); }
    else { p0 = __builtin_amdgcn_mfma_f32_32x32x16_bf16(b0, qr[d0], p0, 0, 0, 0); p1 = __builtin_amdgcn_mfma_f32_32x32x16_bf16(b1, qr[d0], p1, 0, 0, 0); } }
}
__device__ __forceinline__ int v_st(int k, int c) { const int kk = (k & ~0xC) | ((k & 4) << 1) | ((k & 8) >> 1); return ((kk >> 3) * 4 + (c >> 5)) * 512 + ((kk & 7) * 32 + (c & 31)) * 2; }
__device__ __forceinline__ int v_rd_base(int lane) { return ((lane & 3) << 3) | (((lane >> 2) & 3) << 6) | (((lane >> 4) & 1) << 5) | (((lane >> 5) & 1) << 8); }
constexpr int v_rd_off(int d0, int ks, int half) { return d0 * 512 + ks * 4096 + half * 2048; }
template <int OFF> __device__ __forceinline__ s16x4 tr_read(int vb) {
  s16x4 r; asm volatile("ds_read_b64_tr_b16 %0, %1 offset:%2" : "=&v"(r) : "v"(vb), "i"(OFF) : "memory"); return r;
}
template <int D0> __device__ __forceinline__ void pv_one(f32x16& od, int vb, bf16x8 pa0, bf16x8 pa1, bf16x8 pa2, bf16x8 pa3) {
  const s16x4 l0 = tr_read<v_rd_off(D0, 0, 0)>(vb), h0 = tr_read<v_rd_off(D0, 0, 1)>(vb), l1 = tr_read<v_rd_off(D0, 1, 0)>(vb), h1 = tr_read<v_rd_off(D0, 1, 1)>(vb);
  const s16x4 l2 = tr_read<v_rd_off(D0, 2, 0)>(vb), h2 = tr_read<v_rd_off(D0, 2, 1)>(vb), l3 = tr_read<v_rd_off(D0, 3, 0)>(vb), h3 = tr_read<v_rd_off(D0, 3, 1)>(vb);
  asm volatile("s_waitcnt lgkmcnt(0)" ::: "memory"); SBAR();
#define PK(L, H) (bf16x8){L[0], L[1], L[2], L[3], H[0], H[1], H[2], H[3]}
  od = __builtin_amdgcn_mfma_f32_32x32x16_bf16(pa0, PK(l0, h0), od, 0, 0, 0);
  od = __builtin_amdgcn_mfma_f32_32x32x16_bf16(pa1, PK(l1, h1), od, 0, 0, 0);
  od = __builtin_amdgcn_mfma_f32_32x32x16_bf16(pa2, PK(l2, h2), od, 0, 0, 0);
  od = __builtin_amdgcn_mfma_f32_32x32x16_bf16(pa3, PK(l3, h3), od, 0, 0, 0);
#undef PK
}
__device__ __forceinline__ void pv_d0(f32x16* o, int vb, bf16x8 pa0, bf16x8 pa1, bf16x8 pa2, bf16x8 pa3) {
  pv_one<0>(o[0], vb, pa0, pa1, pa2, pa3); pv_one<1>(o[1], vb, pa0, pa1, pa2, pa3); pv_one<2>(o[2], vb, pa0, pa1, pa2, pa3); pv_one<3>(o[3], vb, pa0, pa1, pa2, pa3);
}
template <int MODE> __device__ __forceinline__ void maskf(f32x16& p0, f32x16& p1, int t, const Args& a, int wid, int r32, int hi, const float* bias_lds) {
  if constexpr (MODE == 0) { return; }
  else {
    if (t < a.nctx) return;
    if constexpr (MODE == 1) {
      const int kb = a.kpos0 + (t - a.nctx) * 64, qw = a.qpos0 + wid * 32;
      if (kb + 63 - qw <= 128 && qw + 31 - kb <= 128) return;
      int base = kb + 4 * hi - (qw + r32);
      asm volatile("" : "+v"(base));
#pragma unroll
      for (int r = 0; r < 16; ++r) { const int d0 = base + (r & 3) + 8 * (r >> 2);
        if ((unsigned)(d0 + 128) > 256u) p0[r] = -1e30f;
        if ((unsigned)(d0 + 160) > 256u) p1[r] = -1e30f; }
    } else {
      const int kr = a.klo + (t - a.nctx), rq = a.r0 + (wid >> 1);
      const int rs = min(max(rq - 4, 0), 120);
      if (kr < rs || kr >= rs + 8) {
#pragma unroll
        for (int r = 0; r < 16; ++r) { p0[r] = -1e30f; p1[r] = -1e30f; }
        return; }
      const int c = (wid & 1) * 32 + r32, cs = min(max(c - 8, 0), 48);
      int cb = 4 * hi - c + 63, vb = 4 * hi - cs;
      asm volatile("" : "+v"(cb), "+v"(vb));
      const float* bp = bias_lds + (kr - rq + 7) * 128 + cb;
#pragma unroll
      for (int r = 0; r < 16; ++r) { const int k0 = (r & 3) + 8 * (r >> 2), k1 = k0 + 32;
        const float b0 = bp[k0], b1 = bp[k1];
        p0[r] = ((unsigned)(k0 + vb) < 16u) ? fmaf(b0, a.inv_scale, p0[r]) : -1e30f;
        p1[r] = ((unsigned)(k1 + vb) < 16u) ? fmaf(b1, a.inv_scale, p1[r]) : -1e30f;
        if ((r & 3) == 3) SBAR(); }
    }
  }
}

template <int DQ, int MODE>
__device__ __forceinline__ void attn_unit(const Args& a, char* lds, const int wave0) {
  constexpr int SHM_K = KVBLK * DQ * 2, NQ = DQ / 16, OFF_K = 3 * SHM_V, OFF_WS = OFF_K + 2 * SHM_K;
  const int tid = fresh_tid(wave0), wid = tid >> 6, lane = tid & 63, r32 = lane & 31, hi = lane >> 5;
  char* V_lds = lds; char* K_lds = lds + OFF_K;
  float* ws = (float*)(lds + OFF_WS) + wid * 64; float* li_l = ws; float* al_l = ws + 32;
  float* bias_l = (float*)(lds + OFF_WS + 2048);
  if constexpr (MODE == 2) { if (tid < 465) bias_l[(tid / 31) * 128 + 48 + (tid % 31)] = a.rpb[tid]; }
  float m_reg = 0.f, l_reg = 0; f32x16 o[4] = {}; bf16x8 qr[NQ];
  const float thr = a.thr_raw;
  const bf16* Qw = a.Q + (long)(wid * QBLK + r32) * a.ldq + hi * 8;
#pragma unroll
  for (int d0 = 0; d0 < NQ; ++d0) qr[d0] = *reinterpret_cast<const bf16x8*>(Qw + d0 * 16);
  if constexpr (DQ == 128) {
    if (a.qgain) { float xf[8][8]; float ss = 0.f;
#pragma unroll
      for (int d0 = 0; d0 < 8; ++d0)
#pragma unroll
        for (int e = 0; e < 8; ++e) { xf[d0][e] = __uint_as_float(((unsigned)(unsigned short)qr[d0][e]) << 16); ss += xf[d0][e] * xf[d0][e]; }
      { auto rr = __builtin_amdgcn_permlane32_swap(__float_as_uint(ss), __float_as_uint(ss), false, false); ss = __uint_as_float(rr[0]) + __uint_as_float(rr[1]); }
      const float rstd = rsqrtf(ss * (1.0f / 128.0f) + 1e-6f) * a.C;
#pragma unroll
      for (int d0 = 0; d0 < 8; ++d0) { const float* gp = a.qgain + d0 * 16 + hi * 8;
#pragma unroll
        for (int e = 0; e < 8; ++e) xf[d0][e] = xf[d0][e] * rstd * gp[e]; }
      if (a.qrope_t0 >= 0) { const int t = a.qrope_t0 + wid * QBLK + r32; const float prow = (float)(t >> 6), pcol = (float)(t & 63);
#pragma unroll
        for (int half = 0; half < 2; ++half)
#pragma unroll
          for (int blk = 0; blk < 2; ++blk)
#pragma unroll
            for (int e = 0; e < 8; ++e) { const int j = blk * 16 + hi * 8 + e, da = 4 * half + blk, db = da + 2;
              const float inv_freq = __builtin_amdgcn_exp2f(-(float)j * (13.287712379549449f / 32.0f)); float rev = (half ? pcol : prow) * inv_freq * 0.15915494309189535f; rev -= rintf(rev);
              const float sn = __builtin_amdgcn_sinf(rev), cs = __builtin_amdgcn_cosf(rev);
              const float x = xf[da][e], y = xf[db][e]; xf[da][e] = x * cs - y * sn; xf[db][e] = y * cs + x * sn; } }
#pragma unroll
      for (int d0 = 0; d0 < 8; ++d0) { bf16x8 w;
#pragma unroll
        for (int e = 0; e < 8; ++e) { unsigned u = __float_as_uint(xf[d0][e]); u = (u + 0x7fffu + ((u >> 16) & 1u)) >> 16; w[e] = (short)u; }
        qr[d0] = w; } } }
  if constexpr (DQ == 192) {
    if (a.qrope_t0 >= 0) { const int t = a.qrope_t0 + wid * QBLK + r32; const float prow = (float)(t >> 6), pcol = (float)(t & 63);
#pragma unroll
      for (int half = 0; half < 2; ++half) { bf16x8 xa = qr[8 + 2 * half], xb = qr[9 + 2 * half]; const float pos = half ? pcol : prow;
#pragma unroll
        for (int e = 0; e < 8; ++e) { const int j = hi * 8 + e;
          const float inv_freq = __builtin_amdgcn_exp2f(-(float)j * (13.287712379549449f / 16.0f)); float rev = pos * inv_freq * 0.15915494309189535f; rev -= rintf(rev);
          const float sn = __builtin_amdgcn_sinf(rev), cs = __builtin_amdgcn_cosf(rev);
          const float x = __uint_as_float(((unsigned)(unsigned short)xa[e]) << 16), y = __uint_as_float(((unsigned)(unsigned short)xb[e]) << 16);
          const float nx = x * cs - y * sn, ny = y * cs + x * sn; unsigned ux = __float_as_uint(nx), uy = __float_as_uint(ny);
          ux = (ux + 0x7fffu + ((ux >> 16) & 1u)) >> 16; uy = (uy + 0x7fffu + ((uy >> 16) & 1u)) >> 16; xa[e] = (short)ux; xb[e] = (short)uy; }
        qr[8 + 2 * half] = xa; qr[9 + 2 * half] = xb; } } }
  const int vb0 = (int)(uintptr_t)V_lds + v_rd_base(lane);
  int kx[4];
#pragma unroll
  for (int q = 0; q < 4; ++q) kx[q] = (int)(uintptr_t)K_lds + r32 * (DQ * 2) + ((q * 32 + hi * 16) ^ ((r32 & 7) << 4));
  constexpr int KP = DQ / 64;
  int koff[KP]; bool kk2[KP]; int voff[2];
#pragma unroll
  for (int i = 0; i < KP; ++i) { const int q = (wid * KP + i) * 64 + lane, row = q / (DQ / 8), cs = q % (DQ / 8), c = cs ^ (row & 7);
    kk2[i] = (DQ == 192) && c >= 16; koff[i] = kk2[i] ? row * a.ldk2 + (c - 16) * 8 : row * a.ldk + c * 8; }
#pragma unroll
  for (int i = 0; i < 2; ++i) { const int q = (wid * 2 + i) * 64 + lane, sub = q >> 5, within = q & 31, kk = (sub >> 2) * 8 + (within >> 2), c = (sub & 3) * 32 + (within & 3) * 8;
    const int k = (kk & ~0xC) | ((kk & 4) << 1) | ((kk & 8) >> 1); voff[i] = k * a.ldv + c; }
  const unsigned kdst0 = (unsigned)(uintptr_t)K_lds + (unsigned)(wid * KP) * 1024u, vdst0 = (unsigned)(uintptr_t)V_lds + (unsigned)(wid * 2) * 1024u;
#define KROW(t) ((t) < a.nctx ? a.ctx_row0 + 64 * (t) : a.lat_row0 + 64 * ((t) - a.nctx))
#define GLDS16(gsrc, ldst) do { unsigned keep_; asm volatile("s_mov_b32 %0, m0\n\ts_mov_b32 m0, %2\n\ts_nop 0\n\tglobal_load_lds_dwordx4 %1, off\n\ts_mov_b32 m0, %0" : "=&s"(keep_) : "v"(gsrc), "s"(ldst) : "memory"); } while (0)
#define DMA(t) do { const long kr_ = KROW(t); const unsigned kd_ = (unsigned)__builtin_amdgcn_readfirstlane((int)(kdst0 + (unsigned)(((t) & 1) * SHM_K))), vd_ = (unsigned)__builtin_amdgcn_readfirstlane((int)(vdst0 + (unsigned)(((t) % 3) * SHM_V))); \
    const bf16* vp_ = a.V + kr_ * a.ldv; const bf16* kp_ = a.K + kr_ * a.ldk; const bf16* kp2_ = (DQ == 192) ? a.K2 + kr_ * a.ldk2 : kp_; \
    _Pragma("unroll") for (int i_ = 0; i_ < KP; ++i_) { const bf16* g_ = ((DQ == 192) && kk2[i_] ? kp2_ : kp_) + koff[i_]; GLDS16(g_, kd_ + (unsigned)i_ * 1024u); } \
    _Pragma("unroll") for (int i_ = 0; i_ < 2; ++i_) GLDS16(vp_ + voff[i_], vd_ + (unsigned)i_ * 1024u); } while (0)
#define WAIT_BAR() asm volatile("s_waitcnt vmcnt(0) lgkmcnt(0)\n\ts_barrier" ::: "memory")
#define RESC(al) do { if (__any((al) < 1.f)) { if (hi == 0) al_l[r32] = (al); asm volatile("s_waitcnt lgkmcnt(0)" ::: "memory"); \
    _Pragma("unroll") for (int d = 0; d < 4; ++d) _Pragma("unroll") for (int r = 0; r < 16; ++r) o[d][r] *= al_l[crow(r, hi)]; } } while (0)
  f32x16 pA0, pA1, pB0, pB1; float mnA, mnB, alA, alB; bf16x8 pa0, pa1, pa2, pa3; const int NT = a.NT;
#define STEP(j, PN0, PN1, MNN, ALN, PP0, PP1, ALP) do { const int j_ = (j); \
    WAIT_BAR();                            \
    if (j_ + 1 < NT) DMA(j_ + 1);          \
    SBAR(); qkt<DQ>(PN0, PN1, kx, (j_ & 1) * SHM_K, qr, negm); maskf<MODE>(PN0, PN1, j_, a, wid, r32, hi, bias_l); \
    finishSM(PP0, PP1, ALP, l_reg, pa0, pa1, pa2, pa3); SBAR(); \
    pv_d0(o, vb0 + ((j_ - 1) % 3) * SHM_V, pa0, pa1, pa2, pa3); partialSM<false>(PN0, PN1, m_reg, ALN, negm, thr); \
    RESC(ALN); } while (0)
  DMA(0); DMA(1);
  f32x16 negm = f32x16{}; asm volatile("" : "+v"(negm));
  WAIT_BAR();
  qkt<DQ>(pA0, pA1, kx, 0, qr, negm); maskf<MODE>(pA0, pA1, 0, a, wid, r32, hi, bias_l); partialSM<true>(pA0, pA1, m_reg, alA, negm, thr);
  for (int j = 1; j + 1 < NT; j += 2) {
    STEP(j, pB0, pB1, mnB, alB, pA0, pA1, alA);
    STEP(j + 1, pA0, pA1, mnA, alA, pB0, pB1, alB);
  }
  STEP(NT - 1, pB0, pB1, mnB, alB, pA0, pA1, alA);
  finishSM(pB0, pB1, alB, l_reg, pa0, pa1, pa2, pa3); SBAR();
  pv_d0(o, vb0 + ((NT - 1) % 3) * SHM_V, pa0, pa1, pa2, pa3);
  if constexpr (MODE == 1) l_reg += __builtin_amdgcn_exp2f(a.sink_l2 - m_reg);
  if (hi == 0) li_l[r32] = l_reg; asm volatile("s_waitcnt lgkmcnt(0)" ::: "memory");
  float rli[16];
#pragma unroll
  for (int r = 0; r < 16; ++r) rli[r] = __builtin_amdgcn_rcpf(li_l[crow(r, hi)]);
  asm volatile("s_waitcnt lgkmcnt(0)\n\ts_barrier" ::: "memory");
  { bf16* stg = (bf16*)(lds + wid * 8704);
#pragma unroll
    for (int r = 0; r < 16; ++r) { const int orow = crow(r, hi);
#pragma unroll
      for (int d0 = 0; d0 < 4; ++d0) { const float v = o[d0][r] * rli[r]; unsigned u = __float_as_uint(v); u = (u + 0x7fffu + ((u >> 16) & 1u)) >> 16; stg[orow * 136 + d0 * 32 + r32] = (bf16)u; } }
    asm volatile("s_waitcnt lgkmcnt(0)" ::: "memory");
    bf16* Ow = a.O + (long)(wid * QBLK) * a.ldo;
#pragma unroll
    for (int i = 0; i < 8; ++i) { const int row = i * 4 + (lane >> 4), ch = lane & 15; const u32x4 v = *(const u32x4*)(stg + row * 136 + ch * 8); *(u32x4*)(Ow + (long)row * a.ldo + ch * 8) = v; } }
  asm volatile("s_waitcnt lgkmcnt(0)\n\ts_barrier" ::: "memory");
#undef KROW
#undef GLDS16
#undef DMA
#undef WAIT_BAR
#undef RESC
#undef STEP
}
#undef SBAR
}
#define LAS __attribute__((address_space(3)))
typedef unsigned short bf16;
typedef float f32x4 __attribute__((ext_vector_type(4)));
typedef unsigned v4u __attribute__((ext_vector_type(4)));
typedef unsigned v2u __attribute__((ext_vector_type(2)));
constexpr int NWAVES = 8, NTHR = 512;
constexpr int DM = 2048, SEQ = 8192, NCTX = 256, MLAT = 2 * SEQ, MALL = MLAT + 2 * NCTX, DFF = 5632;
constexpr int N_IN0 = 2816, N_IN1 = 4608, N_UQ = 1536, N_UKV = 2048, N_GU = 2 * DFF;
constexpr float EPS = 1e-6f;
constexpr size_t MiB = 1u << 20;
constexpr size_t WS_MOD = 0, WS_BAR = 512 * 1024, BAR_BYTES = 16384;
constexpr size_t WS_WIN0 = 1 * MiB, WS_WUQ = WS_WIN0 + 11 * MiB, WS_WUKV = WS_WUQ + 2 * MiB, WS_WOUT0 = WS_WUKV + 2 * MiB, WS_WIN1 = WS_WOUT0 + 8 * MiB, WS_WOUT1 = WS_WIN1 + 18 * MiB,
                 WS_WGU = WS_WOUT1 + 8 * MiB, WS_WD = WS_WGU + 88 * MiB, WS_HCTX = WS_WD + 44 * MiB;
constexpr size_t WS_UO = WS_HCTX + 4 * MiB;
constexpr size_t WS_OB = WS_UO + 66 * MiB;
constexpr size_t WS_BIG = WS_UO + 132 * MiB;
constexpr size_t WS_QB = WS_BIG + 91 * MiB, WS_KVB = WS_BIG + 141 * MiB, WS_UB = WS_BIG + 149 * MiB, WS_END = WS_BIG + 215 * MiB;
static_assert((size_t)MALL * DM * 2 == 66 * MiB && (size_t)MALL * N_IN0 * 2 <= 91 * MiB && (size_t)MALL * N_UQ * 2 <= 50 * MiB && (size_t)MALL * N_IN1 * 2 <= 149 * MiB && (size_t)MALL * DFF * 2 <= 215 * MiB, "ws map");

__device__ __forceinline__ unsigned f2bf(float f) { unsigned u = __builtin_bit_cast(unsigned, f); return (u + 0x7fffu + ((u >> 16) & 1u)) >> 16; }
__device__ __forceinline__ unsigned pk2(float lo, float hi) { return f2bf(lo) | (f2bf(hi) << 16); }
__device__ __forceinline__ float bf2f(bf16 v) { return __uint_as_float(((unsigned)v) << 16); }
__device__ __forceinline__ float wave_sum(float v, int lane) {
#pragma unroll
    for (int o = 1; o < 64; o <<= 1) v += __int_as_float(__builtin_amdgcn_ds_bpermute((lane ^ o) << 2, __float_as_int(v)));
    return v;
}
__device__ __forceinline__ float silu_f(float x) { return x / (1.0f + __expf(-x)); }

#define GAS __attribute__((address_space(1)))
#define XB_TMO      128
#define XB_XCNT(j)  (256  + 64 * (j))
#define XB_XSUB(j)  (1280 + 64 * (j))
#define XB_XGEN(j)  (2304 + 64 * (j))
#define XB_TOP      3328
#define XB_TOPGEN   3392
#define XCD_BAR_WORDS 3456
#define XB_SPIN_CAP (1u << 18)

__device__ __forceinline__ unsigned xb_ld(unsigned* p)              { return __hip_atomic_load(p, __ATOMIC_RELAXED, __HIP_MEMORY_SCOPE_AGENT); }
__device__ __forceinline__ unsigned xb_add(unsigned* p, unsigned v) { return __hip_atomic_fetch_add(p, v, __ATOMIC_RELAXED, __HIP_MEMORY_SCOPE_AGENT); }
__device__ __forceinline__ unsigned xb_xcc_id() { return (unsigned)__builtin_amdgcn_s_getreg((3 << 11) | 20) & 0xFu; }
#define XB_SPIN(cond, bar) do { unsigned _sp = 0; while (cond) { __builtin_amdgcn_s_sleep(1); \
    if ((++_sp & 255u) == 0u) { if (xb_ld(&(bar)[XB_TMO])) break; if (_sp > XB_SPIN_CAP) { atomicAdd(&(bar)[XB_TMO], 1u); break; } } } } while (0)

struct XcdBarrier {
    unsigned* bar; unsigned x;
    volatile LAS unsigned* st;
};

__device__ __forceinline__ XcdBarrier xcd_barrier_post(unsigned* bar, volatile LAS unsigned* st) {
    XcdBarrier b; b.bar = bar; b.x = xb_xcc_id(); b.st = st;
    if (threadIdx.x == 0) (void)xb_add(&bar[XB_XCNT(b.x)], 1u);
    return b;
}
__device__ __forceinline__ void xcd_barrier_complete(unsigned* bar, unsigned x, unsigned& nloc, unsigned& nx) {
    const unsigned G = gridDim.x * gridDim.y * gridDim.z;
    unsigned sum, cnt, mine, sp = 0u;
    for (;;) {
        sum = 0u; cnt = 0u; mine = 0u;
#pragma unroll
        for (unsigned j = 0; j < 16; ++j) { const unsigned c = xb_ld(&bar[XB_XCNT(j)]); sum += c; cnt += (c > 0u) ? 1u : 0u; mine = (j == x) ? c : mine; }
        if (sum == G) break;
        __builtin_amdgcn_s_sleep(1);
        if ((++sp & 255u) == 0u) { if (xb_ld(&bar[XB_TMO])) break; if (sp > XB_SPIN_CAP) { atomicAdd(&bar[XB_TMO], 1u); break; } }
    }
    nloc = mine > 0u ? mine : 1u; nx = cnt > 0u ? cnt : 1u;
}

__device__ __forceinline__ void xcd_barrier(const XcdBarrier& b) {
    asm volatile("s_waitcnt vmcnt(0)" ::: "memory");
    __syncthreads();
    if (threadIdx.x == 0) {
        unsigned* bar = b.bar;
        __builtin_amdgcn_s_waitcnt(0);
        unsigned nloc = b.st[0], nx = b.st[1];
        if (nloc == 0u) { xcd_barrier_complete(bar, b.x, nloc, nx); b.st[0] = nloc; b.st[1] = nx; }
        const unsigned old = xb_add(&bar[XB_XSUB(b.x)], 1u);
        const unsigned gen = old / nloc;
        if (old + 1u == (gen + 1u) * nloc) {
            __builtin_amdgcn_fence(__ATOMIC_RELEASE, "agent");
            asm volatile("s_waitcnt vmcnt(0)" ::: "memory");
            const unsigned og = xb_add(&bar[XB_TOP], 1u);
            const unsigned tg = og / nx;
            if (og + 1u == (tg + 1u) * nx) xb_add(&bar[XB_TOPGEN], 1u);
            else XB_SPIN(xb_ld(&bar[XB_TOPGEN]) == tg, bar);
            __builtin_amdgcn_fence(__ATOMIC_ACQUIRE, "agent");
            xb_add(&bar[XB_XGEN(b.x)], 1u);
            asm volatile("s_waitcnt vmcnt(0)" ::: "memory");
        } else {
            XB_SPIN(xb_ld(&bar[XB_XGEN(b.x)]) == gen, bar);
            __builtin_amdgcn_fence(__ATOMIC_ACQUIRE, "agent");
            asm volatile("s_waitcnt vmcnt(0)" ::: "memory");
        }
    }
    __syncthreads();
}

struct KArgs { const float* in[29]; float* out; unsigned char* ws; };
typedef const __attribute__((address_space(4))) KArgs* KAP;
__device__ __forceinline__ KAP kargs() { KAP p = (KAP)__builtin_amdgcn_kernarg_segment_ptr(); asm volatile("" : "+s"(p)); return p; }

__device__ __forceinline__ void transpose_item(const float* W, int K, int N, bf16* WT, int k0, int n0, int drow0, LAS float* scr, int lane, const float wsc) {
#pragma unroll 8
    for (int i = 0; i < 32; ++i) { const int kk = 2 * i + (lane >> 5); scr[kk * 33 + (lane & 31)] = __builtin_nontemporal_load(W + (size_t)(k0 + kk) * N + n0 + (lane & 31)) * wsc; }
    asm volatile("s_waitcnt lgkmcnt(0)" ::: "memory");
    const int c = lane & 7;
#pragma unroll
    for (int j = 0; j < 4; ++j) { const int n = (lane >> 3) + 8 * j; const LAS float* s = scr + (8 * c) * 33 + n;
        v4u o; o.x = pk2(s[0 * 33], s[1 * 33]); o.y = pk2(s[2 * 33], s[3 * 33]); o.z = pk2(s[4 * 33], s[5 * 33]); o.w = pk2(s[6 * 33], s[7 * 33]);
        *(v4u*)(WT + (size_t)(drow0 + n) * K + k0 + 8 * c) = o; }
    asm volatile("s_waitcnt lgkmcnt(0)" ::: "memory");
}
__device__ __forceinline__ bool conv_matrix(int& it, const float* W, int K, int N, bf16* WT, int mode, LAS float* scr, int lane, const float wsc = 1.0f) {
    const int nblk = N / 32, items = (K / 64) * nblk;
    if (it >= items) { it -= items; return false; }
    const int kb = it / nblk, nb = it % nblk, n0 = 32 * nb;
    const int drow0 = mode == 0 ? n0 : ((n0 >> 7) * 256 + (mode == 2 ? 128 : 0) + (n0 & 127));
    transpose_item(W, K, N, WT, 64 * kb, n0, drow0, scr, lane, wsc);
    return true;
}
__device__ __forceinline__ void p0_weights(KAP a, LAS unsigned char* lds, int gw, int NGW, int wave, int lane) {
    LAS float* scr = (LAS float*)(lds + wave * 8704);
    unsigned char* ws = a->ws;
    constexpr int I_TOTAL = (2048 / 64) * (2624 / 32) + (512 / 64) * (1536 / 32) + (512 / 64) * (2048 / 32) + 2 * (2048 / 64) * (2048 / 32) + (2048 / 64) * (4608 / 32)
                          + 4 * (2048 / 64) * (DFF / 32) + 2 * (DFF / 64) * (2048 / 32);
    for (int item = gw; item < I_TOTAL; item += NGW) {
        int it = item;
        if (conv_matrix(it, a->in[13], 2048, 2624, (bf16*)(ws + WS_WIN0), 0, scr, lane)) continue;
        if (conv_matrix(it, a->in[19], 512, 1536, (bf16*)(ws + WS_WUQ), 0, scr, lane, 0.07216878364870322f * 1.4426950408889634f)) continue;
        if (conv_matrix(it, a->in[20], 512, 2048, (bf16*)(ws + WS_WUKV), 0, scr, lane)) continue;
        if (conv_matrix(it, a->in[14], 2048, 2048, (bf16*)(ws + WS_WOUT0), 0, scr, lane)) continue;
        if (conv_matrix(it, a->in[21], 2048, 4608, (bf16*)(ws + WS_WIN1), 0, scr, lane)) continue;
        if (conv_matrix(it, a->in[22], 2048, 2048, (bf16*)(ws + WS_WOUT1), 0, scr, lane)) continue;
        if (conv_matrix(it, a->in[10], 2048, DFF, (bf16*)(ws + WS_WGU), 1, scr, lane)) continue;
        if (conv_matrix(it, a->in[10] + (size_t)2048 * DFF, 2048, DFF, (bf16*)(ws + WS_WGU + 44 * MiB), 1, scr, lane)) continue;
        if (conv_matrix(it, a->in[11], 2048, DFF, (bf16*)(ws + WS_WGU), 2, scr, lane)) continue;
        if (conv_matrix(it, a->in[11] + (size_t)2048 * DFF, 2048, DFF, (bf16*)(ws + WS_WGU + 44 * MiB), 2, scr, lane)) continue;
        if (conv_matrix(it, a->in[12], DFF, 2048, (bf16*)(ws + WS_WD), 0, scr, lane)) continue;
        conv_matrix(it, a->in[12] + (size_t)2048 * DFF, DFF, 2048, (bf16*)(ws + WS_WD + 22 * MiB), 0, scr, lane);
    }
}
__device__ __forceinline__ void p0_mod(KAP a, LAS unsigned char* lds, int tid) {
    LAS float* sv = (LAS float*)lds;
    LAS float* red = (LAS float*)(lds + 24576);
    const int blk = blockIdx.x; if (blk >= 256) return;
    const int layer = blk >> 7, col0 = (blk & 127) * 96;
    for (int i = tid; i < 3 * 2048; i += NTHR) { const int v = i >> 11, k = i & 2047; const float x = v < 2 ? a->in[1][v * 2048 + k] : a->in[3][k]; sv[i] = silu_f(x); }
    __syncthreads();
    const int c4 = tid % 24, ks = tid / 24;
    if (ks < 21) {
        const float* W = a->in[4] + (size_t)layer * 2048 * 12288 + col0 + 4 * c4;
        f32x4 a0 = {0, 0, 0, 0}, a1 = a0, a2 = a0;
#pragma unroll 8
        for (int k = ks; k < 2048; k += 21) { const f32x4 w = __builtin_nontemporal_load((const f32x4*)(W + (size_t)k * 12288)); a0 += w * sv[k]; a1 += w * sv[2048 + k]; a2 += w * sv[4096 + k]; }
        LAS float* r = red + ks * 288 + 4 * c4;
        *(LAS f32x4*)(r) = a0; *(LAS f32x4*)(r + 96) = a1; *(LAS f32x4*)(r + 192) = a2;
    }
    __syncthreads();
    if (tid < 288) { float s = 0.f;
        for (int q = 0; q < 21; ++q) s += red[q * 288 + tid];
        const int v = tid / 96, j = tid % 96;
        ((float*)(a->ws + WS_MOD))[(size_t)(layer * 3 + v) * 12288 + col0 + j] = s + a->in[5][layer * 12288 + col0 + j]; }
    __syncthreads();
}
__device__ __forceinline__ void store_u(bf16* urow, int lane, const f32x4 (&v)[8], float rstd, const float* g, const float* sh, const float* sc) {
#pragma unroll
    for (int j = 0; j < 8; ++j) { const int ci = 256 * j + 4 * lane; const f32x4 g4 = *(const f32x4*)(g + ci), s4 = *(const f32x4*)(sc + ci), h4 = *(const f32x4*)(sh + ci);
        const f32x4 t = (v[j] * rstd * g4) * (1.0f + s4) + h4; v2u w; w.x = pk2(t[0], t[1]); w.y = pk2(t[2], t[3]); *(v2u*)(urow + ci) = w; }
}
__device__ __forceinline__ void pass_pre(const float* hlat, const float* hctx, const float* g, const float* mod, int sh_off, int sc_off, bf16* U, int nrows, int gw, int NGW, int lane) {
    for (int m0 = gw; m0 < nrows; m0 += 2 * NGW) {
        int mr[2]; mr[0] = m0; mr[1] = m0 + NGW; const bool two = mr[1] < nrows; if (!two) mr[1] = m0;
        f32x4 v[2][8]; float ss[2];
#pragma unroll
        for (int r = 0; r < 2; ++r) { const int m = mr[r]; const float* src = m < MLAT ? hlat + (size_t)m * DM : hctx + (size_t)(m - MLAT) * DM;
#pragma unroll
            for (int j = 0; j < 8; ++j) v[r][j] = *(const f32x4*)(src + 256 * j + 4 * lane); }
#pragma unroll
        for (int r = 0; r < 2; ++r) { ss[r] = 0.f;
#pragma unroll
            for (int j = 0; j < 8; ++j) ss[r] += (v[r][j][0] * v[r][j][0] + v[r][j][1] * v[r][j][1]) + (v[r][j][2] * v[r][j][2] + v[r][j][3] * v[r][j][3]); }
#pragma unroll
        for (int r = 0; r < 2; ++r) { if (r == 1 && !two) break; const int m = mr[r]; const float* mv = mod + (m < MLAT ? (m >> 13) : 2) * 12288;
            const float rstd = rsqrtf(wave_sum(ss[r], lane) * (1.0f / DM) + EPS);
            store_u(U + (size_t)m * DM, lane, v[r], rstd, g, mv + sh_off, mv + sc_off); }
    }
}
__device__ __forceinline__ void pass_post(const bf16* o16, const float* opart, const float* hlat, const float* hctx, float* olat, float* octx, const float* gpost, const float* mod, int gt_off,
                                          const float* gpre, const float* modu, int sh_off, int sc_off, bf16* U, int nrows, int gw, int NGW, int lane) {
    for (int m0 = gw; m0 < nrows; m0 += 2 * NGW) {
        int mr[2]; mr[0] = m0; mr[1] = m0 + NGW; const bool two = mr[1] < nrows; if (!two) mr[1] = m0;
        f32x4 v[2][8], hh[2][8]; float ss[2];
#pragma unroll
        for (int r = 0; r < 2; ++r) { const int m = mr[r]; ss[r] = 0.f;
            const float* hs = m < MLAT ? hlat + (size_t)m * DM : hctx + (size_t)(m - MLAT) * DM;
            if (m < MLAT) { const bf16* orow = o16 + (size_t)m * DM;
#pragma unroll
                for (int j = 0; j < 8; ++j) { const v2u raw = *(const v2u*)(orow + 256 * j + 4 * lane);
                    v[r][j] = (f32x4){__uint_as_float(raw.x << 16), __uint_as_float(raw.x & 0xffff0000u), __uint_as_float(raw.y << 16), __uint_as_float(raw.y & 0xffff0000u)}; }
            } else { const float* orow = opart + (size_t)(m - MLAT) * DM;
#pragma unroll
                for (int j = 0; j < 8; ++j) { const int ci = 256 * j + 4 * lane;
                    v[r][j] = (*(const f32x4*)(orow + ci) + *(const f32x4*)(orow + ci + (size_t)512 * DM)) + (*(const f32x4*)(orow + ci + (size_t)1024 * DM) + *(const f32x4*)(orow + ci + (size_t)1536 * DM)); } }
#pragma unroll
            for (int j = 0; j < 8; ++j) hh[r][j] = *(const f32x4*)(hs + 256 * j + 4 * lane);
        }
#pragma unroll
        for (int r = 0; r < 2; ++r)
#pragma unroll
            for (int j = 0; j < 8; ++j) ss[r] += (v[r][j][0] * v[r][j][0] + v[r][j][1] * v[r][j][1]) + (v[r][j][2] * v[r][j][2] + v[r][j][3] * v[r][j][3]);
#pragma unroll
        for (int r = 0; r < 2; ++r) { const int m = mr[r]; if (r == 1 && !two) break;
            float* hd = m < MLAT ? olat + (size_t)m * DM : octx + (size_t)(m - MLAT) * DM; const int vi = (m < MLAT ? (m >> 13) : 2); const float* mv = mod + vi * 12288;
            const float rstd = rsqrtf(wave_sum(ss[r], lane) * (1.0f / DM) + EPS); float s2 = 0.f;
#pragma unroll
            for (int j = 0; j < 8; ++j) { const int ci = 256 * j + 4 * lane; const f32x4 g4 = *(const f32x4*)(gpost + ci), t4 = *(const f32x4*)(mv + gt_off + ci);
                const f32x4 nv = hh[r][j] + t4 * (v[r][j] * rstd * g4); v[r][j] = nv; *(f32x4*)(hd + ci) = nv; s2 += (nv[0] * nv[0] + nv[1] * nv[1]) + (nv[2] * nv[2] + nv[3] * nv[3]); }
            if (U) { const float* mu = modu + vi * 12288; const float rstd2 = rsqrtf(wave_sum(s2, lane) * (1.0f / DM) + EPS); store_u(U + (size_t)m * DM, lane, v[r], rstd2, gpre, mu + sh_off, mu + sc_off); }
        }
    }
}
__device__ __forceinline__ void rope_cs(float pos, int j, float inv_nf, float& cs, float& sn) {
    const float inv_freq = __builtin_amdgcn_exp2f(-(float)j * inv_nf * 13.287712379549449f);
    float rev = pos * inv_freq * 0.15915494309189535f; rev -= rintf(rev);
    sn = __builtin_amdgcn_sinf(rev); cs = __builtin_amdgcn_cosf(rev);
}
template <int NH> __device__ __forceinline__ void heads_load(const bf16* base, int ia, float (&x)[NH], float (&y)[NH]) {
#pragma unroll
    for (int h = 0; h < NH; ++h) { x[h] = bf2f(base[h * 128 + ia]); y[h] = bf2f(base[h * 128 + ia + 32]); }
}
template <int NH> __device__ __forceinline__ void heads_finish(bf16* base, int ia, float (&x)[NH], float (&y)[NH], const float* gain, bool rope, float cs, float sn, int lane) {
    const float ga = gain[ia], gb = gain[ia + 32];
#pragma unroll
    for (int h = 0; h < NH; ++h) {
        const float rstd = rsqrtf(wave_sum(x[h] * x[h] + y[h] * y[h], lane) * (1.0f / 128.0f) + EPS);
        float a = x[h] * rstd * ga, b = y[h] * rstd * gb;
        if (rope) { const float na = a * cs - b * sn, nb = b * cs + a * sn; a = na; b = nb; }
        base[h * 128 + ia] = (bf16)f2bf(a); base[h * 128 + ia + 32] = (bf16)f2bf(b); }
}
__device__ __forceinline__ void unpack8(const v4u raw, float (&x)[8]) {
#pragma unroll
    for (int i = 0; i < 4; ++i) { x[2 * i] = __uint_as_float(raw[i] << 16); x[2 * i + 1] = __uint_as_float(raw[i] & 0xffff0000u); }
}
__device__ __forceinline__ void norm512_finish(bf16* p, const float (&x)[8], const float* gain, int lane) {
    float ss = 0.f;
#pragma unroll
    for (int i = 0; i < 8; ++i) ss += x[i] * x[i];
    const float rstd = rsqrtf(wave_sum(ss, lane) * (1.0f / 512.0f) + EPS);
    const f32x4 g0 = *(const f32x4*)(gain + 8 * lane), g1 = *(const f32x4*)(gain + 8 * lane + 4);
    v4u w; w.x = pk2(x[0] * rstd * g0[0], x[1] * rstd * g0[1]); w.y = pk2(x[2] * rstd * g0[2], x[3] * rstd * g0[3]); w.z = pk2(x[4] * rstd * g1[0], x[5] * rstd * g1[1]); w.w = pk2(x[6] * rstd * g1[2], x[7] * rstd * g1[3]);
    *(v4u*)(p + 8 * lane) = w;
}
__device__ __forceinline__ void rope64(bf16* p, float prow, float pcol, int l32) {
    const int j = l32 & 15, s = (l32 >> 4) & 1, ia = 32 * s + j, ib = ia + 16;
    const float x = bf2f(p[ia]), y = bf2f(p[ib]); float cs, sn; rope_cs(s ? pcol : prow, j, 1.0f / 16.0f, cs, sn);
    p[ia] = (bf16)f2bf(x * cs - y * sn); p[ib] = (bf16)f2bf(y * cs + x * sn);
}
__device__ __forceinline__ void prep_ab(bf16* P, const float* aqn, const float* akn, const float* bqn, const float* bkvn, int gw, int NGW, int lane) {
    const int ia = 64 * (lane >> 5) + (lane & 31);
    for (int m = gw; m < MALL; m += NGW) {
        bf16* row = P + (size_t)m * N_IN0; const bool lat = m < MLAT; const int t = m & (SEQ - 1); const float pr = (float)(t >> 6), pc = (float)(t & 63);
        float xk[2], yk[2], c1[8], c2[8];
        heads_load<2>(row + 1024, ia, xk, yk);
        unpack8(*(const v4u*)(row + 1536 + 8 * lane), c1); unpack8(*(const v4u*)(row + 2048 + 8 * lane), c2);
        if (lat && lane < 32) rope64(row + 2560, pr, pc, lane);
        float cs = 1.f, sn = 0.f; if (lat) rope_cs((lane >> 5) ? pc : pr, lane & 31, 1.0f / 32.0f, cs, sn);
        heads_finish<2>(row + 1024, ia, xk, yk, akn, lat, cs, sn, lane);
        norm512_finish(row + 1536, c1, bqn, lane); norm512_finish(row + 2048, c2, bkvn, lane);
    }
}
__device__ __forceinline__ void prep_qb(bf16* QB, int gw, int NGW, int lane) {
    for (int m = gw; m < MLAT; m += NGW) {
        bf16* row = QB + (size_t)m * N_UQ; const int t = m & (SEQ - 1); const float pr = (float)(t >> 6), pc = (float)(t & 63);
#pragma unroll
        for (int i = 0; i < 4; ++i) rope64(row + (2 * i + (lane >> 5)) * 192 + 128, pr, pc, lane & 31);
    }
}
__device__ __forceinline__ void prep_cd(bf16* P, const float* cqn, const float* ckn, const float* dqn, const float* dkn, int gw, int NGW, int lane) {
    const int ia = 64 * (lane >> 5) + (lane & 31);
    for (int m = gw; m < MALL; m += NGW) {
        bf16* row = P + (size_t)m * N_IN1; const bool lat = m < MLAT; const int t = m & (SEQ - 1); const float pr = (float)(t >> 6), pc = (float)(t & 63);
        float cs = 1.f, sn = 0.f; if (lat) rope_cs((lane >> 5) ? pc : pr, lane & 31, 1.0f / 32.0f, cs, sn);
        float xk[2], yk[2], xd[8], yd[8];
        heads_load<2>(row + 1024, ia, xk, yk); heads_load<8>(row + 2560, ia, xd, yd);
        heads_finish<2>(row + 1024, ia, xk, yk, ckn, lat, cs, sn, lane); heads_finish<8>(row + 2560, ia, xd, yd, dkn, false, 1.f, 0.f, lane);
    }
}
constexpr float LOG2E = 1.4426950408889634f;
__device__ __forceinline__ void attn_phase_ab(const bf16* P0, const bf16* QB, const bf16* KVB, bf16* OB, const float* aqn, char* lds, const int wave0) {
    const int c = blockIdx.x, G = gridDim.x;
    for (int id = c; id < 1024 + 32; id += G) {
        att::Args a{};
        int mixer, b, h, qrow0, NT;
        if (id < 1024) { const int rnd = id >> 8, cc = id & 255; mixer = rnd >> 1; b = rnd & 1; h = cc & 7; qrow0 = b * SEQ + (cc >> 3) * 256; NT = 132; }
        else { const int cc = id - 1024; mixer = cc >> 4; b = (cc >> 3) & 1; h = cc & 7; qrow0 = MLAT + b * NCTX; NT = 4; }
        a.NT = NT; a.nctx = 4; a.ctx_row0 = MLAT + b * NCTX; a.lat_row0 = b * SEQ; a.ldo = DM; a.qrope_t0 = (id < 1024) ? (qrow0 - b * SEQ) : -1;
        if (mixer == 0) {
            a.Q = P0 + (size_t)qrow0 * N_IN0 + h * 128; a.ldq = N_IN0; a.K = P0 + 1024 + (h >> 2) * 128; a.ldk = N_IN0; a.K2 = nullptr; a.ldk2 = 0; a.V = P0 + 1280 + (h >> 2) * 128; a.ldv = N_IN0;
            a.O = OB + (size_t)qrow0 * DM + h * 128; const float scale = 0.08838834764831845f; a.C = scale * LOG2E; a.thr_raw = 8.0f * LOG2E; a.qgain = aqn;

#ifndef DIS_A
            att::attn_unit<128, 0>(a, lds, wave0);
#endif

        } else {
            a.Q = QB + (size_t)qrow0 * N_UQ + h * 192; a.ldq = N_UQ; a.K = KVB + h * 256; a.ldk = N_UKV; a.K2 = P0 + 2560; a.ldk2 = N_IN0; a.V = KVB + h * 256 + 128; a.ldv = N_UKV;
            a.O = OB + (size_t)qrow0 * DM + 1024 + h * 128; const float scale = 0.07216878364870322f; a.C = scale * LOG2E; a.thr_raw = 8.0f * LOG2E;

#ifndef DIS_B
            att::attn_unit<192, 0>(a, lds, wave0);
#endif

        }
    }
}
__device__ __forceinline__ void attn_phase_cd(const bf16* P1, bf16* OB, const float* sink, const float* rpb, const float* cqn, const float* dqn, char* lds, const int wave0) {
    const int c = blockIdx.x, G = gridDim.x;
    for (int id = c; id < 1024; id += G) {
        att::Args a{};
        const int rnd = id >> 8, cc = id & 255, mixer = rnd >> 1, b = rnd & 1, h = cc & 7, qb = cc >> 3, qrow0 = b * SEQ + qb * 256;
        a.nctx = 4; a.ctx_row0 = MLAT + b * NCTX; a.ldo = DM; a.ldq = a.ldk = a.ldv = N_IN1; a.K2 = nullptr; a.ldk2 = 0;
        const float scale = 0.08838834764831845f; a.C = scale * LOG2E; a.thr_raw = 8.0f * LOG2E; a.inv_scale = LOG2E;
        if (mixer == 0) {
            const int kbase = min(max(qb * 256 - 128, 0), SEQ - 512);
            a.NT = 12; a.lat_row0 = b * SEQ + kbase; a.qpos0 = qb * 256; a.kpos0 = kbase; a.sink_l2 = __uint_as_float((unsigned)__builtin_amdgcn_readfirstlane((int)__float_as_uint(sink[h]))) * LOG2E;
            a.qgain = cqn; a.qrope_t0 = qb * 256; a.Q = P1 + (size_t)qrow0 * N_IN1 + h * 128; a.K = P1 + 1024 + (h >> 2) * 128; a.V = P1 + 1280 + (h >> 2) * 128; a.O = OB + (size_t)qrow0 * DM + h * 128;

#ifndef DIS_C
            att::attn_unit<128, 1>(a, lds, wave0);
#endif

        } else {
            const int r0 = qb * 4, klo = min(max(r0 - 4, 0), 116);
            a.NT = 16; a.lat_row0 = b * SEQ + klo * 64; a.r0 = r0; a.klo = klo; a.rpb = rpb + h * (15 * 31);
            a.qgain = dqn; a.qrope_t0 = -1; a.Q = P1 + (size_t)qrow0 * N_IN1 + 1536 + h * 128; a.K = P1 + 2560 + h * 128; a.V = P1 + 3584 + h * 128; a.O = OB + (size_t)qrow0 * DM + 1024 + h * 128;

#ifndef DIS_D
            att::attn_unit<128, 2>(a, lds, wave0);
#endif

        }
    }
}

__global__ void __launch_bounds__(NTHR, 2) fwd_megakernel(KArgs args) {
    extern __shared__ __attribute__((aligned(16))) unsigned char lds[];
    cg::grid_group grid = cg::this_grid();
    LAS unsigned char* ldsl = (LAS unsigned char*)lds;
    const int wave0 = __builtin_amdgcn_readfirstlane(threadIdx.x >> 6);
    const int G = gridDim.x, NGW = G * NWAVES;
#define PHASE_IDS() const int tid = fresh_tid(wave0); const int lane = tid & 63, wave = __builtin_amdgcn_readfirstlane(tid >> 6), gw = blockIdx.x * NWAVES + wave; (void)wave; (void)gw; (void)lane
#define WSB (kargs()->ws)
#define x_ (kargs()->in[0])
#define ctx_ (kargs()->in[2])
#define out_ (kargs()->out)
#define hctx_ ((float*)(WSB + WS_HCTX))
#define MOD_ ((const float*)(WSB + WS_MOD))
#define UA_ ((bf16*)(WSB + WS_UO))
#define OB_ ((bf16*)(WSB + WS_OB))
#define FB_ ((bf16*)(WSB + WS_UO))
#define FP_ ((float*)(WSB + WS_UO + 64 * MiB))
#define OFB_ ((bf16*)(WSB + WS_BIG))
#define OFP_ ((float*)(WSB + WS_BIG + 128 * MiB))
#define PB_ ((bf16*)(WSB + WS_BIG))
#define OF_ ((float*)(WSB + WS_BIG))
#define ACT_ ((bf16*)(WSB + WS_BIG))
#define QB_ ((bf16*)(WSB + WS_QB))
#define KVB_ ((bf16*)(WSB + WS_KVB))
#define UB_ ((bf16*)(WSB + WS_UB))
#ifndef PROBE_G
#define PROBE_G 1
#endif
#ifndef PROBE_A
#define PROBE_A 1
#endif
#ifndef PROBE_S
#define PROBE_S 1
#endif
#define GSYNC() do { for (int s_ = 0; s_ < PROBE_S; ++s_) { xcd_barrier(bar); } } while (0)
    volatile LAS unsigned* MISC = (volatile LAS unsigned*)(ldsl + 131072 + 64);
    if (threadIdx.x < 2) MISC[threadIdx.x] = 0u;
    __syncthreads();
    grid.sync();
    XcdBarrier bar = xcd_barrier_post((unsigned*)(kargs()->ws + WS_BAR), MISC);

    for (int rep_ = 0; rep_ < PROBE_S; ++rep_) {
    { PHASE_IDS(); p0_mod(kargs(), ldsl, tid); }
    { PHASE_IDS(); p0_weights(kargs(), ldsl, gw, NGW, wave, lane); }
    }
    GSYNC();
    { PHASE_IDS(); pass_pre(x_, ctx_, kargs()->in[6], MOD_, 0, DM, UA_, MALL, gw, NGW, lane); }
    GSYNC();
    for (int L = 0; L < 2; ++L) {

        const int Mrows = L == 0 ? MALL : MLAT;
        { pg8::Gemm g = pg8::mk_gemm(L == 0 ? UA_ : UB_, (const bf16*)(WSB + (L == 0 ? WS_WIN0 : WS_WIN1)), MALL, L == 0 ? N_IN0 : N_IN1, DM, DM);
          pg8::StaticOrder S; S.init(g.M, g.N, G, (int)blockIdx.x); pg8::EpiBf16 E{PB_, g.N};
          for (int rep_ = 0; rep_ < PROBE_G; ++rep_) pg8::gemm_phase<pg8::EpiBf16, pg8::StaticOrder, true, true>(ldsl, g, S, E, wave0); }
        GSYNC();
        if (L == 0) {
            { PHASE_IDS(); prep_ab(PB_, kargs()->in[15], kargs()->in[16], kargs()->in[17], kargs()->in[18], gw, NGW, lane); }
            GSYNC();
            for (int q = 0; q < 2; ++q) {
                pg8::Gemm g = pg8::mk_gemm(PB_ + (q == 0 ? 1536 : 2048), (const bf16*)(WSB + (q == 0 ? WS_WUQ : WS_WUKV)), MALL, q == 0 ? N_UQ : N_UKV, 512, N_IN0);
                pg8::StaticOrder S; S.init(g.M, g.N, G, (int)blockIdx.x); pg8::EpiBf16 E{q == 0 ? QB_ : KVB_, g.N};
                for (int rep_ = 0; rep_ < PROBE_G; ++rep_) pg8::gemm_phase<pg8::EpiBf16, pg8::StaticOrder, true, true>(ldsl, g, S, E, wave0);
            }
            GSYNC();
            for (int rep_ = 0; rep_ < PROBE_A; ++rep_) attn_phase_ab(PB_, QB_, KVB_, OB_, kargs()->in[15], (char*)lds, wave0);
        } else {
            { PHASE_IDS(); prep_cd(PB_, kargs()->in[23], kargs()->in[24], kargs()->in[26], kargs()->in[27], gw, NGW, lane); }
            GSYNC();
            for (int rep_ = 0; rep_ < PROBE_A; ++rep_) attn_phase_cd(PB_, OB_, kargs()->in[25], kargs()->in[28], kargs()->in[23], kargs()->in[26], (char*)lds, wave0);
        }
        GSYNC();
        { pg8::Gemm g = pg8::mk_gemm(OB_, (const bf16*)(WSB + (L == 0 ? WS_WOUT0 : WS_WOUT1)), MLAT, DM, DM, DM);
          pg8::StaticOrder S; S.init(g.M, g.N, G, (int)blockIdx.x); pg8::EpiBf16 E{OFB_, DM};
          for (int rep_ = 0; rep_ < PROBE_G; ++rep_) pg8::gemm_phase<pg8::EpiBf16, pg8::StaticOrder, true, true>(ldsl, g, S, E, wave0); }
        if (L == 0) { pg8::Gemm g = pg8::mk_gemm(OB_ + (size_t)MLAT * DM, (const bf16*)(WSB + WS_WOUT0), 2 * NCTX, 4 * DM, DM / 4, DM); g.ldb = DM; g.nNr = DM / 256;
          pg8::StaticOrder S; S.init(g.M, g.N, G, (int)blockIdx.x); pg8::EpiF32Split E{OFP_, DM, DM / 256, (size_t)2 * NCTX * DM};
          for (int rep_ = 0; rep_ < PROBE_G; ++rep_) pg8::gemm_phase<pg8::EpiF32Split, pg8::StaticOrder, true, true>(ldsl, g, S, E, wave0); }
        GSYNC();
        { PHASE_IDS(); pass_post(OFB_, OFP_, L == 0 ? x_ : out_, L == 0 ? ctx_ : hctx_, out_, hctx_, kargs()->in[7] + L * DM, MOD_ + (size_t)L * 3 * 12288, 2 * DM, kargs()->in[8] + L * DM, MOD_ + (size_t)L * 3 * 12288, 3 * DM, 4 * DM, UA_, Mrows, gw, NGW, lane); }
        GSYNC();
        { pg8::Gemm g = pg8::mk_gemm(UA_, (const bf16*)(WSB + WS_WGU + (size_t)L * 44 * MiB), Mrows, N_GU, DM, DM);
          pg8::StaticOrder S; S.init(g.M, g.N, G, (int)blockIdx.x); pg8::EpiSwiglu E{ACT_, DFF};
          for (int rep_ = 0; rep_ < PROBE_G; ++rep_) pg8::gemm_phase<pg8::EpiSwiglu, pg8::StaticOrder, true, true>(ldsl, g, S, E, wave0); }
        GSYNC();
        { pg8::Gemm g = pg8::mk_gemm(ACT_, (const bf16*)(WSB + WS_WD + (size_t)L * 22 * MiB), MLAT, DM, DFF, DFF);
          pg8::StaticOrder S; S.init(g.M, g.N, G, (int)blockIdx.x); pg8::EpiBf16 E{FB_, DM};
          for (int rep_ = 0; rep_ < PROBE_G; ++rep_) pg8::gemm_phase<pg8::EpiBf16, pg8::StaticOrder, true, true>(ldsl, g, S, E, wave0); }
        if (L == 0) { pg8::Gemm g = pg8::mk_gemm(ACT_ + (size_t)MLAT * DFF, (const bf16*)(WSB + WS_WD), 2 * NCTX, 4 * DM, DFF / 4, DFF); g.ldb = DFF; g.nNr = DM / 256;
          pg8::StaticOrder S; S.init(g.M, g.N, G, (int)blockIdx.x); pg8::EpiF32Split E{FP_, DM, DM / 256, (size_t)2 * NCTX * DM};
          for (int rep_ = 0; rep_ < PROBE_G; ++rep_) pg8::gemm_phase<pg8::EpiF32Split, pg8::StaticOrder, true, true>(ldsl, g, S, E, wave0); }
        GSYNC();
        { PHASE_IDS(); pass_post(FB_, FP_, out_, hctx_, out_, hctx_, kargs()->in[9] + L * DM, MOD_ + (size_t)L * 3 * 12288, 5 * DM, kargs()->in[6] + DM, MOD_ + (size_t)3 * 12288, 0, DM, L == 0 ? UB_ : nullptr, Mrows, gw, NGW, lane); }
        if (L == 0) GSYNC();
    }
#undef GSYNC
}

constexpr int LDS_BYTES = 131072 + 1024;
extern "C" void kernel_launch(void* const* d_in, const int* in_sizes, int n_in, void* d_out, int out_size, void* d_ws, size_t ws_size, hipStream_t stream) {
    static int grid = 0;
    if (grid == 0) {
        if (n_in != 29 || out_size != MLAT * DM || ws_size < WS_END) { fprintf(stderr, "kernel_launch: unexpected shapes: n_in %d out %d ws %zu (need %zu)\n", n_in, out_size, ws_size, (size_t)WS_END); grid = -1; return; }
        int dev = 0, cus = 0, per_cu = 0;
        hipGetDevice(&dev); hipDeviceGetAttribute(&cus, hipDeviceAttributeMultiprocessorCount, dev);
        if (hipFuncSetAttribute((const void*)fwd_megakernel, hipFuncAttributeMaxDynamicSharedMemorySize, LDS_BYTES) != hipSuccess) { fprintf(stderr, "kernel_launch: hipFuncSetAttribute failed\n"); grid = -1; return; }
        if (hipOccupancyMaxActiveBlocksPerMultiprocessor(&per_cu, (const void*)fwd_megakernel, NTHR, LDS_BYTES) != hipSuccess || per_cu < 1) { fprintf(stderr, "kernel_launch: occupancy query says %d\n", per_cu); per_cu = 1; }
        (void)hipGetLastError();
        grid = cus;
        fprintf(stderr, "kernel_launch: grid %d (per_cu %d)\n", grid, per_cu);
    }
    if (grid < 0) return;
    if (hipMemsetAsync((char*)d_ws + WS_BAR, 0, BAR_BYTES, stream) != hipSuccess) { fprintf(stderr, "kernel_launch: hipMemsetAsync failed\n"); return; }
    KArgs a{};
    for (int i = 0; i < 29; ++i) a.in[i] = (const float*)d_in[i];
    a.out = (float*)d_out; a.ws = (unsigned char*)d_ws;
    void* params[] = {&a};
    const hipError_t e = hipLaunchCooperativeKernel((const void*)fwd_megakernel, dim3(grid), dim3(NTHR), params, LDS_BYTES, stream);
    if (e != hipSuccess) fprintf(stderr, "kernel_launch: cooperative launch failed: %s (grid %d)\n", hipGetErrorString(e), grid);
}
```

```cpp
#include <hip/hip_runtime.h>
#include <hip/hip_cooperative_groups.h>
#include <cstdio>
#include <cstdint>
namespace cg = cooperative_groups;
__device__ __forceinline__ int fresh_tid(int wave0) { int l; asm volatile("v_mbcnt_lo_u32_b32 %0, -1, 0\n\tv_mbcnt_hi_u32_b32 %0, -1, %0" : "=v"(l)); return wave0 * 64 + l; }
namespace pg8 {
#define PG8_LAS __attribute__((address_space(3)))
typedef unsigned short bf16_t;
typedef short bf16x8 __attribute__((ext_vector_type(8)));
typedef float f32x4 __attribute__((ext_vector_type(4)));
typedef unsigned u32x4 __attribute__((ext_vector_type(4)));
constexpr int BM = 256, BK = 64, HALF = 128, HTB = HALF * BK * 2  , STAGE_BYTES = 8 * HTB, NXCD = 8, WGM = 8;

__host__ __device__ __forceinline__ int lds_byte(int r, int c) { const int st = (r >> 4) * 2 + (c >> 5), rr = r & 15, cc = c & 31, ob = rr * 64 + cc * 2; return st * 1024 + (ob ^ (((ob >> 9) & 1) << 5)); }
__host__ __device__ __forceinline__ void stage_rc(int b, int& R, int& C) { const int st = b / 1024, sb = b % 1024, swz = sb ^ (((sb >> 9) & 1) << 5); R = (st >> 1) * 16 + swz / 64; C = (st & 1) * 32 + (swz % 64) / 2; }
__host__ __device__ __forceinline__ int perm32(int rho) { const int n = rho >> 4, i = rho & 15; return 8 * (i >> 2) + 4 * n + (i & 3); }

struct Unit { int pm, pn; };
struct Gemm { const bf16_t* A; const bf16_t* Bt; int M, N, K, lda, ldb, nNr; };
__host__ __device__ __forceinline__ Gemm mk_gemm(const bf16_t* A, const bf16_t* Bt, int M, int N, int K, int lda) { Gemm g; g.A = A; g.Bt = Bt; g.M = M; g.N = N; g.K = K; g.lda = lda; g.ldb = K; g.nNr = N / BM; return g; }

struct StaticOrder {
    int nM, nN, nwg, G, c;
    __host__ __device__ void init(int M, int N, int G_, int c_) { nM = M / BM; nN = N / BM; nwg = nM * nN; G = G_; c = c_; }
    __host__ __device__ bool next(int i, Unit& u) const {
        const long L = (long)i * G + c; if (L >= nwg) return false;
        int wgid = (int)L; { const int q = nwg / NXCD, r = nwg % NXCD, xcd = wgid % NXCD, off = wgid / NXCD; wgid = (xcd < r ? xcd * (q + 1) : r * (q + 1) + (xcd - r) * q) + off; }
        const int nig = WGM * nN, gid = wgid / nig, fm = gid * WGM, gsz = (nM - fm) < WGM ? (nM - fm) : WGM;
        u.pm = fm + ((wgid % nig) % gsz); u.pn = (wgid % nig) / gsz; return true;
    }
    __device__ __forceinline__ void a_ready(const Unit&) const {}
    __device__ __forceinline__ void done(const Unit&) const {}
};


__device__ __forceinline__ unsigned cvt_pk_bf16(float lo, float hi) { unsigned r; asm volatile("v_cvt_pk_bf16_f32 %0, %1, %2" : "=v"(r) : "v"(lo), "v"(hi)); return r; }
struct EpiBf16 {
    static constexpr bool PERM = true, AFTER_DRAIN = false;
    bf16_t* O; int ldc;
    __device__ __forceinline__ void operator()(const f32x4 (&acc)[2][2][4][2], const Unit& u, int wr, int wc, int fr, int fq) const {
        const int row0 = u.pm * BM + wr * 64 + fr, col0 = u.pn * BM + wc * 32 + 8 * fq;
#pragma unroll
        for (int ai = 0; ai < 2; ++ai)
#pragma unroll
            for (int m = 0; m < 4; ++m) { bf16_t* rowp = O + (size_t)(row0 + ai * HALF + m * 16) * ldc + col0;
#pragma unroll
                for (int bj = 0; bj < 2; ++bj) { const f32x4 v0 = acc[ai][bj][m][0], v1 = acc[ai][bj][m][1];
                    u32x4 w; w.x = cvt_pk_bf16(v0[0], v0[1]); w.y = cvt_pk_bf16(v0[2], v0[3]); w.z = cvt_pk_bf16(v1[0], v1[1]); w.w = cvt_pk_bf16(v1[2], v1[3]);
                    *(u32x4*)(rowp + bj * HALF) = w; } }
    }
};
struct EpiF32 {
    static constexpr bool PERM = false, AFTER_DRAIN = false;
    float* O; int ldc;
    __device__ __forceinline__ void operator()(const f32x4 (&acc)[2][2][4][2], const Unit& u, int wr, int wc, int fr, int fq) const {
        const int row0 = u.pm * BM + wr * 64 + fr, col0 = u.pn * BM + wc * 32 + 4 * fq;
#pragma unroll
        for (int ai = 0; ai < 2; ++ai)
#pragma unroll
            for (int m = 0; m < 4; ++m) { float* rowp = O + (size_t)(row0 + ai * HALF + m * 16) * ldc + col0;
#pragma unroll
                for (int bj = 0; bj < 2; ++bj)
#pragma unroll
                    for (int n = 0; n < 2; ++n) *(f32x4*)(rowp + bj * HALF + n * 16) = acc[ai][bj][m][n]; }
    }
};
struct EpiF32Split {
    static constexpr bool PERM = false, AFTER_DRAIN = false;
    float* O; int ldc; int nNr; size_t sstride;
    __device__ __forceinline__ void operator()(const f32x4 (&acc)[2][2][4][2], const Unit& u, int wr, int wc, int fr, int fq) const {
        const int s = u.pn / nNr, pn = u.pn - s * nNr;
        const int row0 = u.pm * BM + wr * 64 + fr, col0 = pn * BM + wc * 32 + 4 * fq; float* Ob = O + (size_t)s * sstride;
#pragma unroll
        for (int ai = 0; ai < 2; ++ai)
#pragma unroll
            for (int m = 0; m < 4; ++m) { float* rowp = Ob + (size_t)(row0 + ai * HALF + m * 16) * ldc + col0;
#pragma unroll
                for (int bj = 0; bj < 2; ++bj)
#pragma unroll
                    for (int n = 0; n < 2; ++n) *(f32x4*)(rowp + bj * HALF + n * 16) = acc[ai][bj][m][n]; }
    }
};
__device__ __forceinline__ float silu_mul(float g, float u) { return g * __builtin_amdgcn_rcpf(1.0f + __builtin_amdgcn_exp2f(-1.4426950408889634f * g)) * u; }
struct EpiSwiglu {
    static constexpr bool PERM = true, AFTER_DRAIN = false;
    bf16_t* O; int ldc;
    __device__ __forceinline__ void operator()(const f32x4 (&acc)[2][2][4][2], const Unit& u, int wr, int wc, int fr, int fq) const {
        const int row0 = u.pm * BM + wr * 64 + fr, col0 = u.pn * HALF + wc * 32 + 8 * fq;
#pragma unroll
        for (int ai = 0; ai < 2; ++ai)
#pragma unroll
            for (int m = 0; m < 4; ++m) { bf16_t* rowp = O + (size_t)(row0 + ai * HALF + m * 16) * ldc + col0;
                const f32x4 g0 = acc[ai][0][m][0], g1 = acc[ai][0][m][1], u0 = acc[ai][1][m][0], u1 = acc[ai][1][m][1];
                u32x4 w; w.x = cvt_pk_bf16(silu_mul(g0[0], u0[0]), silu_mul(g0[1], u0[1])); w.y = cvt_pk_bf16(silu_mul(g0[2], u0[2]), silu_mul(g0[3], u0[3]));
                w.z = cvt_pk_bf16(silu_mul(g1[0], u1[0]), silu_mul(g1[1], u1[1])); w.w = cvt_pk_bf16(silu_mul(g1[2], u1[2]), silu_mul(g1[3], u1[3]));
                *(u32x4*)rowp = w; }
    }
};

template <class Epi, class Sched, bool ALIGN_EPI = false, bool SP2 = false>
__device__ __forceinline__ void gemm_phase(PG8_LAS unsigned char* lds, const Gemm g, const Sched& S, const Epi& E, const int wave0) {
    const int tid = fresh_tid(wave0), wid = __builtin_amdgcn_readfirstlane(tid >> 6), lane = tid & 63, wr = wid >> 2, wc = wid & 3, fr = lane & 15, fq = lane >> 4;
    const int K = g.K, nt = K / BK;
    unsigned voffA[2], voffB[2];
#pragma unroll
    for (int i = 0; i < 2; ++i) { int R, C; stage_rc(tid * 16 + i * 8192, R, C); const int Rb = Epi::PERM ? ((R & ~31) + perm32(R & 31)) : R;
        voffA[i] = (unsigned)(R * g.lda + C) * 2u; voffB[i] = (unsigned)(Rb * g.ldb + C) * 2u; }
    const size_t kstep = (size_t)(BK * 2);
    const size_t hstepA = (size_t)HALF * g.lda * 2, hstepB = (size_t)HALF * g.ldb * 2; const size_t ksb = (size_t)K * 2;
#define PG8_APTR(u) ((const char*)g.A + (size_t)(u).pm * tstepA + (size_t)((u).pn / g.nNr) * ksb)
#define PG8_BPTR(u) ((const char*)g.Bt + (size_t)((u).pn % g.nNr) * tstepB + (size_t)((u).pn / g.nNr) * ksb)
    const size_t tstepA = 2 * hstepA, tstepB = 2 * hstepB;
    const unsigned ldsw = (unsigned)wid * 1024u;
    const int aoff = lds_byte(wr * 64 + fr, fq * 8), boff = lds_byte(wc * 32 + fr, fq * 8);
#define PG8_SA(b, h) (((b) * 2 + (h)) * HTB)
#define PG8_SB(b, h) ((4 + (b) * 2 + (h)) * HTB)
#define PG8_STAGE(bufoff, gbase, voff) do { _Pragma("unroll") for (int _i = 0; _i < 2; ++_i) \
        __builtin_amdgcn_global_load_lds((const unsigned*)((const char*)(gbase) + (voff)[_i]), (PG8_LAS unsigned*)(lds + (bufoff) + ldsw + _i * 8192), 16, 0, 0); } while (0)
#define PG8_LDA(dst, b, h) do { _Pragma("unroll") for (int m = 0; m < 4; ++m) _Pragma("unroll") for (int k = 0; k < 2; ++k) dst[m][k] = *(const PG8_LAS bf16x8*)(lds + PG8_SA(b, h) + aoff + m * 2048 + k * 1024); } while (0)
#define PG8_LDB(dst, b, h) do { _Pragma("unroll") for (int n = 0; n < 2; ++n) _Pragma("unroll") for (int k = 0; k < 2; ++k) dst[n][k] = *(const PG8_LAS bf16x8*)(lds + PG8_SB(b, h) + boff + n * 2048 + k * 1024); } while (0)
#define PG8_MMA(ai, bj, At, Bt) do { __builtin_amdgcn_s_setprio(1); _Pragma("unroll") for (int m = 0; m < 4; ++m) _Pragma("unroll") for (int n = 0; n < 2; ++n) _Pragma("unroll") for (int k = 0; k < 2; ++k) \
        acc[ai][bj][m][n] = __builtin_amdgcn_mfma_f32_16x16x32_bf16(Bt[n][k], At[m][k], acc[ai][bj][m][n], 0, 0, 0); __builtin_amdgcn_s_setprio(0); } while (0)
#define PG8_WAIT_V(n) asm volatile("s_waitcnt vmcnt(" #n ")" ::: "memory")
#define PG8_WAIT_L(n) asm volatile("s_waitcnt lgkmcnt(" #n ")" ::: "memory")
#define PG8_BAR __builtin_amdgcn_s_barrier()
#define PG8_SCHED __builtin_amdgcn_sched_barrier(0)
    Unit cur, nxt; int ui = 0;
    if (!S.next(0, cur)) return;
    f32x4 acc[2][2][4][2];
#pragma unroll
    for (int a = 0; a < 2; ++a)
#pragma unroll
        for (int b = 0; b < 2; ++b)
#pragma unroll
            for (int m = 0; m < 4; ++m)
#pragma unroll
                for (int n = 0; n < 2; ++n) acc[a][b][m][n] = (f32x4){0.f, 0.f, 0.f, 0.f};
    bf16x8 At[4][2], B0[2][2], B1[2][2];
    const char* cA = PG8_APTR(cur); const char* cB = PG8_BPTR(cur);
    S.a_ready(cur);
    if constexpr (SP2) {
        PG8_STAGE(PG8_SB(0, 0), cB, voffB); PG8_STAGE(PG8_SB(0, 1), cB + hstepB, voffB); PG8_STAGE(PG8_SA(0, 0), cA, voffA); PG8_STAGE(PG8_SA(0, 1), cA + hstepA, voffA);
        if (wr == 1) PG8_BAR;
        PG8_WAIT_V(2); PG8_BAR;
        PG8_STAGE(PG8_SB(1, 0), cB + kstep, voffB); PG8_STAGE(PG8_SA(1, 0), cA + kstep, voffA); PG8_STAGE(PG8_SB(1, 1), cB + hstepB + kstep, voffB);
        PG8_WAIT_V(6); PG8_BAR;
    } else {
        PG8_STAGE(PG8_SB(0, 0), cB, voffB); PG8_STAGE(PG8_SA(0, 0), cA, voffA); PG8_STAGE(PG8_SB(0, 1), cB + hstepB, voffB); PG8_STAGE(PG8_SA(0, 1), cA + hstepA, voffA);
        if (wr == 1) PG8_BAR;
        PG8_WAIT_V(4); PG8_BAR;
        PG8_STAGE(PG8_SB(1, 0), cB + kstep, voffB); PG8_STAGE(PG8_SA(1, 0), cA + kstep, voffA); PG8_STAGE(PG8_SB(1, 1), cB + hstepB + kstep, voffB);
        PG8_WAIT_V(6); PG8_BAR;
    }
    for (;;) {
        const bool has_next = S.next(ui + 1, nxt);
        const char* nA = has_next ? PG8_APTR(nxt) : cA; const char* nB = has_next ? PG8_BPTR(nxt) : cB;
        for (int t = 0; t < nt; t += 2) {
            const bool last = (t == nt - 2);
            const char* a1 = cA + (size_t)(t + 1) * kstep;
            const char* a2 = last ? nA : cA + (size_t)(t + 2) * kstep; const char* b2 = last ? nB : cB + (size_t)(t + 2) * kstep;
            const char* a3 = a2 + kstep; const char* b3 = b2 + kstep;
            if (last && has_next) S.a_ready(nxt);
            if constexpr (SP2) {
            PG8_LDB(B0, 0, 0); PG8_LDB(B1, 0, 1); PG8_SCHED; PG8_LDA(At, 0, 0); PG8_STAGE(PG8_SA(1, 1), a1 + hstepA, voffA);
            PG8_WAIT_V(8); PG8_WAIT_L(0); PG8_BAR; PG8_MMA(0, 0, At, B0); PG8_MMA(0, 1, At, B1); PG8_BAR; PG8_SCHED;
            PG8_LDA(At, 0, 1); PG8_STAGE(PG8_SB(0, 0), b2, voffB); PG8_STAGE(PG8_SB(0, 1), b2 + hstepB, voffB); PG8_STAGE(PG8_SA(0, 0), a2, voffA);
            PG8_WAIT_V(8); PG8_WAIT_L(0); PG8_BAR; PG8_MMA(1, 0, At, B0); PG8_MMA(1, 1, At, B1); PG8_BAR; PG8_SCHED;
            PG8_LDB(B0, 1, 0); PG8_LDB(B1, 1, 1); PG8_SCHED; PG8_LDA(At, 1, 0); PG8_STAGE(PG8_SA(0, 1), a2 + hstepA, voffA);
            PG8_WAIT_V(8); PG8_WAIT_L(0); PG8_BAR; PG8_MMA(0, 0, At, B0); PG8_MMA(0, 1, At, B1); PG8_BAR; PG8_SCHED;
            PG8_LDA(At, 1, 1); PG8_STAGE(PG8_SB(1, 0), b3, voffB); PG8_STAGE(PG8_SB(1, 1), b3 + hstepB, voffB); PG8_STAGE(PG8_SA(1, 0), a3, voffA);
            PG8_WAIT_V(8); PG8_WAIT_L(0); PG8_BAR; PG8_MMA(1, 0, At, B0); PG8_MMA(1, 1, At, B1); PG8_BAR; PG8_SCHED;
            } else {
            PG8_LDB(B0, 0, 0); PG8_SCHED; PG8_LDA(At, 0, 0); PG8_STAGE(PG8_SA(1, 1), a1 + hstepA, voffA);
            PG8_WAIT_L(8); PG8_BAR; PG8_WAIT_L(0); PG8_MMA(0, 0, At, B0); PG8_BAR; PG8_SCHED;
            PG8_LDB(B1, 0, 1); PG8_STAGE(PG8_SB(0, 0), b2, voffB);
            PG8_BAR; PG8_WAIT_L(0); PG8_MMA(0, 1, At, B1); PG8_BAR;
            PG8_LDA(At, 0, 1); PG8_STAGE(PG8_SA(0, 0), a2, voffA);
            PG8_BAR; PG8_WAIT_L(0); PG8_MMA(1, 0, At, B0); PG8_BAR; PG8_SCHED;
            PG8_STAGE(PG8_SB(0, 1), b2 + hstepB, voffB);
            PG8_WAIT_V(6); PG8_BAR; PG8_MMA(1, 1, At, B1); PG8_BAR;
            PG8_LDB(B0, 1, 0); PG8_SCHED; PG8_LDA(At, 1, 0); PG8_STAGE(PG8_SA(0, 1), a2 + hstepA, voffA);
            PG8_WAIT_L(8); PG8_BAR; PG8_WAIT_L(0); PG8_MMA(0, 0, At, B0); PG8_BAR; PG8_SCHED;
            PG8_LDB(B1, 1, 1); PG8_STAGE(PG8_SB(1, 0), b3, voffB);
            PG8_BAR; PG8_WAIT_L(0); PG8_MMA(0, 1, At, B1); PG8_BAR;
            PG8_LDA(At, 1, 1); PG8_STAGE(PG8_SA(1, 0), a3, voffA);
            PG8_BAR; PG8_WAIT_L(0); PG8_MMA(1, 0, At, B0); PG8_BAR; PG8_SCHED;
            PG8_STAGE(PG8_SB(1, 1), b3 + hstepB, voffB);
            PG8_WAIT_V(6); PG8_BAR; PG8_MMA(1, 1, At, B1); PG8_BAR;
            }
        }
        if constexpr (ALIGN_EPI) { if (wr == 0) PG8_BAR; }
        if constexpr (!Epi::AFTER_DRAIN) { E(acc, cur, wr, wc, fr, fq); S.done(cur); }
        if (!has_next) break;
#pragma unroll
        for (int a = 0; a < 2; ++a)
#pragma unroll
            for (int b = 0; b < 2; ++b)
#pragma unroll
                for (int m = 0; m < 4; ++m)
#pragma unroll
                    for (int n = 0; n < 2; ++n) acc[a][b][m][n] = (f32x4){0.f, 0.f, 0.f, 0.f};
        cur = nxt; cA = nA; cB = nB; ++ui;
        if constexpr (ALIGN_EPI) { if (wr == 1) PG8_BAR; }
    }
    PG8_WAIT_V(0);
    if constexpr (!ALIGN_EPI) { if (wr == 0) PG8_BAR; }
    PG8_BAR;
    if constexpr (Epi::AFTER_DRAIN) { E.fused(acc, cur, wr, wc, fr, fq, lds, wid, lane); S.done(cur); }
#undef PG8_APTR
#undef PG8_BPTR
#undef PG8_SA
#undef PG8_SB
#undef PG8_STAGE
#undef PG8_LDA
#undef PG8_LDB
#undef PG8_MMA
#undef PG8_WAIT_V
#undef PG8_WAIT_L
#undef PG8_BAR
#undef PG8_SCHED
}
}
namespace att {
typedef unsigned short bf16;
typedef short bf16x8 __attribute__((ext_vector_type(8)));
typedef short s16x4 __attribute__((ext_vector_type(4)));
typedef float f32x16 __attribute__((ext_vector_type(16)));
typedef unsigned u32x4 __attribute__((ext_vector_type(4)));
constexpr int NW = 8, QBLK = 32, KVBLK = 64;
constexpr int SHM_V = KVBLK * 128 * 2;
#define SBAR() __builtin_amdgcn_sched_barrier(0)
__device__ __forceinline__ int crow(int r, int hi) { return (r & 3) + 8 * (r >> 2) + 4 * hi; }
__device__ __forceinline__ unsigned cvtpk(float lo, float hi) { unsigned r; asm volatile("v_cvt_pk_bf16_f32 %0, %1, %2" : "=v"(r) : "v"(lo), "v"(hi)); return r; }

struct Args {
  const bf16* Q; const bf16* K; const bf16* K2; const bf16* V; bf16* O;
  int ldq, ldk, ldk2, ldv, ldo;
  int NT, nctx, ctx_row0, lat_row0;
  float C, thr_raw;
  int qpos0, kpos0;
  float sink_l2;
  int r0, klo;
  const float* rpb; float inv_scale;
  const float* qgain;
  int qrope_t0;
};

template <bool FIRST> __device__ __forceinline__ void partialSM(f32x16& p0, f32x16& p1, float& m_reg, float& alpha, f32x16& negm, const float thr) {
  float pmax = p0[0];
#pragma unroll
  for (int r = 1; r < 16; ++r) pmax = fmaxf(pmax, p0[r]);
#pragma unroll
  for (int r = 0; r < 16; ++r) pmax = fmaxf(pmax, p1[r]);
  { auto rr = __builtin_amdgcn_permlane32_swap(__float_as_uint(pmax), __float_as_uint(pmax), false, false);
    pmax = fmaxf(__uint_as_float(rr[0]), __uint_as_float(rr[1])); }
  alpha = 1.f;
  if (FIRST || !__builtin_expect(__all(pmax <= thr), 1)) {
    const float delta = FIRST ? pmax : fmaxf(pmax, 0.f);
    m_reg += delta; if (!FIRST) alpha = __builtin_amdgcn_exp2f(-delta);
#pragma unroll
    for (int r = 0; r < 16; ++r) { p0[r] -= delta; p1[r] -= delta; }
    const float nm = -m_reg;
#pragma unroll
    for (int r = 0; r < 16; ++r) negm[r] = nm;
    asm volatile("" : "+v"(negm));
  }
#pragma unroll
  for (int r = 0; r < 16; ++r) p0[r] = __builtin_amdgcn_exp2f(p0[r]);
}
__device__ __forceinline__ void finishSM(f32x16& p0, f32x16& p1, float alpha, float& l_reg, bf16x8& pa0, bf16x8& pa1, bf16x8& pa2, bf16x8& pa3) {
#pragma unroll
  for (int r = 0; r < 16; ++r) p1[r] = __builtin_amdgcn_exp2f(p1[r]);
  float ps = 0;
#pragma unroll
  for (int r = 0; r < 16; ++r) ps += p0[r];
#pragma unroll
  for (int r = 0; r < 16; ++r) ps += p1[r];
  { auto rr = __builtin_amdgcn_permlane32_swap(__float_as_uint(ps), __float_as_uint(ps), false, false);
    ps = __uint_as_float(rr[0]) + __uint_as_float(rr[1]); }
  l_reg = l_reg * alpha + ps;
#define PK8(P, BASE, OUT) do { u32x4 w = {cvtpk(P[BASE + 0], P[BASE + 1]), cvtpk(P[BASE + 2], P[BASE + 3]), cvtpk(P[BASE + 4], P[BASE + 5]), cvtpk(P[BASE + 6], P[BASE + 7])}; \
    OUT = *reinterpret_cast<bf16x8*>(&w); } while (0)
  PK8(p0, 0, pa0); PK8(p0, 8, pa1); PK8(p1, 0, pa2); PK8(p1, 8, pa3);
#undef PK8
}
template <int DQ> __device__ __forceinline__ int kswz(int row, int colB) { return row * (DQ * 2) + (colB ^ ((row & 7) << 4)); }
typedef const __attribute__((address_space(3))) bf16x8* lds_b128_ptr;
template <int DQ> __device__ __forceinline__ void qkt(f32x16& p0, f32x16& p1, const int (&kx)[4], int koff, const bf16x8* qr, const f32x16& negm) {
  lds_b128_ptr k0 = (lds_b128_ptr)(unsigned)(kx[0] + koff), k1 = (lds_b128_ptr)(unsigned)(kx[1] + koff), k2 = (lds_b128_ptr)(unsigned)(kx[2] + koff), k3 = (lds_b128_ptr)(unsigned)(kx[3] + koff);
#pragma unroll
  for (int d0 = 0; d0 < DQ / 16; ++d0) { lds_b128_ptr kp = (d0 & 3) == 0 ? k0 : (d0 & 3) == 1 ? k1 : (d0 & 3) == 2 ? k2 : k3;
    const bf16x8 b0 = kp[(d0 >> 2) * 8];
    const bf16x8 b1 = kp[(d0 >> 2) * 8 + 32 * DQ * 2 / 16];
    if (d0 == 0) { p0 = __builtin_amdgcn_mfma_f32_32x32x16_bf16(b0, qr[0], negm, 0, 0, 0); p1 = __builtin_amdgcn_mfma_f32_32x32x16_bf16(b1, qr[0], negm, 0, 0, 0); }
    else { p0 = __builtin_amdgcn_mfma_f32_32x32x16_bf16(b0, qr[d0], p0, 0, 0, 0); p1 = __builtin_amdgcn_mfma_f32_32x32x16_bf16(b1, qr[d0], p1, 0, 0, 0); } }
}
__device__ __forceinline__ int v_st(int k, int c) { const int kk = (k & ~0xC) | ((k & 4) << 1) | ((k & 8) >> 1); return ((kk >> 3) * 4 + (c >> 5)) * 512 + ((kk & 7) * 32 + (c & 31)) * 2; }
__device__ __forceinline__ int v_rd_base(int lane) { return ((lane & 3) << 3) | (((lane >> 2) & 3) << 6) | (((lane >> 4) & 1) << 5) | (((lane >> 5) & 1) << 8); }
constexpr int v_rd_off(int d0, int ks, int half) { return d0 * 512 + ks * 4096 + half * 2048; }
template <int OFF> __device__ __forceinline__ s16x4 tr_read(int vb) {
  s16x4 r; asm volatile("ds_read_b64_tr_b16 %0, %1 offset:%2" : "=&v"(r) : "v"(vb), "i"(OFF) : "memory"); return r;
}
template <int D0> __device__ __forceinline__ void pv_one(f32x16& od, int vb, bf16x8 pa0, bf16x8 pa1, bf16x8 pa2, bf16x8 pa3) {
  const s16x4 l0 = tr_read<v_rd_off(D0, 0, 0)>(vb), h0 = tr_read<v_rd_off(D0, 0, 1)>(vb), l1 = tr_read<v_rd_off(D0, 1, 0)>(vb), h1 = tr_read<v_rd_off(D0, 1, 1)>(vb);
  const s16x4 l2 = tr_read<v_rd_off(D0, 2, 0)>(vb), h2 = tr_read<v_rd_off(D0, 2, 1)>(vb), l3 = tr_read<v_rd_off(D0, 3, 0)>(vb), h3 = tr_read<v_rd_off(D0, 3, 1)>(vb);
  asm volatile("s_waitcnt lgkmcnt(0)" ::: "memory"); SBAR();
#define PK(L, H) (bf16x8){L[0], L[1], L[2], L[3], H[0], H[1], H[2], H[3]}
  od = __builtin_amdgcn_mfma_f32_32x32x16_bf16(pa0, PK(l0, h0), od, 0, 0, 0);
  od = __builtin_amdgcn_mfma_f32_32x32x16_bf16(pa1, PK(l1, h1), od, 0, 0, 0);
  od = __builtin_amdgcn_mfma_f32_32x32x16_bf16(pa2, PK(l2, h2), od, 0, 0, 0);
  od = __builtin_amdgcn_mfma_f32_32x32x16_bf16(pa3, PK(l3, h3), od, 0, 0, 0);
#undef PK
}
__device__ __forceinline__ void pv_d0(f32x16* o, int vb, bf16x8 pa0, bf16x8 pa1, bf16x8 pa2, bf16x8 pa3) {
  pv_one<0>(o[0], vb, pa0, pa1, pa2, pa3); pv_one<1>(o[1], vb, pa0, pa1, pa2, pa3); pv_one<2>(o[2], vb, pa0, pa1, pa2, pa3); pv_one<3>(o[3], vb, pa0, pa1, pa2, pa3);
}
template <int MODE> __device__ __forceinline__ void maskf(f32x16& p0, f32x16& p1, int t, const Args& a, int wid, int r32, int hi, const float* bias_lds) {
  if constexpr (MODE == 0) { return; }
  else {
    if (t < a.nctx) return;
    if constexpr (MODE == 1) {
      const int kb = a.kpos0 + (t - a.nctx) * 64, qw = a.qpos0 + wid * 32;
      if (kb + 63 - qw <= 128 && qw + 31 - kb <= 128) return;
      int base = kb + 4 * hi - (qw + r32);
      asm volatile("" : "+v"(base));
#pragma unroll
      for (int r = 0; r < 16; ++r) { const int d0 = base + (r & 3) + 8 * (r >> 2);
        if ((unsigned)(d0 + 128) > 256u) p0[r] = -1e30f;
        if ((unsigned)(d0 + 160) > 256u) p1[r] = -1e30f; }
    } else {
      const int kr = a.klo + (t - a.nctx), rq = a.r0 + (wid >> 1);
      const int rs = min(max(rq - 4, 0), 120);
      if (kr < rs || kr >= rs + 8) {
#pragma unroll
        for (int r = 0; r < 16; ++r) { p0[r] = -1e30f; p1[r] = -1e30f; }
        return; }
      const int c = (wid & 1) * 32 + r32, cs = min(max(c - 8, 0), 48);
      int cb = 4 * hi - c + 63, vb = 4 * hi - cs;
      asm volatile("" : "+v"(cb), "+v"(vb));
      const float* bp = bias_lds + (kr - rq + 7) * 128 + cb;
#pragma unroll
      for (int r = 0; r < 16; ++r) { const int k0 = (r & 3) + 8 * (r >> 2), k1 = k0 + 32;
        const float b0 = bp[k0], b1 = bp[k1];
        p0[r] = ((unsigned)(k0 + vb) < 16u) ? fmaf(b0, a.inv_scale, p0[r]) : -1e30f;
        p1[r] = ((unsigned)(k1 + vb) < 16u) ? fmaf(b1, a.inv_scale, p1[r]) : -1e30f;
        if ((r & 3) == 3) SBAR(); }
    }
  }
}

template <int DQ, int MODE>
__device__ __forceinline__ void attn_unit(const Args& a, char* lds, const int wave0) {
  constexpr int SHM_K = KVBLK * DQ * 2, NQ = DQ / 16, OFF_K = 3 * SHM_V, OFF_WS = OFF_K + 2 * SHM_K;
  const int tid = fresh_tid(wave0), wid = tid >> 6, lane = tid & 63, r32 = lane & 31, hi = lane >> 5;
  char* V_lds = lds; char* K_lds = lds + OFF_K;
  float* ws = (float*)(lds + OFF_WS) + wid * 64; float* li_l = ws; float* al_l = ws + 32;
  float* bias_l = (float*)(lds + OFF_WS + 2048);
  if constexpr (MODE == 2) { if (tid < 465) bias_l[(tid / 31) * 128 + 48 + (tid % 31)] = a.rpb[tid]; }
  float m_reg = 0.f, l_reg = 0; f32x16 o[4] = {}; bf16x8 qr[NQ];
  const float thr = a.thr_raw;
  const bf16* Qw = a.Q + (long)(wid * QBLK + r32) * a.ldq + hi * 8;
#pragma unroll
  for (int d0 = 0; d0 < NQ; ++d0) qr[d0] = *reinterpret_cast<const bf16x8*>(Qw + d0 * 16);
  if constexpr (DQ == 128) {
    if (a.qgain) { float xf[8][8]; float ss = 0.f;
#pragma unroll
      for (int d0 = 0; d0 < 8; ++d0)
#pragma unroll
        for (int e = 0; e < 8; ++e) { xf[d0][e] = __uint_as_float(((unsigned)(unsigned short)qr[d0][e]) << 16); ss += xf[d0][e] * xf[d0][e]; }
      { auto rr = __builtin_amdgcn_permlane32_swap(__float_as_uint(ss), __float_as_uint(ss), false, false); ss = __uint_as_float(rr[0]) + __uint_as_float(rr[1]); }
      const float rstd = rsqrtf(ss * (1.0f / 128.0f) + 1e-6f) * a.C;
#pragma unroll
      for (int d0 = 0; d0 < 8; ++d0) { const float* gp = a.qgain + d0 * 16 + hi * 8;
#pragma unroll
        for (int e = 0; e < 8; ++e) xf[d0][e] = xf[d0][e] * rstd * gp[e]; }
      if (a.qrope_t0 >= 0) { const int t = a.qrope_t0 + wid * QBLK + r32; const float prow = (float)(t >> 6), pcol = (float)(t & 63);
#pragma unroll
        for (int half = 0; half < 2; ++half)
#pragma unroll
          for (int blk = 0; blk < 2; ++blk)
#pragma unroll
            for (int e = 0; e < 8; ++e) { const int j = blk * 16 + hi * 8 + e, da = 4 * half + blk, db = da + 2;
              const float inv_freq = __builtin_amdgcn_exp2f(-(float)j * (13.287712379549449f / 32.0f)); float rev = (half ? pcol : prow) * inv_freq * 0.15915494309189535f; rev -= rintf(rev);
              const float sn = __builtin_amdgcn_sinf(rev), cs = __builtin_amdgcn_cosf(rev);
              const float x = xf[da][e], y = xf[db][e]; xf[da][e] = x * cs - y * sn; xf[db][e] = y * cs + x * sn; } }
#pragma unroll
      for (int d0 = 0; d0 < 8; ++d0) { bf16x8 w;
#pragma unroll
        for (int e = 0; e < 8; ++e) { unsigned u = __float_as_uint(xf[d0][e]); u = (u + 0x7fffu + ((u >> 16) & 1u)) >> 16; w[e] = (short)u; }
        qr[d0] = w; } } }
  if constexpr (DQ == 192) {
    if (a.qrope_t0 >= 0) { const int t = a.qrope_t0 + wid * QBLK + r32; const float prow = (float)(t >> 6), pcol = (float)(t & 63);
#pragma unroll
      for (int half = 0; half < 2; ++half) { bf16x8 xa = qr[8 + 2 * half], xb = qr[9 + 2 * half]; const float pos = half ? pcol : prow;
#pragma unroll
        for (int e = 0; e < 8; ++e) { const int j = hi * 8 + e;
          const float inv_freq = __builtin_amdgcn_exp2f(-(float)j * (13.287712379549449f / 16.0f)); float rev = pos * inv_freq * 0.15915494309189535f; rev -= rintf(rev);
          const float sn = __builtin_amdgcn_sinf(rev), cs = __builtin_amdgcn_cosf(rev);
          const float x = __uint_as_float(((unsigned)(unsigned short)xa[e]) << 16), y = __uint_as_float(((unsigned)(unsigned short)xb[e]) << 16);
          const float nx = x * cs - y * sn, ny = y * cs + x * sn; unsigned ux = __float_as_uint(nx), uy = __float_as_uint(ny);
          ux = (ux + 0x7fffu + ((ux >> 16) & 1u)) >> 16; uy = (uy + 0x7fffu + ((uy >> 16) & 1u)) >> 16; xa[e] = (short)ux; xb[e] = (short)uy; }
        qr[8 + 2 * half] = xa; qr[9 + 2 * half] = xb; } } }
  const int vb0 = (int)(uintptr_t)V_lds + v_rd_base(lane);
  int kx[4];
#pragma unroll
  for (int q = 0; q < 4; ++q) kx[q] = (int)(uintptr_t)K_lds + r32 * (DQ * 2) + ((q * 32 + hi * 16) ^ ((r32 & 7) << 4));
  constexpr int KP = DQ / 64;
  int koff[KP]; bool kk2[KP]; int voff[2];
#pragma unroll
  for (int i = 0; i < KP; ++i) { const int q = (wid * KP + i) * 64 + lane, row = q / (DQ / 8), cs = q % (DQ / 8), c = cs ^ (row & 7);
    kk2[i] = (DQ == 192) && c >= 16; koff[i] = kk2[i] ? row * a.ldk2 + (c - 16) * 8 : row * a.ldk + c * 8; }
#pragma unroll
  for (int i = 0; i < 2; ++i) { const int q = (wid * 2 + i) * 64 + lane, sub = q >> 5, within = q & 31, kk = (sub >> 2) * 8 + (within >> 2), c = (sub & 3) * 32 + (within & 3) * 8;
    const int k = kk; voff[i] = k * a.ldv + c; }
  const unsigned kdst0 = (unsigned)(uintptr_t)K_lds + (unsigned)(wid * KP) * 1024u, vdst0 = (unsigned)(uintptr_t)V_lds + (unsigned)(wid * 2) * 1024u;
#define KROW(t) ((t) < a.nctx ? a.ctx_row0 + 64 * (t) : a.lat_row0 + 64 * ((t) - a.nctx))
#define GLDS16(gsrc, ldst) do { unsigned keep_; asm volatile("s_mov_b32 %0, m0\n\ts_mov_b32 m0, %2\n\ts_nop 0\n\tglobal_load_lds_dwordx4 %1, off\n\ts_mov_b32 m0, %0" : "=&s"(keep_) : "v"(gsrc), "s"(ldst) : "memory"); } while (0)
#define DMA(t) do { const long kr_ = KROW(t); const unsigned kd_ = (unsigned)__builtin_amdgcn_readfirstlane((int)(kdst0 + (unsigned)(((t) & 1) * SHM_K))), vd_ = (unsigned)__builtin_amdgcn_readfirstlane((int)(vdst0 + (unsigned)(((t) % 3) * SHM_V))); \
    const bf16* vp_ = a.V + kr_ * a.ldv; const bf16* kp_ = a.K + kr_ * a.ldk; const bf16* kp2_ = (DQ == 192) ? a.K2 + kr_ * a.ldk2 : kp_; \
    _Pragma("unroll") for (int i_ = 0; i_ < KP; ++i_) { const bf16* g_ = ((DQ == 192) && kk2[i_] ? kp2_ : kp_) + koff[i_]; GLDS16(g_, kd_ + (unsigned)i_ * 1024u); } \
    _Pragma("unroll") for (int i_ = 0; i_ < 2; ++i_) GLDS16(vp_ + voff[i_], vd_ + (unsigned)i_ * 1024u); } while (0)
#define WAIT_BAR() asm volatile("s_waitcnt vmcnt(0) lgkmcnt(0)\n\ts_barrier" ::: "memory")
#define RESC(al) do { if (__any((al) < 1.f)) { if (hi == 0) al_l[r32] = (al); asm volatile("s_waitcnt lgkmcnt(0)" ::: "memory"); \
    _Pragma("unroll") for (int d = 0; d < 4; ++d) _Pragma("unroll") for (int r = 0; r < 16; ++r) o[d][r] *= al_l[crow(r, hi)]; } } while (0)
  f32x16 pA0, pA1, pB0, pB1; float mnA, mnB, alA, alB; bf16x8 pa0, pa1, pa2, pa3; const int NT = a.NT;
#define STEP(j, PN0, PN1, MNN, ALN, PP0, PP1, ALP) do { const int j_ = (j); \
    WAIT_BAR();                            \
    if (j_ + 1 < NT) DMA(j_ + 1);          \
    SBAR(); qkt<DQ>(PN0, PN1, kx, (j_ & 1) * SHM_K, qr, negm); maskf<MODE>(PN0, PN1, j_, a, wid, r32, hi, bias_l); \
    finishSM(PP0, PP1, ALP, l_reg, pa0, pa1, pa2, pa3); SBAR(); \
    pv_d0(o, vb0 + ((j_ - 1) % 3) * SHM_V, pa0, pa1, pa2, pa3); partialSM<false>(PN0, PN1, m_reg, ALN, negm, thr); \
    RESC(ALN); } while (0)
  DMA(0); DMA(1);
  f32x16 negm = f32x16{}; asm volatile("" : "+v"(negm));
  WAIT_BAR();
  qkt<DQ>(pA0, pA1, kx, 0, qr, negm); maskf<MODE>(pA0, pA1, 0, a, wid, r32, hi, bias_l); partialSM<true>(pA0, pA1, m_reg, alA, negm, thr);
  for (int j = 1; j + 1 < NT; j += 2) {
    STEP(j, pB0, pB1, mnB, alB, pA0, pA1, alA);
    STEP(j + 1, pA0, pA1, mnA, alA, pB0, pB1, alB);
  }
  STEP(NT - 1, pB0, pB1, mnB, alB, pA0, pA1, alA);
  finishSM(pB0, pB1, alB, l_reg, pa0, pa1, pa2, pa3); SBAR();
  pv_d0(o, vb0 + ((NT - 1) % 3) * SHM_V, pa0, pa1, pa2, pa3);
  if constexpr (MODE == 1) l_reg += __builtin_amdgcn_exp2f(a.sink_l2 - m_reg);
  if (hi == 0) li_l[r32] = l_reg; asm volatile("s_waitcnt lgkmcnt(0)" ::: "memory");
  float rli[16];
#pragma unroll
  for (int r = 0; r < 16; ++r) rli[r] = __builtin_amdgcn_rcpf(li_l[crow(r, hi)]);
  asm volatile("s_waitcnt lgkmcnt(0)\n\ts_barrier" ::: "memory");
  { bf16* stg = (bf16*)(lds + wid * 8704);
#pragma unroll
    for (int r = 0; r < 16; ++r) { const int orow = crow(r, hi);
#pragma unroll
      for (int d0 = 0; d0 < 4; ++d0) { const float v = o[d0][r] * rli[r]; unsigned u = __float_as_uint(v); u = (u + 0x7fffu + ((u >> 16) & 1u)) >> 16; stg[orow * 136 + d0 * 32 + r32] = (bf16)u; } }
    asm volatile("s_waitcnt lgkmcnt(0)" ::: "memory");
    bf16* Ow = a.O + (long)(wid * QBLK) * a.ldo;
#pragma unroll
    for (int i = 0; i < 8; ++i) { const int row = i * 4 + (lane >> 4), ch = lane & 15; const u32x4 v = *(const u32x4*)(stg + row * 136 + ch * 8); *(u32x4*)(Ow + (long)row * a.ldo + ch * 8) = v; } }
  asm volatile("s_waitcnt lgkmcnt(0)\n\ts_barrier" ::: "memory");
#undef KROW
#undef GLDS16
#undef DMA
#undef WAIT_BAR
#undef RESC
#undef STEP
}
#undef SBAR
}
#define LAS __attribute__((address_space(3)))
typedef unsigned short bf16;
typedef float f32x4 __attribute__((ext_vector_type(4)));
typedef unsigned v4u __attribute__((ext_vector_type(4)));
typedef unsigned v2u __attribute__((ext_vector_type(2)));
constexpr int NWAVES = 8, NTHR = 512;
constexpr int DM = 2048, SEQ = 8192, NCTX = 256, MLAT = 2 * SEQ, MALL = MLAT + 2 * NCTX, DFF = 5632;
constexpr int N_IN0 = 2816, N_IN1 = 4608, N_UQ = 1536, N_UKV = 2048, N_GU = 2 * DFF;
constexpr float EPS = 1e-6f;
constexpr size_t MiB = 1u << 20;
constexpr size_t WS_MOD = 0, WS_BAR = 512 * 1024, BAR_BYTES = 16384;
constexpr size_t WS_WIN0 = 1 * MiB, WS_WUQ = WS_WIN0 + 11 * MiB, WS_WUKV = WS_WUQ + 2 * MiB, WS_WOUT0 = WS_WUKV + 2 * MiB, WS_WIN1 = WS_WOUT0 + 8 * MiB, WS_WOUT1 = WS_WIN1 + 18 * MiB,
                 WS_WGU = WS_WOUT1 + 8 * MiB, WS_WD = WS_WGU + 88 * MiB, WS_HCTX = WS_WD + 44 * MiB;
constexpr size_t WS_UO = WS_HCTX + 4 * MiB;
constexpr size_t WS_OB = WS_UO + 66 * MiB;
constexpr size_t WS_BIG = WS_UO + 132 * MiB;
constexpr size_t WS_QB = WS_BIG + 91 * MiB, WS_KVB = WS_BIG + 141 * MiB, WS_UB = WS_BIG + 149 * MiB, WS_END = WS_BIG + 215 * MiB;
static_assert((size_t)MALL * DM * 2 == 66 * MiB && (size_t)MALL * N_IN0 * 2 <= 91 * MiB && (size_t)MALL * N_UQ * 2 <= 50 * MiB && (size_t)MALL * N_IN1 * 2 <= 149 * MiB && (size_t)MALL * DFF * 2 <= 215 * MiB, "ws map");

__device__ __forceinline__ unsigned f2bf(float f) { unsigned u = __builtin_bit_cast(unsigned, f); return (u + 0x7fffu + ((u >> 16) & 1u)) >> 16; }
__device__ __forceinline__ unsigned pk2(float lo, float hi) { return f2bf(lo) | (f2bf(hi) << 16); }
__device__ __forceinline__ float bf2f(bf16 v) { return __uint_as_float(((unsigned)v) << 16); }
__device__ __forceinline__ float wave_sum(float v, int lane) {
#pragma unroll
    for (int o = 1; o < 64; o <<= 1) v += __int_as_float(__builtin_amdgcn_ds_bpermute((lane ^ o) << 2, __float_as_int(v)));
    return v;
}
__device__ __forceinline__ float silu_f(float x) { return x / (1.0f + __expf(-x)); }

#define GAS __attribute__((address_space(1)))
#define XB_TMO      128
#define XB_XCNT(j)  (256  + 64 * (j))
#define XB_XSUB(j)  (1280 + 64 * (j))
#define XB_XGEN(j)  (2304 + 64 * (j))
#define XB_TOP      3328
#define XB_TOPGEN   3392
#define XCD_BAR_WORDS 3456
#define XB_SPIN_CAP (1u << 18)

__device__ __forceinline__ unsigned xb_ld(unsigned* p)              { return __hip_atomic_load(p, __ATOMIC_RELAXED, __HIP_MEMORY_SCOPE_AGENT); }
__device__ __forceinline__ unsigned xb_add(unsigned* p, unsigned v) { return __hip_atomic_fetch_add(p, v, __ATOMIC_RELAXED, __HIP_MEMORY_SCOPE_AGENT); }
__device__ __forceinline__ unsigned xb_xcc_id() { return (unsigned)__builtin_amdgcn_s_getreg((3 << 11) | 20) & 0xFu; }
#define XB_SPIN(cond, bar) do { unsigned _sp = 0; while (cond) { __builtin_amdgcn_s_sleep(1); \
    if ((++_sp & 255u) == 0u) { if (xb_ld(&(bar)[XB_TMO])) break; if (_sp > XB_SPIN_CAP) { atomicAdd(&(bar)[XB_TMO], 1u); break; } } } } while (0)

struct XcdBarrier {
    unsigned* bar; unsigned x;
    volatile LAS unsigned* st;
};

__device__ __forceinline__ XcdBarrier xcd_barrier_post(unsigned* bar, volatile LAS unsigned* st) {
    XcdBarrier b; b.bar = bar; b.x = xb_xcc_id(); b.st = st;
    if (threadIdx.x == 0) (void)xb_add(&bar[XB_XCNT(b.x)], 1u);
    return b;
}
__device__ __forceinline__ void xcd_barrier_complete(unsigned* bar, unsigned x, unsigned& nloc, unsigned& nx) {
    const unsigned G = gridDim.x * gridDim.y * gridDim.z;
    unsigned sum, cnt, mine, sp = 0u;
    for (;;) {
        sum = 0u; cnt = 0u; mine = 0u;
#pragma unroll
        for (unsigned j = 0; j < 16; ++j) { const unsigned c = xb_ld(&bar[XB_XCNT(j)]); sum += c; cnt += (c > 0u) ? 1u : 0u; mine = (j == x) ? c : mine; }
        if (sum == G) break;
        __builtin_amdgcn_s_sleep(1);
        if ((++sp & 255u) == 0u) { if (xb_ld(&bar[XB_TMO])) break; if (sp > XB_SPIN_CAP) { atomicAdd(&bar[XB_TMO], 1u); break; } }
    }
    nloc = mine > 0u ? mine : 1u; nx = cnt > 0u ? cnt : 1u;
}

__device__ __forceinline__ void xcd_barrier(const XcdBarrier& b) {
    asm volatile("s_waitcnt vmcnt(0)" ::: "memory");
    __syncthreads();
    if (threadIdx.x == 0) {
        unsigned* bar = b.bar;
        __builtin_amdgcn_s_waitcnt(0);
        unsigned nloc = b.st[0], nx = b.st[1];
        if (nloc == 0u) { xcd_barrier_complete(bar, b.x, nloc, nx); b.st[0] = nloc; b.st[1] = nx; }
        const unsigned old = xb_add(&bar[XB_XSUB(b.x)], 1u);
        const unsigned gen = old / nloc;
        if (old + 1u == (gen + 1u) * nloc) {
            __builtin_amdgcn_fence(__ATOMIC_RELEASE, "agent");
            asm volatile("s_waitcnt vmcnt(0)" ::: "memory");
            const unsigned og = xb_add(&bar[XB_TOP], 1u);
            const unsigned tg = og / nx;
            if (og + 1u == (tg + 1u) * nx) xb_add(&bar[XB_TOPGEN], 1u);
            else XB_SPIN(xb_ld(&bar[XB_TOPGEN]) == tg, bar);
            __builtin_amdgcn_fence(__ATOMIC_ACQUIRE, "agent");
            xb_add(&bar[XB_XGEN(b.x)], 1u);
            asm volatile("s_waitcnt vmcnt(0)" ::: "memory");
        } else {
            XB_SPIN(xb_ld(&bar[XB_XGEN(b.x)]) == gen, bar);
            __builtin_amdgcn_fence(__ATOMIC_ACQUIRE, "agent");
            asm volatile("s_waitcnt vmcnt(0)" ::: "memory");
        }
    }
    __syncthreads();
}

struct KArgs { const float* in[29]; float* out; unsigned char* ws; };
typedef const __attribute__((address_space(4))) KArgs* KAP;
__device__ __forceinline__ KAP kargs() { KAP p = (KAP)__builtin_amdgcn_kernarg_segment_ptr(); asm volatile("" : "+s"(p)); return p; }

__device__ __forceinline__ void transpose_item(const float* W, int K, int N, bf16* WT, int k0, int n0, int drow0, LAS float* scr, int lane, const float wsc) {
#pragma unroll 8
    for (int i = 0; i < 32; ++i) { const int kk = 2 * i + (lane >> 5); scr[kk * 33 + (lane & 31)] = __builtin_nontemporal_load(W + (size_t)(k0 + kk) * N + n0 + (lane & 31)) * wsc; }
    asm volatile("s_waitcnt lgkmcnt(0)" ::: "memory");
    const int c = lane & 7;
#pragma unroll
    for (int j = 0; j < 4; ++j) { const int n = (lane >> 3) + 8 * j; const LAS float* s = scr + (8 * c) * 33 + n;
        v4u o; o.x = pk2(s[0 * 33], s[1 * 33]); o.y = pk2(s[2 * 33], s[3 * 33]); o.z = pk2(s[4 * 33], s[5 * 33]); o.w = pk2(s[6 * 33], s[7 * 33]);
        *(v4u*)(WT + (size_t)(drow0 + n) * K + k0 + 8 * c) = o; }
    asm volatile("s_waitcnt lgkmcnt(0)" ::: "memory");
}
__device__ __forceinline__ bool conv_matrix(int& it, const float* W, int K, int N, bf16* WT, int mode, LAS float* scr, int lane, const float wsc = 1.0f) {
    const int nblk = N / 32, items = (K / 64) * nblk;
    if (it >= items) { it -= items; return false; }
    const int kb = it / nblk, nb = it % nblk, n0 = 32 * nb;
    const int drow0 = mode == 0 ? n0 : ((n0 >> 7) * 256 + (mode == 2 ? 128 : 0) + (n0 & 127));
    transpose_item(W, K, N, WT, 64 * kb, n0, drow0, scr, lane, wsc);
    return true;
}
__device__ __forceinline__ void p0_weights(KAP a, LAS unsigned char* lds, int gw, int NGW, int wave, int lane) {
    LAS float* scr = (LAS float*)(lds + wave * 8704);
    unsigned char* ws = a->ws;
    constexpr int I_TOTAL = (2048 / 64) * (2624 / 32) + (512 / 64) * (1536 / 32) + (512 / 64) * (2048 / 32) + 2 * (2048 / 64) * (2048 / 32) + (2048 / 64) * (4608 / 32)
                          + 4 * (2048 / 64) * (DFF / 32) + 2 * (DFF / 64) * (2048 / 32);
    for (int item = gw; item < I_TOTAL; item += NGW) {
        int it = item;
        if (conv_matrix(it, a->in[13], 2048, 2624, (bf16*)(ws + WS_WIN0), 0, scr, lane)) continue;
        if (conv_matrix(it, a->in[19], 512, 1536, (bf16*)(ws + WS_WUQ), 0, scr, lane, 0.07216878364870322f * 1.4426950408889634f)) continue;
        if (conv_matrix(it, a->in[20], 512, 2048, (bf16*)(ws + WS_WUKV), 0, scr, lane)) continue;
        if (conv_matrix(it, a->in[14], 2048, 2048, (bf16*)(ws + WS_WOUT0), 0, scr, lane)) continue;
        if (conv_matrix(it, a->in[21], 2048, 4608, (bf16*)(ws + WS_WIN1), 0, scr, lane)) continue;
        if (conv_matrix(it, a->in[22], 2048, 2048, (bf16*)(ws + WS_WOUT1), 0, scr, lane)) continue;
        if (conv_matrix(it, a->in[10], 2048, DFF, (bf16*)(ws + WS_WGU), 1, scr, lane)) continue;
        if (conv_matrix(it, a->in[10] + (size_t)2048 * DFF, 2048, DFF, (bf16*)(ws + WS_WGU + 44 * MiB), 1, scr, lane)) continue;
        if (conv_matrix(it, a->in[11], 2048, DFF, (bf16*)(ws + WS_WGU), 2, scr, lane)) continue;
        if (conv_matrix(it, a->in[11] + (size_t)2048 * DFF, 2048, DFF, (bf16*)(ws + WS_WGU + 44 * MiB), 2, scr, lane)) continue;
        if (conv_matrix(it, a->in[12], DFF, 2048, (bf16*)(ws + WS_WD), 0, scr, lane)) continue;
        conv_matrix(it, a->in[12] + (size_t)2048 * DFF, DFF, 2048, (bf16*)(ws + WS_WD + 22 * MiB), 0, scr, lane);
    }
}
__device__ __forceinline__ void p0_mod(KAP a, LAS unsigned char* lds, int tid) {
    LAS float* sv = (LAS float*)lds;
    LAS float* red = (LAS float*)(lds + 24576);
    const int blk = blockIdx.x; if (blk >= 256) return;
    const int layer = blk >> 7, col0 = (blk & 127) * 96;
    for (int i = tid; i < 3 * 2048; i += NTHR) { const int v = i >> 11, k = i & 2047; const float x = v < 2 ? a->in[1][v * 2048 + k] : a->in[3][k]; sv[i] = silu_f(x); }
    __syncthreads();
    const int c4 = tid % 24, ks = tid / 24;
    if (ks < 21) {
        const float* W = a->in[4] + (size_t)layer * 2048 * 12288 + col0 + 4 * c4;
        f32x4 a0 = {0, 0, 0, 0}, a1 = a0, a2 = a0;
#pragma unroll 8
        for (int k = ks; k < 2048; k += 21) { const f32x4 w = __builtin_nontemporal_load((const f32x4*)(W + (size_t)k * 12288)); a0 += w * sv[k]; a1 += w * sv[2048 + k]; a2 += w * sv[4096 + k]; }
        LAS float* r = red + ks * 288 + 4 * c4;
        *(LAS f32x4*)(r) = a0; *(LAS f32x4*)(r + 96) = a1; *(LAS f32x4*)(r + 192) = a2;
    }
    __syncthreads();
    if (tid < 288) { float s = 0.f;
        for (int q = 0; q < 21; ++q) s += red[q * 288 + tid];
        const int v = tid / 96, j = tid % 96;
        ((float*)(a->ws + WS_MOD))[(size_t)(layer * 3 + v) * 12288 + col0 + j] = s + a->in[5][layer * 12288 + col0 + j]; }
    __syncthreads();
}
__device__ __forceinline__ void store_u(bf16* urow, int lane, const f32x4 (&v)[8], float rstd, const float* g, const float* sh, const float* sc) {
#pragma unroll
    for (int j = 0; j < 8; ++j) { const int ci = 256 * j + 4 * lane; const f32x4 g4 = *(const f32x4*)(g + ci), s4 = *(const f32x4*)(sc + ci), h4 = *(const f32x4*)(sh + ci);
        const f32x4 t = (v[j] * rstd * g4) * (1.0f + s4) + h4; v2u w; w.x = pk2(t[0], t[1]); w.y = pk2(t[2], t[3]); *(v2u*)(urow + ci) = w; }
}
__device__ __forceinline__ void pass_pre(const float* hlat, const float* hctx, const float* g, const float* mod, int sh_off, int sc_off, bf16* U, int nrows, int gw, int NGW, int lane) {
    for (int m0 = gw; m0 < nrows; m0 += 2 * NGW) {
        int mr[2]; mr[0] = m0; mr[1] = m0 + NGW; const bool two = mr[1] < nrows; if (!two) mr[1] = m0;
        f32x4 v[2][8]; float ss[2];
#pragma unroll
        for (int r = 0; r < 2; ++r) { const int m = mr[r]; const float* src = m < MLAT ? hlat + (size_t)m * DM : hctx + (size_t)(m - MLAT) * DM;
#pragma unroll
            for (int j = 0; j < 8; ++j) v[r][j] = *(const f32x4*)(src + 256 * j + 4 * lane); }
#pragma unroll
        for (int r = 0; r < 2; ++r) { ss[r] = 0.f;
#pragma unroll
            for (int j = 0; j < 8; ++j) ss[r] += (v[r][j][0] * v[r][j][0] + v[r][j][1] * v[r][j][1]) + (v[r][j][2] * v[r][j][2] + v[r][j][3] * v[r][j][3]); }
#pragma unroll
        for (int r = 0; r < 2; ++r) { if (r == 1 && !two) break; const int m = mr[r]; const float* mv = mod + (m < MLAT ? (m >> 13) : 2) * 12288;
            const float rstd = rsqrtf(wave_sum(ss[r], lane) * (1.0f / DM) + EPS);
            store_u(U + (size_t)m * DM, lane, v[r], rstd, g, mv + sh_off, mv + sc_off); }
    }
}
__device__ __forceinline__ void pass_post(const bf16* o16, const float* opart, const float* hlat, const float* hctx, float* olat, float* octx, const float* gpost, const float* mod, int gt_off,
                                          const float* gpre, const float* modu, int sh_off, int sc_off, bf16* U, int nrows, int gw, int NGW, int lane) {
    for (int m0 = gw; m0 < nrows; m0 += 2 * NGW) {
        int mr[2]; mr[0] = m0; mr[1] = m0 + NGW; const bool two = mr[1] < nrows; if (!two) mr[1] = m0;
        f32x4 v[2][8], hh[2][8]; float ss[2];
#pragma unroll
        for (int r = 0; r < 2; ++r) { const int m = mr[r]; ss[r] = 0.f;
            const float* hs = m < MLAT ? hlat + (size_t)m * DM : hctx + (size_t)(m - MLAT) * DM;
            if (m < MLAT) { const bf16* orow = o16 + (size_t)m * DM;
#pragma unroll
                for (int j = 0; j < 8; ++j) { const v2u raw = *(const v2u*)(orow + 256 * j + 4 * lane);
                    v[r][j] = (f32x4){__uint_as_float(raw.x << 16), __uint_as_float(raw.x & 0xffff0000u), __uint_as_float(raw.y << 16), __uint_as_float(raw.y & 0xffff0000u)}; }
            } else { const float* orow = opart + (size_t)(m - MLAT) * DM;
#pragma unroll
                for (int j = 0; j < 8; ++j) { const int ci = 256 * j + 4 * lane;
                    v[r][j] = (*(const f32x4*)(orow + ci) + *(const f32x4*)(orow + ci + (size_t)512 * DM)) + (*(const f32x4*)(orow + ci + (size_t)1024 * DM) + *(const f32x4*)(orow + ci + (size_t)1536 * DM)); } }
#pragma unroll
            for (int j = 0; j < 8; ++j) hh[r][j] = *(const f32x4*)(hs + 256 * j + 4 * lane);
        }
#pragma unroll
        for (int r = 0; r < 2; ++r)
#pragma unroll
            for (int j = 0; j < 8; ++j) ss[r] += (v[r][j][0] * v[r][j][0] + v[r][j][1] * v[r][j][1]) + (v[r][j][2] * v[r][j][2] + v[r][j][3] * v[r][j][3]);
#pragma unroll
        for (int r = 0; r < 2; ++r) { const int m = mr[r]; if (r == 1 && !two) break;
            float* hd = m < MLAT ? olat + (size_t)m * DM : octx + (size_t)(m - MLAT) * DM; const int vi = (m < MLAT ? (m >> 13) : 2); const float* mv = mod + vi * 12288;
            const float rstd = rsqrtf(wave_sum(ss[r], lane) * (1.0f / DM) + EPS); float s2 = 0.f;
#pragma unroll
            for (int j = 0; j < 8; ++j) { const int ci = 256 * j + 4 * lane; const f32x4 g4 = *(const f32x4*)(gpost + ci), t4 = *(const f32x4*)(mv + gt_off + ci);
                const f32x4 nv = hh[r][j] + t4 * (v[r][j] * rstd * g4); v[r][j] = nv; *(f32x4*)(hd + ci) = nv; s2 += (nv[0] * nv[0] + nv[1] * nv[1]) + (nv[2] * nv[2] + nv[3] * nv[3]); }
            if (U) { const float* mu = modu + vi * 12288; const float rstd2 = rsqrtf(wave_sum(s2, lane) * (1.0f / DM) + EPS); store_u(U + (size_t)m * DM, lane, v[r], rstd2, gpre, mu + sh_off, mu + sc_off); }
        }
    }
}
__device__ __forceinline__ void rope_cs(float pos, int j, float inv_nf, float& cs, float& sn) {
    const float inv_freq = __builtin_amdgcn_exp2f(-(float)j * inv_nf * 13.287712379549449f);
    float rev = pos * inv_freq * 0.15915494309189535f; rev -= rintf(rev);
    sn = __builtin_amdgcn_sinf(rev); cs = __builtin_amdgcn_cosf(rev);
}
template <int NH> __device__ __forceinline__ void heads_load(const bf16* base, int ia, float (&x)[NH], float (&y)[NH]) {
#pragma unroll
    for (int h = 0; h < NH; ++h) { x[h] = bf2f(base[h * 128 + ia]); y[h] = bf2f(base[h * 128 + ia + 32]); }
}
template <int NH> __device__ __forceinline__ void heads_finish(bf16* base, int ia, float (&x)[NH], float (&y)[NH], const float* gain, bool rope, float cs, float sn, int lane) {
    const float ga = gain[ia], gb = gain[ia + 32];
#pragma unroll
    for (int h = 0; h < NH; ++h) {
        const float rstd = rsqrtf(wave_sum(x[h] * x[h] + y[h] * y[h], lane) * (1.0f / 128.0f) + EPS);
        float a = x[h] * rstd * ga, b = y[h] * rstd * gb;
        if (rope) { const float na = a * cs - b * sn, nb = b * cs + a * sn; a = na; b = nb; }
        base[h * 128 + ia] = (bf16)f2bf(a); base[h * 128 + ia + 32] = (bf16)f2bf(b); }
}
__device__ __forceinline__ void unpack8(const v4u raw, float (&x)[8]) {
#pragma unroll
    for (int i = 0; i < 4; ++i) { x[2 * i] = __uint_as_float(raw[i] << 16); x[2 * i + 1] = __uint_as_float(raw[i] & 0xffff0000u); }
}
__device__ __forceinline__ void norm512_finish(bf16* p, const float (&x)[8], const float* gain, int lane) {
    float ss = 0.f;
#pragma unroll
    for (int i = 0; i < 8; ++i) ss += x[i] * x[i];
    const float rstd = rsqrtf(wave_sum(ss, lane) * (1.0f / 512.0f) + EPS);
    const f32x4 g0 = *(const f32x4*)(gain + 8 * lane), g1 = *(const f32x4*)(gain + 8 * lane + 4);
    v4u w; w.x = pk2(x[0] * rstd * g0[0], x[1] * rstd * g0[1]); w.y = pk2(x[2] * rstd * g0[2], x[3] * rstd * g0[3]); w.z = pk2(x[4] * rstd * g1[0], x[5] * rstd * g1[1]); w.w = pk2(x[6] * rstd * g1[2], x[7] * rstd * g1[3]);
    *(v4u*)(p + 8 * lane) = w;
}
__device__ __forceinline__ void rope64(bf16* p, float prow, float pcol, int l32) {
    const int j = l32 & 15, s = (l32 >> 4) & 1, ia = 32 * s + j, ib = ia + 16;
    const float x = bf2f(p[ia]), y = bf2f(p[ib]); float cs, sn; rope_cs(s ? pcol : prow, j, 1.0f / 16.0f, cs, sn);
    p[ia] = (bf16)f2bf(x * cs - y * sn); p[ib] = (bf16)f2bf(y * cs + x * sn);
}
__device__ __forceinline__ void prep_ab(bf16* P, const float* aqn, const float* akn, const float* bqn, const float* bkvn, int gw, int NGW, int lane) {
    const int ia = 64 * (lane >> 5) + (lane & 31);
    for (int m = gw; m < MALL; m += NGW) {
        bf16* row = P + (size_t)m * N_IN0; const bool lat = m < MLAT; const int t = m & (SEQ - 1); const float pr = (float)(t >> 6), pc = (float)(t & 63);
        float xk[2], yk[2], c1[8], c2[8];
        heads_load<2>(row + 1024, ia, xk, yk);
        unpack8(*(const v4u*)(row + 1536 + 8 * lane), c1); unpack8(*(const v4u*)(row + 2048 + 8 * lane), c2);
        if (lat && lane < 32) rope64(row + 2560, pr, pc, lane);
        float cs = 1.f, sn = 0.f; if (lat) rope_cs((lane >> 5) ? pc : pr, lane & 31, 1.0f / 32.0f, cs, sn);
        heads_finish<2>(row + 1024, ia, xk, yk, akn, lat, cs, sn, lane);
        norm512_finish(row + 1536, c1, bqn, lane); norm512_finish(row + 2048, c2, bkvn, lane);
    }
}
__device__ __forceinline__ void prep_qb(bf16* QB, int gw, int NGW, int lane) {
    for (int m = gw; m < MLAT; m += NGW) {
        bf16* row = QB + (size_t)m * N_UQ; const int t = m & (SEQ - 1); const float pr = (float)(t >> 6), pc = (float)(t & 63);
#pragma unroll
        for (int i = 0; i < 4; ++i) rope64(row + (2 * i + (lane >> 5)) * 192 + 128, pr, pc, lane & 31);
    }
}
__device__ __forceinline__ void prep_cd(bf16* P, const float* cqn, const float* ckn, const float* dqn, const float* dkn, int gw, int NGW, int lane) {
    const int ia = 64 * (lane >> 5) + (lane & 31);
    for (int m = gw; m < MALL; m += NGW) {
        bf16* row = P + (size_t)m * N_IN1; const bool lat = m < MLAT; const int t = m & (SEQ - 1); const float pr = (float)(t >> 6), pc = (float)(t & 63);
        float cs = 1.f, sn = 0.f; if (lat) rope_cs((lane >> 5) ? pc : pr, lane & 31, 1.0f / 32.0f, cs, sn);
        float xk[2], yk[2], xd[8], yd[8];
        heads_load<2>(row + 1024, ia, xk, yk); heads_load<8>(row + 2560, ia, xd, yd);
        heads_finish<2>(row + 1024, ia, xk, yk, ckn, lat, cs, sn, lane); heads_finish<8>(row + 2560, ia, xd, yd, dkn, false, 1.f, 0.f, lane);
    }
}
constexpr float LOG2E = 1.4426950408889634f;
__device__ __forceinline__ void attn_phase_ab(const bf16* P0, const bf16* QB, const bf16* KVB, bf16* OB, const float* aqn, char* lds, const int wave0) {
    const int c = blockIdx.x, G = gridDim.x;
    for (int id = c; id < 1024 + 32; id += G) {
        att::Args a{};
        int mixer, b, h, qrow0, NT;
        if (id < 1024) { const int rnd = id >> 8, cc = id & 255; mixer = rnd >> 1; b = rnd & 1; h = cc & 7; qrow0 = b * SEQ + (cc >> 3) * 256; NT = 132; }
        else { const int cc = id - 1024; mixer = cc >> 4; b = (cc >> 3) & 1; h = cc & 7; qrow0 = MLAT + b * NCTX; NT = 4; }
        a.NT = NT; a.nctx = 4; a.ctx_row0 = MLAT + b * NCTX; a.lat_row0 = b * SEQ; a.ldo = DM; a.qrope_t0 = (id < 1024) ? (qrow0 - b * SEQ) : -1;
        if (mixer == 0) {
            a.Q = P0 + (size_t)qrow0 * N_IN0 + h * 128; a.ldq = N_IN0; a.K = P0 + 1024 + (h >> 2) * 128; a.ldk = N_IN0; a.K2 = nullptr; a.ldk2 = 0; a.V = P0 + 1280 + (h >> 2) * 128; a.ldv = N_IN0;
            a.O = OB + (size_t)qrow0 * DM + h * 128; const float scale = 0.08838834764831845f; a.C = scale * LOG2E; a.thr_raw = 8.0f * LOG2E; a.qgain = aqn;

#ifndef DIS_A
            att::attn_unit<128, 0>(a, lds, wave0);
#endif

        } else {
            a.Q = QB + (size_t)qrow0 * N_UQ + h * 192; a.ldq = N_UQ; a.K = KVB + h * 256; a.ldk = N_UKV; a.K2 = P0 + 2560; a.ldk2 = N_IN0; a.V = KVB + h * 256 + 128; a.ldv = N_UKV;
            a.O = OB + (size_t)qrow0 * DM + 1024 + h * 128; const float scale = 0.07216878364870322f; a.C = scale * LOG2E; a.thr_raw = 8.0f * LOG2E;

#ifndef DIS_B
            att::attn_unit<192, 0>(a, lds, wave0);
#endif

        }
    }
}
__device__ __forceinline__ void attn_phase_cd(const bf16* P1, bf16* OB, const float* sink, const float* rpb, const float* cqn, const float* dqn, char* lds, const int wave0) {
    const int c = blockIdx.x, G = gridDim.x;
    for (int id = c; id < 1024; id += G) {
        att::Args a{};
        const int rnd = id >> 8, cc = id & 255, mixer = rnd >> 1, b = rnd & 1, h = cc & 7, qb = cc >> 3, qrow0 = b * SEQ + qb * 256;
        a.nctx = 4; a.ctx_row0 = MLAT + b * NCTX; a.ldo = DM; a.ldq = a.ldk = a.ldv = N_IN1; a.K2 = nullptr; a.ldk2 = 0;
        const float scale = 0.08838834764831845f; a.C = scale * LOG2E; a.thr_raw = 8.0f * LOG2E; a.inv_scale = LOG2E;
        if (mixer == 0) {
            const int kbase = min(max(qb * 256 - 128, 0), SEQ - 512);
            a.NT = 12; a.lat_row0 = b * SEQ + kbase; a.qpos0 = qb * 256; a.kpos0 = kbase; a.sink_l2 = __uint_as_float((unsigned)__builtin_amdgcn_readfirstlane((int)__float_as_uint(sink[h]))) * LOG2E;
            a.qgain = cqn; a.qrope_t0 = qb * 256; a.Q = P1 + (size_t)qrow0 * N_IN1 + h * 128; a.K = P1 + 1024 + (h >> 2) * 128; a.V = P1 + 1280 + (h >> 2) * 128; a.O = OB + (size_t)qrow0 * DM + h * 128;

#ifndef DIS_C
            att::attn_unit<128, 1>(a, lds, wave0);
#endif

        } else {
            const int r0 = qb * 4, klo = min(max(r0 - 4, 0), 116);
            a.NT = 16; a.lat_row0 = b * SEQ + klo * 64; a.r0 = r0; a.klo = klo; a.rpb = rpb + h * (15 * 31);
            a.qgain = dqn; a.qrope_t0 = -1; a.Q = P1 + (size_t)qrow0 * N_IN1 + 1536 + h * 128; a.K = P1 + 2560 + h * 128; a.V = P1 + 3584 + h * 128; a.O = OB + (size_t)qrow0 * DM + 1024 + h * 128;

#ifndef DIS_D
            att::attn_unit<128, 2>(a, lds, wave0);
#endif

        }
    }
}

__global__ void __launch_bounds__(NTHR, 2) fwd_megakernel(KArgs args) {
    extern __shared__ __attribute__((aligned(16))) unsigned char lds[];
    cg::grid_group grid = cg::this_grid();
    LAS unsigned char* ldsl = (LAS unsigned char*)lds;
    const int wave0 = __builtin_amdgcn_readfirstlane(threadIdx.x >> 6);
    const int G = gridDim.x, NGW = G * NWAVES;
#define PHASE_IDS() const int tid = fresh_tid(wave0); const int lane = tid & 63, wave = __builtin_amdgcn_readfirstlane(tid >> 6), gw = blockIdx.x * NWAVES + wave; (void)wave; (void)gw; (void)lane
#define WSB (kargs()->ws)
#define x_ (kargs()->in[0])
#define ctx_ (kargs()->in[2])
#define out_ (kargs()->out)
#define hctx_ ((float*)(WSB + WS_HCTX))
#define MOD_ ((const float*)(WSB + WS_MOD))
#define UA_ ((bf16*)(WSB + WS_UO))
#define OB_ ((bf16*)(WSB + WS_OB))
#define FB_ ((bf16*)(WSB + WS_UO))
#define FP_ ((float*)(WSB + WS_UO + 64 * MiB))
#define OFB_ ((bf16*)(WSB + WS_BIG))
#define OFP_ ((float*)(WSB + WS_BIG + 128 * MiB))
#define PB_ ((bf16*)(WSB + WS_BIG))
#define OF_ ((float*)(WSB + WS_BIG))
#define ACT_ ((bf16*)(WSB + WS_BIG))
#define QB_ ((bf16*)(WSB + WS_QB))
#define KVB_ ((bf16*)(WSB + WS_KVB))
#define UB_ ((bf16*)(WSB + WS_UB))
#ifndef PROBE_G
#define PROBE_G 1
#endif
#ifndef PROBE_A
#define PROBE_A 1
#endif
#ifndef PROBE_S
#define PROBE_S 1
#endif
#define GSYNC() do { for (int s_ = 0; s_ < PROBE_S; ++s_) { xcd_barrier(bar); } } while (0)
    volatile LAS unsigned* MISC = (volatile LAS unsigned*)(ldsl + 131072 + 64);
    if (threadIdx.x < 2) MISC[threadIdx.x] = 0u;
    __syncthreads();
    grid.sync();
    XcdBarrier bar = xcd_barrier_post((unsigned*)(kargs()->ws + WS_BAR), MISC);

    for (int rep_ = 0; rep_ < PROBE_S; ++rep_) {
    { PHASE_IDS(); p0_mod(kargs(), ldsl, tid); }
    { PHASE_IDS(); p0_weights(kargs(), ldsl, gw, NGW, wave, lane); }
    }
    GSYNC();
    { PHASE_IDS(); pass_pre(x_, ctx_, kargs()->in[6], MOD_, 0, DM, UA_, MALL, gw, NGW, lane); }
    GSYNC();
    for (int L = 0; L < 2; ++L) {

        const int Mrows = L == 0 ? MALL : MLAT;
        { pg8::Gemm g = pg8::mk_gemm(L == 0 ? UA_ : UB_, (const bf16*)(WSB + (L == 0 ? WS_WIN0 : WS_WIN1)), MALL, L == 0 ? N_IN0 : N_IN1, DM, DM);
          pg8::StaticOrder S; S.init(g.M, g.N, G, (int)blockIdx.x); pg8::EpiBf16 E{PB_, g.N};
          for (int rep_ = 0; rep_ < PROBE_G; ++rep_) pg8::gemm_phase<pg8::EpiBf16, pg8::StaticOrder, true, true>(ldsl, g, S, E, wave0); }
        GSYNC();
        if (L == 0) {
            { PHASE_IDS(); prep_ab(PB_, kargs()->in[15], kargs()->in[16], kargs()->in[17], kargs()->in[18], gw, NGW, lane); }
            GSYNC();
            for (int q = 0; q < 2; ++q) {
                pg8::Gemm g = pg8::mk_gemm(PB_ + (q == 0 ? 1536 : 2048), (const bf16*)(WSB + (q == 0 ? WS_WUQ : WS_WUKV)), MALL, q == 0 ? N_UQ : N_UKV, 512, N_IN0);
                pg8::StaticOrder S; S.init(g.M, g.N, G, (int)blockIdx.x); pg8::EpiBf16 E{q == 0 ? QB_ : KVB_, g.N};
                for (int rep_ = 0; rep_ < PROBE_G; ++rep_) pg8::gemm_phase<pg8::EpiBf16, pg8::StaticOrder, true, true>(ldsl, g, S, E, wave0);
            }
            GSYNC();
            for (int rep_ = 0; rep_ < PROBE_A; ++rep_) attn_phase_ab(PB_, QB_, KVB_, OB_, kargs()->in[15], (char*)lds, wave0);
        } else {
            { PHASE_IDS(); prep_cd(PB_, kargs()->in[23], kargs()->in[24], kargs()->in[26], kargs()->in[27], gw, NGW, lane); }
            GSYNC();
            for (int rep_ = 0; rep_ < PROBE_A; ++rep_) attn_phase_cd(PB_, OB_, kargs()->in[25], kargs()->in[28], kargs()->in[23], kargs()->in[26], (char*)lds, wave0);
        }
        GSYNC();
        { pg8::Gemm g = pg8::mk_gemm(OB_, (const bf16*)(WSB + (L == 0 ? WS_WOUT0 : WS_WOUT1)), MLAT, DM, DM, DM);
          pg8::StaticOrder S; S.init(g.M, g.N, G, (int)blockIdx.x); pg8::EpiBf16 E{OFB_, DM};
          for (int rep_ = 0; rep_ < PROBE_G; ++rep_) pg8::gemm_phase<pg8::EpiBf16, pg8::StaticOrder, true, true>(ldsl, g, S, E, wave0); }
        if (L == 0) { pg8::Gemm g = pg8::mk_gemm(OB_ + (size_t)MLAT * DM, (const bf16*)(WSB + WS_WOUT0), 2 * NCTX, 4 * DM, DM / 4, DM); g.ldb = DM; g.nNr = DM / 256;
          pg8::StaticOrder S; S.init(g.M, g.N, G, (int)blockIdx.x); pg8::EpiF32Split E{OFP_, DM, DM / 256, (size_t)2 * NCTX * DM};
          for (int rep_ = 0; rep_ < PROBE_G; ++rep_) pg8::gemm_phase<pg8::EpiF32Split, pg8::StaticOrder, true, true>(ldsl, g, S, E, wave0); }
        GSYNC();
        { PHASE_IDS(); pass_post(OFB_, OFP_, L == 0 ? x_ : out_, L == 0 ? ctx_ : hctx_, out_, hctx_, kargs()->in[7] + L * DM, MOD_ + (size_t)L * 3 * 12288, 2 * DM, kargs()->in[8] + L * DM, MOD_ + (size_t)L * 3 * 12288, 3 * DM, 4 * DM, UA_, Mrows, gw, NGW, lane); }
        GSYNC();
        { pg8::Gemm g = pg8::mk_gemm(UA_, (const bf16*)(WSB + WS_WGU + (size_t)L * 44 * MiB), Mrows, N_GU, DM, DM);
          pg8::StaticOrder S; S.init(g.M, g.N, G, (int)blockIdx.x); pg8::EpiSwiglu E{ACT_, DFF};
          for (int rep_ = 0; rep_ < PROBE_G; ++rep_) pg8::gemm_phase<pg8::EpiSwiglu, pg8::StaticOrder, true, true>(ldsl, g, S, E, wave0); }
        GSYNC();
        { pg8::Gemm g = pg8::mk_gemm(ACT_, (const bf16*)(WSB + WS_WD + (size_t)L * 22 * MiB), MLAT, DM, DFF, DFF);
          pg8::StaticOrder S; S.init(g.M, g.N, G, (int)blockIdx.x); pg8::EpiBf16 E{FB_, DM};
          for (int rep_ = 0; rep_ < PROBE_G; ++rep_) pg8::gemm_phase<pg8::EpiBf16, pg8::StaticOrder, true, true>(ldsl, g, S, E, wave0); }
        if (L == 0) { pg8::Gemm g = pg8::mk_gemm(ACT_ + (size_t)MLAT * DFF, (const bf16*)(WSB + WS_WD), 2 * NCTX, 4 * DM, DFF / 4, DFF); g.ldb = DFF; g.nNr = DM / 256;
          pg8::StaticOrder S; S.init(g.M, g.N, G, (int)blockIdx.x); pg8::EpiF32Split E{FP_, DM, DM / 256, (size_t)2 * NCTX * DM};
          for (int rep_ = 0; rep_ < PROBE_G; ++rep_) pg8::gemm_phase<pg8::EpiF32Split, pg8::StaticOrder, true, true>(ldsl, g, S, E, wave0); }
        GSYNC();
        { PHASE_IDS(); pass_post(FB_, FP_, out_, hctx_, out_, hctx_, kargs()->in[9] + L * DM, MOD_ + (size_t)L * 3 * 12288, 5 * DM, kargs()->in[6] + DM, MOD_ + (size_t)3 * 12288, 0, DM, L == 0 ? UB_ : nullptr, Mrows, gw, NGW, lane); }
        if (L == 0) GSYNC();
    }
#undef GSYNC
}

constexpr int LDS_BYTES = 131072 + 1024;
extern "C" void kernel_launch(void* const* d_in, const int* in_sizes, int n_in, void* d_out, int out_size, void* d_ws, size_t ws_size, hipStream_t stream) {
    static int grid = 0;
    if (grid == 0) {
        if (n_in != 29 || out_size != MLAT * DM || ws_size < WS_END) { fprintf(stderr, "kernel_launch: unexpected shapes: n_in %d out %d ws %zu (need %zu)\n", n_in, out_size, ws_size, (size_t)WS_END); grid = -1; return; }
        int dev = 0, cus = 0, per_cu = 0;
        hipGetDevice(&dev); hipDeviceGetAttribute(&cus, hipDeviceAttributeMultiprocessorCount, dev);
        if (hipFuncSetAttribute((const void*)fwd_megakernel, hipFuncAttributeMaxDynamicSharedMemorySize, LDS_BYTES) != hipSuccess) { fprintf(stderr, "kernel_launch: hipFuncSetAttribute failed\n"); grid = -1; return; }
        if (hipOccupancyMaxActiveBlocksPerMultiprocessor(&per_cu, (const void*)fwd_megakernel, NTHR, LDS_BYTES) != hipSuccess || per_cu < 1) { fprintf(stderr, "kernel_launch: occupancy query says %d\n", per_cu); per_cu = 1; }
        (void)hipGetLastError();
        grid = cus;
        fprintf(stderr, "kernel_launch: grid %d (per_cu %d)\n", grid, per_cu);
    }
    if (grid < 0) return;
    if (hipMemsetAsync((char*)d_ws + WS_BAR, 0, BAR_BYTES, stream) != hipSuccess) { fprintf(stderr, "kernel_launch: hipMemsetAsync failed\n"); return; }
    KArgs a{};
    for (int i = 0; i < 29; ++i) a.in[i] = (const float*)d_in[i];
    a.out = (float*)d_out; a.ws = (unsigned char*)d_ws;
    void* params[] = {&a};
    const hipError_t e = hipLaunchCooperativeKernel((const void*)fwd_megakernel, dim3(grid), dim3(NTHR), params, LDS_BYTES, stream);
    if (e != hipSuccess) fprintf(stderr, "kernel_launch: cooperative launch failed: %s (grid %d)\n", hipGetErrorString(e), grid);
}
```

```cpp
#include <hip/hip_runtime.h>
#include <hip/hip_cooperative_groups.h>
#include <cstdio>
#include <cstdint>
namespace cg = cooperative_groups;
__device__ __forceinline__ int fresh_tid(int wave0) { int l; asm volatile("v_mbcnt_lo_u32_b32 %0, -1, 0\n\tv_mbcnt_hi_u32_b32 %0, -1, %0" : "=v"(l)); return wave0 * 64 + l; }
namespace pg8 {
#define PG8_LAS __attribute__((address_space(3)))
typedef unsigned short bf16_t;
typedef short bf16x8 __attribute__((ext_vector_type(8)));
typedef float f32x4 __attribute__((ext_vector_type(4)));
typedef unsigned u32x4 __attribute__((ext_vector_type(4)));
constexpr int BM = 256, BK = 64, HALF = 128, HTB = HALF * BK * 2  , STAGE_BYTES = 8 * HTB, NXCD = 8, WGM = 8;

__host__ __device__ __forceinline__ int lds_byte(int r, int c) { const int st = (r >> 4) * 2 + (c >> 5), rr = r & 15, cc = c & 31, ob = rr * 64 + cc * 2; return st * 1024 + (ob ^ (((ob >> 9) & 1) << 5)); }
__host__ __device__ __forceinline__ void stage_rc(int b, int& R, int& C) { const int st = b / 1024, sb = b % 1024, swz = sb ^ (((sb >> 9) & 1) << 5); R = (st >> 1) * 16 + swz / 64; C = (st & 1) * 32 + (swz % 64) / 2; }
__host__ __device__ __forceinline__ int perm32(int rho) { const int n = rho >> 4, i = rho & 15; return 8 * (i >> 2) + 4 * n + (i & 3); }

struct Unit { int pm, pn; };
struct Gemm { const bf16_t* A; const bf16_t* Bt; int M, N, K, lda, ldb, nNr; };
__host__ __device__ __forceinline__ Gemm mk_gemm(const bf16_t* A, const bf16_t* Bt, int M, int N, int K, int lda) { Gemm g; g.A = A; g.Bt = Bt; g.M = M; g.N = N; g.K = K; g.lda = lda; g.ldb = K; g.nNr = N / BM; return g; }

struct StaticOrder {
    int nM, nN, nwg, G, c;
    __host__ __device__ void init(int M, int N, int G_, int c_) { nM = M / BM; nN = N / BM; nwg = nM * nN; G = G_; c = c_; }
    __host__ __device__ bool next(int i, Unit& u) const {
        const long L = (long)i * G + c; if (L >= nwg) return false;
        int wgid = (int)L; { const int q = nwg / NXCD, r = nwg % NXCD, xcd = wgid % NXCD, off = wgid / NXCD; wgid = (xcd < r ? xcd * (q + 1) : r * (q + 1) + (xcd - r) * q) + off; }
        const int nig = WGM * nN, gid = wgid / nig, fm = gid * WGM, gsz = (nM - fm) < WGM ? (nM - fm) : WGM;
        u.pm = fm + ((wgid % nig) % gsz); u.pn = (wgid % nig) / gsz; return true;
    }
    __device__ __forceinline__ void a_ready(const Unit&) const {}
    __device__ __forceinline__ void done(const Unit&) const {}
};


__device__ __forceinline__ unsigned cvt_pk_bf16(float lo, float hi) { unsigned r; asm volatile("v_cvt_pk_bf16_f32 %0, %1, %2" : "=v"(r) : "v"(lo), "v"(hi)); return r; }
struct EpiBf16 {
    static constexpr bool PERM = true, AFTER_DRAIN = false;
    bf16_t* O; int ldc;
    __device__ __forceinline__ void operator()(const f32x4 (&acc)[2][2][4][2], const Unit& u, int wr, int wc, int fr, int fq) const {
        const int row0 = u.pm * BM + wr * 64 + fr, col0 = u.pn * BM + wc * 32 + 8 * fq;
#pragma unroll
        for (int ai = 0; ai < 2; ++ai)
#pragma unroll
            for (int m = 0; m < 4; ++m) { bf16_t* rowp = O + (size_t)(row0 + ai * HALF + m * 16) * ldc + col0;
#pragma unroll
                for (int bj = 0; bj < 2; ++bj) { const f32x4 v0 = acc[ai][bj][m][0], v1 = acc[ai][bj][m][1];
                    u32x4 w; w.x = cvt_pk_bf16(v0[0], v0[1]); w.y = cvt_pk_bf16(v0[2], v0[3]); w.z = cvt_pk_bf16(v1[0], v1[1]); w.w = cvt_pk_bf16(v1[2], v1[3]);
                    *(u32x4*)(rowp + bj * HALF) = w; } }
    }
};
struct EpiF32 {
    static constexpr bool PERM = false, AFTER_DRAIN = false;
    float* O; int ldc;
    __device__ __forceinline__ void operator()(const f32x4 (&acc)[2][2][4][2], const Unit& u, int wr, int wc, int fr, int fq) const {
        const int row0 = u.pm * BM + wr * 64 + fr, col0 = u.pn * BM + wc * 32 + 4 * fq;
#pragma unroll
        for (int ai = 0; ai < 2; ++ai)
#pragma unroll
            for (int m = 0; m < 4; ++m) { float* rowp = O + (size_t)(row0 + ai * HALF + m * 16) * ldc + col0;
#pragma unroll
                for (int bj = 0; bj < 2; ++bj)
#pragma unroll
                    for (int n = 0; n < 2; ++n) *(f32x4*)(rowp + bj * HALF + n * 16) = acc[ai][bj][m][n]; }
    }
};
struct EpiF32Split {
    static constexpr bool PERM = false, AFTER_DRAIN = false;
    float* O; int ldc; int nNr; size_t sstride;
    __device__ __forceinline__ void operator()(const f32x4 (&acc)[2][2][4][2], const Unit& u, int wr, int wc, int fr, int fq) const {
        const int s = u.pn / nNr, pn = u.pn - s * nNr;
        const int row0 = u.pm * BM + wr * 64 + fr, col0 = pn * BM + wc * 32 + 4 * fq; float* Ob = O + (size_t)s * sstride;
#pragma unroll
        for (int ai = 0; ai < 2; ++ai)
#pragma unroll
            for (int m = 0; m < 4; ++m) { float* rowp = Ob + (size_t)(row0 + ai * HALF + m * 16) * ldc + col0;
#pragma unroll
                for (int bj = 0; bj < 2; ++bj)
#pragma unroll
                    for (int n = 0; n < 2; ++n) *(f32x4*)(rowp + bj * HALF + n * 16) = acc[ai][bj][m][n]; }
    }
};
__device__ __forceinline__ float silu_mul(float g, float u) { return g * __builtin_amdgcn_rcpf(1.0f + __builtin_amdgcn_exp2f(-1.4426950408889634f * g)) * u; }
struct EpiSwiglu {
    static constexpr bool PERM = true, AFTER_DRAIN = false;
    bf16_t* O; int ldc;
    __device__ __forceinline__ void operator()(const f32x4 (&acc)[2][2][4][2], const Unit& u, int wr, int wc, int fr, int fq) const {
        const int row0 = u.pm * BM + wr * 64 + fr, col0 = u.pn * HALF + wc * 32 + 8 * fq;
#pragma unroll
        for (int ai = 0; ai < 2; ++ai)
#pragma unroll
            for (int m = 0; m < 4; ++m) { bf16_t* rowp = O + (size_t)(row0 + ai * HALF + m * 16) * ldc + col0;
                const f32x4 g0 = acc[ai][0][m][0], g1 = acc[ai][0][m][1], u0 = acc[ai][1][m][0], u1 = acc[ai][1][m][1];
                u32x4 w; w.x = cvt_pk_bf16(silu_mul(g0[0], u0[0]), silu_mul(g0[1], u0[1])); w.y = cvt_pk_bf16(silu_mul(g0[2], u0[2]), silu_mul(g0[3], u0[3]));
                w.z = cvt_pk_bf16(silu_mul(g1[0], u1[0]), silu_mul(g1[1], u1[1])); w.w = cvt_pk_bf16(silu_mul(g1[2], u1[2]), silu_mul(g1[3], u1[3]));
                *(u32x4*)rowp = w; }
    }
};

template <class Epi, class Sched, bool ALIGN_EPI = false, bool SP2 = false>
__device__ __forceinline__ void gemm_phase(PG8_LAS unsigned char* lds, const Gemm g, const Sched& S, const Epi& E, const int wave0) {
    const int tid = fresh_tid(wave0), wid = __builtin_amdgcn_readfirstlane(tid >> 6), lane = tid & 63, wr = wid >> 2, wc = wid & 3, fr = lane & 15, fq = lane >> 4;
    const int K = g.K, nt = K / BK;
    unsigned voffA[2], voffB[2];
#pragma unroll
    for (int i = 0; i < 2; ++i) { int R, C; stage_rc(tid * 16 + i * 8192, R, C); const int Rb = Epi::PERM ? ((R & ~31) + perm32(R & 31)) : R;
        voffA[i] = (unsigned)(R * g.lda + C) * 2u; voffB[i] = (unsigned)(Rb * g.ldb + C) * 2u; }
    const size_t kstep = (size_t)(BK * 2);
    const size_t hstepA = (size_t)HALF * g.lda * 2, hstepB = (size_t)HALF * g.ldb * 2; const size_t ksb = (size_t)K * 2;
#define PG8_APTR(u) ((const char*)g.A + (size_t)(u).pm * tstepA + (size_t)((u).pn / g.nNr) * ksb)
#define PG8_BPTR(u) ((const char*)g.Bt + (size_t)((u).pn % g.nNr) * tstepB + (size_t)((u).pn / g.nNr) * ksb)
    const size_t tstepA = 2 * hstepA, tstepB = 2 * hstepB;
    const unsigned ldsw = (unsigned)wid * 1024u;
    const int aoff = lds_byte(wr * 64 + fr, fq * 8), boff = lds_byte(wc * 32 + fr, fq * 8);
#define PG8_SA(b, h) (((b) * 2 + (h)) * HTB)
#define PG8_SB(b, h) ((4 + (b) * 2 + (h)) * HTB)
#define PG8_STAGE(bufoff, gbase, voff) do { _Pragma("unroll") for (int _i = 0; _i < 2; ++_i) \
        __builtin_amdgcn_global_load_lds((const unsigned*)((const char*)(gbase) + (voff)[_i]), (PG8_LAS unsigned*)(lds + (bufoff) + ldsw + _i * 8192), 16, 0, 0); } while (0)
#define PG8_LDA(dst, b, h) do { _Pragma("unroll") for (int m = 0; m < 4; ++m) _Pragma("unroll") for (int k = 0; k < 2; ++k) dst[m][k] = *(const PG8_LAS bf16x8*)(lds + PG8_SA(b, h) + aoff + m * 2048 + k * 1024); } while (0)
#define PG8_LDB(dst, b, h) do { _Pragma("unroll") for (int n = 0; n < 2; ++n) _Pragma("unroll") for (int k = 0; k < 2; ++k) dst[n][k] = *(const PG8_LAS bf16x8*)(lds + PG8_SB(b, h) + boff + n * 2048 + k * 1024); } while (0)
#define PG8_MMA(ai, bj, At, Bt) do { __builtin_amdgcn_s_setprio(1); _Pragma("unroll") for (int m = 0; m < 4; ++m) _Pragma("unroll") for (int n = 0; n < 2; ++n) _Pragma("unroll") for (int k = 0; k < 2; ++k) \
        acc[ai][bj][m][n] = __builtin_amdgcn_mfma_f32_16x16x32_bf16(Bt[n][k], At[m][k], acc[ai][bj][m][n], 0, 0, 0); __builtin_amdgcn_s_setprio(0); } while (0)
#define PG8_WAIT_V(n) asm volatile("s_waitcnt vmcnt(" #n ")" ::: "memory")
#define PG8_WAIT_L(n) asm volatile("s_waitcnt lgkmcnt(" #n ")" ::: "memory")
#define PG8_BAR __builtin_amdgcn_s_barrier()
#define PG8_SCHED __builtin_amdgcn_sched_barrier(0)
    Unit cur, nxt; int ui = 0;
    if (!S.next(0, cur)) return;
    f32x4 acc[2][2][4][2];
#pragma unroll
    for (int a = 0; a < 2; ++a)
#pragma unroll
        for (int b = 0; b < 2; ++b)
#pragma unroll
            for (int m = 0; m < 4; ++m)
#pragma unroll
                for (int n = 0; n < 2; ++n) acc[a][b][m][n] = (f32x4){0.f, 0.f, 0.f, 0.f};
    bf16x8 At[4][2], B0[2][2], B1[2][2];
    const char* cA = PG8_APTR(cur); const char* cB = PG8_BPTR(cur);
    S.a_ready(cur);
    if constexpr (SP2) {
        PG8_STAGE(PG8_SB(0, 0), cB, voffB); PG8_STAGE(PG8_SB(0, 1), cB + hstepB, voffB); PG8_STAGE(PG8_SA(0, 0), cA, voffA); PG8_STAGE(PG8_SA(0, 1), cA + hstepA, voffA);
        if (wr == 1) PG8_BAR;
        PG8_WAIT_V(2); PG8_BAR;
        PG8_STAGE(PG8_SB(1, 0), cB + kstep, voffB); PG8_STAGE(PG8_SA(1, 0), cA + kstep, voffA); PG8_STAGE(PG8_SB(1, 1), cB + hstepB + kstep, voffB);
        PG8_WAIT_V(6); PG8_BAR;
    } else {
        PG8_STAGE(PG8_SB(0, 0), cB, voffB); PG8_STAGE(PG8_SA(0, 0), cA, voffA); PG8_STAGE(PG8_SB(0, 1), cB + hstepB, voffB); PG8_STAGE(PG8_SA(0, 1), cA + hstepA, voffA);
        if (wr == 1) PG8_BAR;
        PG8_WAIT_V(4); PG8_BAR;
        PG8_STAGE(PG8_SB(1, 0), cB + kstep, voffB); PG8_STAGE(PG8_SA(1, 0), cA + kstep, voffA); PG8_STAGE(PG8_SB(1, 1), cB + hstepB + kstep, voffB);
        PG8_WAIT_V(6); PG8_BAR;
    }
    for (;;) {
        const bool has_next = S.next(ui + 1, nxt);
        const char* nA = has_next ? PG8_APTR(nxt) : cA; const char* nB = has_next ? PG8_BPTR(nxt) : cB;
        for (int t = 0; t < nt; t += 2) {
            const bool last = (t == nt - 2);
            const char* a1 = cA + (size_t)(t + 1) * kstep;
            const char* a2 = last ? nA : cA + (size_t)(t + 2) * kstep; const char* b2 = last ? nB : cB + (size_t)(t + 2) * kstep;
            const char* a3 = a2 + kstep; const char* b3 = b2 + kstep;
            if (last && has_next) S.a_ready(nxt);
            if constexpr (SP2) {
            PG8_LDB(B0, 0, 0); PG8_LDB(B1, 0, 1); PG8_SCHED; PG8_LDA(At, 0, 0); PG8_STAGE(PG8_SA(1, 1), a1 + hstepA, voffA);
            PG8_WAIT_V(8); PG8_WAIT_L(0); PG8_BAR; PG8_MMA(0, 0, At, B0); PG8_MMA(0, 1, At, B1); PG8_BAR; PG8_SCHED;
            PG8_LDA(At, 0, 1); PG8_STAGE(PG8_SB(0, 0), b2, voffB); PG8_STAGE(PG8_SB(0, 1), b2 + hstepB, voffB); PG8_STAGE(PG8_SA(0, 0), a2, voffA);
            PG8_WAIT_V(8); PG8_WAIT_L(0); PG8_BAR; PG8_MMA(1, 0, At, B0); PG8_MMA(1, 1, At, B1); PG8_BAR; PG8_SCHED;
            PG8_LDB(B0, 1, 0); PG8_LDB(B1, 1, 1); PG8_SCHED; PG8_LDA(At, 1, 0); PG8_STAGE(PG8_SA(0, 1), a2 + hstepA, voffA);
            PG8_WAIT_V(8); PG8_WAIT_L(0); PG8_BAR; PG8_MMA(0, 0, At, B0); PG8_MMA(0, 1, At, B1); PG8_BAR; PG8_SCHED;
            PG8_LDA(At, 1, 1); PG8_STAGE(PG8_SB(1, 0), b3, voffB); PG8_STAGE(PG8_SB(1, 1), b3 + hstepB, voffB); PG8_STAGE(PG8_SA(1, 0), a3, voffA);
            PG8_WAIT_V(8); PG8_WAIT_L(0); PG8_BAR; PG8_MMA(1, 0, At, B0); PG8_MMA(1, 1, At, B1); PG8_BAR; PG8_SCHED;
            } else {
            PG8_LDB(B0, 0, 0); PG8_SCHED; PG8_LDA(At, 0, 0); PG8_STAGE(PG8_SA(1, 1), a1 + hstepA, voffA);
            PG8_WAIT_L(8); PG8_BAR; PG8_WAIT_L(0); PG8_MMA(0, 0, At, B0); PG8_BAR; PG8_SCHED;
            PG8_LDB(B1, 0, 1); PG8_STAGE(PG8_SB(0, 0), b2, voffB);
            PG8_BAR; PG8_WAIT_L(0); PG8_MMA(0, 1, At, B1); PG8_BAR;
            PG8_LDA(At, 0, 1); PG8_STAGE(PG8_SA(0, 0), a2, voffA);
            PG8_BAR; PG8_WAIT_L(0); PG8_MMA(1, 0, At, B0); PG8_BAR; PG8_SCHED;
            PG8_STAGE(PG8_SB(0, 1), b2 + hstepB, voffB);
            PG8_WAIT_V(6); PG8_BAR; PG8_MMA(1, 1, At, B1); PG8_BAR;
            PG8_LDB(B0, 1, 0); PG8_SCHED; PG8_LDA(At, 1, 0); PG8_STAGE(PG8_SA(0, 1), a2 + hstepA, voffA);
            PG8_WAIT_L(8); PG8_BAR; PG8_WAIT_L(0); PG8_MMA(0, 0, At, B0); PG8_BAR; PG8_SCHED;
            PG8_LDB(B1, 1, 1); PG8_STAGE(PG8_SB(1, 0), b3, voffB);
            PG8_BAR; PG8_WAIT_L(0); PG8_MMA(0, 1, At, B1); PG8_BAR;
            PG8_LDA(At, 1, 1); PG8_STAGE(PG8_SA(1, 0), a3, voffA);
            PG8_BAR; PG8_WAIT_L(0); PG8_MMA(1, 0, At, B0); PG8_BAR; PG8_SCHED;
            PG8_STAGE(PG8_SB(1, 1), b3 + hstepB, voffB);
            PG8_WAIT_V(6); PG8_BAR; PG8_MMA(1, 1, At, B1); PG8_BAR;
            }
        }
        if constexpr (ALIGN_EPI) { if (wr == 0) PG8_BAR; }
        if constexpr (!Epi::AFTER_DRAIN) { E(acc, cur, wr, wc, fr, fq); S.done(cur); }
        if (!has_next) break;
#pragma unroll
        for (int a = 0; a < 2; ++a)
#pragma unroll
            for (int b = 0; b < 2; ++b)
#pragma unroll
                for (int m = 0; m < 4; ++m)
#pragma unroll
                    for (int n = 0; n < 2; ++n) acc[a][b][m][n] = (f32x4){0.f, 0.f, 0.f, 0.f};
        cur = nxt; cA = nA; cB = nB; ++ui;
        if constexpr (ALIGN_EPI) { if (wr == 1) PG8_BAR; }
    }
    PG8_WAIT_V(0);
    if constexpr (!ALIGN_EPI) { if (wr == 0) PG8_BAR; }
    PG8_BAR;
    if constexpr (Epi::AFTER_DRAIN) { E.fused(acc, cur, wr, wc, fr, fq, lds, wid, lane); S.done(cur); }
#undef PG8_APTR
#undef PG8_BPTR
#undef PG8_SA
#undef PG8_SB
#undef PG8_STAGE
#undef PG8_LDA
#undef PG8_LDB
#undef PG8_MMA
#undef PG8_WAIT_V
#undef PG8_WAIT_L
#undef PG8_BAR
#undef PG8_SCHED
}
}
namespace att {
typedef unsigned short bf16;
typedef short bf16x8 __attribute__((ext_vector_type(8)));
typedef short s16x4 __attribute__((ext_vector_type(4)));
typedef float f32x16 __attribute__((ext_vector_type(16)));
typedef unsigned u32x4 __attribute__((ext_vector_type(4)));
constexpr int NW = 8, QBLK = 32, KVBLK = 64;
constexpr int SHM_V = KVBLK * 128 * 2;
#define SBAR() __builtin_amdgcn_sched_barrier(0)
__device__ __forceinline__ int crow(int r, int hi) { return (r & 3) + 8 * (r >> 2) + 4 * hi; }
__device__ __forceinline__ unsigned cvtpk(float lo, float hi) { unsigned r; asm volatile("v_cvt_pk_bf16_f32 %0, %1, %2" : "=v"(r) : "v"(lo), "v"(hi)); return r; }

struct Args {
  const bf16* Q; const bf16* K; const bf16* K2; const bf16* V; bf16* O;
  int ldq, ldk, ldk2, ldv, ldo;
  int NT, nctx, ctx_row0, lat_row0;
  float C, thr_raw;
  int qpos0, kpos0;
  float sink_l2;
  int r0, klo;
  const float* rpb; float inv_scale;
  const float* qgain;
  int qrope_t0;
};

template <bool FIRST> __device__ __forceinline__ void partialSM(f32x16& p0, f32x16& p1, float& m_reg, float& alpha, f32x16& negm, const float thr) {
  float pmax = p0[0];
#pragma unroll
  for (int r = 1; r < 16; ++r) pmax = fmaxf(pmax, p0[r]);
#pragma unroll
  for (int r = 0; r < 16; ++r) pmax = fmaxf(pmax, p1[r]);
  { auto rr = __builtin_amdgcn_permlane32_swap(__float_as_uint(pmax), __float_as_uint(pmax), false, false);
    pmax = fmaxf(__uint_as_float(rr[0]), __uint_as_float(rr[1])); }
  alpha = 1.f;
  if (FIRST || !__builtin_expect(__all(pmax <= thr), 1)) {
    const float delta = FIRST ? pmax : fmaxf(pmax, 0.f);
    m_reg += delta; if (!FIRST) alpha = __builtin_amdgcn_exp2f(-delta);
#pragma unroll
    for (int r = 0; r < 16; ++r) { p0[r] -= delta; p1[r] -= delta; }
    const float nm = -m_reg;
#pragma unroll
    for (int r = 0; r < 16; ++r) negm[r] = nm;
    asm volatile("" : "+v"(negm));
  }
#pragma unroll
  for (int r = 0; r < 16; ++r) p0[r] = __builtin_amdgcn_exp2f(p0[r]);
}
__device__ __forceinline__ void finishSM(f32x16& p0, f32x16& p1, float alpha, float& l_reg, bf16x8& pa0, bf16x8& pa1, bf16x8& pa2, bf16x8& pa3) {
#pragma unroll
  for (int r = 0; r < 16; ++r) p1[r] = __builtin_amdgcn_exp2f(p1[r]);
  float ps = 0;
#pragma unroll
  for (int r = 0; r < 16; ++r) ps += p0[r];
#pragma unroll
  for (int r = 0; r < 16; ++r) ps += p1[r];
  { auto rr = __builtin_amdgcn_permlane32_swap(__float_as_uint(ps), __float_as_uint(ps), false, false);
    ps = __uint_as_float(rr[0]) + __uint_as_float(rr[1]); }
  l_reg = l_reg * alpha + ps;
#define PK8(P, BASE, OUT) do { u32x4 w = {cvtpk(P[BASE + 0], P[BASE + 1]), cvtpk(P[BASE + 2], P[BASE + 3]), cvtpk(P[BASE + 4], P[BASE + 5]), cvtpk(P[BASE + 6], P[BASE + 7])}; \
    OUT = *reinterpret_cast<bf16x8*>(&w); } while (0)
  PK8(p0, 0, pa0); PK8(p0, 8, pa1); PK8(p1, 0, pa2); PK8(p1, 8, pa3);
#undef PK8
}
template <int DQ> __device__ __forceinline__ int kswz(int row, int colB) { return row * (DQ * 2) + (colB ^ ((row & 7) << 4)); }
typedef const __attribute__((address_space(3))) bf16x8* lds_b128_ptr;
template <int DQ> __device__ __forceinline__ void qkt(f32x16& p0, f32x16& p1, const int (&kx)[4], int koff, const bf16x8* qr, const f32x16& negm) {
  lds_b128_ptr k0 = (lds_b128_ptr)(unsigned)(kx[0] + koff), k1 = (lds_b128_ptr)(unsigned)(kx[1] + koff), k2 = (lds_b128_ptr)(unsigned)(kx[2] + koff), k3 = (lds_b128_ptr)(unsigned)(kx[3] + koff);
#pragma unroll
  for (int d0 = 0; d0 < DQ / 16; ++d0) { lds_b128_ptr kp = (d0 & 3) == 0 ? k0 : (d0 & 3) == 1 ? k1 : (d0 & 3) == 2 ? k2 : k3;
    const bf16x8 b0 = kp[(d0 >> 2) * 8];
    const bf16x8 b1 = kp[(d0 >> 2) * 8 + 32 * DQ * 2 / 16];
    if (d0 == 0) { p0 = __builtin_amdgcn_mfma_f32_32x32x16_bf16(b0, qr[0], negm, 0, 0, 0); p1 = __builtin_amdgcn_mfma_f32_32x32x16_bf16(b1, qr[0], negm, 0, 0, 0); }
    else { p0 = __builtin_amdgcn_mfma_f32_32x32x16_bf16(b0, qr[d0], p0, 0, 0, 0); p1 = __builtin_amdgcn_mfma_f32_32x32x16_bf16(b1, qr[d0], p1, 0, 0, 0); } }
}
__device__ __forceinline__ int v_st(int k, int c) { const int kk = (k & ~0xC) | ((k & 4) << 1) | ((k & 8) >> 1); return ((kk >> 3) * 4 + (c >> 5)) * 512 + ((kk & 7) * 32 + (c & 31)) * 2; }
__device__ __forceinline__ int v_rd_base(int lane) { return ((lane & 3) << 3) | (((lane >> 2) & 3) << 6) | (((lane >> 4) & 1) << 5) | (((lane >> 5) & 1) << 8); }
constexpr int v_rd_off(int d0, int ks, int half) { return d0 * 512 + ks * 4096 + half * 2048; }
template <int OFF> __device__ __forceinline__ s16x4 tr_read(int vb) {
  s16x4 r; asm volatile("ds_read_b64_tr_b16 %0, %1 offset:%2" : "=&v"(r) : "v"(vb), "i"(OFF) : "memory"); return r;
}
template <int D0> __device__ __forceinline__ void pv_one(f32x16& od, int vb, bf16x8 pa0, bf16x8 pa1, bf16x8 pa2, bf16x8 pa3) {
  const s16x4 l0 = tr_read<v_rd_off(D0, 0, 0)>(vb), h0 = tr_read<v_rd_off(D0, 0, 1)>(vb), l1 = tr_read<v_rd_off(D0, 1, 0)>(vb), h1 = tr_read<v_rd_off(D0, 1, 1)>(vb);
  const s16x4 l2 = tr_read<v_rd_off(D0, 2, 0)>(vb), h2 = tr_read<v_rd_off(D0, 2, 1)>(vb), l3 = tr_read<v_rd_off(D0, 3, 0)>(vb), h3 = tr_read<v_rd_off(D0, 3, 1)>(vb);
  asm volatile("s_waitcnt lgkmcnt(0)" ::: "memory"); SBAR();
#define PK(L, H) (bf16x8){L[0], L[1], L[2], L[3], H[0], H[1], H[2], H[3]}
  od = __builtin_amdgcn_mfma_f32_32x32x16_bf16(pa0, PK(l0, h0), od, 0, 0, 0);
  od = __builtin_amdgcn_mfma_f32_32x32x16_bf16(pa1, PK(l1, h1), od, 0, 0, 0);
  od = __builtin_amdgcn_mfma_f32_32x32x16_bf16(pa2, PK(l2, h2), od, 0, 0, 0);
  od = __builtin_amdgcn_mfma_f32_32x32x16_bf16(pa3, PK(l3, h3), od, 0, 0, 0);
#undef PK
}
__device__ __forceinline__ void pv_d0(f32x16* o, int vb, bf16x8 pa0, bf16x8 pa1, bf16x8 pa2, bf16x8 pa3) {
  pv_one<0>(o[0], vb, pa0, pa1, pa2, pa3); pv_one<1>(o[1], vb, pa0, pa1, pa2, pa3); pv_one<2>(o[2], vb, pa0, pa1, pa2, pa3); pv_one<3>(o[3], vb, pa0, pa1, pa2, pa3);
}
template <int MODE> __device__ __forceinline__ void maskf(f32x16& p0, f32x16& p1, int t, const Args& a, int wid, int r32, int hi, const float* bias_lds) {
  if constexpr (MODE == 0) { return; }
  else {
    if (t < a.nctx) return;
    if constexpr (MODE == 1) {
      const int kb = a.kpos0 + (t - a.nctx) * 64, qw = a.qpos0 + wid * 32;
      if (kb + 63 - qw <= 128 && qw + 31 - kb <= 128) return;
      int base = kb + 4 * hi - (qw + r32);
      asm volatile("" : "+v"(base));
#pragma unroll
      for (int r = 0; r < 16; ++r) { const int d0 = base + (r & 3) + 8 * (r >> 2);
        if ((unsigned)(d0 + 128) > 256u) p0[r] = -1e30f;
        if ((unsigned)(d0 + 160) > 256u) p1[r] = -1e30f; }
    } else {
      const int kr = a.klo + (t - a.nctx), rq = a.r0 + (wid >> 1);
      const int rs = min(max(rq - 4, 0), 120);
      if (kr < rs || kr >= rs + 8) {
#pragma unroll
        for (int r = 0; r < 16; ++r) { p0[r] = -1e30f; p1[r] = -1e30f; }
        return; }
      const int c = (wid & 1) * 32 + r32, cs = min(max(c - 8, 0), 48);
      int cb = 4 * hi - c + 63, vb = 4 * hi - cs;
      asm volatile("" : "+v"(cb), "+v"(vb));
      const float* bp = bias_lds + (kr - rq + 7) * 128 + cb;
#pragma unroll
      for (int r = 0; r < 16; ++r) { const int k0 = (r & 3) + 8 * (r >> 2), k1 = k0 + 32;
        const float b0 = bp[k0], b1 = bp[k1];
        p0[r] = ((unsigned)(k0 + vb) < 16u) ? fmaf(b0, a.inv_scale, p0[r]) : -1e30f;
        p1[r] = ((unsigned)(k1 + vb) < 16u) ? fmaf(b1, a.inv_scale, p1[r]) : -1e30f;
        if ((r & 3) == 3) SBAR(); }
    }
  }
}

template <int DQ, int MODE>
__device__ __forceinline__ void attn_unit(const Args& a, char* lds, const int wave0) {
  constexpr int SHM_K = KVBLK * DQ * 2, NQ = DQ / 16, OFF_K = 3 * SHM_V, OFF_WS = OFF_K + 2 * SHM_K;
  const int tid = fresh_tid(wave0), wid = tid >> 6, lane = tid & 63, r32 = lane & 31, hi = lane >> 5;
  char* V_lds = lds; char* K_lds = lds + OFF_K;
  float* ws = (float*)(lds + OFF_WS) + wid * 64; float* li_l = ws; float* al_l = ws + 32;
  float* bias_l = (float*)(lds + OFF_WS + 2048);
  if constexpr (MODE == 2) { if (tid < 465) bias_l[(tid / 31) * 128 + 48 + (tid % 31)] = a.rpb[tid]; }
  float m_reg = 0.f, l_reg = 0; f32x16 o[4] = {}; bf16x8 qr[NQ];
  const float thr = a.thr_raw;
  const bf16* Qw = a.Q + (long)(wid * QBLK + r32) * a.ldq + hi * 8;
#pragma unroll
  for (int d0 = 0; d0 < NQ; ++d0) qr[d0] = *reinterpret_cast<const bf16x8*>(Qw + d0 * 16);
  if constexpr (DQ == 128) {
    if (a.qgain) { float xf[8][8]; float ss = 0.f;
#pragma unroll
      for (int d0 = 0; d0 < 8; ++d0)
#pragma unroll
        for (int e = 0; e < 8; ++e) { xf[d0][e] = __uint_as_float(((unsigned)(unsigned short)qr[d0][e]) << 16); ss += xf[d0][e] * xf[d0][e]; }
      { auto rr = __builtin_amdgcn_permlane32_swap(__float_as_uint(ss), __float_as_uint(ss), false, false); ss = __uint_as_float(rr[0]) + __uint_as_float(rr[1]); }
      const float rstd = rsqrtf(ss * (1.0f / 128.0f) + 1e-6f) * a.C;
#pragma unroll
      for (int d0 = 0; d0 < 8; ++d0) { const float* gp = a.qgain + d0 * 16 + hi * 8;
#pragma unroll
        for (int e = 0; e < 8; ++e) xf[d0][e] = xf[d0][e] * rstd * gp[e]; }
      if (a.qrope_t0 >= 0) { const int t = a.qrope_t0 + wid * QBLK + r32; const float prow = (float)(t >> 6), pcol = (float)(t & 63);
#pragma unroll
        for (int half = 0; half < 2; ++half)
#pragma unroll
          for (int blk = 0; blk < 2; ++blk)
#pragma unroll
            for (int e = 0; e < 8; ++e) { const int j = blk * 16 + hi * 8 + e, da = 4 * half + blk, db = da + 2;
              const float inv_freq = __builtin_amdgcn_exp2f(-(float)j * (13.287712379549449f / 32.0f)); float rev = (half ? pcol : prow) * inv_freq * 0.15915494309189535f; rev -= rintf(rev);
              const float sn = __builtin_amdgcn_sinf(rev), cs = __builtin_amdgcn_cosf(rev);
              const float x = xf[da][e], y = xf[db][e]; xf[da][e] = x * cs - y * sn; xf[db][e] = y * cs + x * sn; } }
#pragma unroll
      for (int d0 = 0; d0 < 8; ++d0) { bf16x8 w;
#pragma unroll
        for (int e = 0; e < 8; ++e) { unsigned u = __float_as_uint(xf[d0][e]); u = (u + 0x7fffu + ((u >> 16) & 1u)) >> 16; w[e] = (short)u; }
        qr[d0] = w; } } }
  if constexpr (DQ == 192) {
    if (a.qrope_t0 >= 0) { const int t = a.qrope_t0 + wid * QBLK + r32; const float prow = (float)(t >> 6), pcol = (float)(t & 63);
#pragma unroll
      for (int half = 0; half < 2; ++half) { bf16x8 xa = qr[8 + 2 * half], xb = qr[9 + 2 * half]; const float pos = half ? pcol : prow;
#pragma unroll
        for (int e = 0; e < 8; ++e) { const int j = hi * 8 + e;
          const float inv_freq = __builtin_amdgcn_exp2f(-(float)j * (13.287712379549449f / 16.0f)); float rev = pos * inv_freq * 0.15915494309189535f; rev -= rintf(rev);
          const float sn = __builtin_amdgcn_sinf(rev), cs = __builtin_amdgcn_cosf(rev);
          const float x = __uint_as_float(((unsigned)(unsigned short)xa[e]) << 16), y = __uint_as_float(((unsigned)(unsigned short)xb[e]) << 16);
          const float nx = x * cs - y * sn, ny = y * cs + x * sn; unsigned ux = __float_as_uint(nx), uy = __float_as_uint(ny);
          ux = (ux + 0x7fffu + ((ux >> 16) & 1u)) >> 16; uy = (uy + 0x7fffu + ((uy >> 16) & 1u)) >> 16; xa[e] = (short)ux; xb[e] = (short)uy; }
        qr[8 + 2 * half] = xa; qr[9 + 2 * half] = xb; } } }
  const int vb0 = (int)(uintptr_t)V_lds + v_rd_base(lane);
  int kx[4];
#pragma unroll
  for (int q = 0; q < 4; ++q) kx[q] = (int)(uintptr_t)K_lds + r32 * (DQ * 2) + ((q * 32 + hi * 16) ^ ((r32 & 7) << 4));
  constexpr int KP = DQ / 64;
  int koff[KP]; bool kk2[KP]; int voff[2];
#pragma unroll
  for (int i = 0; i < KP; ++i) { const int q = (wid * KP + i) * 64 + lane, row = q / (DQ / 8), cs = q % (DQ / 8), c = cs ^ (row & 7);
    kk2[i] = (DQ == 192) && c >= 16; koff[i] = kk2[i] ? row * a.ldk2 + (c - 16) * 8 : row * a.ldk + c * 8; }
#pragma unroll
  for (int i = 0; i < 2; ++i) { const int q = (wid * 2 + i) * 64 + lane, sub = q >> 5, within = q & 31, kk = (sub >> 2) * 8 + (within >> 2), c = (sub & 3) * 32 + (within & 3) * 8;
    const int k = kk; voff[i] = k * a.ldv + c; }
  const unsigned kdst0 = (unsigned)(uintptr_t)K_lds + (unsigned)(wid * KP) * 1024u, vdst0 = (unsigned)(uintptr_t)V_lds + (unsigned)(wid * 2) * 1024u;
#define KROW(t) ((t) < a.nctx ? a.ctx_row0 + 64 * (t) : a.lat_row0 + 64 * ((t) - a.nctx))
#define GLDS16(gsrc, ldst) do { unsigned keep_; asm volatile("s_mov_b32 %0, m0\n\ts_mov_b32 m0, %2\n\ts_nop 0\n\tglobal_load_lds_dwordx4 %1, off\n\ts_mov_b32 m0, %0" : "=&s"(keep_) : "v"(gsrc), "s"(ldst) : "memory"); } while (0)
#define DMA(t) do { const long kr_ = KROW(t); const unsigned kd_ = (unsigned)__builtin_amdgcn_readfirstlane((int)(kdst0 + (unsigned)(((t) & 1) * SHM_K))), vd_ = (unsigned)__builtin_amdgcn_readfirstlane((int)(vdst0 + (unsigned)(((t) % 3) * SHM_V))); \
    const bf16* vp_ = a.V + kr_ * a.ldv; const bf16* kp_ = a.K + kr_ * a.ldk; const bf16* kp2_ = (DQ == 192) ? a.K2 + kr_ * a.ldk2 : kp_; \
    _Pragma("unroll") for (int i_ = 0; i_ < KP; ++i_) { const bf16* g_ = ((DQ == 192) && kk2[i_] ? kp2_ : kp_) + koff[i_]; GLDS16(g_, kd_ + (unsigned)i_ * 1024u); } \
    _Pragma("unroll") for (int i_ = 0; i_ < 2; ++i_) GLDS16(vp_ + voff[i_], vd_ + (unsigned)i_ * 1024u); } while (0)
#define WAIT_BAR() asm volatile("s_waitcnt vmcnt(0) lgkmcnt(0)\n\ts_barrier" ::: "memory")
#define RESC(al) do { if (__any((al) < 1.f)) { if (hi == 0) al_l[r32] = (al); asm volatile("s_waitcnt lgkmcnt(0)" ::: "memory"); \
    _Pragma("unroll") for (int d = 0; d < 4; ++d) _Pragma("unroll") for (int r = 0; r < 16; ++r) o[d][r] *= al_l[crow(r, hi)]; } } while (0)
  f32x16 pA0, pA1, pB0, pB1; float mnA, mnB, alA, alB; bf16x8 pa0, pa1, pa2, pa3; const int NT = a.NT;
#define STEP(j, PN0, PN1, MNN, ALN, PP0, PP1, ALP) do { const int j_ = (j); \
    WAIT_BAR();                            \
    if (j_ + 1 < NT) DMA(j_ + 1);          \
    SBAR(); qkt<DQ>(PN0, PN1, kx, (j_ & 1) * SHM_K, qr, negm); maskf<MODE>(PN0, PN1, j_, a, wid, r32, hi, bias_l); \
    finishSM(PP0, PP1, ALP, l_reg, pa0, pa1, pa2, pa3); SBAR(); \
    pv_d0(o, vb0 + ((j_ - 1) % 3) * SHM_V, pa0, pa1, pa2, pa3); partialSM<false>(PN0, PN1, m_reg, ALN, negm, thr); \
    RESC(ALN); } while (0)
  DMA(0); DMA(1);
  f32x16 negm = f32x16{}; asm volatile("" : "+v"(negm));
  WAIT_BAR();
  qkt<DQ>(pA0, pA1, kx, 0, qr, negm); maskf<MODE>(pA0, pA1, 0, a, wid, r32, hi, bias_l); partialSM<true>(pA0, pA1, m_reg, alA, negm, thr);
  for (int j = 1; j + 1 < NT; j += 2) {
    STEP(j, pB0, pB1, mnB, alB, pA0, pA1, alA);
    STEP(j + 1, pA0, pA1, mnA, alA, pB0, pB1, alB);
  }
  STEP(NT - 1, pB0, pB1, mnB, alB, pA0, pA1, alA);
  finishSM(pB0, pB1, alB, l_reg, pa0, pa1, pa2, pa3); SBAR();
  pv_d0(o, vb0 + ((NT - 1) % 3) * SHM_V, pa0, pa1, pa2, pa3);
  if constexpr (MODE == 1) l_reg += __builtin_amdgcn_exp2f(a.sink_l2 - m_reg);
  if (hi == 0) li_l[r32] = l_reg; asm volatile("s_waitcnt lgkmcnt(0)" ::: "memory");
  float rli[16];
#pragma unroll
  for (int r = 0; r < 16; ++r) rli[r] = __builtin_amdgcn_rcpf(li_l[crow(r, hi)]);
  asm volatile("s_waitcnt lgkmcnt(0)\n\ts_barrier" ::: "memory");
  { bf16* stg = (bf16*)(lds + wid * 8704);
#pragma unroll
    for (int r = 0; r < 16; ++r) { const int orow = crow(r, hi);
#pragma unroll
      for (int d0 = 0; d0 < 4; ++d0) { const float v = o[d0][r] * rli[r]; unsigned u = __float_as_uint(v); u = (u + 0x7fffu + ((u >> 16) & 1u)) >> 16; stg[orow * 136 + d0 * 32 + r32] = (bf16)u; } }
    asm volatile("s_waitcnt lgkmcnt(0)" ::: "memory");
    bf16* Ow = a.O + (long)(wid * QBLK) * a.ldo;
#pragma unroll
    for (int i = 0; i < 8; ++i) { const int row = i * 4 + (lane >> 4), ch = lane & 15; const u32x4 v = *(const u32x4*)(stg + row * 136 + ch * 8); *(u32x4*)(Ow + (long)row * a.ldo + ch * 8) = v; } }
  asm volatile("s_waitcnt lgkmcnt(0)\n\ts_barrier" ::: "memory");
#undef KROW
#undef GLDS16
#undef DMA
#undef WAIT_BAR
#undef RESC
#undef STEP
}
#undef SBAR
}
#define LAS __attribute__((address_space(3)))
typedef unsigned short bf16;
typedef float f32x4 __attribute__((ext_vector_type(4)));
typedef unsigned v4u __attribute__((ext_vector_type(4)));
typedef unsigned v2u __attribute__((ext_vector_type(2)));
constexpr int NWAVES = 8, NTHR = 512;
constexpr int DM = 2048, SEQ = 8192, NCTX = 256, MLAT = 2 * SEQ, MALL = MLAT + 2 * NCTX, DFF = 5632;
constexpr int N_IN0 = 2816, N_IN1 = 4608, N_UQ = 1536, N_UKV = 2048, N_GU = 2 * DFF;
constexpr float EPS = 1e-6f;
constexpr size_t MiB = 1u << 20;
constexpr size_t WS_MOD = 0, WS_BAR = 512 * 1024, BAR_BYTES = 16384;
constexpr size_t WS_WIN0 = 1 * MiB, WS_WUQ = WS_WIN0 + 11 * MiB, WS_WUKV = WS_WUQ + 2 * MiB, WS_WOUT0 = WS_WUKV + 2 * MiB, WS_WIN1 = WS_WOUT0 + 8 * MiB, WS_WOUT1 = WS_WIN1 + 18 * MiB,
                 WS_WGU = WS_WOUT1 + 8 * MiB, WS_WD = WS_WGU + 88 * MiB, WS_HCTX = WS_WD + 44 * MiB;
constexpr size_t WS_UO = WS_HCTX + 4 * MiB;
constexpr size_t WS_OB = WS_UO + 66 * MiB;
constexpr size_t WS_BIG = WS_UO + 132 * MiB;
constexpr size_t WS_QB = WS_BIG + 91 * MiB, WS_KVB = WS_BIG + 141 * MiB, WS_UB = WS_BIG + 149 * MiB, WS_FP = WS_BIG + 215 * MiB, WS_END = WS_FP + 16 * MiB;
static_assert((size_t)MALL * DM * 2 == 66 * MiB && (size_t)MALL * N_IN0 * 2 <= 91 * MiB && (size_t)MALL * N_UQ * 2 <= 50 * MiB && (size_t)MALL * N_IN1 * 2 <= 149 * MiB && (size_t)MALL * DFF * 2 <= 215 * MiB, "ws map");

__device__ __forceinline__ unsigned f2bf(float f) { unsigned u = __builtin_bit_cast(unsigned, f); return (u + 0x7fffu + ((u >> 16) & 1u)) >> 16; }
__device__ __forceinline__ unsigned pk2(float lo, float hi) { return f2bf(lo) | (f2bf(hi) << 16); }
__device__ __forceinline__ float bf2f(bf16 v) { return __uint_as_float(((unsigned)v) << 16); }
__device__ __forceinline__ float wave_sum(float v, int lane) {
#pragma unroll
    for (int o = 1; o < 64; o <<= 1) v += __int_as_float(__builtin_amdgcn_ds_bpermute((lane ^ o) << 2, __float_as_int(v)));
    return v;
}
__device__ __forceinline__ float silu_f(float x) { return x / (1.0f + __expf(-x)); }

#define GAS __attribute__((address_space(1)))
#define XB_TMO      128
#define XB_XCNT(j)  (256  + 64 * (j))
#define XB_XSUB(j)  (1280 + 64 * (j))
#define XB_XGEN(j)  (2304 + 64 * (j))
#define XB_TOP      3328
#define XB_TOPGEN   3392
#define XCD_BAR_WORDS 3456
#define XB_SPIN_CAP (1u << 18)

__device__ __forceinline__ unsigned xb_ld(unsigned* p)              { return __hip_atomic_load(p, __ATOMIC_RELAXED, __HIP_MEMORY_SCOPE_AGENT); }
__device__ __forceinline__ unsigned xb_add(unsigned* p, unsigned v) { return __hip_atomic_fetch_add(p, v, __ATOMIC_RELAXED, __HIP_MEMORY_SCOPE_AGENT); }
__device__ __forceinline__ unsigned xb_xcc_id() { return (unsigned)__builtin_amdgcn_s_getreg((3 << 11) | 20) & 0xFu; }
#define XB_SPIN(cond, bar) do { unsigned _sp = 0; while (cond) { __builtin_amdgcn_s_sleep(1); \
    if ((++_sp & 255u) == 0u) { if (xb_ld(&(bar)[XB_TMO])) break; if (_sp > XB_SPIN_CAP) { atomicAdd(&(bar)[XB_TMO], 1u); break; } } } } while (0)

struct XcdBarrier {
    unsigned* bar; unsigned x;
    volatile LAS unsigned* st;
};

__device__ __forceinline__ XcdBarrier xcd_barrier_post(unsigned* bar, volatile LAS unsigned* st) {
    XcdBarrier b; b.bar = bar; b.x = xb_xcc_id(); b.st = st;
    if (threadIdx.x == 0) (void)xb_add(&bar[XB_XCNT(b.x)], 1u);
    return b;
}
__device__ __forceinline__ void xcd_barrier_complete(unsigned* bar, unsigned x, unsigned& nloc, unsigned& nx) {
    const unsigned G = gridDim.x * gridDim.y * gridDim.z;
    unsigned sum, cnt, mine, sp = 0u;
    for (;;) {
        sum = 0u; cnt = 0u; mine = 0u;
#pragma unroll
        for (unsigned j = 0; j < 16; ++j) { const unsigned c = xb_ld(&bar[XB_XCNT(j)]); sum += c; cnt += (c > 0u) ? 1u : 0u; mine = (j == x) ? c : mine; }
        if (sum == G) break;
        __builtin_amdgcn_s_sleep(1);
        if ((++sp & 255u) == 0u) { if (xb_ld(&bar[XB_TMO])) break; if (sp > XB_SPIN_CAP) { atomicAdd(&bar[XB_TMO], 1u); break; } }
    }
    nloc = mine > 0u ? mine : 1u; nx = cnt > 0u ? cnt : 1u;
}

__device__ __forceinline__ void xcd_barrier(const XcdBarrier& b) {
    asm volatile("s_waitcnt vmcnt(0)" ::: "memory");
    __syncthreads();
    if (threadIdx.x == 0) {
        unsigned* bar = b.bar;
        __builtin_amdgcn_s_waitcnt(0);
        unsigned nloc = b.st[0], nx = b.st[1];
        if (nloc == 0u) { xcd_barrier_complete(bar, b.x, nloc, nx); b.st[0] = nloc; b.st[1] = nx; }
        const unsigned old = xb_add(&bar[XB_XSUB(b.x)], 1u);
        const unsigned gen = old / nloc;
        if (old + 1u == (gen + 1u) * nloc) {
            __builtin_amdgcn_fence(__ATOMIC_RELEASE, "agent");
            asm volatile("s_waitcnt vmcnt(0)" ::: "memory");
            const unsigned og = xb_add(&bar[XB_TOP], 1u);
            const unsigned tg = og / nx;
            if (og + 1u == (tg + 1u) * nx) xb_add(&bar[XB_TOPGEN], 1u);
            else XB_SPIN(xb_ld(&bar[XB_TOPGEN]) == tg, bar);
            __builtin_amdgcn_fence(__ATOMIC_ACQUIRE, "agent");
            xb_add(&bar[XB_XGEN(b.x)], 1u);
            asm volatile("s_waitcnt vmcnt(0)" ::: "memory");
        } else {
            XB_SPIN(xb_ld(&bar[XB_XGEN(b.x)]) == gen, bar);
            __builtin_amdgcn_fence(__ATOMIC_ACQUIRE, "agent");
            asm volatile("s_waitcnt vmcnt(0)" ::: "memory");
        }
    }
    __syncthreads();
}

struct KArgs { const float* in[29]; float* out; unsigned char* ws; };
typedef const __attribute__((address_space(4))) KArgs* KAP;
__device__ __forceinline__ KAP kargs() { KAP p = (KAP)__builtin_amdgcn_kernarg_segment_ptr(); asm volatile("" : "+s"(p)); return p; }

__device__ __forceinline__ void transpose_item(const float* W, int K, int N, bf16* WT, int k0, int n0, int drow0, LAS float* scr, int lane, const float wsc) {
#pragma unroll 8
    for (int i = 0; i < 32; ++i) { const int kk = 2 * i + (lane >> 5); scr[kk * 33 + (lane & 31)] = __builtin_nontemporal_load(W + (size_t)(k0 + kk) * N + n0 + (lane & 31)) * wsc; }
    asm volatile("s_waitcnt lgkmcnt(0)" ::: "memory");
    const int c = lane & 7;
#pragma unroll
    for (int j = 0; j < 4; ++j) { const int n = (lane >> 3) + 8 * j; const LAS float* s = scr + (8 * c) * 33 + n;
        v4u o; o.x = pk2(s[0 * 33], s[1 * 33]); o.y = pk2(s[2 * 33], s[3 * 33]); o.z = pk2(s[4 * 33], s[5 * 33]); o.w = pk2(s[6 * 33], s[7 * 33]);
        *(v4u*)(WT + (size_t)(drow0 + n) * K + k0 + 8 * c) = o; }
    asm volatile("s_waitcnt lgkmcnt(0)" ::: "memory");
}
__device__ __forceinline__ bool conv_matrix(int& it, const float* W, int K, int N, bf16* WT, int mode, LAS float* scr, int lane, const float wsc = 1.0f) {
    const int nblk = N / 32, items = (K / 64) * nblk;
    if (it >= items) { it -= items; return false; }
    const int kb = it / nblk, nb = it % nblk, n0 = 32 * nb;
    const int drow0 = mode == 0 ? n0 : ((n0 >> 7) * 256 + (mode == 2 ? 128 : 0) + (n0 & 127));
    transpose_item(W, K, N, WT, 64 * kb, n0, drow0, scr, lane, wsc);
    return true;
}
__device__ __forceinline__ void p0_weights(KAP a, LAS unsigned char* lds, int gw, int NGW, int wave, int lane) {
    LAS float* scr = (LAS float*)(lds + wave * 8704);
    unsigned char* ws = a->ws;
    constexpr int I_TOTAL = (2048 / 64) * (2624 / 32) + (512 / 64) * (1536 / 32) + (512 / 64) * (2048 / 32) + 2 * (2048 / 64) * (2048 / 32) + (2048 / 64) * (4608 / 32)
                          + 4 * (2048 / 64) * (DFF / 32) + 2 * (DFF / 64) * (2048 / 32);
    for (int item = gw; item < I_TOTAL; item += NGW) {
        int it = item;
        if (conv_matrix(it, a->in[13], 2048, 2624, (bf16*)(ws + WS_WIN0), 0, scr, lane)) continue;
        if (conv_matrix(it, a->in[19], 512, 1536, (bf16*)(ws + WS_WUQ), 0, scr, lane, 0.07216878364870322f * 1.4426950408889634f)) continue;
        if (conv_matrix(it, a->in[20], 512, 2048, (bf16*)(ws + WS_WUKV), 0, scr, lane)) continue;
        if (conv_matrix(it, a->in[14], 2048, 2048, (bf16*)(ws + WS_WOUT0), 0, scr, lane)) continue;
        if (conv_matrix(it, a->in[21], 2048, 4608, (bf16*)(ws + WS_WIN1), 0, scr, lane)) continue;
        if (conv_matrix(it, a->in[22], 2048, 2048, (bf16*)(ws + WS_WOUT1), 0, scr, lane)) continue;
        if (conv_matrix(it, a->in[10], 2048, DFF, (bf16*)(ws + WS_WGU), 1, scr, lane)) continue;
        if (conv_matrix(it, a->in[10] + (size_t)2048 * DFF, 2048, DFF, (bf16*)(ws + WS_WGU + 44 * MiB), 1, scr, lane)) continue;
        if (conv_matrix(it, a->in[11], 2048, DFF, (bf16*)(ws + WS_WGU), 2, scr, lane)) continue;
        if (conv_matrix(it, a->in[11] + (size_t)2048 * DFF, 2048, DFF, (bf16*)(ws + WS_WGU + 44 * MiB), 2, scr, lane)) continue;
        if (conv_matrix(it, a->in[12], DFF, 2048, (bf16*)(ws + WS_WD), 0, scr, lane)) continue;
        conv_matrix(it, a->in[12] + (size_t)2048 * DFF, DFF, 2048, (bf16*)(ws + WS_WD + 22 * MiB), 0, scr, lane);
    }
}
__device__ __forceinline__ void p0_mod(KAP a, LAS unsigned char* lds, int tid) {
    LAS float* sv = (LAS float*)lds;
    LAS float* red = (LAS float*)(lds + 24576);
    const int blk = blockIdx.x; if (blk >= 256) return;
    const int layer = blk >> 7, col0 = (blk & 127) * 96;
    for (int i = tid; i < 3 * 2048; i += NTHR) { const int v = i >> 11, k = i & 2047; const float x = v < 2 ? a->in[1][v * 2048 + k] : a->in[3][k]; sv[i] = silu_f(x); }
    __syncthreads();
    const int c4 = tid % 24, ks = tid / 24;
    if (ks < 21) {
        const float* W = a->in[4] + (size_t)layer * 2048 * 12288 + col0 + 4 * c4;
        f32x4 a0 = {0, 0, 0, 0}, a1 = a0, a2 = a0;
#pragma unroll 8
        for (int k = ks; k < 2048; k += 21) { const f32x4 w = __builtin_nontemporal_load((const f32x4*)(W + (size_t)k * 12288)); a0 += w * sv[k]; a1 += w * sv[2048 + k]; a2 += w * sv[4096 + k]; }
        LAS float* r = red + ks * 288 + 4 * c4;
        *(LAS f32x4*)(r) = a0; *(LAS f32x4*)(r + 96) = a1; *(LAS f32x4*)(r + 192) = a2;
    }
    __syncthreads();
    if (tid < 288) { float s = 0.f;
        for (int q = 0; q < 21; ++q) s += red[q * 288 + tid];
        const int v = tid / 96, j = tid % 96;
        ((float*)(a->ws + WS_MOD))[(size_t)(layer * 3 + v) * 12288 + col0 + j] = s + a->in[5][layer * 12288 + col0 + j]; }
    __syncthreads();
}
__device__ __forceinline__ void store_u(bf16* urow, int lane, const f32x4 (&v)[8], float rstd, const float* g, const float* sh, const float* sc) {
#pragma unroll
    for (int j = 0; j < 8; ++j) { const int ci = 256 * j + 4 * lane; const f32x4 g4 = *(const f32x4*)(g + ci), s4 = *(const f32x4*)(sc + ci), h4 = *(const f32x4*)(sh + ci);
        const f32x4 t = (v[j] * rstd * g4) * (1.0f + s4) + h4; v2u w; w.x = pk2(t[0], t[1]); w.y = pk2(t[2], t[3]); *(v2u*)(urow + ci) = w; }
}
__device__ __forceinline__ void pass_pre(const float* hlat, const float* hctx, const float* g, const float* mod, int sh_off, int sc_off, bf16* U, int nrows, int gw, int NGW, int lane) {
    for (int m0 = gw; m0 < nrows; m0 += 2 * NGW) {
        int mr[2]; mr[0] = m0; mr[1] = m0 + NGW; const bool two = mr[1] < nrows; if (!two) mr[1] = m0;
        f32x4 v[2][8]; float ss[2];
#pragma unroll
        for (int r = 0; r < 2; ++r) { const int m = mr[r]; const float* src = m < MLAT ? hlat + (size_t)m * DM : hctx + (size_t)(m - MLAT) * DM;
#pragma unroll
            for (int j = 0; j < 8; ++j) v[r][j] = *(const f32x4*)(src + 256 * j + 4 * lane); }
#pragma unroll
        for (int r = 0; r < 2; ++r) { ss[r] = 0.f;
#pragma unroll
            for (int j = 0; j < 8; ++j) ss[r] += (v[r][j][0] * v[r][j][0] + v[r][j][1] * v[r][j][1]) + (v[r][j][2] * v[r][j][2] + v[r][j][3] * v[r][j][3]); }
#pragma unroll
        for (int r = 0; r < 2; ++r) { if (r == 1 && !two) break; const int m = mr[r]; const float* mv = mod + (m < MLAT ? (m >> 13) : 2) * 12288;
            const float rstd = rsqrtf(wave_sum(ss[r], lane) * (1.0f / DM) + EPS);
            store_u(U + (size_t)m * DM, lane, v[r], rstd, g, mv + sh_off, mv + sc_off); }
    }
}
__device__ __forceinline__ void pass_post(const bf16* o16, const float* opart, const float* hlat, const float* hctx, const bf16* h16in, float* olat, float* octx, bf16* h16out, const float* gpost, const float* mod, int gt_off,
                                          const float* gpre, const float* modu, int sh_off, int sc_off, bf16* U, int nrows, int gw, int NGW, int lane) {
    for (int m0 = gw; m0 < nrows; m0 += 2 * NGW) {
        int mr[2]; mr[0] = m0; mr[1] = m0 + NGW; const bool two = mr[1] < nrows; if (!two) mr[1] = m0;
        f32x4 v[2][8], hh[2][8]; float ss[2];
#pragma unroll
        for (int r = 0; r < 2; ++r) { const int m = mr[r]; ss[r] = 0.f;
            const float* hs = m < MLAT ? hlat + (size_t)m * DM : hctx + (size_t)(m - MLAT) * DM;
            if (m < MLAT) { const bf16* orow = o16 + (size_t)m * DM;
#pragma unroll
                for (int j = 0; j < 8; ++j) { const v2u raw = *(const v2u*)(orow + 256 * j + 4 * lane);
                    v[r][j] = (f32x4){__uint_as_float(raw.x << 16), __uint_as_float(raw.x & 0xffff0000u), __uint_as_float(raw.y << 16), __uint_as_float(raw.y & 0xffff0000u)}; }
            } else { const float* orow = opart + (size_t)(m - MLAT) * DM;
#pragma unroll
                for (int j = 0; j < 8; ++j) { const int ci = 256 * j + 4 * lane;
                    v[r][j] = (*(const f32x4*)(orow + ci) + *(const f32x4*)(orow + ci + (size_t)512 * DM)) + (*(const f32x4*)(orow + ci + (size_t)1024 * DM) + *(const f32x4*)(orow + ci + (size_t)1536 * DM)); } }
            if (h16in) { const bf16* hrow = h16in + (size_t)m * DM;
#pragma unroll
                for (int j = 0; j < 8; ++j) { const v2u raw = *(const v2u*)(hrow + 256 * j + 4 * lane);
                    hh[r][j] = (f32x4){__uint_as_float(raw.x << 16), __uint_as_float(raw.x & 0xffff0000u), __uint_as_float(raw.y << 16), __uint_as_float(raw.y & 0xffff0000u)}; }
            } else {
#pragma unroll
                for (int j = 0; j < 8; ++j) hh[r][j] = *(const f32x4*)(hs + 256 * j + 4 * lane); }
        }
#pragma unroll
        for (int r = 0; r < 2; ++r)
#pragma unroll
            for (int j = 0; j < 8; ++j) ss[r] += (v[r][j][0] * v[r][j][0] + v[r][j][1] * v[r][j][1]) + (v[r][j][2] * v[r][j][2] + v[r][j][3] * v[r][j][3]);
#pragma unroll
        for (int r = 0; r < 2; ++r) { const int m = mr[r]; if (r == 1 && !two) break;
            float* hd = m < MLAT ? olat + (size_t)m * DM : octx + (size_t)(m - MLAT) * DM; const int vi = (m < MLAT ? (m >> 13) : 2); const float* mv = mod + vi * 12288;
            const float rstd = rsqrtf(wave_sum(ss[r], lane) * (1.0f / DM) + EPS); float s2 = 0.f;
#pragma unroll
            for (int j = 0; j < 8; ++j) { const int ci = 256 * j + 4 * lane; const f32x4 g4 = *(const f32x4*)(gpost + ci), t4 = *(const f32x4*)(mv + gt_off + ci);
                const f32x4 nv = hh[r][j] + t4 * (v[r][j] * rstd * g4); v[r][j] = nv;
                if (h16out) { v2u w; w.x = pk2(nv[0], nv[1]); w.y = pk2(nv[2], nv[3]); *(v2u*)(h16out + (size_t)m * DM + ci) = w; } else *(f32x4*)(hd + ci) = nv;
                s2 += (nv[0] * nv[0] + nv[1] * nv[1]) + (nv[2] * nv[2] + nv[3] * nv[3]); }
            if (U) { const float* mu = modu + vi * 12288; const float rstd2 = rsqrtf(wave_sum(s2, lane) * (1.0f / DM) + EPS); store_u(U + (size_t)m * DM, lane, v[r], rstd2, gpre, mu + sh_off, mu + sc_off); }
        }
    }
}
__device__ __forceinline__ void rope_cs(float pos, int j, float inv_nf, float& cs, float& sn) {
    const float inv_freq = __builtin_amdgcn_exp2f(-(float)j * inv_nf * 13.287712379549449f);
    float rev = pos * inv_freq * 0.15915494309189535f; rev -= rintf(rev);
    sn = __builtin_amdgcn_sinf(rev); cs = __builtin_amdgcn_cosf(rev);
}
template <int NH> __device__ __forceinline__ void heads_load(const bf16* base, int ia, float (&x)[NH], float (&y)[NH]) {
#pragma unroll
    for (int h = 0; h < NH; ++h) { x[h] = bf2f(base[h * 128 + ia]); y[h] = bf2f(base[h * 128 + ia + 32]); }
}
template <int NH> __device__ __forceinline__ void heads_finish(bf16* base, int ia, float (&x)[NH], float (&y)[NH], const float* gain, bool rope, float cs, float sn, int lane) {
    const float ga = gain[ia], gb = gain[ia + 32];
#pragma unroll
    for (int h = 0; h < NH; ++h) {
        const float rstd = rsqrtf(wave_sum(x[h] * x[h] + y[h] * y[h], lane) * (1.0f / 128.0f) + EPS);
        float a = x[h] * rstd * ga, b = y[h] * rstd * gb;
        if (rope) { const float na = a * cs - b * sn, nb = b * cs + a * sn; a = na; b = nb; }
        base[h * 128 + ia] = (bf16)f2bf(a); base[h * 128 + ia + 32] = (bf16)f2bf(b); }
}
__device__ __forceinline__ void unpack8(const v4u raw, float (&x)[8]) {
#pragma unroll
    for (int i = 0; i < 4; ++i) { x[2 * i] = __uint_as_float(raw[i] << 16); x[2 * i + 1] = __uint_as_float(raw[i] & 0xffff0000u); }
}
__device__ __forceinline__ void norm512_finish(bf16* p, const float (&x)[8], const float* gain, int lane) {
    float ss = 0.f;
#pragma unroll
    for (int i = 0; i < 8; ++i) ss += x[i] * x[i];
    const float rstd = rsqrtf(wave_sum(ss, lane) * (1.0f / 512.0f) + EPS);
    const f32x4 g0 = *(const f32x4*)(gain + 8 * lane), g1 = *(const f32x4*)(gain + 8 * lane + 4);
    v4u w; w.x = pk2(x[0] * rstd * g0[0], x[1] * rstd * g0[1]); w.y = pk2(x[2] * rstd * g0[2], x[3] * rstd * g0[3]); w.z = pk2(x[4] * rstd * g1[0], x[5] * rstd * g1[1]); w.w = pk2(x[6] * rstd * g1[2], x[7] * rstd * g1[3]);
    *(v4u*)(p + 8 * lane) = w;
}
__device__ __forceinline__ void rope64(bf16* p, float prow, float pcol, int l32) {
    const int j = l32 & 15, s = (l32 >> 4) & 1, ia = 32 * s + j, ib = ia + 16;
    const float x = bf2f(p[ia]), y = bf2f(p[ib]); float cs, sn; rope_cs(s ? pcol : prow, j, 1.0f / 16.0f, cs, sn);
    p[ia] = (bf16)f2bf(x * cs - y * sn); p[ib] = (bf16)f2bf(y * cs + x * sn);
}
__device__ __forceinline__ void prep_ab(bf16* P, const float* aqn, const float* akn, const float* bqn, const float* bkvn, int gw, int NGW, int lane) {
    const int ia = 64 * (lane >> 5) + (lane & 31);
    for (int m = gw; m < MALL; m += NGW) {
        bf16* row = P + (size_t)m * N_IN0; const bool lat = m < MLAT; const int t = m & (SEQ - 1); const float pr = (float)(t >> 6), pc = (float)(t & 63);
        float xk[2], yk[2], c1[8], c2[8];
        heads_load<2>(row + 1024, ia, xk, yk);
        unpack8(*(const v4u*)(row + 1536 + 8 * lane), c1); unpack8(*(const v4u*)(row + 2048 + 8 * lane), c2);
        if (lat && lane < 32) rope64(row + 2560, pr, pc, lane);
        float cs = 1.f, sn = 0.f; if (lat) rope_cs((lane >> 5) ? pc : pr, lane & 31, 1.0f / 32.0f, cs, sn);
        heads_finish<2>(row + 1024, ia, xk, yk, akn, lat, cs, sn, lane);
        norm512_finish(row + 1536, c1, bqn, lane); norm512_finish(row + 2048, c2, bkvn, lane);
    }
}
__device__ __forceinline__ void prep_qb(bf16* QB, int gw, int NGW, int lane) {
    for (int m = gw; m < MLAT; m += NGW) {
        bf16* row = QB + (size_t)m * N_UQ; const int t = m & (SEQ - 1); const float pr = (float)(t >> 6), pc = (float)(t & 63);
#pragma unroll
        for (int i = 0; i < 4; ++i) rope64(row + (2 * i + (lane >> 5)) * 192 + 128, pr, pc, lane & 31);
    }
}
__device__ __forceinline__ void prep_cd(bf16* P, const float* cqn, const float* ckn, const float* dqn, const float* dkn, int gw, int NGW, int lane) {
    const int ia = 64 * (lane >> 5) + (lane & 31);
    for (int m = gw; m < MALL; m += NGW) {
        bf16* row = P + (size_t)m * N_IN1; const bool lat = m < MLAT; const int t = m & (SEQ - 1); const float pr = (float)(t >> 6), pc = (float)(t & 63);
        float cs = 1.f, sn = 0.f; if (lat) rope_cs((lane >> 5) ? pc : pr, lane & 31, 1.0f / 32.0f, cs, sn);
        float xk[2], yk[2], xd[8], yd[8];
        heads_load<2>(row + 1024, ia, xk, yk); heads_load<8>(row + 2560, ia, xd, yd);
        heads_finish<2>(row + 1024, ia, xk, yk, ckn, lat, cs, sn, lane); heads_finish<8>(row + 2560, ia, xd, yd, dkn, false, 1.f, 0.f, lane);
    }
}
constexpr float LOG2E = 1.4426950408889634f;
__device__ __forceinline__ void attn_phase_ab(const bf16* P0, const bf16* QB, const bf16* KVB, bf16* OB, const float* aqn, char* lds, const int wave0) {
    const int c = blockIdx.x, G = gridDim.x;
    for (int id = c; id < 1024 + 32; id += G) {
        att::Args a{};
        int mixer, b, h, qrow0, NT;
        if (id < 1024) { const int rnd = id >> 8, cc = id & 255; mixer = rnd >> 1; b = rnd & 1; h = cc & 7; qrow0 = b * SEQ + (cc >> 3) * 256; NT = 132; }
        else { const int cc = id - 1024; mixer = cc >> 4; b = (cc >> 3) & 1; h = cc & 7; qrow0 = MLAT + b * NCTX; NT = 4; }
        a.NT = NT; a.nctx = 4; a.ctx_row0 = MLAT + b * NCTX; a.lat_row0 = b * SEQ; a.ldo = DM; a.qrope_t0 = (id < 1024) ? (qrow0 - b * SEQ) : -1;
        if (mixer == 0) {
            a.Q = P0 + (size_t)qrow0 * N_IN0 + h * 128; a.ldq = N_IN0; a.K = P0 + 1024 + (h >> 2) * 128; a.ldk = N_IN0; a.K2 = nullptr; a.ldk2 = 0; a.V = P0 + 1280 + (h >> 2) * 128; a.ldv = N_IN0;
            a.O = OB + (size_t)qrow0 * DM + h * 128; const float scale = 0.08838834764831845f; a.C = scale * LOG2E; a.thr_raw = 8.0f * LOG2E; a.qgain = aqn;

#ifndef DIS_A
            att::attn_unit<128, 0>(a, lds, wave0);
#endif

        } else {
            a.Q = QB + (size_t)qrow0 * N_UQ + h * 192; a.ldq = N_UQ; a.K = KVB + h * 256; a.ldk = N_UKV; a.K2 = P0 + 2560; a.ldk2 = N_IN0; a.V = KVB + h * 256 + 128; a.ldv = N_UKV;
            a.O = OB + (size_t)qrow0 * DM + 1024 + h * 128; const float scale = 0.07216878364870322f; a.C = scale * LOG2E; a.thr_raw = 8.0f * LOG2E;

#ifndef DIS_B
            att::attn_unit<192, 0>(a, lds, wave0);
#endif

        }
    }
}
__device__ __forceinline__ void attn_phase_cd(const bf16* P1, bf16* OB, const float* sink, const float* rpb, const float* cqn, const float* dqn, char* lds, const int wave0) {
    const int c = blockIdx.x, G = gridDim.x;
    for (int id = c; id < 1024; id += G) {
        att::Args a{};
        const int rnd = id >> 8, cc = id & 255, mixer = rnd >> 1, b = rnd & 1, h = cc & 7, qb = cc >> 3, qrow0 = b * SEQ + qb * 256;
        a.nctx = 4; a.ctx_row0 = MLAT + b * NCTX; a.ldo = DM; a.ldq = a.ldk = a.ldv = N_IN1; a.K2 = nullptr; a.ldk2 = 0;
        const float scale = 0.08838834764831845f; a.C = scale * LOG2E; a.thr_raw = 8.0f * LOG2E; a.inv_scale = LOG2E;
        if (mixer == 0) {
            const int kbase = min(max(qb * 256 - 128, 0), SEQ - 512);
            a.NT = 12; a.lat_row0 = b * SEQ + kbase; a.qpos0 = qb * 256; a.kpos0 = kbase; a.sink_l2 = __uint_as_float((unsigned)__builtin_amdgcn_readfirstlane((int)__float_as_uint(sink[h]))) * LOG2E;
            a.qgain = cqn; a.qrope_t0 = qb * 256; a.Q = P1 + (size_t)qrow0 * N_IN1 + h * 128; a.K = P1 + 1024 + (h >> 2) * 128; a.V = P1 + 1280 + (h >> 2) * 128; a.O = OB + (size_t)qrow0 * DM + h * 128;

#ifndef DIS_C
            att::attn_unit<128, 1>(a, lds, wave0);
#endif

        } else {
            const int r0 = qb * 4, klo = min(max(r0 - 4, 0), 116);
            a.NT = 16; a.lat_row0 = b * SEQ + klo * 64; a.r0 = r0; a.klo = klo; a.rpb = rpb + h * (15 * 31);
            a.qgain = dqn; a.qrope_t0 = -1; a.Q = P1 + (size_t)qrow0 * N_IN1 + 1536 + h * 128; a.K = P1 + 2560 + h * 128; a.V = P1 + 3584 + h * 128; a.O = OB + (size_t)qrow0 * DM + 1024 + h * 128;

#ifndef DIS_D
            att::attn_unit<128, 2>(a, lds, wave0);
#endif

        }
    }
}

__global__ void __launch_bounds__(NTHR, 2) fwd_megakernel(KArgs args) {
    extern __shared__ __attribute__((aligned(16))) unsigned char lds[];
    cg::grid_group grid = cg::this_grid();
    LAS unsigned char* ldsl = (LAS unsigned char*)lds;
    const int wave0 = __builtin_amdgcn_readfirstlane(threadIdx.x >> 6);
    const int G = gridDim.x, NGW = G * NWAVES;
#define PHASE_IDS() const int tid = fresh_tid(wave0); const int lane = tid & 63, wave = __builtin_amdgcn_readfirstlane(tid >> 6), gw = blockIdx.x * NWAVES + wave; (void)wave; (void)gw; (void)lane
#define WSB (kargs()->ws)
#define x_ (kargs()->in[0])
#define ctx_ (kargs()->in[2])
#define out_ (kargs()->out)
#define hctx_ ((float*)(WSB + WS_HCTX))
#define MOD_ ((const float*)(WSB + WS_MOD))
#define UA_ ((bf16*)(WSB + WS_UO))
#define OB_ ((bf16*)(WSB + WS_OB))
#define FB_ ((bf16*)(WSB + WS_UO))
#define FP_ ((float*)(WSB + WS_FP))
#define HB_ ((bf16*)(WSB + WS_OB))
#define OFB_ ((bf16*)(WSB + WS_BIG))
#define OFP_ ((float*)(WSB + WS_BIG + 128 * MiB))
#define PB_ ((bf16*)(WSB + WS_BIG))
#define OF_ ((float*)(WSB + WS_BIG))
#define ACT_ ((bf16*)(WSB + WS_BIG))
#define QB_ ((bf16*)(WSB + WS_QB))
#define KVB_ ((bf16*)(WSB + WS_KVB))
#define UB_ ((bf16*)(WSB + WS_UB))
#ifndef PROBE_G
#define PROBE_G 1
#endif
#ifndef PROBE_A
#define PROBE_A 1
#endif
#ifndef PROBE_S
#define PROBE_S 1
#endif
#define GSYNC() do { for (int s_ = 0; s_ < PROBE_S; ++s_) { xcd_barrier(bar); } } while (0)
    volatile LAS unsigned* MISC = (volatile LAS unsigned*)(ldsl + 131072 + 64);
    if (threadIdx.x < 2) MISC[threadIdx.x] = 0u;
    __syncthreads();
    grid.sync();
    XcdBarrier bar = xcd_barrier_post((unsigned*)(kargs()->ws + WS_BAR), MISC);

    for (int rep_ = 0; rep_ < PROBE_S; ++rep_) {
    { PHASE_IDS(); p0_mod(kargs(), ldsl, tid); }
    { PHASE_IDS(); p0_weights(kargs(), ldsl, gw, NGW, wave, lane); }
    }
    GSYNC();
    { PHASE_IDS(); pass_pre(x_, ctx_, kargs()->in[6], MOD_, 0, DM, UA_, MALL, gw, NGW, lane); }
    GSYNC();
    for (int L = 0; L < 2; ++L) {

        const int Mrows = L == 0 ? MALL : MLAT;
        { pg8::Gemm g = pg8::mk_gemm(L == 0 ? UA_ : UB_, (const bf16*)(WSB + (L == 0 ? WS_WIN0 : WS_WIN1)), MALL, L == 0 ? N_IN0 : N_IN1, DM, DM);
          pg8::StaticOrder S; S.init(g.M, g.N, G, (int)blockIdx.x); pg8::EpiBf16 E{PB_, g.N};
          for (int rep_ = 0; rep_ < PROBE_G; ++rep_) pg8::gemm_phase<pg8::EpiBf16, pg8::StaticOrder, true, true>(ldsl, g, S, E, wave0); }
        GSYNC();
        if (L == 0) {
            { PHASE_IDS(); prep_ab(PB_, kargs()->in[15], kargs()->in[16], kargs()->in[17], kargs()->in[18], gw, NGW, lane); }
            GSYNC();
            for (int q = 0; q < 2; ++q) {
                pg8::Gemm g = pg8::mk_gemm(PB_ + (q == 0 ? 1536 : 2048), (const bf16*)(WSB + (q == 0 ? WS_WUQ : WS_WUKV)), MALL, q == 0 ? N_UQ : N_UKV, 512, N_IN0);
                pg8::StaticOrder S; S.init(g.M, g.N, G, (int)blockIdx.x); pg8::EpiBf16 E{q == 0 ? QB_ : KVB_, g.N};
                for (int rep_ = 0; rep_ < PROBE_G; ++rep_) pg8::gemm_phase<pg8::EpiBf16, pg8::StaticOrder, true, true>(ldsl, g, S, E, wave0);
            }
            GSYNC();
            for (int rep_ = 0; rep_ < PROBE_A; ++rep_) attn_phase_ab(PB_, QB_, KVB_, OB_, kargs()->in[15], (char*)lds, wave0);
        } else {
            { PHASE_IDS(); prep_cd(PB_, kargs()->in[23], kargs()->in[24], kargs()->in[26], kargs()->in[27], gw, NGW, lane); }
            GSYNC();
            for (int rep_ = 0; rep_ < PROBE_A; ++rep_) attn_phase_cd(PB_, OB_, kargs()->in[25], kargs()->in[28], kargs()->in[23], kargs()->in[26], (char*)lds, wave0);
        }
        GSYNC();
        { pg8::Gemm g = pg8::mk_gemm(OB_, (const bf16*)(WSB + (L == 0 ? WS_WOUT0 : WS_WOUT1)), MLAT, DM, DM, DM);
          pg8::StaticOrder S; S.init(g.M, g.N, G, (int)blockIdx.x); pg8::EpiBf16 E{OFB_, DM};
          for (int rep_ = 0; rep_ < PROBE_G; ++rep_) pg8::gemm_phase<pg8::EpiBf16, pg8::StaticOrder, true, true>(ldsl, g, S, E, wave0); }
        if (L == 0) { pg8::Gemm g = pg8::mk_gemm(OB_ + (size_t)MLAT * DM, (const bf16*)(WSB + WS_WOUT0), 2 * NCTX, 4 * DM, DM / 4, DM); g.ldb = DM; g.nNr = DM / 256;
          pg8::StaticOrder S; S.init(g.M, g.N, G, (int)blockIdx.x); pg8::EpiF32Split E{OFP_, DM, DM / 256, (size_t)2 * NCTX * DM};
          for (int rep_ = 0; rep_ < PROBE_G; ++rep_) pg8::gemm_phase<pg8::EpiF32Split, pg8::StaticOrder, true, true>(ldsl, g, S, E, wave0); }
        GSYNC();
        { PHASE_IDS(); pass_post(OFB_, OFP_, L == 0 ? x_ : out_, L == 0 ? ctx_ : hctx_, nullptr, out_, hctx_, HB_, kargs()->in[7] + L * DM, MOD_ + (size_t)L * 3 * 12288, 2 * DM, kargs()->in[8] + L * DM, MOD_ + (size_t)L * 3 * 12288, 3 * DM, 4 * DM, UA_, Mrows, gw, NGW, lane); }
        GSYNC();
        { pg8::Gemm g = pg8::mk_gemm(UA_, (const bf16*)(WSB + WS_WGU + (size_t)L * 44 * MiB), Mrows, N_GU, DM, DM);
          pg8::StaticOrder S; S.init(g.M, g.N, G, (int)blockIdx.x); pg8::EpiSwiglu E{ACT_, DFF};
          for (int rep_ = 0; rep_ < PROBE_G; ++rep_) pg8::gemm_phase<pg8::EpiSwiglu, pg8::StaticOrder, true, true>(ldsl, g, S, E, wave0); }
        GSYNC();
        { pg8::Gemm g = pg8::mk_gemm(ACT_, (const bf16*)(WSB + WS_WD + (size_t)L * 22 * MiB), MLAT, DM, DFF, DFF);
          pg8::StaticOrder S; S.init(g.M, g.N, G, (int)blockIdx.x); pg8::EpiBf16 E{FB_, DM};
          for (int rep_ = 0; rep_ < PROBE_G; ++rep_) pg8::gemm_phase<pg8::EpiBf16, pg8::StaticOrder, true, true>(ldsl, g, S, E, wave0); }
        if (L == 0) { pg8::Gemm g = pg8::mk_gemm(ACT_ + (size_t)MLAT * DFF, (const bf16*)(WSB + WS_WD), 2 * NCTX, 4 * DM, DFF / 4, DFF); g.ldb = DFF; g.nNr = DM / 256;
          pg8::StaticOrder S; S.init(g.M, g.N, G, (int)blockIdx.x); pg8::EpiF32Split E{FP_, DM, DM / 256, (size_t)2 * NCTX * DM};
          for (int rep_ = 0; rep_ < PROBE_G; ++rep_) pg8::gemm_phase<pg8::EpiF32Split, pg8::StaticOrder, true, true>(ldsl, g, S, E, wave0); }
        GSYNC();
        { PHASE_IDS(); pass_post(FB_, FP_, out_, hctx_, HB_, out_, hctx_, nullptr, kargs()->in[9] + L * DM, MOD_ + (size_t)L * 3 * 12288, 5 * DM, kargs()->in[6] + DM, MOD_ + (size_t)3 * 12288, 0, DM, L == 0 ? UB_ : nullptr, Mrows, gw, NGW, lane); }
        if (L == 0) GSYNC();
    }
#undef GSYNC
}

constexpr int LDS_BYTES = 131072 + 1024;
extern "C" void kernel_launch(void* const* d_in, const int* in_sizes, int n_in, void* d_out, int out_size, void* d_ws, size_t ws_size, hipStream_t stream) {
    static int grid = 0;
    if (grid == 0) {
        if (n_in != 29 || out_size != MLAT * DM || ws_size < WS_END) { fprintf(stderr, "kernel_launch: unexpected shapes: n_in %d out %d ws %zu (need %zu)\n", n_in, out_size, ws_size, (size_t)WS_END); grid = -1; return; }
        int dev = 0, cus = 0, per_cu = 0;
        hipGetDevice(&dev); hipDeviceGetAttribute(&cus, hipDeviceAttributeMultiprocessorCount, dev);
        if (hipFuncSetAttribute((const void*)fwd_megakernel, hipFuncAttributeMaxDynamicSharedMemorySize, LDS_BYTES) != hipSuccess) { fprintf(stderr, "kernel_launch: hipFuncSetAttribute failed\n"); grid = -1; return; }
        if (hipOccupancyMaxActiveBlocksPerMultiprocessor(&per_cu, (const void*)fwd_megakernel, NTHR, LDS_BYTES) != hipSuccess || per_cu < 1) { fprintf(stderr, "kernel_launch: occupancy query says %d\n", per_cu); per_cu = 1; }
        (void)hipGetLastError();
        grid = cus;
        fprintf(stderr, "kernel_launch: grid %d (per_cu %d)\n", grid, per_cu);
    }
    if (grid < 0) return;
    if (hipMemsetAsync((char*)d_ws + WS_BAR, 0, BAR_BYTES, stream) != hipSuccess) { fprintf(stderr, "kernel_launch: hipMemsetAsync failed\n"); return; }
    KArgs a{};
    for (int i = 0; i < 29; ++i) a.in[i] = (const float*)d_in[i];
    a.out = (float*)d_out; a.ws = (unsigned char*)d_ws;
    void* params[] = {&a};
    const hipError_t e = hipLaunchCooperativeKernel((const void*)fwd_megakernel, dim3(grid), dim3(NTHR), params, LDS_BYTES, stream);
    if (e != hipSuccess) fprintf(stderr, "kernel_launch: cooperative launch failed: %s (grid %d)\n", hipGetErrorString(e), grid);
}
```

```cpp
#include <hip/hip_runtime.h>
#include <hip/hip_cooperative_groups.h>
#include <cstdio>
#include <cstdint>
namespace cg = cooperative_groups;
__device__ __forceinline__ int fresh_tid(int wave0) { int l; asm volatile("v_mbcnt_lo_u32_b32 %0, -1, 0\n\tv_mbcnt_hi_u32_b32 %0, -1, %0" : "=v"(l)); return wave0 * 64 + l; }
namespace pg8 {
#define PG8_LAS __attribute__((address_space(3)))
typedef unsigned short bf16_t;
typedef short bf16x8 __attribute__((ext_vector_type(8)));
typedef float f32x4 __attribute__((ext_vector_type(4)));
typedef unsigned u32x4 __attribute__((ext_vector_type(4)));
constexpr int BM = 256, BK = 64, HALF = 128, HTB = HALF * BK * 2  , STAGE_BYTES = 8 * HTB, NXCD = 8, WGM = 8;

__host__ __device__ __forceinline__ int lds_byte(int r, int c) { const int st = (r >> 4) * 2 + (c >> 5), rr = r & 15, cc = c & 31, ob = rr * 64 + cc * 2; return st * 1024 + (ob ^ (((ob >> 9) & 1) << 5)); }
__host__ __device__ __forceinline__ void stage_rc(int b, int& R, int& C) { const int st = b / 1024, sb = b % 1024, swz = sb ^ (((sb >> 9) & 1) << 5); R = (st >> 1) * 16 + swz / 64; C = (st & 1) * 32 + (swz % 64) / 2; }
__host__ __device__ __forceinline__ int perm32(int rho) { const int n = rho >> 4, i = rho & 15; return 8 * (i >> 2) + 4 * n + (i & 3); }

struct Unit { int pm, pn; };
struct Gemm { const bf16_t* A; const bf16_t* Bt; int M, N, K, lda, ldb, nNr; };
__host__ __device__ __forceinline__ Gemm mk_gemm(const bf16_t* A, const bf16_t* Bt, int M, int N, int K, int lda) { Gemm g; g.A = A; g.Bt = Bt; g.M = M; g.N = N; g.K = K; g.lda = lda; g.ldb = K; g.nNr = N / BM; return g; }

struct StaticOrder {
    int nM, nN, nwg, G, c;
    __host__ __device__ void init(int M, int N, int G_, int c_) { nM = M / BM; nN = N / BM; nwg = nM * nN; G = G_; c = c_; }
    __host__ __device__ bool next(int i, Unit& u) const {
        const long L = (long)i * G + c; if (L >= nwg) return false;
        int wgid = (int)L; { const int q = nwg / NXCD, r = nwg % NXCD, xcd = wgid % NXCD, off = wgid / NXCD; wgid = (xcd < r ? xcd * (q + 1) : r * (q + 1) + (xcd - r) * q) + off; }
        const int nig = WGM * nN, gid = wgid / nig, fm = gid * WGM, gsz = (nM - fm) < WGM ? (nM - fm) : WGM;
        u.pm = fm + ((wgid % nig) % gsz); u.pn = (wgid % nig) / gsz; return true;
    }
    __device__ __forceinline__ void a_ready(const Unit&) const {}
    __device__ __forceinline__ void done(const Unit&) const {}
};


__device__ __forceinline__ unsigned cvt_pk_bf16(float lo, float hi) { unsigned r; asm volatile("v_cvt_pk_bf16_f32 %0, %1, %2" : "=v"(r) : "v"(lo), "v"(hi)); return r; }
struct EpiBf16 {
    static constexpr bool PERM = true, AFTER_DRAIN = false;
    bf16_t* O; int ldc;
    __device__ __forceinline__ void operator()(const f32x4 (&acc)[2][2][4][2], const Unit& u, int wr, int wc, int fr, int fq) const {
        const int row0 = u.pm * BM + wr * 64 + fr, col0 = u.pn * BM + wc * 32 + 8 * fq;
#pragma unroll
        for (int ai = 0; ai < 2; ++ai)
#pragma unroll
            for (int m = 0; m < 4; ++m) { bf16_t* rowp = O + (size_t)(row0 + ai * HALF + m * 16) * ldc + col0;
#pragma unroll
                for (int bj = 0; bj < 2; ++bj) { const f32x4 v0 = acc[ai][bj][m][0], v1 = acc[ai][bj][m][1];
                    u32x4 w; w.x = cvt_pk_bf16(v0[0], v0[1]); w.y = cvt_pk_bf16(v0[2], v0[3]); w.z = cvt_pk_bf16(v1[0], v1[1]); w.w = cvt_pk_bf16(v1[2], v1[3]);
                    *(u32x4*)(rowp + bj * HALF) = w; } }
    }
};
struct EpiF32 {
    static constexpr bool PERM = false, AFTER_DRAIN = false;
    float* O; int ldc;
    __device__ __forceinline__ void operator()(const f32x4 (&acc)[2][2][4][2], const Unit& u, int wr, int wc, int fr, int fq) const {
        const int row0 = u.pm * BM + wr * 64 + fr, col0 = u.pn * BM + wc * 32 + 4 * fq;
#pragma unroll
        for (int ai = 0; ai < 2; ++ai)
#pragma unroll
            for (int m = 0; m < 4; ++m) { float* rowp = O + (size_t)(row0 + ai * HALF + m * 16) * ldc + col0;
#pragma unroll
                for (int bj = 0; bj < 2; ++bj)
#pragma unroll
                    for (int n = 0; n < 2; ++n) *(f32x4*)(rowp + bj * HALF + n * 16) = acc[ai][bj][m][n]; }
    }
};
struct EpiF32Split {
    static constexpr bool PERM = false, AFTER_DRAIN = false;
    float* O; int ldc; int nNr; size_t sstride;
    __device__ __forceinline__ void operator()(const f32x4 (&acc)[2][2][4][2], const Unit& u, int wr, int wc, int fr, int fq) const {
        const int s = u.pn / nNr, pn = u.pn - s * nNr;
        const int row0 = u.pm * BM + wr * 64 + fr, col0 = pn * BM + wc * 32 + 4 * fq; float* Ob = O + (size_t)s * sstride;
#pragma unroll
        for (int ai = 0; ai < 2; ++ai)
#pragma unroll
            for (int m = 0; m < 4; ++m) { float* rowp = Ob + (size_t)(row0 + ai * HALF + m * 16) * ldc + col0;
#pragma unroll
                for (int bj = 0; bj < 2; ++bj)
#pragma unroll
                    for (int n = 0; n < 2; ++n) *(f32x4*)(rowp + bj * HALF + n * 16) = acc[ai][bj][m][n]; }
    }
};
__device__ __forceinline__ float silu_mul(float g, float u) { return g * __builtin_amdgcn_rcpf(1.0f + __builtin_amdgcn_exp2f(-1.4426950408889634f * g)) * u; }
struct EpiSwiglu {
    static constexpr bool PERM = true, AFTER_DRAIN = false;
    bf16_t* O; int ldc;
    __device__ __forceinline__ void operator()(const f32x4 (&acc)[2][2][4][2], const Unit& u, int wr, int wc, int fr, int fq) const {
        const int row0 = u.pm * BM + wr * 64 + fr, col0 = u.pn * HALF + wc * 32 + 8 * fq;
#pragma unroll
        for (int ai = 0; ai < 2; ++ai)
#pragma unroll
            for (int m = 0; m < 4; ++m) { bf16_t* rowp = O + (size_t)(row0 + ai * HALF + m * 16) * ldc + col0;
                const f32x4 g0 = acc[ai][0][m][0], g1 = acc[ai][0][m][1], u0 = acc[ai][1][m][0], u1 = acc[ai][1][m][1];
                u32x4 w; w.x = cvt_pk_bf16(silu_mul(g0[0], u0[0]), silu_mul(g0[1], u0[1])); w.y = cvt_pk_bf16(silu_mul(g0[2], u0[2]), silu_mul(g0[3], u0[3]));
                w.z = cvt_pk_bf16(silu_mul(g1[0], u1[0]), silu_mul(g1[1], u1[1])); w.w = cvt_pk_bf16(silu_mul(g1[2], u1[2]), silu_mul(g1[3], u1[3]));
                *(u32x4*)rowp = w; }
    }
};

template <class Epi, class Sched, bool ALIGN_EPI = false, bool SP2 = false>
__device__ __forceinline__ void gemm_phase(PG8_LAS unsigned char* lds, const Gemm g, const Sched& S, const Epi& E, const int wave0) {
    const int tid = fresh_tid(wave0), wid = __builtin_amdgcn_readfirstlane(tid >> 6), lane = tid & 63, wr = wid >> 2, wc = wid & 3, fr = lane & 15, fq = lane >> 4;
    const int K = g.K, nt = K / BK;
    const unsigned ldsb0 = (unsigned)(uintptr_t)lds;
    unsigned voffA[2], voffB[2];
#pragma unroll
    for (int i = 0; i < 2; ++i) { int R, C; stage_rc(tid * 16 + i * 8192, R, C); const int Rb = Epi::PERM ? ((R & ~31) + perm32(R & 31)) : R;
        voffA[i] = (unsigned)(R * g.lda + C) * 2u; voffB[i] = (unsigned)(Rb * g.ldb + C) * 2u; }
    const size_t kstep = (size_t)(BK * 2);
    const size_t hstepA = (size_t)HALF * g.lda * 2, hstepB = (size_t)HALF * g.ldb * 2; const size_t ksb = (size_t)K * 2;
#define PG8_APTR(u) ((const char*)g.A + (size_t)(u).pm * tstepA + (size_t)((u).pn / g.nNr) * ksb)
#define PG8_BPTR(u) ((const char*)g.Bt + (size_t)((u).pn % g.nNr) * tstepB + (size_t)((u).pn / g.nNr) * ksb)
    const size_t tstepA = 2 * hstepA, tstepB = 2 * hstepB;
    const unsigned ldsw = (unsigned)wid * 1024u;
    const int aoff = lds_byte(wr * 64 + fr, fq * 8), boff = lds_byte(wc * 32 + fr, fq * 8);
#define PG8_SA(b, h) (((b) * 2 + (h)) * HTB)
#define PG8_SB(b, h) ((4 + (b) * 2 + (h)) * HTB)
#define PG8_STAGE(bufoff, gbase, voff) do { _Pragma("unroll") for (int _i = 0; _i < 2; ++_i) { \
        const unsigned ldst_ = ldsb0 + (unsigned)(bufoff) + ldsw + (unsigned)_i * 8192u; const char* gb_ = (const char*)(gbase); \
        asm volatile("s_mov_b32 m0, %2\n\ts_nop 0\n\tglobal_load_lds_dwordx4 %0, %1" :: "v"((voff)[_i]), "s"(gb_), "s"(ldst_) : "memory"); } } while (0)
#define PG8_LDA(dst, b, h) do { _Pragma("unroll") for (int m = 0; m < 4; ++m) _Pragma("unroll") for (int k = 0; k < 2; ++k) dst[m][k] = *(const PG8_LAS bf16x8*)(lds + PG8_SA(b, h) + aoff + m * 2048 + k * 1024); } while (0)
#define PG8_LDB(dst, b, h) do { _Pragma("unroll") for (int n = 0; n < 2; ++n) _Pragma("unroll") for (int k = 0; k < 2; ++k) dst[n][k] = *(const PG8_LAS bf16x8*)(lds + PG8_SB(b, h) + boff + n * 2048 + k * 1024); } while (0)
#define PG8_MMA(ai, bj, At, Bt) do { __builtin_amdgcn_s_setprio(1); _Pragma("unroll") for (int m = 0; m < 4; ++m) _Pragma("unroll") for (int n = 0; n < 2; ++n) _Pragma("unroll") for (int k = 0; k < 2; ++k) \
        acc[ai][bj][m][n] = __builtin_amdgcn_mfma_f32_16x16x32_bf16(Bt[n][k], At[m][k], acc[ai][bj][m][n], 0, 0, 0); __builtin_amdgcn_s_setprio(0); } while (0)
#define PG8_WAIT_V(n) asm volatile("s_waitcnt vmcnt(" #n ")" ::: "memory")
#define PG8_WAIT_L(n) asm volatile("s_waitcnt lgkmcnt(" #n ")" ::: "memory")
#define PG8_BAR __builtin_amdgcn_s_barrier()
#define PG8_SCHED __builtin_amdgcn_sched_barrier(0)
    Unit cur, nxt; int ui = 0;
    if (!S.next(0, cur)) return;
    f32x4 acc[2][2][4][2];
#pragma unroll
    for (int a = 0; a < 2; ++a)
#pragma unroll
        for (int b = 0; b < 2; ++b)
#pragma unroll
            for (int m = 0; m < 4; ++m)
#pragma unroll
                for (int n = 0; n < 2; ++n) acc[a][b][m][n] = (f32x4){0.f, 0.f, 0.f, 0.f};
    bf16x8 At[4][2], B0[2][2], B1[2][2];
    const char* cA = PG8_APTR(cur); const char* cB = PG8_BPTR(cur);
    S.a_ready(cur);
    if constexpr (SP2) {
        PG8_STAGE(PG8_SB(0, 0), cB, voffB); PG8_STAGE(PG8_SB(0, 1), cB + hstepB, voffB); PG8_STAGE(PG8_SA(0, 0), cA, voffA); PG8_STAGE(PG8_SA(0, 1), cA + hstepA, voffA);
        if (wr == 1) PG8_BAR;
        PG8_WAIT_V(2); PG8_BAR;
        PG8_STAGE(PG8_SB(1, 0), cB + kstep, voffB); PG8_STAGE(PG8_SA(1, 0), cA + kstep, voffA); PG8_STAGE(PG8_SB(1, 1), cB + hstepB + kstep, voffB);
        PG8_WAIT_V(6); PG8_BAR;
    } else {
        PG8_STAGE(PG8_SB(0, 0), cB, voffB); PG8_STAGE(PG8_SA(0, 0), cA, voffA); PG8_STAGE(PG8_SB(0, 1), cB + hstepB, voffB); PG8_STAGE(PG8_SA(0, 1), cA + hstepA, voffA);
        if (wr == 1) PG8_BAR;
        PG8_WAIT_V(4); PG8_BAR;
        PG8_STAGE(PG8_SB(1, 0), cB + kstep, voffB); PG8_STAGE(PG8_SA(1, 0), cA + kstep, voffA); PG8_STAGE(PG8_SB(1, 1), cB + hstepB + kstep, voffB);
        PG8_WAIT_V(6); PG8_BAR;
    }
    for (;;) {
        const bool has_next = S.next(ui + 1, nxt);
        const char* nA = has_next ? PG8_APTR(nxt) : cA; const char* nB = has_next ? PG8_BPTR(nxt) : cB;
        for (int t = 0; t < nt; t += 2) {
            const bool last = (t == nt - 2);
            const char* a1 = cA + (size_t)(t + 1) * kstep;
            const char* a2 = last ? nA : cA + (size_t)(t + 2) * kstep; const char* b2 = last ? nB : cB + (size_t)(t + 2) * kstep;
            const char* a3 = a2 + kstep; const char* b3 = b2 + kstep;
            if (last && has_next) S.a_ready(nxt);
            if constexpr (SP2) {
            PG8_LDB(B0, 0, 0); PG8_LDB(B1, 0, 1); PG8_SCHED; PG8_LDA(At, 0, 0); PG8_STAGE(PG8_SA(1, 1), a1 + hstepA, voffA);
            PG8_WAIT_V(8); PG8_WAIT_L(0); PG8_BAR; PG8_MMA(0, 0, At, B0); PG8_MMA(0, 1, At, B1); PG8_BAR; PG8_SCHED;
            PG8_LDA(At, 0, 1); PG8_STAGE(PG8_SB(0, 0), b2, voffB); PG8_STAGE(PG8_SB(0, 1), b2 + hstepB, voffB); PG8_STAGE(PG8_SA(0, 0), a2, voffA);
            PG8_WAIT_V(8); PG8_WAIT_L(0); PG8_BAR; PG8_MMA(1, 0, At, B0); PG8_MMA(1, 1, At, B1); PG8_BAR; PG8_SCHED;
            PG8_LDB(B0, 1, 0); PG8_LDB(B1, 1, 1); PG8_SCHED; PG8_LDA(At, 1, 0); PG8_STAGE(PG8_SA(0, 1), a2 + hstepA, voffA);
            PG8_WAIT_V(8); PG8_WAIT_L(0); PG8_BAR; PG8_MMA(0, 0, At, B0); PG8_MMA(0, 1, At, B1); PG8_BAR; PG8_SCHED;
            PG8_LDA(At, 1, 1); PG8_STAGE(PG8_SB(1, 0), b3, voffB); PG8_STAGE(PG8_SB(1, 1), b3 + hstepB, voffB); PG8_STAGE(PG8_SA(1, 0), a3, voffA);
            PG8_WAIT_V(8); PG8_WAIT_L(0); PG8_BAR; PG8_MMA(1, 0, At, B0); PG8_MMA(1, 1, At, B1); PG8_BAR; PG8_SCHED;
            } else {
            PG8_LDB(B0, 0, 0); PG8_SCHED; PG8_LDA(At, 0, 0); PG8_STAGE(PG8_SA(1, 1), a1 + hstepA, voffA);
            PG8_WAIT_L(8); PG8_BAR; PG8_WAIT_L(0); PG8_MMA(0, 0, At, B0); PG8_BAR; PG8_SCHED;
            PG8_LDB(B1, 0, 1); PG8_STAGE(PG8_SB(0, 0), b2, voffB);
            PG8_BAR; PG8_WAIT_L(0); PG8_MMA(0, 1, At, B1); PG8_BAR;
            PG8_LDA(At, 0, 1); PG8_STAGE(PG8_SA(0, 0), a2, voffA);
            PG8_BAR; PG8_WAIT_L(0); PG8_MMA(1, 0, At, B0); PG8_BAR; PG8_SCHED;
            PG8_STAGE(PG8_SB(0, 1), b2 + hstepB, voffB);
            PG8_WAIT_V(6); PG8_BAR; PG8_MMA(1, 1, At, B1); PG8_BAR;
            PG8_LDB(B0, 1, 0); PG8_SCHED; PG8_LDA(At, 1, 0); PG8_STAGE(PG8_SA(0, 1), a2 + hstepA, voffA);
            PG8_WAIT_L(8); PG8_BAR; PG8_WAIT_L(0); PG8_MMA(0, 0, At, B0); PG8_BAR; PG8_SCHED;
            PG8_LDB(B1, 1, 1); PG8_STAGE(PG8_SB(1, 0), b3, voffB);
            PG8_BAR; PG8_WAIT_L(0); PG8_MMA(0, 1, At, B1); PG8_BAR;
            PG8_LDA(At, 1, 1); PG8_STAGE(PG8_SA(1, 0), a3, voffA);
            PG8_BAR; PG8_WAIT_L(0); PG8_MMA(1, 0, At, B0); PG8_BAR; PG8_SCHED;
            PG8_STAGE(PG8_SB(1, 1), b3 + hstepB, voffB);
            PG8_WAIT_V(6); PG8_BAR; PG8_MMA(1, 1, At, B1); PG8_BAR;
            }
        }
        if constexpr (ALIGN_EPI) { if (wr == 0) PG8_BAR; }
        if constexpr (!Epi::AFTER_DRAIN) { E(acc, cur, wr, wc, fr, fq); S.done(cur); }
        if (!has_next) break;
#pragma unroll
        for (int a = 0; a < 2; ++a)
#pragma unroll
            for (int b = 0; b < 2; ++b)
#pragma unroll
                for (int m = 0; m < 4; ++m)
#pragma unroll
                    for (int n = 0; n < 2; ++n) acc[a][b][m][n] = (f32x4){0.f, 0.f, 0.f, 0.f};
        cur = nxt; cA = nA; cB = nB; ++ui;
        if constexpr (ALIGN_EPI) { if (wr == 1) PG8_BAR; }
    }
    PG8_WAIT_V(0);
    if constexpr (!ALIGN_EPI) { if (wr == 0) PG8_BAR; }
    PG8_BAR;
    if constexpr (Epi::AFTER_DRAIN) { E.fused(acc, cur, wr, wc, fr, fq, lds, wid, lane); S.done(cur); }
#undef PG8_APTR
#undef PG8_BPTR
#undef PG8_SA
#undef PG8_SB
#undef PG8_STAGE
#undef PG8_LDA
#undef PG8_LDB
#undef PG8_MMA
#undef PG8_WAIT_V
#undef PG8_WAIT_L
#undef PG8_BAR
#undef PG8_SCHED
}
}
namespace att {
typedef unsigned short bf16;
typedef short bf16x8 __attribute__((ext_vector_type(8)));
typedef short s16x4 __attribute__((ext_vector_type(4)));
typedef float f32x16 __attribute__((ext_vector_type(16)));
typedef unsigned u32x4 __attribute__((ext_vector_type(4)));
constexpr int NW = 8, QBLK = 32, KVBLK = 64;
constexpr int SHM_V = KVBLK * 128 * 2;
#define SBAR() __builtin_amdgcn_sched_barrier(0)
__device__ __forceinline__ int crow(int r, int hi) { return (r & 3) + 8 * (r >> 2) + 4 * hi; }
__device__ __forceinline__ unsigned cvtpk(float lo, float hi) { unsigned r; asm volatile("v_cvt_pk_bf16_f32 %0, %1, %2" : "=v"(r) : "v"(lo), "v"(hi)); return r; }

struct Args {
  const bf16* Q; const bf16* K; const bf16* K2; const bf16* V; bf16* O;
  int ldq, ldk, ldk2, ldv, ldo;
  int NT, nctx, ctx_row0, lat_row0;
  float C, thr_raw;
  int qpos0, kpos0;
  float sink_l2;
  int r0, klo;
  const float* rpb; float inv_scale;
  const float* qgain;
  int qrope_t0;
};

template <bool FIRST> __device__ __forceinline__ void partialSM(f32x16& p0, f32x16& p1, float& m_reg, float& alpha, f32x16& negm, const float thr) {
  float pmax = p0[0];
#pragma unroll
  for (int r = 1; r < 16; ++r) pmax = fmaxf(pmax, p0[r]);
#pragma unroll
  for (int r = 0; r < 16; ++r) pmax = fmaxf(pmax, p1[r]);
  { auto rr = __builtin_amdgcn_permlane32_swap(__float_as_uint(pmax), __float_as_uint(pmax), false, false);
    pmax = fmaxf(__uint_as_float(rr[0]), __uint_as_float(rr[1])); }
  alpha = 1.f;
  if (FIRST || !__builtin_expect(__all(pmax <= thr), 1)) {
    const float delta = FIRST ? pmax : fmaxf(pmax, 0.f);
    m_reg += delta; if (!FIRST) alpha = __builtin_amdgcn_exp2f(-delta);
#pragma unroll
    for (int r = 0; r < 16; ++r) { p0[r] -= delta; p1[r] -= delta; }
    const float nm = -m_reg;
#pragma unroll
    for (int r = 0; r < 16; ++r) negm[r] = nm;
    asm volatile("" : "+v"(negm));
  }
#pragma unroll
  for (int r = 0; r < 16; ++r) p0[r] = __builtin_amdgcn_exp2f(p0[r]);
}
__device__ __forceinline__ void finishSM(f32x16& p0, f32x16& p1, float alpha, float& l_reg, bf16x8& pa0, bf16x8& pa1, bf16x8& pa2, bf16x8& pa3) {
#pragma unroll
  for (int r = 0; r < 16; ++r) p1[r] = __builtin_amdgcn_exp2f(p1[r]);
  float ps = 0;
#pragma unroll
  for (int r = 0; r < 16; ++r) ps += p0[r];
#pragma unroll
  for (int r = 0; r < 16; ++r) ps += p1[r];
  { auto rr = __builtin_amdgcn_permlane32_swap(__float_as_uint(ps), __float_as_uint(ps), false, false);
    ps = __uint_as_float(rr[0]) + __uint_as_float(rr[1]); }
  l_reg = l_reg * alpha + ps;
#define PK8(P, BASE, OUT) do { u32x4 w = {cvtpk(P[BASE + 0], P[BASE + 1]), cvtpk(P[BASE + 2], P[BASE + 3]), cvtpk(P[BASE + 4], P[BASE + 5]), cvtpk(P[BASE + 6], P[BASE + 7])}; \
    OUT = *reinterpret_cast<bf16x8*>(&w); } while (0)
  PK8(p0, 0, pa0); PK8(p0, 8, pa1); PK8(p1, 0, pa2); PK8(p1, 8, pa3);
#undef PK8
}
template <int DQ> __device__ __forceinline__ int kswz(int row, int colB) { return row * (DQ * 2) + (colB ^ ((row & 7) << 4)); }
typedef const __attribute__((address_space(3))) bf16x8* lds_b128_ptr;
template <int DQ> __device__ __forceinline__ void qkt(f32x16& p0, f32x16& p1, const int (&kx)[4], int koff, const bf16x8* qr, const f32x16& negm) {
  lds_b128_ptr k0 = (lds_b128_ptr)(unsigned)(kx[0] + koff), k1 = (lds_b128_ptr)(unsigned)(kx[1] + koff), k2 = (lds_b128_ptr)(unsigned)(kx[2] + koff), k3 = (lds_b128_ptr)(unsigned)(kx[3] + koff);
#pragma unroll
  for (int d0 = 0; d0 < DQ / 16; ++d0) { lds_b128_ptr kp = (d0 & 3) == 0 ? k0 : (d0 & 3) == 1 ? k1 : (d0 & 3) == 2 ? k2 : k3;
    const bf16x8 b0 = kp[(d0 >> 2) * 8];
    const bf16x8 b1 = kp[(d0 >> 2) * 8 + 32 * DQ * 2 / 16];
    if (d0 == 0) { p0 = __builtin_amdgcn_mfma_f32_32x32x16_bf16(b0, qr[0], negm, 0, 0, 0); p1 = __builtin_amdgcn_mfma_f32_32x32x16_bf16(b1, qr[0], negm, 0, 0, 0); }
    else { p0 = __builtin_amdgcn_mfma_f32_32x32x16_bf16(b0, qr[d0], p0, 0, 0, 0); p1 = __builtin_amdgcn_mfma_f32_32x32x16_bf16(b1, qr[d0], p1, 0, 0, 0); } }
}
__device__ __forceinline__ int v_st(int k, int c) { const int kk = (k & ~0xC) | ((k & 4) << 1) | ((k & 8) >> 1); return ((kk >> 3) * 4 + (c >> 5)) * 512 + ((kk & 7) * 32 + (c & 31)) * 2; }
__device__ __forceinline__ int v_rd_base(int lane) { return ((lane & 3) << 3) | (((lane >> 2) & 3) << 6) | (((lane >> 4) & 1) << 5) | (((lane >> 5) & 1) << 8); }
constexpr int v_rd_off(int d0, int ks, int half) { return d0 * 512 + ks * 4096 + half * 2048; }
template <int OFF> __device__ __forceinline__ s16x4 tr_read(int vb) {
  s16x4 r; asm volatile("ds_read_b64_tr_b16 %0, %1 offset:%2" : "=&v"(r) : "v"(vb), "i"(OFF) : "memory"); return r;
}
template <int D0> __device__ __forceinline__ void pv_one(f32x16& od, int vb, bf16x8 pa0, bf16x8 pa1, bf16x8 pa2, bf16x8 pa3) {
  const s16x4 l0 = tr_read<v_rd_off(D0, 0, 0)>(vb), h0 = tr_read<v_rd_off(D0, 0, 1)>(vb), l1 = tr_read<v_rd_off(D0, 1, 0)>(vb), h1 = tr_read<v_rd_off(D0, 1, 1)>(vb);
  const s16x4 l2 = tr_read<v_rd_off(D0, 2, 0)>(vb), h2 = tr_read<v_rd_off(D0, 2, 1)>(vb), l3 = tr_read<v_rd_off(D0, 3, 0)>(vb), h3 = tr_read<v_rd_off(D0, 3, 1)>(vb);
  asm volatile("s_waitcnt lgkmcnt(0)" ::: "memory"); SBAR();
#define PK(L, H) (bf16x8){L[0], L[1], L[2], L[3], H[0], H[1], H[2], H[3]}
  od = __builtin_amdgcn_mfma_f32_32x32x16_bf16(pa0, PK(l0, h0), od, 0, 0, 0);
  od = __builtin_amdgcn_mfma_f32_32x32x16_bf16(pa1, PK(l1, h1), od, 0, 0, 0);
  od = __builtin_amdgcn_mfma_f32_32x32x16_bf16(pa2, PK(l2, h2), od, 0, 0, 0);
  od = __builtin_amdgcn_mfma_f32_32x32x16_bf16(pa3, PK(l3, h3), od, 0, 0, 0);
#undef PK
}
__device__ __forceinline__ void pv_d0(f32x16* o, int vb, bf16x8 pa0, bf16x8 pa1, bf16x8 pa2, bf16x8 pa3) {
  pv_one<0>(o[0], vb, pa0, pa1, pa2, pa3); pv_one<1>(o[1], vb, pa0, pa1, pa2, pa3); pv_one<2>(o[2], vb, pa0, pa1, pa2, pa3); pv_one<3>(o[3], vb, pa0, pa1, pa2, pa3);
}
template <int MODE> __device__ __forceinline__ void maskf(f32x16& p0, f32x16& p1, int t, const Args& a, int wid, int r32, int hi, const float* bias_lds) {
  if constexpr (MODE == 0) { return; }
  else {
    if (t < a.nctx) return;
    if constexpr (MODE == 1) {
      const int kb = a.kpos0 + (t - a.nctx) * 64, qw = a.qpos0 + wid * 32;
      if (kb + 63 - qw <= 128 && qw + 31 - kb <= 128) return;
      int base = kb + 4 * hi - (qw + r32);
      asm volatile("" : "+v"(base));
#pragma unroll
      for (int r = 0; r < 16; ++r) { const int d0 = base + (r & 3) + 8 * (r >> 2);
        if ((unsigned)(d0 + 128) > 256u) p0[r] = -1e30f;
        if ((unsigned)(d0 + 160) > 256u) p1[r] = -1e30f; }
    } else {
      const int kr = a.klo + (t - a.nctx), rq = a.r0 + (wid >> 1);
      const int rs = min(max(rq - 4, 0), 120);
      if (kr < rs || kr >= rs + 8) {
#pragma unroll
        for (int r = 0; r < 16; ++r) { p0[r] = -1e30f; p1[r] = -1e30f; }
        return; }
      const int c = (wid & 1) * 32 + r32, cs = min(max(c - 8, 0), 48);
      int cb = 4 * hi - c + 63, vb = 4 * hi - cs;
      asm volatile("" : "+v"(cb), "+v"(vb));
      const float* bp = bias_lds + (kr - rq + 7) * 128 + cb;
#pragma unroll
      for (int r = 0; r < 16; ++r) { const int k0 = (r & 3) + 8 * (r >> 2), k1 = k0 + 32;
        const float b0 = bp[k0], b1 = bp[k1];
        p0[r] = ((unsigned)(k0 + vb) < 16u) ? fmaf(b0, a.inv_scale, p0[r]) : -1e30f;
        p1[r] = ((unsigned)(k1 + vb) < 16u) ? fmaf(b1, a.inv_scale, p1[r]) : -1e30f;
        if ((r & 3) == 3) SBAR(); }
    }
  }
}

template <int DQ, int MODE>
__device__ __forceinline__ void attn_unit(const Args& a, char* lds, const int wave0) {
  constexpr int SHM_K = KVBLK * DQ * 2, NQ = DQ / 16, OFF_K = 3 * SHM_V, OFF_WS = OFF_K + 2 * SHM_K;
  const int tid = fresh_tid(wave0), wid = tid >> 6, lane = tid & 63, r32 = lane & 31, hi = lane >> 5;
  char* V_lds = lds; char* K_lds = lds + OFF_K;
  float* ws = (float*)(lds + OFF_WS) + wid * 64; float* li_l = ws; float* al_l = ws + 32;
  float* bias_l = (float*)(lds + OFF_WS + 2048);
  if constexpr (MODE == 2) { if (tid < 465) bias_l[(tid / 31) * 128 + 48 + (tid % 31)] = a.rpb[tid]; }
  float m_reg = 0.f, l_reg = 0; f32x16 o[4] = {}; bf16x8 qr[NQ];
  const float thr = a.thr_raw;
  const bf16* Qw = a.Q + (long)(wid * QBLK + r32) * a.ldq + hi * 8;
#pragma unroll
  for (int d0 = 0; d0 < NQ; ++d0) qr[d0] = *reinterpret_cast<const bf16x8*>(Qw + d0 * 16);
  if constexpr (DQ == 128) {
    if (a.qgain) { float xf[8][8]; float ss = 0.f;
#pragma unroll
      for (int d0 = 0; d0 < 8; ++d0)
#pragma unroll
        for (int e = 0; e < 8; ++e) { xf[d0][e] = __uint_as_float(((unsigned)(unsigned short)qr[d0][e]) << 16); ss += xf[d0][e] * xf[d0][e]; }
      { auto rr = __builtin_amdgcn_permlane32_swap(__float_as_uint(ss), __float_as_uint(ss), false, false); ss = __uint_as_float(rr[0]) + __uint_as_float(rr[1]); }
      const float rstd = rsqrtf(ss * (1.0f / 128.0f) + 1e-6f) * a.C;
#pragma unroll
      for (int d0 = 0; d0 < 8; ++d0) { const float* gp = a.qgain + d0 * 16 + hi * 8;
#pragma unroll
        for (int e = 0; e < 8; ++e) xf[d0][e] = xf[d0][e] * rstd * gp[e]; }
      if (a.qrope_t0 >= 0) { const int t = a.qrope_t0 + wid * QBLK + r32; const float prow = (float)(t >> 6), pcol = (float)(t & 63);
#pragma unroll
        for (int half = 0; half < 2; ++half)
#pragma unroll
          for (int blk = 0; blk < 2; ++blk)
#pragma unroll
            for (int e = 0; e < 8; ++e) { const int j = blk * 16 + hi * 8 + e, da = 4 * half + blk, db = da + 2;
              const float inv_freq = __builtin_amdgcn_exp2f(-(float)j * (13.287712379549449f / 32.0f)); float rev = (half ? pcol : prow) * inv_freq * 0.15915494309189535f; rev -= rintf(rev);
              const float sn = __builtin_amdgcn_sinf(rev), cs = __builtin_amdgcn_cosf(rev);
              const float x = xf[da][e], y = xf[db][e]; xf[da][e] = x * cs - y * sn; xf[db][e] = y * cs + x * sn; } }
#pragma unroll
      for (int d0 = 0; d0 < 8; ++d0) { bf16x8 w;
#pragma unroll
        for (int e = 0; e < 8; ++e) { unsigned u = __float_as_uint(xf[d0][e]); u = (u + 0x7fffu + ((u >> 16) & 1u)) >> 16; w[e] = (short)u; }
        qr[d0] = w; } } }
  if constexpr (DQ == 192) {
    if (a.qrope_t0 >= 0) { const int t = a.qrope_t0 + wid * QBLK + r32; const float prow = (float)(t >> 6), pcol = (float)(t & 63);
#pragma unroll
      for (int half = 0; half < 2; ++half) { bf16x8 xa = qr[8 + 2 * half], xb = qr[9 + 2 * half]; const float pos = half ? pcol : prow;
#pragma unroll
        for (int e = 0; e < 8; ++e) { const int j = hi * 8 + e;
          const float inv_freq = __builtin_amdgcn_exp2f(-(float)j * (13.287712379549449f / 16.0f)); float rev = pos * inv_freq * 0.15915494309189535f; rev -= rintf(rev);
          const float sn = __builtin_amdgcn_sinf(rev), cs = __builtin_amdgcn_cosf(rev);
          const float x = __uint_as_float(((unsigned)(unsigned short)xa[e]) << 16), y = __uint_as_float(((unsigned)(unsigned short)xb[e]) << 16);
          const float nx = x * cs - y * sn, ny = y * cs + x * sn; unsigned ux = __float_as_uint(nx), uy = __float_as_uint(ny);
          ux = (ux + 0x7fffu + ((ux >> 16) & 1u)) >> 16; uy = (uy + 0x7fffu + ((uy >> 16) & 1u)) >> 16; xa[e] = (short)ux; xb[e] = (short)uy; }
        qr[8 + 2 * half] = xa; qr[9 + 2 * half] = xb; } } }
  const int vb0 = (int)(uintptr_t)V_lds + v_rd_base(lane);
  int kx[4];
#pragma unroll
  for (int q = 0; q < 4; ++q) kx[q] = (int)(uintptr_t)K_lds + r32 * (DQ * 2) + ((q * 32 + hi * 16) ^ ((r32 & 7) << 4));
  constexpr int KP = DQ / 64;
  int koff[KP]; bool kk2[KP]; int voff[2];
#pragma unroll
  for (int i = 0; i < KP; ++i) { const int q = (wid * KP + i) * 64 + lane, row = q / (DQ / 8), cs = q % (DQ / 8), c = cs ^ (row & 7);
    kk2[i] = (DQ == 192) && c >= 16; koff[i] = kk2[i] ? row * a.ldk2 + (c - 16) * 8 : row * a.ldk + c * 8; }
#pragma unroll
  for (int i = 0; i < 2; ++i) { const int q = (wid * 2 + i) * 64 + lane, sub = q >> 5, within = q & 31, kk = (sub >> 2) * 8 + (within >> 2), c = (sub & 3) * 32 + (within & 3) * 8;
    const int k = kk; voff[i] = k * a.ldv + c; }
  const unsigned kdst0 = (unsigned)(uintptr_t)K_lds + (unsigned)(wid * KP) * 1024u, vdst0 = (unsigned)(uintptr_t)V_lds + (unsigned)(wid * 2) * 1024u;
#define KROW(t) ((t) < a.nctx ? a.ctx_row0 + 64 * (t) : a.lat_row0 + 64 * ((t) - a.nctx))
#define GLDS16(gsrc, ldst) do { unsigned keep_; asm volatile("s_mov_b32 %0, m0\n\ts_mov_b32 m0, %2\n\ts_nop 0\n\tglobal_load_lds_dwordx4 %1, off\n\ts_mov_b32 m0, %0" : "=&s"(keep_) : "v"(gsrc), "s"(ldst) : "memory"); } while (0)
#define DMA(t) do { const long kr_ = KROW(t); const unsigned kd_ = (unsigned)__builtin_amdgcn_readfirstlane((int)(kdst0 + (unsigned)(((t) & 1) * SHM_K))), vd_ = (unsigned)__builtin_amdgcn_readfirstlane((int)(vdst0 + (unsigned)(((t) % 3) * SHM_V))); \
    const bf16* vp_ = a.V + kr_ * a.ldv; const bf16* kp_ = a.K + kr_ * a.ldk; const bf16* kp2_ = (DQ == 192) ? a.K2 + kr_ * a.ldk2 : kp_; \
    _Pragma("unroll") for (int i_ = 0; i_ < KP; ++i_) { const bf16* g_ = ((DQ == 192) && kk2[i_] ? kp2_ : kp_) + koff[i_]; GLDS16(g_, kd_ + (unsigned)i_ * 1024u); } \
    _Pragma("unroll") for (int i_ = 0; i_ < 2; ++i_) GLDS16(vp_ + voff[i_], vd_ + (unsigned)i_ * 1024u); } while (0)
#define WAIT_BAR() asm volatile("s_waitcnt vmcnt(0) lgkmcnt(0)\n\ts_barrier" ::: "memory")
#define RESC(al) do { if (__any((al) < 1.f)) { if (hi == 0) al_l[r32] = (al); asm volatile("s_waitcnt lgkmcnt(0)" ::: "memory"); \
    _Pragma("unroll") for (int d = 0; d < 4; ++d) _Pragma("unroll") for (int r = 0; r < 16; ++r) o[d][r] *= al_l[crow(r, hi)]; } } while (0)
  f32x16 pA0, pA1, pB0, pB1; float mnA, mnB, alA, alB; bf16x8 pa0, pa1, pa2, pa3; const int NT = a.NT;
#define STEP(j, PN0, PN1, MNN, ALN, PP0, PP1, ALP) do { const int j_ = (j); \
    WAIT_BAR();                            \
    if (j_ + 1 < NT) DMA(j_ + 1);          \
    SBAR(); qkt<DQ>(PN0, PN1, kx, (j_ & 1) * SHM_K, qr, negm); maskf<MODE>(PN0, PN1, j_, a, wid, r32, hi, bias_l); \
    finishSM(PP0, PP1, ALP, l_reg, pa0, pa1, pa2, pa3); SBAR(); \
    pv_d0(o, vb0 + ((j_ - 1) % 3) * SHM_V, pa0, pa1, pa2, pa3); partialSM<false>(PN0, PN1, m_reg, ALN, negm, thr); \
    RESC(ALN); } while (0)
  DMA(0); DMA(1);
  f32x16 negm = f32x16{}; asm volatile("" : "+v"(negm));
  WAIT_BAR();
  qkt<DQ>(pA0, pA1, kx, 0, qr, negm); maskf<MODE>(pA0, pA1, 0, a, wid, r32, hi, bias_l); partialSM<true>(pA0, pA1, m_reg, alA, negm, thr);
  for (int j = 1; j + 1 < NT; j += 2) {
    STEP(j, pB0, pB1, mnB, alB, pA0, pA1, alA);
    STEP(j + 1, pA0, pA1, mnA, alA, pB0, pB1, alB);
  }
  STEP(NT - 1, pB0, pB1, mnB, alB, pA0, pA1, alA);
  finishSM(pB0, pB1, alB, l_reg, pa0, pa1, pa2, pa3); SBAR();
  pv_d0(o, vb0 + ((NT - 1) % 3) * SHM_V, pa0, pa1, pa2, pa3);
  if constexpr (MODE == 1) l_reg += __builtin_amdgcn_exp2f(a.sink_l2 - m_reg);
  if (hi == 0) li_l[r32] = l_reg; asm volatile("s_waitcnt lgkmcnt(0)" ::: "memory");
  float rli[16];
#pragma unroll
  for (int r = 0; r < 16; ++r) rli[r] = __builtin_amdgcn_rcpf(li_l[crow(r, hi)]);
  asm volatile("s_waitcnt lgkmcnt(0)\n\ts_barrier" ::: "memory");
  { bf16* stg = (bf16*)(lds + wid * 8704);
#pragma unroll
    for (int r = 0; r < 16; ++r) { const int orow = crow(r, hi);
#pragma unroll
      for (int d0 = 0; d0 < 4; ++d0) { const float v = o[d0][r] * rli[r]; unsigned u = __float_as_uint(v); u = (u + 0x7fffu + ((u >> 16) & 1u)) >> 16; stg[orow * 136 + d0 * 32 + r32] = (bf16)u; } }
    asm volatile("s_waitcnt lgkmcnt(0)" ::: "memory");
    bf16* Ow = a.O + (long)(wid * QBLK) * a.ldo;
#pragma unroll
    for (int i = 0; i < 8; ++i) { const int row = i * 4 + (lane >> 4), ch = lane & 15; const u32x4 v = *(const u32x4*)(stg + row * 136 + ch * 8); *(u32x4*)(Ow + (long)row * a.ldo + ch * 8) = v; } }
  asm volatile("s_waitcnt lgkmcnt(0)\n\ts_barrier" ::: "memory");
#undef KROW
#undef GLDS16
#undef DMA
#undef WAIT_BAR
#undef RESC
#undef STEP
}
#undef SBAR
}
#define LAS __attribute__((address_space(3)))
typedef unsigned short bf16;
typedef float f32x4 __attribute__((ext_vector_type(4)));
typedef unsigned v4u __attribute__((ext_vector_type(4)));
typedef unsigned v2u __attribute__((ext_vector_type(2)));
constexpr int NWAVES = 8, NTHR = 512;
constexpr int DM = 2048, SEQ = 8192, NCTX = 256, MLAT = 2 * SEQ, MALL = MLAT + 2 * NCTX, DFF = 5632;
constexpr int N_IN0 = 2816, N_IN1 = 4608, N_UQ = 1536, N_UKV = 2048, N_GU = 2 * DFF;
constexpr float EPS = 1e-6f;
constexpr size_t MiB = 1u << 20;
constexpr size_t WS_MOD = 0, WS_BAR = 512 * 1024, BAR_BYTES = 16384;
constexpr size_t WS_WIN0 = 1 * MiB, WS_WUQ = WS_WIN0 + 11 * MiB, WS_WUKV = WS_WUQ + 2 * MiB, WS_WOUT0 = WS_WUKV + 2 * MiB, WS_WIN1 = WS_WOUT0 + 8 * MiB, WS_WOUT1 = WS_WIN1 + 18 * MiB,
                 WS_WGU = WS_WOUT1 + 8 * MiB, WS_WD = WS_WGU + 88 * MiB, WS_HCTX = WS_WD + 44 * MiB;
constexpr size_t WS_UO = WS_HCTX + 4 * MiB;
constexpr size_t WS_OB = WS_UO + 66 * MiB;
constexpr size_t WS_BIG = WS_UO + 132 * MiB;
constexpr size_t WS_QB = WS_BIG + 91 * MiB, WS_KVB = WS_BIG + 141 * MiB, WS_UB = WS_BIG + 149 * MiB, WS_FP = WS_BIG + 215 * MiB, WS_END = WS_FP + 16 * MiB;
static_assert((size_t)MALL * DM * 2 == 66 * MiB && (size_t)MALL * N_IN0 * 2 <= 91 * MiB && (size_t)MALL * N_UQ * 2 <= 50 * MiB && (size_t)MALL * N_IN1 * 2 <= 149 * MiB && (size_t)MALL * DFF * 2 <= 215 * MiB, "ws map");

__device__ __forceinline__ unsigned f2bf(float f) { unsigned u = __builtin_bit_cast(unsigned, f); return (u + 0x7fffu + ((u >> 16) & 1u)) >> 16; }
__device__ __forceinline__ unsigned pk2(float lo, float hi) { return f2bf(lo) | (f2bf(hi) << 16); }
__device__ __forceinline__ float bf2f(bf16 v) { return __uint_as_float(((unsigned)v) << 16); }
__device__ __forceinline__ float wave_sum(float v, int lane) {
#pragma unroll
    for (int o = 1; o < 64; o <<= 1) v += __int_as_float(__builtin_amdgcn_ds_bpermute((lane ^ o) << 2, __float_as_int(v)));
    return v;
}
__device__ __forceinline__ float silu_f(float x) { return x / (1.0f + __expf(-x)); }

#define GAS __attribute__((address_space(1)))
#define XB_TMO      128
#define XB_XCNT(j)  (256  + 64 * (j))
#define XB_XSUB(j)  (1280 + 64 * (j))
#define XB_XGEN(j)  (2304 + 64 * (j))
#define XB_TOP      3328
#define XB_TOPGEN   3392
#define XCD_BAR_WORDS 3456
#define XB_SPIN_CAP (1u << 18)

__device__ __forceinline__ unsigned xb_ld(unsigned* p)              { return __hip_atomic_load(p, __ATOMIC_RELAXED, __HIP_MEMORY_SCOPE_AGENT); }
__device__ __forceinline__ unsigned xb_add(unsigned* p, unsigned v) { return __hip_atomic_fetch_add(p, v, __ATOMIC_RELAXED, __HIP_MEMORY_SCOPE_AGENT); }
__device__ __forceinline__ unsigned xb_xcc_id() { return (unsigned)__builtin_amdgcn_s_getreg((3 << 11) | 20) & 0xFu; }
#define XB_SPIN(cond, bar) do { unsigned _sp = 0; while (cond) { __builtin_amdgcn_s_sleep(1); \
    if ((++_sp & 255u) == 0u) { if (xb_ld(&(bar)[XB_TMO])) break; if (_sp > XB_SPIN_CAP) { atomicAdd(&(bar)[XB_TMO], 1u); break; } } } } while (0)

struct XcdBarrier {
    unsigned* bar; unsigned x;
    volatile LAS unsigned* st;
};

__device__ __forceinline__ XcdBarrier xcd_barrier_post(unsigned* bar, volatile LAS unsigned* st) {
    XcdBarrier b; b.bar = bar; b.x = xb_xcc_id(); b.st = st;
    if (threadIdx.x == 0) (void)xb_add(&bar[XB_XCNT(b.x)], 1u);
    return b;
}
__device__ __forceinline__ void xcd_barrier_complete(unsigned* bar, unsigned x, unsigned& nloc, unsigned& nx) {
    const unsigned G = gridDim.x * gridDim.y * gridDim.z;
    unsigned sum, cnt, mine, sp = 0u;
    for (;;) {
        sum = 0u; cnt = 0u; mine = 0u;
#pragma unroll
        for (unsigned j = 0; j < 16; ++j) { const unsigned c = xb_ld(&bar[XB_XCNT(j)]); sum += c; cnt += (c > 0u) ? 1u : 0u; mine = (j == x) ? c : mine; }
        if (sum == G) break;
        __builtin_amdgcn_s_sleep(1);
        if ((++sp & 255u) == 0u) { if (xb_ld(&bar[XB_TMO])) break; if (sp > XB_SPIN_CAP) { atomicAdd(&bar[XB_TMO], 1u); break; } }
    }
    nloc = mine > 0u ? mine : 1u; nx = cnt > 0u ? cnt : 1u;
}

__device__ __forceinline__ void xcd_barrier(const XcdBarrier& b) {
    asm volatile("s_waitcnt vmcnt(0)" ::: "memory");
    __syncthreads();
    if (threadIdx.x == 0) {
        unsigned* bar = b.bar;
        __builtin_amdgcn_s_waitcnt(0);
        unsigned nloc = b.st[0], nx = b.st[1];
        if (nloc == 0u) { xcd_barrier_complete(bar, b.x, nloc, nx); b.st[0] = nloc; b.st[1] = nx; }
        const unsigned old = xb_add(&bar[XB_XSUB(b.x)], 1u);
        const unsigned gen = old / nloc;
        if (old + 1u == (gen + 1u) * nloc) {
            __builtin_amdgcn_fence(__ATOMIC_RELEASE, "agent");
            asm volatile("s_waitcnt vmcnt(0)" ::: "memory");
            const unsigned og = xb_add(&bar[XB_TOP], 1u);
            const unsigned tg = og / nx;
            if (og + 1u == (tg + 1u) * nx) xb_add(&bar[XB_TOPGEN], 1u);
            else XB_SPIN(xb_ld(&bar[XB_TOPGEN]) == tg, bar);
            __builtin_amdgcn_fence(__ATOMIC_ACQUIRE, "agent");
            xb_add(&bar[XB_XGEN(b.x)], 1u);
            asm volatile("s_waitcnt vmcnt(0)" ::: "memory");
        } else {
            XB_SPIN(xb_ld(&bar[XB_XGEN(b.x)]) == gen, bar);
            __builtin_amdgcn_fence(__ATOMIC_ACQUIRE, "agent");
            asm volatile("s_waitcnt vmcnt(0)" ::: "memory");
        }
    }
    __syncthreads();
}

struct KArgs { const float* in[29]; float* out; unsigned char* ws; };
typedef const __attribute__((address_space(4))) KArgs* KAP;
__device__ __forceinline__ KAP kargs() { KAP p = (KAP)__builtin_amdgcn_kernarg_segment_ptr(); asm volatile("" : "+s"(p)); return p; }

__device__ __forceinline__ void transpose_item(const float* W, int K, int N, bf16* WT, int k0, int n0, int drow0, LAS float* scr, int lane, const float wsc) {
#pragma unroll 8
    for (int i = 0; i < 32; ++i) { const int kk = 2 * i + (lane >> 5); scr[kk * 33 + (lane & 31)] = __builtin_nontemporal_load(W + (size_t)(k0 + kk) * N + n0 + (lane & 31)) * wsc; }
    asm volatile("s_waitcnt lgkmcnt(0)" ::: "memory");
    const int c = lane & 7;
#pragma unroll
    for (int j = 0; j < 4; ++j) { const int n = (lane >> 3) + 8 * j; const LAS float* s = scr + (8 * c) * 33 + n;
        v4u o; o.x = pk2(s[0 * 33], s[1 * 33]); o.y = pk2(s[2 * 33], s[3 * 33]); o.z = pk2(s[4 * 33], s[5 * 33]); o.w = pk2(s[6 * 33], s[7 * 33]);
        *(v4u*)(WT + (size_t)(drow0 + n) * K + k0 + 8 * c) = o; }
    asm volatile("s_waitcnt lgkmcnt(0)" ::: "memory");
}
__device__ __forceinline__ bool conv_matrix(int& it, const float* W, int K, int N, bf16* WT, int mode, LAS float* scr, int lane, const float wsc = 1.0f) {
    const int nblk = N / 32, items = (K / 64) * nblk;
    if (it >= items) { it -= items; return false; }
    const int kb = it / nblk, nb = it % nblk, n0 = 32 * nb;
    const int drow0 = mode == 0 ? n0 : ((n0 >> 7) * 256 + (mode == 2 ? 128 : 0) + (n0 & 127));
    transpose_item(W, K, N, WT, 64 * kb, n0, drow0, scr, lane, wsc);
    return true;
}
__device__ __forceinline__ void p0_weights(KAP a, LAS unsigned char* lds, int gw, int NGW, int wave, int lane) {
    LAS float* scr = (LAS float*)(lds + wave * 8704);
    unsigned char* ws = a->ws;
    constexpr int I_TOTAL = (2048 / 64) * (2624 / 32) + (512 / 64) * (1536 / 32) + (512 / 64) * (2048 / 32) + 2 * (2048 / 64) * (2048 / 32) + (2048 / 64) * (4608 / 32)
                          + 4 * (2048 / 64) * (DFF / 32) + 2 * (DFF / 64) * (2048 / 32);
    for (int item = gw; item < I_TOTAL; item += NGW) {
        int it = item;
        if (conv_matrix(it, a->in[13], 2048, 2624, (bf16*)(ws + WS_WIN0), 0, scr, lane)) continue;
        if (conv_matrix(it, a->in[19], 512, 1536, (bf16*)(ws + WS_WUQ), 0, scr, lane, 0.07216878364870322f * 1.4426950408889634f)) continue;
        if (conv_matrix(it, a->in[20], 512, 2048, (bf16*)(ws + WS_WUKV), 0, scr, lane)) continue;
        if (conv_matrix(it, a->in[14], 2048, 2048, (bf16*)(ws + WS_WOUT0), 0, scr, lane)) continue;
        if (conv_matrix(it, a->in[21], 2048, 4608, (bf16*)(ws + WS_WIN1), 0, scr, lane)) continue;
        if (conv_matrix(it, a->in[22], 2048, 2048, (bf16*)(ws + WS_WOUT1), 0, scr, lane)) continue;
        if (conv_matrix(it, a->in[10], 2048, DFF, (bf16*)(ws + WS_WGU), 1, scr, lane)) continue;
        if (conv_matrix(it, a->in[10] + (size_t)2048 * DFF, 2048, DFF, (bf16*)(ws + WS_WGU + 44 * MiB), 1, scr, lane)) continue;
        if (conv_matrix(it, a->in[11], 2048, DFF, (bf16*)(ws + WS_WGU), 2, scr, lane)) continue;
        if (conv_matrix(it, a->in[11] + (size_t)2048 * DFF, 2048, DFF, (bf16*)(ws + WS_WGU + 44 * MiB), 2, scr, lane)) continue;
        if (conv_matrix(it, a->in[12], DFF, 2048, (bf16*)(ws + WS_WD), 0, scr, lane)) continue;
        conv_matrix(it, a->in[12] + (size_t)2048 * DFF, DFF, 2048, (bf16*)(ws + WS_WD + 22 * MiB), 0, scr, lane);
    }
}
__device__ __forceinline__ void p0_mod(KAP a, LAS unsigned char* lds, int tid) {
    LAS float* sv = (LAS float*)lds;
    LAS float* red = (LAS float*)(lds + 24576);
    const int blk = blockIdx.x; if (blk >= 256) return;
    const int layer = blk >> 7, col0 = (blk & 127) * 96;
    for (int i = tid; i < 3 * 2048; i += NTHR) { const int v = i >> 11, k = i & 2047; const float x = v < 2 ? a->in[1][v * 2048 + k] : a->in[3][k]; sv[i] = silu_f(x); }
    __syncthreads();
    const int c4 = tid % 24, ks = tid / 24;
    if (ks < 21) {
        const float* W = a->in[4] + (size_t)layer * 2048 * 12288 + col0 + 4 * c4;
        f32x4 a0 = {0, 0, 0, 0}, a1 = a0, a2 = a0;
#pragma unroll 8
        for (int k = ks; k < 2048; k += 21) { const f32x4 w = __builtin_nontemporal_load((const f32x4*)(W + (size_t)k * 12288)); a0 += w * sv[k]; a1 += w * sv[2048 + k]; a2 += w * sv[4096 + k]; }
        LAS float* r = red + ks * 288 + 4 * c4;
        *(LAS f32x4*)(r) = a0; *(LAS f32x4*)(r + 96) = a1; *(LAS f32x4*)(r + 192) = a2;
    }
    __syncthreads();
    if (tid < 288) { float s = 0.f;
        for (int q = 0; q < 21; ++q) s += red[q * 288 + tid];
        const int v = tid / 96, j = tid % 96;
        ((float*)(a->ws + WS_MOD))[(size_t)(layer * 3 + v) * 12288 + col0 + j] = s + a->in[5][layer * 12288 + col0 + j]; }
    __syncthreads();
}
__device__ __forceinline__ void store_u(bf16* urow, int lane, const f32x4 (&v)[8], float rstd, const float* g, const float* sh, const float* sc) {
#pragma unroll
    for (int j = 0; j < 8; ++j) { const int ci = 256 * j + 4 * lane; const f32x4 g4 = *(const f32x4*)(g + ci), s4 = *(const f32x4*)(sc + ci), h4 = *(const f32x4*)(sh + ci);
        const f32x4 t = (v[j] * rstd * g4) * (1.0f + s4) + h4; v2u w; w.x = pk2(t[0], t[1]); w.y = pk2(t[2], t[3]); *(v2u*)(urow + ci) = w; }
}
__device__ __forceinline__ void pass_pre(const float* hlat, const float* hctx, const float* g, const float* mod, int sh_off, int sc_off, bf16* U, int nrows, int gw, int NGW, int lane) {
    for (int m0 = gw; m0 < nrows; m0 += 2 * NGW) {
        int mr[2]; mr[0] = m0; mr[1] = m0 + NGW; const bool two = mr[1] < nrows; if (!two) mr[1] = m0;
        f32x4 v[2][8]; float ss[2];
#pragma unroll
        for (int r = 0; r < 2; ++r) { const int m = mr[r]; const float* src = m < MLAT ? hlat + (size_t)m * DM : hctx + (size_t)(m - MLAT) * DM;
#pragma unroll
            for (int j = 0; j < 8; ++j) v[r][j] = *(const f32x4*)(src + 256 * j + 4 * lane); }
#pragma unroll
        for (int r = 0; r < 2; ++r) { ss[r] = 0.f;
#pragma unroll
            for (int j = 0; j < 8; ++j) ss[r] += (v[r][j][0] * v[r][j][0] + v[r][j][1] * v[r][j][1]) + (v[r][j][2] * v[r][j][2] + v[r][j][3] * v[r][j][3]); }
#pragma unroll
        for (int r = 0; r < 2; ++r) { if (r == 1 && !two) break; const int m = mr[r]; const float* mv = mod + (m < MLAT ? (m >> 13) : 2) * 12288;
            const float rstd = rsqrtf(wave_sum(ss[r], lane) * (1.0f / DM) + EPS);
            store_u(U + (size_t)m * DM, lane, v[r], rstd, g, mv + sh_off, mv + sc_off); }
    }
}
__device__ __forceinline__ void pass_post(const bf16* o16, const float* opart, const float* hlat, const float* hctx, const bf16* h16in, float* olat, float* octx, bf16* h16out, const float* gpost, const float* mod, int gt_off,
                                          const float* gpre, const float* modu, int sh_off, int sc_off, bf16* U, int nrows, int gw, int NGW, int lane) {
    for (int m0 = gw; m0 < nrows; m0 += 2 * NGW) {
        int mr[2]; mr[0] = m0; mr[1] = m0 + NGW; const bool two = mr[1] < nrows; if (!two) mr[1] = m0;
        f32x4 v[2][8], hh[2][8]; float ss[2];
#pragma unroll
        for (int r = 0; r < 2; ++r) { const int m = mr[r]; ss[r] = 0.f;
            const float* hs = m < MLAT ? hlat + (size_t)m * DM : hctx + (size_t)(m - MLAT) * DM;
            if (m < MLAT) { const bf16* orow = o16 + (size_t)m * DM;
#pragma unroll
                for (int j = 0; j < 8; ++j) { const v2u raw = *(const v2u*)(orow + 256 * j + 4 * lane);
                    v[r][j] = (f32x4){__uint_as_float(raw.x << 16), __uint_as_float(raw.x & 0xffff0000u), __uint_as_float(raw.y << 16), __uint_as_float(raw.y & 0xffff0000u)}; }
            } else { const float* orow = opart + (size_t)(m - MLAT) * DM;
#pragma unroll
                for (int j = 0; j < 8; ++j) { const int ci = 256 * j + 4 * lane;
                    v[r][j] = (*(const f32x4*)(orow + ci) + *(const f32x4*)(orow + ci + (size_t)512 * DM)) + (*(const f32x4*)(orow + ci + (size_t)1024 * DM) + *(const f32x4*)(orow + ci + (size_t)1536 * DM)); } }
            if (h16in) { const bf16* hrow = h16in + (size_t)m * DM;
#pragma unroll
                for (int j = 0; j < 8; ++j) { const v2u raw = *(const v2u*)(hrow + 256 * j + 4 * lane);
                    hh[r][j] = (f32x4){__uint_as_float(raw.x << 16), __uint_as_float(raw.x & 0xffff0000u), __uint_as_float(raw.y << 16), __uint_as_float(raw.y & 0xffff0000u)}; }
            } else {
#pragma unroll
                for (int j = 0; j < 8; ++j) hh[r][j] = *(const f32x4*)(hs + 256 * j + 4 * lane); }
        }
#pragma unroll
        for (int r = 0; r < 2; ++r)
#pragma unroll
            for (int j = 0; j < 8; ++j) ss[r] += (v[r][j][0] * v[r][j][0] + v[r][j][1] * v[r][j][1]) + (v[r][j][2] * v[r][j][2] + v[r][j][3] * v[r][j][3]);
#pragma unroll
        for (int r = 0; r < 2; ++r) { const int m = mr[r]; if (r == 1 && !two) break;
            float* hd = m < MLAT ? olat + (size_t)m * DM : octx + (size_t)(m - MLAT) * DM; const int vi = (m < MLAT ? (m >> 13) : 2); const float* mv = mod + vi * 12288;
            const float rstd = rsqrtf(wave_sum(ss[r], lane) * (1.0f / DM) + EPS); float s2 = 0.f;
#pragma unroll
            for (int j = 0; j < 8; ++j) { const int ci = 256 * j + 4 * lane; const f32x4 g4 = *(const f32x4*)(gpost + ci), t4 = *(const f32x4*)(mv + gt_off + ci);
                const f32x4 nv = hh[r][j] + t4 * (v[r][j] * rstd * g4); v[r][j] = nv;
                if (h16out) { v2u w; w.x = pk2(nv[0], nv[1]); w.y = pk2(nv[2], nv[3]); *(v2u*)(h16out + (size_t)m * DM + ci) = w; } else *(f32x4*)(hd + ci) = nv;
                s2 += (nv[0] * nv[0] + nv[1] * nv[1]) + (nv[2] * nv[2] + nv[3] * nv[3]); }
            if (U) { const float* mu = modu + vi * 12288; const float rstd2 = rsqrtf(wave_sum(s2, lane) * (1.0f / DM) + EPS); store_u(U + (size_t)m * DM, lane, v[r], rstd2, gpre, mu + sh_off, mu + sc_off); }
        }
    }
}
__device__ __forceinline__ void rope_cs(float pos, int j, float inv_nf, float& cs, float& sn) {
    const float inv_freq = __builtin_amdgcn_exp2f(-(float)j * inv_nf * 13.287712379549449f);
    float rev = pos * inv_freq * 0.15915494309189535f; rev -= rintf(rev);
    sn = __builtin_amdgcn_sinf(rev); cs = __builtin_amdgcn_cosf(rev);
}
template <int NH> __device__ __forceinline__ void heads_load(const bf16* base, int ia, float (&x)[NH], float (&y)[NH]) {
#pragma unroll
    for (int h = 0; h < NH; ++h) { x[h] = bf2f(base[h * 128 + ia]); y[h] = bf2f(base[h * 128 + ia + 32]); }
}
template <int NH> __device__ __forceinline__ void heads_finish(bf16* base, int ia, float (&x)[NH], float (&y)[NH], const float* gain, bool rope, float cs, float sn, int lane) {
    const float ga = gain[ia], gb = gain[ia + 32];
#pragma unroll
    for (int h = 0; h < NH; ++h) {
        const float rstd = rsqrtf(wave_sum(x[h] * x[h] + y[h] * y[h], lane) * (1.0f / 128.0f) + EPS);
        float a = x[h] * rstd * ga, b = y[h] * rstd * gb;
        if (rope) { const float na = a * cs - b * sn, nb = b * cs + a * sn; a = na; b = nb; }
        base[h * 128 + ia] = (bf16)f2bf(a); base[h * 128 + ia + 32] = (bf16)f2bf(b); }
}
__device__ __forceinline__ void unpack8(const v4u raw, float (&x)[8]) {
#pragma unroll
    for (int i = 0; i < 4; ++i) { x[2 * i] = __uint_as_float(raw[i] << 16); x[2 * i + 1] = __uint_as_float(raw[i] & 0xffff0000u); }
}
__device__ __forceinline__ void norm512_finish(bf16* p, const float (&x)[8], const float* gain, int lane) {
    float ss = 0.f;
#pragma unroll
    for (int i = 0; i < 8; ++i) ss += x[i] * x[i];
    const float rstd = rsqrtf(wave_sum(ss, lane) * (1.0f / 512.0f) + EPS);
    const f32x4 g0 = *(const f32x4*)(gain + 8 * lane), g1 = *(const f32x4*)(gain + 8 * lane + 4);
    v4u w; w.x = pk2(x[0] * rstd * g0[0], x[1] * rstd * g0[1]); w.y = pk2(x[2] * rstd * g0[2], x[3] * rstd * g0[3]); w.z = pk2(x[4] * rstd * g1[0], x[5] * rstd * g1[1]); w.w = pk2(x[6] * rstd * g1[2], x[7] * rstd * g1[3]);
    *(v4u*)(p + 8 * lane) = w;
}
__device__ __forceinline__ void rope64(bf16* p, float prow, float pcol, int l32) {
    const int j = l32 & 15, s = (l32 >> 4) & 1, ia = 32 * s + j, ib = ia + 16;
    const float x = bf2f(p[ia]), y = bf2f(p[ib]); float cs, sn; rope_cs(s ? pcol : prow, j, 1.0f / 16.0f, cs, sn);
    p[ia] = (bf16)f2bf(x * cs - y * sn); p[ib] = (bf16)f2bf(y * cs + x * sn);
}
__device__ __forceinline__ void prep_ab(bf16* P, const float* aqn, const float* akn, const float* bqn, const float* bkvn, int gw, int NGW, int lane) {
    const int ia = 64 * (lane >> 5) + (lane & 31);
    for (int m = gw; m < MALL; m += NGW) {
        bf16* row = P + (size_t)m * N_IN0; const bool lat = m < MLAT; const int t = m & (SEQ - 1); const float pr = (float)(t >> 6), pc = (float)(t & 63);
        float xk[2], yk[2], c1[8], c2[8];
        heads_load<2>(row + 1024, ia, xk, yk);
        unpack8(*(const v4u*)(row + 1536 + 8 * lane), c1); unpack8(*(const v4u*)(row + 2048 + 8 * lane), c2);
        if (lat && lane < 32) rope64(row + 2560, pr, pc, lane);
        float cs = 1.f, sn = 0.f; if (lat) rope_cs((lane >> 5) ? pc : pr, lane & 31, 1.0f / 32.0f, cs, sn);
        heads_finish<2>(row + 1024, ia, xk, yk, akn, lat, cs, sn, lane);
        norm512_finish(row + 1536, c1, bqn, lane); norm512_finish(row + 2048, c2, bkvn, lane);
    }
}
__device__ __forceinline__ void prep_qb(bf16* QB, int gw, int NGW, int lane) {
    for (int m = gw; m < MLAT; m += NGW) {
        bf16* row = QB + (size_t)m * N_UQ; const int t = m & (SEQ - 1); const float pr = (float)(t >> 6), pc = (float)(t & 63);
#pragma unroll
        for (int i = 0; i < 4; ++i) rope64(row + (2 * i + (lane >> 5)) * 192 + 128, pr, pc, lane & 31);
    }
}
__device__ __forceinline__ void prep_cd(bf16* P, const float* cqn, const float* ckn, const float* dqn, const float* dkn, int gw, int NGW, int lane) {
    const int ia = 64 * (lane >> 5) + (lane & 31);
    for (int m = gw; m < MALL; m += NGW) {
        bf16* row = P + (size_t)m * N_IN1; const bool lat = m < MLAT; const int t = m & (SEQ - 1); const float pr = (float)(t >> 6), pc = (float)(t & 63);
        float cs = 1.f, sn = 0.f; if (lat) rope_cs((lane >> 5) ? pc : pr, lane & 31, 1.0f / 32.0f, cs, sn);
        float xk[2], yk[2], xd[8], yd[8];
        heads_load<2>(row + 1024, ia, xk, yk); heads_load<8>(row + 2560, ia, xd, yd);
        heads_finish<2>(row + 1024, ia, xk, yk, ckn, lat, cs, sn, lane); heads_finish<8>(row + 2560, ia, xd, yd, dkn, false, 1.f, 0.f, lane);
    }
}
constexpr float LOG2E = 1.4426950408889634f;
__device__ __forceinline__ void attn_phase_ab(const bf16* P0, const bf16* QB, const bf16* KVB, bf16* OB, const float* aqn, char* lds, const int wave0) {
    const int c = blockIdx.x, G = gridDim.x;
    for (int id = c; id < 1024 + 32; id += G) {
        att::Args a{};
        int mixer, b, h, qrow0, NT;
        if (id < 1024) { const int rnd = id >> 8, cc = id & 255; mixer = rnd >> 1; b = rnd & 1; h = cc & 7; qrow0 = b * SEQ + (cc >> 3) * 256; NT = 132; }
        else { const int cc = id - 1024; mixer = cc >> 4; b = (cc >> 3) & 1; h = cc & 7; qrow0 = MLAT + b * NCTX; NT = 4; }
        a.NT = NT; a.nctx = 4; a.ctx_row0 = MLAT + b * NCTX; a.lat_row0 = b * SEQ; a.ldo = DM; a.qrope_t0 = (id < 1024) ? (qrow0 - b * SEQ) : -1;
        if (mixer == 0) {
            a.Q = P0 + (size_t)qrow0 * N_IN0 + h * 128; a.ldq = N_IN0; a.K = P0 + 1024 + (h >> 2) * 128; a.ldk = N_IN0; a.K2 = nullptr; a.ldk2 = 0; a.V = P0 + 1280 + (h >> 2) * 128; a.ldv = N_IN0;
            a.O = OB + (size_t)qrow0 * DM + h * 128; const float scale = 0.08838834764831845f; a.C = scale * LOG2E; a.thr_raw = 8.0f * LOG2E; a.qgain = aqn;

#ifndef DIS_A
            att::attn_unit<128, 0>(a, lds, wave0);
#endif

        } else {
            a.Q = QB + (size_t)qrow0 * N_UQ + h * 192; a.ldq = N_UQ; a.K = KVB + h * 256; a.ldk = N_UKV; a.K2 = P0 + 2560; a.ldk2 = N_IN0; a.V = KVB + h * 256 + 128; a.ldv = N_UKV;
            a.O = OB + (size_t)qrow0 * DM + 1024 + h * 128; const float scale = 0.07216878364870322f; a.C = scale * LOG2E; a.thr_raw = 8.0f * LOG2E;

#ifndef DIS_B
            att::attn_unit<192, 0>(a, lds, wave0);
#endif

        }
    }
}
__device__ __forceinline__ void attn_phase_cd(const bf16* P1, bf16* OB, const float* sink, const float* rpb, const float* cqn, const float* dqn, char* lds, const int wave0) {
    const int c = blockIdx.x, G = gridDim.x;
    for (int id = c; id < 1024; id += G) {
        att::Args a{};
        const int rnd = id >> 8, cc = id & 255, mixer = rnd >> 1, b = rnd & 1, h = cc & 7, qb = cc >> 3, qrow0 = b * SEQ + qb * 256;
        a.nctx = 4; a.ctx_row0 = MLAT + b * NCTX; a.ldo = DM; a.ldq = a.ldk = a.ldv = N_IN1; a.K2 = nullptr; a.ldk2 = 0;
        const float scale = 0.08838834764831845f; a.C = scale * LOG2E; a.thr_raw = 8.0f * LOG2E; a.inv_scale = LOG2E;
        if (mixer == 0) {
            const int kbase = min(max(qb * 256 - 128, 0), SEQ - 512);
            a.NT = 12; a.lat_row0 = b * SEQ + kbase; a.qpos0 = qb * 256; a.kpos0 = kbase; a.sink_l2 = __uint_as_float((unsigned)__builtin_amdgcn_readfirstlane((int)__float_as_uint(sink[h]))) * LOG2E;
            a.qgain = cqn; a.qrope_t0 = qb * 256; a.Q = P1 + (size_t)qrow0 * N_IN1 + h * 128; a.K = P1 + 1024 + (h >> 2) * 128; a.V = P1 + 1280 + (h >> 2) * 128; a.O = OB + (size_t)qrow0 * DM + h * 128;

#ifndef DIS_C
            att::attn_unit<128, 1>(a, lds, wave0);
#endif

        } else {
            const int r0 = qb * 4, klo = min(max(r0 - 4, 0), 116);
            a.NT = 16; a.lat_row0 = b * SEQ + klo * 64; a.r0 = r0; a.klo = klo; a.rpb = rpb + h * (15 * 31);
            a.qgain = dqn; a.qrope_t0 = -1; a.Q = P1 + (size_t)qrow0 * N_IN1 + 1536 + h * 128; a.K = P1 + 2560 + h * 128; a.V = P1 + 3584 + h * 128; a.O = OB + (size_t)qrow0 * DM + 1024 + h * 128;

#ifndef DIS_D
            att::attn_unit<128, 2>(a, lds, wave0);
#endif

        }
    }
}

__global__ void __launch_bounds__(NTHR, 2) fwd_megakernel(KArgs args) {
    extern __shared__ __attribute__((aligned(16))) unsigned char lds[];
    cg::grid_group grid = cg::this_grid();
    LAS unsigned char* ldsl = (LAS unsigned char*)lds;
    const int wave0 = __builtin_amdgcn_readfirstlane(threadIdx.x >> 6);
    const int G = gridDim.x, NGW = G * NWAVES;
#define PHASE_IDS() const int tid = fresh_tid(wave0); const int lane = tid & 63, wave = __builtin_amdgcn_readfirstlane(tid >> 6), gw = blockIdx.x * NWAVES + wave; (void)wave; (void)gw; (void)lane
#define WSB (kargs()->ws)
#define x_ (kargs()->in[0])
#define ctx_ (kargs()->in[2])
#define out_ (kargs()->out)
#define hctx_ ((float*)(WSB + WS_HCTX))
#define MOD_ ((const float*)(WSB + WS_MOD))
#define UA_ ((bf16*)(WSB + WS_UO))
#define OB_ ((bf16*)(WSB + WS_OB))
#define FB_ ((bf16*)(WSB + WS_UO))
#define FP_ ((float*)(WSB + WS_FP))
#define HB_ ((bf16*)(WSB + WS_OB))
#define OFB_ ((bf16*)(WSB + WS_BIG))
#define OFP_ ((float*)(WSB + WS_BIG + 128 * MiB))
#define PB_ ((bf16*)(WSB + WS_BIG))
#define OF_ ((float*)(WSB + WS_BIG))
#define ACT_ ((bf16*)(WSB + WS_BIG))
#define QB_ ((bf16*)(WSB + WS_QB))
#define KVB_ ((bf16*)(WSB + WS_KVB))
#define UB_ ((bf16*)(WSB + WS_UB))
#ifndef PROBE_G
#define PROBE_G 1
#endif
#ifndef PROBE_A
#define PROBE_A 1
#endif
#ifndef PROBE_S
#define PROBE_S 1
#endif
#define GSYNC() do { for (int s_ = 0; s_ < PROBE_S; ++s_) { xcd_barrier(bar); } } while (0)
    volatile LAS unsigned* MISC = (volatile LAS unsigned*)(ldsl + 131072 + 64);
    if (threadIdx.x < 2) MISC[threadIdx.x] = 0u;
    __syncthreads();
    grid.sync();
    XcdBarrier bar = xcd_barrier_post((unsigned*)(kargs()->ws + WS_BAR), MISC);

    for (int rep_ = 0; rep_ < PROBE_S; ++rep_) {
    { PHASE_IDS(); p0_mod(kargs(), ldsl, tid); }
    { PHASE_IDS(); p0_weights(kargs(), ldsl, gw, NGW, wave, lane); }
    }
    GSYNC();
    { PHASE_IDS(); pass_pre(x_, ctx_, kargs()->in[6], MOD_, 0, DM, UA_, MALL, gw, NGW, lane); }
    GSYNC();
    for (int L = 0; L < 2; ++L) {

        const int Mrows = L == 0 ? MALL : MLAT;
        { pg8::Gemm g = pg8::mk_gemm(L == 0 ? UA_ : UB_, (const bf16*)(WSB + (L == 0 ? WS_WIN0 : WS_WIN1)), MALL, L == 0 ? N_IN0 : N_IN1, DM, DM);
          pg8::StaticOrder S; S.init(g.M, g.N, G, (int)blockIdx.x); pg8::EpiBf16 E{PB_, g.N};
          for (int rep_ = 0; rep_ < PROBE_G; ++rep_) pg8::gemm_phase<pg8::EpiBf16, pg8::StaticOrder, true, true>(ldsl, g, S, E, wave0); }
        GSYNC();
        if (L == 0) {
            { PHASE_IDS(); prep_ab(PB_, kargs()->in[15], kargs()->in[16], kargs()->in[17], kargs()->in[18], gw, NGW, lane); }
            GSYNC();
            for (int q = 0; q < 2; ++q) {
                pg8::Gemm g = pg8::mk_gemm(PB_ + (q == 0 ? 1536 : 2048), (const bf16*)(WSB + (q == 0 ? WS_WUQ : WS_WUKV)), MALL, q == 0 ? N_UQ : N_UKV, 512, N_IN0);
                pg8::StaticOrder S; S.init(g.M, g.N, G, (int)blockIdx.x); pg8::EpiBf16 E{q == 0 ? QB_ : KVB_, g.N};
                for (int rep_ = 0; rep_ < PROBE_G; ++rep_) pg8::gemm_phase<pg8::EpiBf16, pg8::StaticOrder, true, true>(ldsl, g, S, E, wave0);
            }
            GSYNC();
            for (int rep_ = 0; rep_ < PROBE_A; ++rep_) attn_phase_ab(PB_, QB_, KVB_, OB_, kargs()->in[15], (char*)lds, wave0);
        } else {
            { PHASE_IDS(); prep_cd(PB_, kargs()->in[23], kargs()->in[24], kargs()->in[26], kargs()->in[27], gw, NGW, lane); }
            GSYNC();
            for (int rep_ = 0; rep_ < PROBE_A; ++rep_) attn_phase_cd(PB_, OB_, kargs()->in[25], kargs()->in[28], kargs()->in[23], kargs()->in[26], (char*)lds, wave0);
        }
        GSYNC();
        { pg8::Gemm g = pg8::mk_gemm(OB_, (const bf16*)(WSB + (L == 0 ? WS_WOUT0 : WS_WOUT1)), MLAT, DM, DM, DM);
          pg8::StaticOrder S; S.init(g.M, g.N, G, (int)blockIdx.x); pg8::EpiBf16 E{OFB_, DM};
          for (int rep_ = 0; rep_ < PROBE_G; ++rep_) pg8::gemm_phase<pg8::EpiBf16, pg8::StaticOrder, true, true>(ldsl, g, S, E, wave0); }
        if (L == 0) { pg8::Gemm g = pg8::mk_gemm(OB_ + (size_t)MLAT * DM, (const bf16*)(WSB + WS_WOUT0), 2 * NCTX, 4 * DM, DM / 4, DM); g.ldb = DM; g.nNr = DM / 256;
          pg8::StaticOrder S; S.init(g.M, g.N, G, (int)blockIdx.x); pg8::EpiF32Split E{OFP_, DM, DM / 256, (size_t)2 * NCTX * DM};
          for (int rep_ = 0; rep_ < PROBE_G; ++rep_) pg8::gemm_phase<pg8::EpiF32Split, pg8::StaticOrder, true, true>(ldsl, g, S, E, wave0); }
        GSYNC();
        { PHASE_IDS(); pass_post(OFB_, OFP_, L == 0 ? x_ : out_, L == 0 ? ctx_ : hctx_, nullptr, out_, hctx_, HB_, kargs()->in[7] + L * DM, MOD_ + (size_t)L * 3 * 12288, 2 * DM, kargs()->in[8] + L * DM, MOD_ + (size_t)L * 3 * 12288, 3 * DM, 4 * DM, UA_, Mrows, gw, NGW, lane); }
        GSYNC();
        { pg8::Gemm g = pg8::mk_gemm(UA_, (const bf16*)(WSB + WS_WGU + (size_t)L * 44 * MiB), Mrows, N_GU, DM, DM);
          pg8::StaticOrder S; S.init(g.M, g.N, G, (int)blockIdx.x); pg8::EpiSwiglu E{ACT_, DFF};
          for (int rep_ = 0; rep_ < PROBE_G; ++rep_) pg8::gemm_phase<pg8::EpiSwiglu, pg8::StaticOrder, true, true>(ldsl, g, S, E, wave0); }
        GSYNC();
        { pg8::Gemm g = pg8::mk_gemm(ACT_, (const bf16*)(WSB + WS_WD + (size_t)L * 22 * MiB), MLAT, DM, DFF, DFF);
          pg8::StaticOrder S; S.init(g.M, g.N, G, (int)blockIdx.x); pg8::EpiBf16 E{FB_, DM};
          for (int rep_ = 0; rep_ < PROBE_G; ++rep_) pg8::gemm_phase<pg8::EpiBf16, pg8::StaticOrder, true, true>(ldsl, g, S, E, wave0); }
        if (L == 0) { pg8::Gemm g = pg8::mk_gemm(ACT_ + (size_t)MLAT * DFF, (const bf16*)(WSB + WS_WD), 2 * NCTX, 4 * DM, DFF / 4, DFF); g.ldb = DFF; g.nNr = DM / 256;
          pg8::StaticOrder S; S.init(g.M, g.N, G, (int)blockIdx.x); pg8::EpiF32Split E{FP_, DM, DM / 256, (size_t)2 * NCTX * DM};
          for (int rep_ = 0; rep_ < PROBE_G; ++rep_) pg8::gemm_phase<pg8::EpiF32Split, pg8::StaticOrder, true, true>(ldsl, g, S, E, wave0); }
        GSYNC();
        { PHASE_IDS(); pass_post(FB_, FP_, out_, hctx_, HB_, out_, hctx_, nullptr, kargs()->in[9] + L * DM, MOD_ + (size_t)L * 3 * 12288, 5 * DM, kargs()->in[6] + DM, MOD_ + (size_t)3 * 12288, 0, DM, L == 0 ? UB_ : nullptr, Mrows, gw, NGW, lane); }
        if (L == 0) GSYNC();
    }
#undef GSYNC
}

constexpr int LDS_BYTES = 131072 + 1024;
extern "C" void kernel_launch(void* const* d_in, const int* in_sizes, int n_in, void* d_out, int out_size, void* d_ws, size_t ws_size, hipStream_t stream) {
    static int grid = 0;
    if (grid == 0) {
        if (n_in != 29 || out_size != MLAT * DM || ws_size < WS_END) { fprintf(stderr, "kernel_launch: unexpected shapes: n_in %d out %d ws %zu (need %zu)\n", n_in, out_size, ws_size, (size_t)WS_END); grid = -1; return; }
        int dev = 0, cus = 0, per_cu = 0;
        hipGetDevice(&dev); hipDeviceGetAttribute(&cus, hipDeviceAttributeMultiprocessorCount, dev);
        if (hipFuncSetAttribute((const void*)fwd_megakernel, hipFuncAttributeMaxDynamicSharedMemorySize, LDS_BYTES) != hipSuccess) { fprintf(stderr, "kernel_launch: hipFuncSetAttribute failed\n"); grid = -1; return; }
        if (hipOccupancyMaxActiveBlocksPerMultiprocessor(&per_cu, (const void*)fwd_megakernel, NTHR, LDS_BYTES) != hipSuccess || per_cu < 1) { fprintf(stderr, "kernel_launch: occupancy query says %d\n", per_cu); per_cu = 1; }
        (void)hipGetLastError();
        grid = cus;
        fprintf(stderr, "kernel_launch: grid %d (per_cu %d)\n", grid, per_cu);
    }
    if (grid < 0) return;
    if (hipMemsetAsync((char*)d_ws + WS_BAR, 0, BAR_BYTES, stream) != hipSuccess) { fprintf(stderr, "kernel_launch: hipMemsetAsync failed\n"); return; }
    KArgs a{};
    for (int i = 0; i < 29; ++i) a.in[i] = (const float*)d_in[i];
    a.out = (float*)d_out; a.ws = (unsigned char*)d_ws;
    void* params[] = {&a};
    const hipError_t e = hipLaunchCooperativeKernel((const void*)fwd_megakernel, dim3(grid), dim3(NTHR), params, LDS_BYTES, stream);
    if (e != hipSuccess) fprintf(stderr, "kernel_launch: cooperative launch failed: %s (grid %d)\n", hipGetErrorString(e), grid);
}
```

```cpp
#include <hip/hip_runtime.h>
#include <hip/hip_cooperative_groups.h>
#include <cstdio>
#include <cstdint>
namespace cg = cooperative_groups;
__device__ __forceinline__ int fresh_tid(int wave0) { int l; asm volatile("v_mbcnt_lo_u32_b32 %0, -1, 0\n\tv_mbcnt_hi_u32_b32 %0, -1, %0" : "=v"(l)); return wave0 * 64 + l; }
namespace pg8 {
#define PG8_LAS __attribute__((address_space(3)))
typedef unsigned short bf16_t;
typedef short bf16x8 __attribute__((ext_vector_type(8)));
typedef float f32x4 __attribute__((ext_vector_type(4)));
typedef unsigned u32x4 __attribute__((ext_vector_type(4)));
constexpr int BM = 256, BK = 64, HALF = 128, HTB = HALF * BK * 2  , STAGE_BYTES = 8 * HTB, NXCD = 8, WGM = 8;

__host__ __device__ __forceinline__ int lds_byte(int r, int c) { const int st = (r >> 4) * 2 + (c >> 5), rr = r & 15, cc = c & 31, ob = rr * 64 + cc * 2; return st * 1024 + (ob ^ (((ob >> 9) & 1) << 5)); }
__host__ __device__ __forceinline__ void stage_rc(int b, int& R, int& C) { const int st = b / 1024, sb = b % 1024, swz = sb ^ (((sb >> 9) & 1) << 5); R = (st >> 1) * 16 + swz / 64; C = (st & 1) * 32 + (swz % 64) / 2; }
__host__ __device__ __forceinline__ int perm32(int rho) { const int n = rho >> 4, i = rho & 15; return 8 * (i >> 2) + 4 * n + (i & 3); }

struct Unit { int pm, pn; };
struct Gemm { const bf16_t* A; const bf16_t* Bt; int M, N, K, lda, ldb, nNr; };
__host__ __device__ __forceinline__ Gemm mk_gemm(const bf16_t* A, const bf16_t* Bt, int M, int N, int K, int lda) { Gemm g; g.A = A; g.Bt = Bt; g.M = M; g.N = N; g.K = K; g.lda = lda; g.ldb = K; g.nNr = N / BM; return g; }

struct StaticOrder {
    int nM, nN, nwg, G, c;
    __host__ __device__ void init(int M, int N, int G_, int c_) { nM = M / BM; nN = N / BM; nwg = nM * nN; G = G_; c = c_; }
    __host__ __device__ bool next(int i, Unit& u) const {
        const long L = (long)i * G + c; if (L >= nwg) return false;
        int wgid = (int)L; { const int q = nwg / NXCD, r = nwg % NXCD, xcd = wgid % NXCD, off = wgid / NXCD; wgid = (xcd < r ? xcd * (q + 1) : r * (q + 1) + (xcd - r) * q) + off; }
        const int nig = WGM * nN, gid = wgid / nig, fm = gid * WGM, gsz = (nM - fm) < WGM ? (nM - fm) : WGM;
        u.pm = fm + ((wgid % nig) % gsz); u.pn = (wgid % nig) / gsz; return true;
    }
    __device__ __forceinline__ void a_ready(const Unit&) const {}
    __device__ __forceinline__ void done(const Unit&) const {}
};


__device__ __forceinline__ unsigned cvt_pk_bf16(float lo, float hi) { unsigned r; asm volatile("v_cvt_pk_bf16_f32 %0, %1, %2" : "=v"(r) : "v"(lo), "v"(hi)); return r; }
struct EpiBf16 {
    static constexpr bool PERM = true, AFTER_DRAIN = false;
    bf16_t* O; int ldc;
    __device__ __forceinline__ void operator()(const f32x4 (&acc)[2][2][4][2], const Unit& u, int wr, int wc, int fr, int fq) const {
        const int row0 = u.pm * BM + wr * 64 + fr, col0 = u.pn * BM + wc * 32 + 8 * fq;
#pragma unroll
        for (int ai = 0; ai < 2; ++ai)
#pragma unroll
            for (int m = 0; m < 4; ++m) { bf16_t* rowp = O + (size_t)(row0 + ai * HALF + m * 16) * ldc + col0;
#pragma unroll
                for (int bj = 0; bj < 2; ++bj) { const f32x4 v0 = acc[ai][bj][m][0], v1 = acc[ai][bj][m][1];
                    u32x4 w; w.x = cvt_pk_bf16(v0[0], v0[1]); w.y = cvt_pk_bf16(v0[2], v0[3]); w.z = cvt_pk_bf16(v1[0], v1[1]); w.w = cvt_pk_bf16(v1[2], v1[3]);
                    *(u32x4*)(rowp + bj * HALF) = w; } }
    }
};
struct EpiF32 {
    static constexpr bool PERM = false, AFTER_DRAIN = false;
    float* O; int ldc;
    __device__ __forceinline__ void operator()(const f32x4 (&acc)[2][2][4][2], const Unit& u, int wr, int wc, int fr, int fq) const {
        const int row0 = u.pm * BM + wr * 64 + fr, col0 = u.pn * BM + wc * 32 + 4 * fq;
#pragma unroll
        for (int ai = 0; ai < 2; ++ai)
#pragma unroll
            for (int m = 0; m < 4; ++m) { float* rowp = O + (size_t)(row0 + ai * HALF + m * 16) * ldc + col0;
#pragma unroll
                for (int bj = 0; bj < 2; ++bj)
#pragma unroll
                    for (int n = 0; n < 2; ++n) *(f32x4*)(rowp + bj * HALF + n * 16) = acc[ai][bj][m][n]; }
    }
};
struct EpiF32Split {
    static constexpr bool PERM = false, AFTER_DRAIN = false;
    float* O; int ldc; int nNr; size_t sstride;
    __device__ __forceinline__ void operator()(const f32x4 (&acc)[2][2][4][2], const Unit& u, int wr, int wc, int fr, int fq) const {
        const int s = u.pn / nNr, pn = u.pn - s * nNr;
        const int row0 = u.pm * BM + wr * 64 + fr, col0 = pn * BM + wc * 32 + 4 * fq; float* Ob = O + (size_t)s * sstride;
#pragma unroll
        for (int ai = 0; ai < 2; ++ai)
#pragma unroll
            for (int m = 0; m < 4; ++m) { float* rowp = Ob + (size_t)(row0 + ai * HALF + m * 16) * ldc + col0;
#pragma unroll
                for (int bj = 0; bj < 2; ++bj)
#pragma unroll
                    for (int n = 0; n < 2; ++n) *(f32x4*)(rowp + bj * HALF + n * 16) = acc[ai][bj][m][n]; }
    }
};
__device__ __forceinline__ float silu_mul(float g, float u) { return g * __builtin_amdgcn_rcpf(1.0f + __builtin_amdgcn_exp2f(-1.4426950408889634f * g)) * u; }
struct EpiSwiglu {
    static constexpr bool PERM = true, AFTER_DRAIN = false;
    bf16_t* O; int ldc;
    __device__ __forceinline__ void operator()(const f32x4 (&acc)[2][2][4][2], const Unit& u, int wr, int wc, int fr, int fq) const {
        const int row0 = u.pm * BM + wr * 64 + fr, col0 = u.pn * HALF + wc * 32 + 8 * fq;
#pragma unroll
        for (int ai = 0; ai < 2; ++ai)
#pragma unroll
            for (int m = 0; m < 4; ++m) { bf16_t* rowp = O + (size_t)(row0 + ai * HALF + m * 16) * ldc + col0;
                const f32x4 g0 = acc[ai][0][m][0], g1 = acc[ai][0][m][1], u0 = acc[ai][1][m][0], u1 = acc[ai][1][m][1];
                u32x4 w; w.x = cvt_pk_bf16(silu_mul(g0[0], u0[0]), silu_mul(g0[1], u0[1])); w.y = cvt_pk_bf16(silu_mul(g0[2], u0[2]), silu_mul(g0[3], u0[3]));
                w.z = cvt_pk_bf16(silu_mul(g1[0], u1[0]), silu_mul(g1[1], u1[1])); w.w = cvt_pk_bf16(silu_mul(g1[2], u1[2]), silu_mul(g1[3], u1[3]));
                *(u32x4*)rowp = w; }
    }
};

template <class Epi, class Sched, bool ALIGN_EPI = false, bool SP2 = false>
__device__ __forceinline__ void gemm_phase(PG8_LAS unsigned char* lds, const Gemm g, const Sched& S, const Epi& E, const int wave0) {
    const int tid = fresh_tid(wave0), wid = __builtin_amdgcn_readfirstlane(tid >> 6), lane = tid & 63, wr = wid >> 2, wc = wid & 3, fr = lane & 15, fq = lane >> 4;
    const int K = g.K, nt = K / BK;
    const unsigned ldsb0 = (unsigned)(uintptr_t)lds;
    unsigned voffA[2], voffB[2];
#pragma unroll
    for (int i = 0; i < 2; ++i) { int R, C; stage_rc(tid * 16 + i * 8192, R, C); const int Rb = Epi::PERM ? ((R & ~31) + perm32(R & 31)) : R;
        voffA[i] = (unsigned)(R * g.lda + C) * 2u; voffB[i] = (unsigned)(Rb * g.ldb + C) * 2u; }
    const size_t kstep = (size_t)(BK * 2);
    const size_t hstepA = (size_t)HALF * g.lda * 2, hstepB = (size_t)HALF * g.ldb * 2; const size_t ksb = (size_t)K * 2;
#define PG8_APTR(u) ((const char*)g.A + (size_t)(u).pm * tstepA + (size_t)((u).pn / g.nNr) * ksb)
#define PG8_BPTR(u) ((const char*)g.Bt + (size_t)((u).pn % g.nNr) * tstepB + (size_t)((u).pn / g.nNr) * ksb)
    const size_t tstepA = 2 * hstepA, tstepB = 2 * hstepB;
    const unsigned ldsw = (unsigned)wid * 1024u;
    const int aoff = lds_byte(wr * 64 + fr, fq * 8), boff = lds_byte(wc * 32 + fr, fq * 8);
#define PG8_SA(b, h) (((b) * 2 + (h)) * HTB)
#define PG8_SB(b, h) ((4 + (b) * 2 + (h)) * HTB)
#define PG8_STAGE(bufoff, gbase, voff) do { _Pragma("unroll") for (int _i = 0; _i < 2; ++_i) { \
        const unsigned ldst_ = ldsb0 + (unsigned)(bufoff) + ldsw + (unsigned)_i * 8192u; const char* gb_ = (const char*)(gbase); \
        asm volatile("s_mov_b32 m0, %2\n\ts_nop 0\n\tglobal_load_lds_dwordx4 %0, %1" :: "v"((voff)[_i]), "s"(gb_), "s"(ldst_) : "memory"); } } while (0)
#define PG8_LDA(dst, b, h) do { _Pragma("unroll") for (int m = 0; m < 4; ++m) _Pragma("unroll") for (int k = 0; k < 2; ++k) dst[m][k] = *(const PG8_LAS bf16x8*)(lds + PG8_SA(b, h) + aoff + m * 2048 + k * 1024); } while (0)
#define PG8_LDB(dst, b, h) do { _Pragma("unroll") for (int n = 0; n < 2; ++n) _Pragma("unroll") for (int k = 0; k < 2; ++k) dst[n][k] = *(const PG8_LAS bf16x8*)(lds + PG8_SB(b, h) + boff + n * 2048 + k * 1024); } while (0)
#define PG8_MMA(ai, bj, At, Bt) do { __builtin_amdgcn_s_setprio(1); _Pragma("unroll") for (int m = 0; m < 4; ++m) _Pragma("unroll") for (int n = 0; n < 2; ++n) _Pragma("unroll") for (int k = 0; k < 2; ++k) \
        acc[ai][bj][m][n] = __builtin_amdgcn_mfma_f32_16x16x32_bf16(Bt[n][k], At[m][k], acc[ai][bj][m][n], 0, 0, 0); __builtin_amdgcn_s_setprio(0); } while (0)
#define PG8_WAIT_V(n) asm volatile("s_waitcnt vmcnt(" #n ")" ::: "memory")
#define PG8_WAIT_L(n) asm volatile("s_waitcnt lgkmcnt(" #n ")" ::: "memory")
#define PG8_BAR __builtin_amdgcn_s_barrier()
#define PG8_SCHED __builtin_amdgcn_sched_barrier(0)
    Unit cur, nxt; int ui = 0;
    if (!S.next(0, cur)) return;
    f32x4 acc[2][2][4][2];
#pragma unroll
    for (int a = 0; a < 2; ++a)
#pragma unroll
        for (int b = 0; b < 2; ++b)
#pragma unroll
            for (int m = 0; m < 4; ++m)
#pragma unroll
                for (int n = 0; n < 2; ++n) acc[a][b][m][n] = (f32x4){0.f, 0.f, 0.f, 0.f};
    bf16x8 At[4][2], B0[2][2], B1[2][2];
    const char* cA = PG8_APTR(cur); const char* cB = PG8_BPTR(cur);
    S.a_ready(cur);
    if constexpr (SP2) {
        PG8_STAGE(PG8_SB(0, 0), cB, voffB); PG8_STAGE(PG8_SB(0, 1), cB + hstepB, voffB); PG8_STAGE(PG8_SA(0, 0), cA, voffA); PG8_STAGE(PG8_SA(0, 1), cA + hstepA, voffA);
        if (wr == 1) PG8_BAR;
        PG8_WAIT_V(2); PG8_BAR;
        PG8_STAGE(PG8_SB(1, 0), cB + kstep, voffB); PG8_STAGE(PG8_SA(1, 0), cA + kstep, voffA); PG8_STAGE(PG8_SB(1, 1), cB + hstepB + kstep, voffB);
        PG8_WAIT_V(6); PG8_BAR;
    } else {
        PG8_STAGE(PG8_SB(0, 0), cB, voffB); PG8_STAGE(PG8_SA(0, 0), cA, voffA); PG8_STAGE(PG8_SB(0, 1), cB + hstepB, voffB); PG8_STAGE(PG8_SA(0, 1), cA + hstepA, voffA);
        if (wr == 1) PG8_BAR;
        PG8_WAIT_V(4); PG8_BAR;
        PG8_STAGE(PG8_SB(1, 0), cB + kstep, voffB); PG8_STAGE(PG8_SA(1, 0), cA + kstep, voffA); PG8_STAGE(PG8_SB(1, 1), cB + hstepB + kstep, voffB);
        PG8_WAIT_V(6); PG8_BAR;
    }
    for (;;) {
        const bool has_next = S.next(ui + 1, nxt);
        const char* nA = has_next ? PG8_APTR(nxt) : cA; const char* nB = has_next ? PG8_BPTR(nxt) : cB;
        for (int t = 0; t < nt; t += 2) {
            const bool last = (t == nt - 2);
            const char* a1 = cA + (size_t)(t + 1) * kstep;
            const char* a2 = last ? nA : cA + (size_t)(t + 2) * kstep; const char* b2 = last ? nB : cB + (size_t)(t + 2) * kstep;
            const char* a3 = a2 + kstep; const char* b3 = b2 + kstep;
            if (last && has_next) S.a_ready(nxt);
            if constexpr (SP2) {
            PG8_LDB(B0, 0, 0); PG8_LDB(B1, 0, 1); PG8_SCHED; PG8_LDA(At, 0, 0); PG8_STAGE(PG8_SA(1, 1), a1 + hstepA, voffA);
            PG8_WAIT_V(8); PG8_WAIT_L(0); PG8_BAR; PG8_MMA(0, 0, At, B0); PG8_MMA(0, 1, At, B1); PG8_BAR; PG8_SCHED;
            PG8_LDA(At, 0, 1); PG8_STAGE(PG8_SB(0, 0), b2, voffB); PG8_STAGE(PG8_SB(0, 1), b2 + hstepB, voffB); PG8_STAGE(PG8_SA(0, 0), a2, voffA);
            PG8_WAIT_V(8); PG8_WAIT_L(0); PG8_BAR; PG8_MMA(1, 0, At, B0); PG8_MMA(1, 1, At, B1); PG8_BAR; PG8_SCHED;
            PG8_LDB(B0, 1, 0); PG8_LDB(B1, 1, 1); PG8_SCHED; PG8_LDA(At, 1, 0); PG8_STAGE(PG8_SA(0, 1), a2 + hstepA, voffA);
            PG8_WAIT_V(8); PG8_WAIT_L(0); PG8_BAR; PG8_MMA(0, 0, At, B0); PG8_MMA(0, 1, At, B1); PG8_BAR; PG8_SCHED;
            PG8_LDA(At, 1, 1); PG8_STAGE(PG8_SB(1, 0), b3, voffB); PG8_STAGE(PG8_SB(1, 1), b3 + hstepB, voffB); PG8_STAGE(PG8_SA(1, 0), a3, voffA);
            PG8_WAIT_V(8); PG8_WAIT_L(0); PG8_BAR; PG8_MMA(1, 0, At, B0); PG8_MMA(1, 1, At, B1); PG8_BAR; PG8_SCHED;
            } else {
            PG8_LDB(B0, 0, 0); PG8_SCHED; PG8_LDA(At, 0, 0); PG8_STAGE(PG8_SA(1, 1), a1 + hstepA, voffA);
            PG8_WAIT_L(8); PG8_BAR; PG8_WAIT_L(0); PG8_MMA(0, 0, At, B0); PG8_BAR; PG8_SCHED;
            PG8_LDB(B1, 0, 1); PG8_STAGE(PG8_SB(0, 0), b2, voffB);
            PG8_BAR; PG8_WAIT_L(0); PG8_MMA(0, 1, At, B1); PG8_BAR;
            PG8_LDA(At, 0, 1); PG8_STAGE(PG8_SA(0, 0), a2, voffA);
            PG8_BAR; PG8_WAIT_L(0); PG8_MMA(1, 0, At, B0); PG8_BAR; PG8_SCHED;
            PG8_STAGE(PG8_SB(0, 1), b2 + hstepB, voffB);
            PG8_WAIT_V(6); PG8_BAR; PG8_MMA(1, 1, At, B1); PG8_BAR;
            PG8_LDB(B0, 1, 0); PG8_SCHED; PG8_LDA(At, 1, 0); PG8_STAGE(PG8_SA(0, 1), a2 + hstepA, voffA);
            PG8_WAIT_L(8); PG8_BAR; PG8_WAIT_L(0); PG8_MMA(0, 0, At, B0); PG8_BAR; PG8_SCHED;
            PG8_LDB(B1, 1, 1); PG8_STAGE(PG8_SB(1, 0), b3, voffB);
            PG8_BAR; PG8_WAIT_L(0); PG8_MMA(0, 1, At, B1); PG8_BAR;
            PG8_LDA(At, 1, 1); PG8_STAGE(PG8_SA(1, 0), a3, voffA);
            PG8_BAR; PG8_WAIT_L(0); PG8_MMA(1, 0, At, B0); PG8_BAR; PG8_SCHED;
            PG8_STAGE(PG8_SB(1, 1), b3 + hstepB, voffB);
            PG8_WAIT_V(6); PG8_BAR; PG8_MMA(1, 1, At, B1); PG8_BAR;
            }
        }
        if constexpr (ALIGN_EPI) { if (wr == 0) PG8_BAR; }
        if constexpr (!Epi::AFTER_DRAIN) { E(acc, cur, wr, wc, fr, fq); S.done(cur); }
        if (!has_next) break;
#pragma unroll
        for (int a = 0; a < 2; ++a)
#pragma unroll
            for (int b = 0; b < 2; ++b)
#pragma unroll
                for (int m = 0; m < 4; ++m)
#pragma unroll
                    for (int n = 0; n < 2; ++n) acc[a][b][m][n] = (f32x4){0.f, 0.f, 0.f, 0.f};
        cur = nxt; cA = nA; cB = nB; ++ui;
        if constexpr (ALIGN_EPI) { if (wr == 1) PG8_BAR; }
    }
    PG8_WAIT_V(0);
    if constexpr (!ALIGN_EPI) { if (wr == 0) PG8_BAR; }
    PG8_BAR;
    if constexpr (Epi::AFTER_DRAIN) { E.fused(acc, cur, wr, wc, fr, fq, lds, wid, lane); S.done(cur); }
#undef PG8_APTR
#undef PG8_BPTR
#undef PG8_SA
#undef PG8_SB
#undef PG8_STAGE
#undef PG8_LDA
#undef PG8_LDB
#undef PG8_MMA
#undef PG8_WAIT_V
#undef PG8_WAIT_L
#undef PG8_BAR
#undef PG8_SCHED
}
}
namespace att {
typedef unsigned short bf16;
typedef short bf16x8 __attribute__((ext_vector_type(8)));
typedef short s16x4 __attribute__((ext_vector_type(4)));
typedef float f32x16 __attribute__((ext_vector_type(16)));
typedef unsigned u32x4 __attribute__((ext_vector_type(4)));
constexpr int NW = 8, QBLK = 32, KVBLK = 64;
constexpr int SHM_V = KVBLK * 128 * 2;
#define SBAR() __builtin_amdgcn_sched_barrier(0)
__device__ __forceinline__ int crow(int r, int hi) { return (r & 3) + 8 * (r >> 2) + 4 * hi; }
__device__ __forceinline__ unsigned cvtpk(float lo, float hi) { unsigned r; asm volatile("v_cvt_pk_bf16_f32 %0, %1, %2" : "=v"(r) : "v"(lo), "v"(hi)); return r; }

struct Args {
  const bf16* Q; const bf16* K; const bf16* K2; const bf16* V; bf16* O;
  int ldq, ldk, ldk2, ldv, ldo;
  int NT, nctx, ctx_row0, lat_row0;
  float C, thr_raw;
  int qpos0, kpos0;
  float sink_l2;
  int r0, klo;
  const float* rpb; float inv_scale;
  const float* qgain;
  int qrope_t0;
};

template <bool FIRST> __device__ __forceinline__ void partialSM(f32x16& p0, f32x16& p1, float& m_reg, float& alpha, f32x16& negm, const float thr) {
  float pmax = p0[0];
#pragma unroll
  for (int r = 1; r < 16; ++r) pmax = fmaxf(pmax, p0[r]);
#pragma unroll
  for (int r = 0; r < 16; ++r) pmax = fmaxf(pmax, p1[r]);
  { auto rr = __builtin_amdgcn_permlane32_swap(__float_as_uint(pmax), __float_as_uint(pmax), false, false);
    pmax = fmaxf(__uint_as_float(rr[0]), __uint_as_float(rr[1])); }
  alpha = 1.f;
  if (FIRST || !__builtin_expect(__all(pmax <= thr), 1)) {
    const float delta = FIRST ? pmax : fmaxf(pmax, 0.f);
    m_reg += delta; if (!FIRST) alpha = __builtin_amdgcn_exp2f(-delta);
#pragma unroll
    for (int r = 0; r < 16; ++r) { p0[r] -= delta; p1[r] -= delta; }
    const float nm = -m_reg;
#pragma unroll
    for (int r = 0; r < 16; ++r) negm[r] = nm;
    asm volatile("" : "+v"(negm));
  }
#pragma unroll
  for (int r = 0; r < 16; ++r) p0[r] = __builtin_amdgcn_exp2f(p0[r]);
}
__device__ __forceinline__ void finishSM(f32x16& p0, f32x16& p1, float alpha, float& l_reg, bf16x8& pa0, bf16x8& pa1, bf16x8& pa2, bf16x8& pa3) {
#pragma unroll
  for (int r = 0; r < 16; ++r) p1[r] = __builtin_amdgcn_exp2f(p1[r]);
  float ps = 0;
#pragma unroll
  for (int r = 0; r < 16; ++r) ps += p0[r];
#pragma unroll
  for (int r = 0; r < 16; ++r) ps += p1[r];
  { auto rr = __builtin_amdgcn_permlane32_swap(__float_as_uint(ps), __float_as_uint(ps), false, false);
    ps = __uint_as_float(rr[0]) + __uint_as_float(rr[1]); }
  l_reg = l_reg * alpha + ps;
#define PK8(P, BASE, OUT) do { u32x4 w = {cvtpk(P[BASE + 0], P[BASE + 1]), cvtpk(P[BASE + 2], P[BASE + 3]), cvtpk(P[BASE + 4], P[BASE + 5]), cvtpk(P[BASE + 6], P[BASE + 7])}; \
    OUT = *reinterpret_cast<bf16x8*>(&w); } while (0)
  PK8(p0, 0, pa0); PK8(p0, 8, pa1); PK8(p1, 0, pa2); PK8(p1, 8, pa3);
#undef PK8
}
template <int DQ> __device__ __forceinline__ int kswz(int row, int colB) { return row * (DQ * 2) + (colB ^ ((row & 7) << 4)); }
typedef const __attribute__((address_space(3))) bf16x8* lds_b128_ptr;
template <int DQ> __device__ __forceinline__ void qkt(f32x16& p0, f32x16& p1, const int (&kx)[4], int koff, const bf16x8* qr, const f32x16& negm) {
  lds_b128_ptr k0 = (lds_b128_ptr)(unsigned)(kx[0] + koff), k1 = (lds_b128_ptr)(unsigned)(kx[1] + koff), k2 = (lds_b128_ptr)(unsigned)(kx[2] + koff), k3 = (lds_b128_ptr)(unsigned)(kx[3] + koff);
#pragma unroll
  for (int d0 = 0; d0 < DQ / 16; ++d0) { lds_b128_ptr kp = (d0 & 3) == 0 ? k0 : (d0 & 3) == 1 ? k1 : (d0 & 3) == 2 ? k2 : k3;
    const bf16x8 b0 = kp[(d0 >> 2) * 8];
    const bf16x8 b1 = kp[(d0 >> 2) * 8 + 32 * DQ * 2 / 16];
    if (d0 == 0) { p0 = __builtin_amdgcn_mfma_f32_32x32x16_bf16(b0, qr[0], negm, 0, 0, 0); p1 = __builtin_amdgcn_mfma_f32_32x32x16_bf16(b1, qr[0], negm, 0, 0, 0); }
    else { p0 = __builtin_amdgcn_mfma_f32_32x32x16_bf16(b0, qr[d0], p0, 0, 0, 0); p1 = __builtin_amdgcn_mfma_f32_32x32x16_bf16(b1, qr[d0], p1, 0, 0, 0); } }
}
__device__ __forceinline__ int v_st(int k, int c) { const int kk = (k & ~0xC) | ((k & 4) << 1) | ((k & 8) >> 1); return ((kk >> 3) * 4 + (c >> 5)) * 512 + ((kk & 7) * 32 + (c & 31)) * 2; }
__device__ __forceinline__ int v_rd_base(int lane) { return ((lane & 3) << 3) | (((lane >> 2) & 3) << 6) | (((lane >> 4) & 1) << 5) | (((lane >> 5) & 1) << 8); }
constexpr int v_rd_off(int d0, int ks, int half) { return d0 * 512 + ks * 4096 + half * 2048; }
template <int OFF> __device__ __forceinline__ s16x4 tr_read(int vb) {
  s16x4 r; asm volatile("ds_read_b64_tr_b16 %0, %1 offset:%2" : "=&v"(r) : "v"(vb), "i"(OFF) : "memory"); return r;
}
template <int D0> __device__ __forceinline__ void pv_one(f32x16& od, int vb, bf16x8 pa0, bf16x8 pa1, bf16x8 pa2, bf16x8 pa3) {
  const s16x4 l0 = tr_read<v_rd_off(D0, 0, 0)>(vb), h0 = tr_read<v_rd_off(D0, 0, 1)>(vb), l1 = tr_read<v_rd_off(D0, 1, 0)>(vb), h1 = tr_read<v_rd_off(D0, 1, 1)>(vb);
  const s16x4 l2 = tr_read<v_rd_off(D0, 2, 0)>(vb), h2 = tr_read<v_rd_off(D0, 2, 1)>(vb), l3 = tr_read<v_rd_off(D0, 3, 0)>(vb), h3 = tr_read<v_rd_off(D0, 3, 1)>(vb);
  asm volatile("s_waitcnt lgkmcnt(0)" ::: "memory"); SBAR();
#define PK(L, H) (bf16x8){L[0], L[1], L[2], L[3], H[0], H[1], H[2], H[3]}
  od = __builtin_amdgcn_mfma_f32_32x32x16_bf16(pa0, PK(l0, h0), od, 0, 0, 0);
  od = __builtin_amdgcn_mfma_f32_32x32x16_bf16(pa1, PK(l1, h1), od, 0, 0, 0);
  od = __builtin_amdgcn_mfma_f32_32x32x16_bf16(pa2, PK(l2, h2), od, 0, 0, 0);
  od = __builtin_amdgcn_mfma_f32_32x32x16_bf16(pa3, PK(l3, h3), od, 0, 0, 0);
#undef PK
}
__device__ __forceinline__ void pv_d0(f32x16* o, int vb, bf16x8 pa0, bf16x8 pa1, bf16x8 pa2, bf16x8 pa3) {
  pv_one<0>(o[0], vb, pa0, pa1, pa2, pa3); pv_one<1>(o[1], vb, pa0, pa1, pa2, pa3); pv_one<2>(o[2], vb, pa0, pa1, pa2, pa3); pv_one<3>(o[3], vb, pa0, pa1, pa2, pa3);
}
template <int MODE> __device__ __forceinline__ void maskf(f32x16& p0, f32x16& p1, int t, const Args& a, int wid, int r32, int hi, const float* bias_lds) {
  if constexpr (MODE == 0) { return; }
  else {
    if (t < a.nctx) return;
    if constexpr (MODE == 1) {
      const int kb = a.kpos0 + (t - a.nctx) * 64, qw = a.qpos0 + wid * 32;
      if (kb + 63 - qw <= 128 && qw + 31 - kb <= 128) return;
      int base = kb + 4 * hi - (qw + r32);
      asm volatile("" : "+v"(base));
#pragma unroll
      for (int r = 0; r < 16; ++r) { const int d0 = base + (r & 3) + 8 * (r >> 2);
        if ((unsigned)(d0 + 128) > 256u) p0[r] = -1e30f;
        if ((unsigned)(d0 + 160) > 256u) p1[r] = -1e30f; }
    } else {
      const int kr = a.klo + (t - a.nctx), rq = a.r0 + (wid >> 1);
      const int rs = min(max(rq - 4, 0), 120);
      if (kr < rs || kr >= rs + 8) {
#pragma unroll
        for (int r = 0; r < 16; ++r) { p0[r] = -1e30f; p1[r] = -1e30f; }
        return; }
      const int c = (wid & 1) * 32 + r32, cs = min(max(c - 8, 0), 48);
      int cb = 4 * hi - c + 63, vb = 4 * hi - cs;
      asm volatile("" : "+v"(cb), "+v"(vb));
      const float* bp = bias_lds + (kr - rq + 7) * 128 + cb;
#pragma unroll
      for (int r = 0; r < 16; ++r) { const int k0 = (r & 3) + 8 * (r >> 2), k1 = k0 + 32;
        const float b0 = bp[k0], b1 = bp[k1];
        p0[r] = ((unsigned)(k0 + vb) < 16u) ? fmaf(b0, a.inv_scale, p0[r]) : -1e30f;
        p1[r] = ((unsigned)(k1 + vb) < 16u) ? fmaf(b1, a.inv_scale, p1[r]) : -1e30f;
        if ((r & 3) == 3) SBAR(); }
    }
  }
}

template <int DQ, int MODE>
__device__ __forceinline__ void attn_unit(const Args& a, char* lds, const int wave0) {
  constexpr int SHM_K = KVBLK * DQ * 2, NQ = DQ / 16, OFF_K = 3 * SHM_V, OFF_WS = OFF_K + 2 * SHM_K;
  const int tid = fresh_tid(wave0), wid = tid >> 6, lane = tid & 63, r32 = lane & 31, hi = lane >> 5;
  char* V_lds = lds; char* K_lds = lds + OFF_K;
  float* ws = (float*)(lds + OFF_WS) + wid * 64; float* li_l = ws; float* al_l = ws + 32;
  float* bias_l = (float*)(lds + OFF_WS + 2048);
  if constexpr (MODE == 2) { if (tid < 465) bias_l[(tid / 31) * 128 + 48 + (tid % 31)] = a.rpb[tid]; }
  float m_reg = 0.f, l_reg = 0; f32x16 o[4] = {}; bf16x8 qr[NQ];
  const float thr = a.thr_raw;
  const bf16* Qw = a.Q + (long)(wid * QBLK + r32) * a.ldq + hi * 8;
#pragma unroll
  for (int d0 = 0; d0 < NQ; ++d0) qr[d0] = *reinterpret_cast<const bf16x8*>(Qw + d0 * 16);
  if constexpr (DQ == 128) {
    if (a.qgain) { float xf[8][8]; float ss = 0.f;
#pragma unroll
      for (int d0 = 0; d0 < 8; ++d0)
#pragma unroll
        for (int e = 0; e < 8; ++e) { xf[d0][e] = __uint_as_float(((unsigned)(unsigned short)qr[d0][e]) << 16); ss += xf[d0][e] * xf[d0][e]; }
      { auto rr = __builtin_amdgcn_permlane32_swap(__float_as_uint(ss), __float_as_uint(ss), false, false); ss = __uint_as_float(rr[0]) + __uint_as_float(rr[1]); }
      const float rstd = rsqrtf(ss * (1.0f / 128.0f) + 1e-6f) * a.C;
#pragma unroll
      for (int d0 = 0; d0 < 8; ++d0) { const float* gp = a.qgain + d0 * 16 + hi * 8;
#pragma unroll
        for (int e = 0; e < 8; ++e) xf[d0][e] = xf[d0][e] * rstd * gp[e]; }
      if (a.qrope_t0 >= 0) { const int t = a.qrope_t0 + wid * QBLK + r32; const float prow = (float)(t >> 6), pcol = (float)(t & 63);
#pragma unroll
        for (int half = 0; half < 2; ++half)
#pragma unroll
          for (int blk = 0; blk < 2; ++blk)
#pragma unroll
            for (int e = 0; e < 8; ++e) { const int j = blk * 16 + hi * 8 + e, da = 4 * half + blk, db = da + 2;
              const float inv_freq = __builtin_amdgcn_exp2f(-(float)j * (13.287712379549449f / 32.0f)); float rev = (half ? pcol : prow) * inv_freq * 0.15915494309189535f; rev -= rintf(rev);
              const float sn = __builtin_amdgcn_sinf(rev), cs = __builtin_amdgcn_cosf(rev);
              const float x = xf[da][e], y = xf[db][e]; xf[da][e] = x * cs - y * sn; xf[db][e] = y * cs + x * sn; } }
#pragma unroll
      for (int d0 = 0; d0 < 8; ++d0) { bf16x8 w;
#pragma unroll
        for (int e = 0; e < 8; ++e) { unsigned u = __float_as_uint(xf[d0][e]); u = (u + 0x7fffu + ((u >> 16) & 1u)) >> 16; w[e] = (short)u; }
        qr[d0] = w; } } }
  if constexpr (DQ == 192) {
    if (a.qrope_t0 >= 0) { const int t = a.qrope_t0 + wid * QBLK + r32; const float prow = (float)(t >> 6), pcol = (float)(t & 63);
#pragma unroll
      for (int half = 0; half < 2; ++half) { bf16x8 xa = qr[8 + 2 * half], xb = qr[9 + 2 * half]; const float pos = half ? pcol : prow;
#pragma unroll
        for (int e = 0; e < 8; ++e) { const int j = hi * 8 + e;
          const float inv_freq = __builtin_amdgcn_exp2f(-(float)j * (13.287712379549449f / 16.0f)); float rev = pos * inv_freq * 0.15915494309189535f; rev -= rintf(rev);
          const float sn = __builtin_amdgcn_sinf(rev), cs = __builtin_amdgcn_cosf(rev);
          const float x = __uint_as_float(((unsigned)(unsigned short)xa[e]) << 16), y = __uint_as_float(((unsigned)(unsigned short)xb[e]) << 16);
          const float nx = x * cs - y * sn, ny = y * cs + x * sn; unsigned ux = __float_as_uint(nx), uy = __float_as_uint(ny);
          ux = (ux + 0x7fffu + ((ux >> 16) & 1u)) >> 16; uy = (uy + 0x7fffu + ((uy >> 16) & 1u)) >> 16; xa[e] = (short)ux; xb[e] = (short)uy; }
        qr[8 + 2 * half] = xa; qr[9 + 2 * half] = xb; } } }
  const int vb0 = (int)(uintptr_t)V_lds + v_rd_base(lane);
  int kx[4];
#pragma unroll
  for (int q = 0; q < 4; ++q) kx[q] = (int)(uintptr_t)K_lds + r32 * (DQ * 2) + ((q * 32 + hi * 16) ^ ((r32 & 7) << 4));
  constexpr int KP = DQ / 64;
  int koff[KP]; bool kk2[KP]; int voff[2];
#pragma unroll
  for (int i = 0; i < KP; ++i) { const int q = (wid * KP + i) * 64 + lane, row = q / (DQ / 8), cs = q % (DQ / 8), c = cs ^ (row & 7);
    kk2[i] = (DQ == 192) && c >= 16; koff[i] = kk2[i] ? row * a.ldk2 + (c - 16) * 8 : row * a.ldk + c * 8; }
#pragma unroll
  for (int i = 0; i < 2; ++i) { const int q = (wid * 2 + i) * 64 + lane, sub = q >> 5, within = q & 31, kk = (sub >> 2) * 8 + (within >> 2), c = (sub & 3) * 32 + (within & 3) * 8;
    const int k = kk; voff[i] = k * a.ldv + c; }
  const unsigned kdst0 = (unsigned)(uintptr_t)K_lds + (unsigned)(wid * KP) * 1024u, vdst0 = (unsigned)(uintptr_t)V_lds + (unsigned)(wid * 2) * 1024u;
#define KROW(t) ((t) < a.nctx ? a.ctx_row0 + 64 * (t) : a.lat_row0 + 64 * ((t) - a.nctx))
#define GLDS16(gsrc, ldst) do { unsigned keep_; asm volatile("s_mov_b32 %0, m0\n\ts_mov_b32 m0, %2\n\ts_nop 0\n\tglobal_load_lds_dwordx4 %1, off\n\ts_mov_b32 m0, %0" : "=&s"(keep_) : "v"(gsrc), "s"(ldst) : "memory"); } while (0)
#define DMA(t) do { const long kr_ = KROW(t); const unsigned kd_ = (unsigned)__builtin_amdgcn_readfirstlane((int)(kdst0 + (unsigned)(((t) & 1) * SHM_K))), vd_ = (unsigned)__builtin_amdgcn_readfirstlane((int)(vdst0 + (unsigned)(((t) % 3) * SHM_V))); \
    const bf16* vp_ = a.V + kr_ * a.ldv; const bf16* kp_ = a.K + kr_ * a.ldk; const bf16* kp2_ = (DQ == 192) ? a.K2 + kr_ * a.ldk2 : kp_; \
    _Pragma("unroll") for (int i_ = 0; i_ < KP; ++i_) { const bf16* g_ = ((DQ == 192) && kk2[i_] ? kp2_ : kp_) + koff[i_]; GLDS16(g_, kd_ + (unsigned)i_ * 1024u); } \
    _Pragma("unroll") for (int i_ = 0; i_ < 2; ++i_) GLDS16(vp_ + voff[i_], vd_ + (unsigned)i_ * 1024u); } while (0)
#define WAIT_BAR() asm volatile("s_waitcnt vmcnt(0) lgkmcnt(0)\n\ts_barrier" ::: "memory")
#define RESC(al) do { if (__any((al) < 1.f)) { if (hi == 0) al_l[r32] = (al); asm volatile("s_waitcnt lgkmcnt(0)" ::: "memory"); \
    _Pragma("unroll") for (int d = 0; d < 4; ++d) _Pragma("unroll") for (int r = 0; r < 16; ++r) o[d][r] *= al_l[crow(r, hi)]; } } while (0)
  f32x16 pA0, pA1, pB0, pB1; float mnA, mnB, alA, alB; bf16x8 pa0, pa1, pa2, pa3; const int NT = a.NT;
#define STEP(j, PN0, PN1, MNN, ALN, PP0, PP1, ALP) do { const int j_ = (j); \
    WAIT_BAR();                            \
    if (j_ + 1 < NT) DMA(j_ + 1);          \
    SBAR(); qkt<DQ>(PN0, PN1, kx, (j_ & 1) * SHM_K, qr, negm); maskf<MODE>(PN0, PN1, j_, a, wid, r32, hi, bias_l); \
    finishSM(PP0, PP1, ALP, l_reg, pa0, pa1, pa2, pa3); SBAR(); \
    pv_d0(o, vb0 + ((j_ - 1) % 3) * SHM_V, pa0, pa1, pa2, pa3); partialSM<false>(PN0, PN1, m_reg, ALN, negm, thr); \
    RESC(ALN); } while (0)
  DMA(0); DMA(1);
  f32x16 negm = f32x16{}; asm volatile("" : "+v"(negm));
  WAIT_BAR();
  qkt<DQ>(pA0, pA1, kx, 0, qr, negm); maskf<MODE>(pA0, pA1, 0, a, wid, r32, hi, bias_l); partialSM<true>(pA0, pA1, m_reg, alA, negm, thr);
  for (int j = 1; j + 1 < NT; j += 2) {
    STEP(j, pB0, pB1, mnB, alB, pA0, pA1, alA);
    STEP(j + 1, pA0, pA1, mnA, alA, pB0, pB1, alB);
  }
  STEP(NT - 1, pB0, pB1, mnB, alB, pA0, pA1, alA);
  finishSM(pB0, pB1, alB, l_reg, pa0, pa1, pa2, pa3); SBAR();
  pv_d0(o, vb0 + ((NT - 1) % 3) * SHM_V, pa0, pa1, pa2, pa3);
  if constexpr (MODE == 1) l_reg += __builtin_amdgcn_exp2f(a.sink_l2 - m_reg);
  if (hi == 0) li_l[r32] = l_reg; asm volatile("s_waitcnt lgkmcnt(0)" ::: "memory");
  float rli[16];
#pragma unroll
  for (int r = 0; r < 16; ++r) rli[r] = __builtin_amdgcn_rcpf(li_l[crow(r, hi)]);
  asm volatile("s_waitcnt lgkmcnt(0)\n\ts_barrier" ::: "memory");
  { bf16* stg = (bf16*)(lds + wid * 8704);
#pragma unroll
    for (int r = 0; r < 16; ++r) { const int orow = crow(r, hi);
#pragma unroll
      for (int d0 = 0; d0 < 4; ++d0) { const float v = o[d0][r] * rli[r]; unsigned u = __float_as_uint(v); u = (u + 0x7fffu + ((u >> 16) & 1u)) >> 16; stg[orow * 136 + d0 * 32 + r32] = (bf16)u; } }
    asm volatile("s_waitcnt lgkmcnt(0)" ::: "memory");
    bf16* Ow = a.O + (long)(wid * QBLK) * a.ldo;
#pragma unroll
    for (int i = 0; i < 8; ++i) { const int row = i * 4 + (lane >> 4), ch = lane & 15; const u32x4 v = *(const u32x4*)(stg + row * 136 + ch * 8); *(u32x4*)(Ow + (long)row * a.ldo + ch * 8) = v; } }
  asm volatile("s_waitcnt lgkmcnt(0)\n\ts_barrier" ::: "memory");
#undef KROW
#undef GLDS16
#undef DMA
#undef WAIT_BAR
#undef RESC
#undef STEP
}
#undef SBAR
}
#define LAS __attribute__((address_space(3)))
typedef unsigned short bf16;
typedef float f32x4 __attribute__((ext_vector_type(4)));
typedef unsigned v4u __attribute__((ext_vector_type(4)));
typedef unsigned v2u __attribute__((ext_vector_type(2)));
constexpr int NWAVES = 8, NTHR = 512;
constexpr int DM = 2048, SEQ = 8192, NCTX = 256, MLAT = 2 * SEQ, MALL = MLAT + 2 * NCTX, DFF = 5632;
constexpr int N_IN0 = 2816, N_IN1 = 4608, N_UQ = 1536, N_UKV = 2048, N_GU = 2 * DFF;
constexpr float EPS = 1e-6f;
constexpr size_t MiB = 1u << 20;
constexpr size_t WS_MOD = 0, WS_BAR = 512 * 1024, BAR_BYTES = 16384;
constexpr size_t WS_WIN0 = 1 * MiB, WS_WUQ = WS_WIN0 + 11 * MiB, WS_WUKV = WS_WUQ + 2 * MiB, WS_WOUT0 = WS_WUKV + 2 * MiB, WS_WIN1 = WS_WOUT0 + 8 * MiB, WS_WOUT1 = WS_WIN1 + 18 * MiB,
                 WS_WGU = WS_WOUT1 + 8 * MiB, WS_WD = WS_WGU + 88 * MiB, WS_HCTX = WS_WD + 44 * MiB;
constexpr size_t WS_UO = WS_HCTX + 4 * MiB;
constexpr size_t WS_OB = WS_UO + 66 * MiB;
constexpr size_t WS_BIG = WS_UO + 132 * MiB;
constexpr size_t WS_QB = WS_BIG + 91 * MiB, WS_KVB = WS_BIG + 141 * MiB, WS_UB = WS_BIG + 149 * MiB, WS_FP = WS_BIG + 215 * MiB, WS_END = WS_FP + 16 * MiB;
static_assert((size_t)MALL * DM * 2 == 66 * MiB && (size_t)MALL * N_IN0 * 2 <= 91 * MiB && (size_t)MALL * N_UQ * 2 <= 50 * MiB && (size_t)MALL * N_IN1 * 2 <= 149 * MiB && (size_t)MALL * DFF * 2 <= 215 * MiB, "ws map");

__device__ __forceinline__ unsigned f2bf(float f) { unsigned u = __builtin_bit_cast(unsigned, f); return (u + 0x7fffu + ((u >> 16) & 1u)) >> 16; }
__device__ __forceinline__ unsigned pk2(float lo, float hi) { return f2bf(lo) | (f2bf(hi) << 16); }
__device__ __forceinline__ float bf2f(bf16 v) { return __uint_as_float(((unsigned)v) << 16); }
__device__ __forceinline__ float wave_sum(float v, int lane) {
#pragma unroll
    for (int o = 1; o < 64; o <<= 1) v += __int_as_float(__builtin_amdgcn_ds_bpermute((lane ^ o) << 2, __float_as_int(v)));
    return v;
}
__device__ __forceinline__ float silu_f(float x) { return x / (1.0f + __expf(-x)); }

#define GAS __attribute__((address_space(1)))
#define XB_TMO      128
#define XB_XCNT(j)  (256  + 64 * (j))
#define XB_XSUB(j)  (1280 + 64 * (j))
#define XB_XGEN(j)  (2304 + 64 * (j))
#define XB_TOP      3328
#define XB_TOPGEN   3392
#define XCD_BAR_WORDS 3456
#define XB_SPIN_CAP (1u << 18)

__device__ __forceinline__ unsigned xb_ld(unsigned* p)              { return __hip_atomic_load(p, __ATOMIC_RELAXED, __HIP_MEMORY_SCOPE_AGENT); }
__device__ __forceinline__ unsigned xb_add(unsigned* p, unsigned v) { return __hip_atomic_fetch_add(p, v, __ATOMIC_RELAXED, __HIP_MEMORY_SCOPE_AGENT); }
__device__ __forceinline__ unsigned xb_xcc_id() { return (unsigned)__builtin_amdgcn_s_getreg((3 << 11) | 20) & 0xFu; }
#define XB_SPIN(cond, bar) do { unsigned _sp = 0; while (cond) { __builtin_amdgcn_s_sleep(1); \
    if ((++_sp & 255u) == 0u) { if (xb_ld(&(bar)[XB_TMO])) break; if (_sp > XB_SPIN_CAP) { atomicAdd(&(bar)[XB_TMO], 1u); break; } } } } while (0)

struct XcdBarrier {
    unsigned* bar; unsigned x;
    volatile LAS unsigned* st;
};

__device__ __forceinline__ XcdBarrier xcd_barrier_post(unsigned* bar, volatile LAS unsigned* st) {
    XcdBarrier b; b.bar = bar; b.x = xb_xcc_id(); b.st = st;
    if (threadIdx.x == 0) (void)xb_add(&bar[XB_XCNT(b.x)], 1u);
    return b;
}
__device__ __forceinline__ void xcd_barrier_complete(unsigned* bar, unsigned x, unsigned& nloc, unsigned& nx) {
    const unsigned G = gridDim.x * gridDim.y * gridDim.z;
    unsigned sum, cnt, mine, sp = 0u;
    for (;;) {
        sum = 0u; cnt = 0u; mine = 0u;
#pragma unroll
        for (unsigned j = 0; j < 16; ++j) { const unsigned c = xb_ld(&bar[XB_XCNT(j)]); sum += c; cnt += (c > 0u) ? 1u : 0u; mine = (j == x) ? c : mine; }
        if (sum == G) break;
        __builtin_amdgcn_s_sleep(1);
        if ((++sp & 255u) == 0u) { if (xb_ld(&bar[XB_TMO])) break; if (sp > XB_SPIN_CAP) { atomicAdd(&bar[XB_TMO], 1u); break; } }
    }
    nloc = mine > 0u ? mine : 1u; nx = cnt > 0u ? cnt : 1u;
}

__device__ __forceinline__ void xcd_barrier(const XcdBarrier& b) {
    asm volatile("s_waitcnt vmcnt(0)" ::: "memory");
    __syncthreads();
    if (threadIdx.x == 0) {
        unsigned* bar = b.bar;
        __builtin_amdgcn_s_waitcnt(0);
        unsigned nloc = b.st[0], nx = b.st[1];
        if (nloc == 0u) { xcd_barrier_complete(bar, b.x, nloc, nx); b.st[0] = nloc; b.st[1] = nx; }
        const unsigned old = xb_add(&bar[XB_XSUB(b.x)], 1u);
        const unsigned gen = old / nloc;
        if (old + 1u == (gen + 1u) * nloc) {
            __builtin_amdgcn_fence(__ATOMIC_RELEASE, "agent");
            asm volatile("s_waitcnt vmcnt(0)" ::: "memory");
            const unsigned og = xb_add(&bar[XB_TOP], 1u);
            const unsigned tg = og / nx;
            if (og + 1u == (tg + 1u) * nx) xb_add(&bar[XB_TOPGEN], 1u);
            else XB_SPIN(xb_ld(&bar[XB_TOPGEN]) == tg, bar);
            __builtin_amdgcn_fence(__ATOMIC_ACQUIRE, "agent");
            xb_add(&bar[XB_XGEN(b.x)], 1u);
            asm volatile("s_waitcnt vmcnt(0)" ::: "memory");
        } else {
            XB_SPIN(xb_ld(&bar[XB_XGEN(b.x)]) == gen, bar);
            __builtin_amdgcn_fence(__ATOMIC_ACQUIRE, "agent");
            asm volatile("s_waitcnt vmcnt(0)" ::: "memory");
        }
    }
    __syncthreads();
}

struct KArgs { const float* in[29]; float* out; unsigned char* ws; };
typedef const __attribute__((address_space(4))) KArgs* KAP;
__device__ __forceinline__ KAP kargs() { KAP p = (KAP)__builtin_amdgcn_kernarg_segment_ptr(); asm volatile("" : "+s"(p)); return p; }

__device__ __forceinline__ void transpose_item(const float* W, int K, int N, bf16* WT, int k0, int n0, int drow0, LAS float* scr, int lane, const float wsc) {
#pragma unroll 8
    for (int i = 0; i < 32; ++i) { const int kk = 2 * i + (lane >> 5); scr[kk * 33 + (lane & 31)] = __builtin_nontemporal_load(W + (size_t)(k0 + kk) * N + n0 + (lane & 31)) * wsc; }
    asm volatile("s_waitcnt lgkmcnt(0)" ::: "memory");
    const int c = lane & 7;
#pragma unroll
    for (int j = 0; j < 4; ++j) { const int n = (lane >> 3) + 8 * j; const LAS float* s = scr + (8 * c) * 33 + n;
        v4u o; o.x = pk2(s[0 * 33], s[1 * 33]); o.y = pk2(s[2 * 33], s[3 * 33]); o.z = pk2(s[4 * 33], s[5 * 33]); o.w = pk2(s[6 * 33], s[7 * 33]);
        *(v4u*)(WT + (size_t)(drow0 + n) * K + k0 + 8 * c) = o; }
    asm volatile("s_waitcnt lgkmcnt(0)" ::: "memory");
}
__device__ __forceinline__ bool conv_matrix(int& it, const float* W, int K, int N, bf16* WT, int mode, LAS float* scr, int lane, const float wsc = 1.0f) {
    const int nblk = N / 32, items = (K / 64) * nblk;
    if (it >= items) { it -= items; return false; }
    const int kb = it / nblk, nb = it % nblk, n0 = 32 * nb;
    const int drow0 = mode == 0 ? n0 : ((n0 >> 7) * 256 + (mode == 2 ? 128 : 0) + (n0 & 127));
    transpose_item(W, K, N, WT, 64 * kb, n0, drow0, scr, lane, wsc);
    return true;
}
__device__ __forceinline__ void p0_weights(KAP a, LAS unsigned char* lds, int gw, int NGW, int wave, int lane) {
    LAS float* scr = (LAS float*)(lds + wave * 8704);
    unsigned char* ws = a->ws;
    constexpr int I_TOTAL = (2048 / 64) * (2624 / 32) + (512 / 64) * (1536 / 32) + (512 / 64) * (2048 / 32) + 2 * (2048 / 64) * (2048 / 32) + (2048 / 64) * (4608 / 32)
                          + 4 * (2048 / 64) * (DFF / 32) + 2 * (DFF / 64) * (2048 / 32);
    for (int item = gw; item < I_TOTAL; item += NGW) {
        int it = item;
        if (conv_matrix(it, a->in[13], 2048, 2624, (bf16*)(ws + WS_WIN0), 0, scr, lane)) continue;
        if (conv_matrix(it, a->in[19], 512, 1536, (bf16*)(ws + WS_WUQ), 0, scr, lane, 0.07216878364870322f * 1.4426950408889634f)) continue;
        if (conv_matrix(it, a->in[20], 512, 2048, (bf16*)(ws + WS_WUKV), 0, scr, lane)) continue;
        if (conv_matrix(it, a->in[14], 2048, 2048, (bf16*)(ws + WS_WOUT0), 0, scr, lane)) continue;
        if (conv_matrix(it, a->in[21], 2048, 4608, (bf16*)(ws + WS_WIN1), 0, scr, lane)) continue;
        if (conv_matrix(it, a->in[22], 2048, 2048, (bf16*)(ws + WS_WOUT1), 0, scr, lane)) continue;
        if (conv_matrix(it, a->in[10], 2048, DFF, (bf16*)(ws + WS_WGU), 1, scr, lane)) continue;
        if (conv_matrix(it, a->in[10] + (size_t)2048 * DFF, 2048, DFF, (bf16*)(ws + WS_WGU + 44 * MiB), 1, scr, lane)) continue;
        if (conv_matrix(it, a->in[11], 2048, DFF, (bf16*)(ws + WS_WGU), 2, scr, lane)) continue;
        if (conv_matrix(it, a->in[11] + (size_t)2048 * DFF, 2048, DFF, (bf16*)(ws + WS_WGU + 44 * MiB), 2, scr, lane)) continue;
        if (conv_matrix(it, a->in[12], DFF, 2048, (bf16*)(ws + WS_WD), 0, scr, lane)) continue;
        conv_matrix(it, a->in[12] + (size_t)2048 * DFF, DFF, 2048, (bf16*)(ws + WS_WD + 22 * MiB), 0, scr, lane);
    }
}
__device__ __forceinline__ void p0_mod(KAP a, LAS unsigned char* lds, int tid) {
    LAS float* sv = (LAS float*)lds;
    LAS float* red = (LAS float*)(lds + 24576);
    const int blk = blockIdx.x; if (blk >= 256) return;
    const int layer = blk >> 7, col0 = (blk & 127) * 96;
    for (int i = tid; i < 3 * 2048; i += NTHR) { const int v = i >> 11, k = i & 2047; const float x = v < 2 ? a->in[1][v * 2048 + k] : a->in[3][k]; sv[i] = silu_f(x); }
    __syncthreads();
    const int c4 = tid % 24, ks = tid / 24;
    if (ks < 21) {
        const float* W = a->in[4] + (size_t)layer * 2048 * 12288 + col0 + 4 * c4;
        f32x4 a0 = {0, 0, 0, 0}, a1 = a0, a2 = a0;
#pragma unroll 8
        for (int k = ks; k < 2048; k += 21) { const f32x4 w = __builtin_nontemporal_load((const f32x4*)(W + (size_t)k * 12288)); a0 += w * sv[k]; a1 += w * sv[2048 + k]; a2 += w * sv[4096 + k]; }
        LAS float* r = red + ks * 288 + 4 * c4;
        *(LAS f32x4*)(r) = a0; *(LAS f32x4*)(r + 96) = a1; *(LAS f32x4*)(r + 192) = a2;
    }
    __syncthreads();
    if (tid < 288) { float s = 0.f;
        for (int q = 0; q < 21; ++q) s += red[q * 288 + tid];
        const int v = tid / 96, j = tid % 96;
        ((float*)(a->ws + WS_MOD))[(size_t)(layer * 3 + v) * 12288 + col0 + j] = s + a->in[5][layer * 12288 + col0 + j]; }
    __syncthreads();
}
__device__ __forceinline__ void lds_vec(LAS float* dst, const float* src, int tid) { *(LAS f32x4*)(dst + 4 * tid) = *(const f32x4*)(src + 4 * tid); }
__device__ __forceinline__ void store_u(bf16* urow, int lane, const f32x4 (&v)[8], float rstd, const LAS float* g, const LAS float* sh, const LAS float* sc) {
#pragma unroll
    for (int j = 0; j < 8; ++j) { const int ci = 256 * j + 4 * lane; const f32x4 g4 = *(const LAS f32x4*)(g + ci), s4 = *(const LAS f32x4*)(sc + ci), h4 = *(const LAS f32x4*)(sh + ci);
        const f32x4 t = (v[j] * rstd * g4) * (1.0f + s4) + h4; v2u w; w.x = pk2(t[0], t[1]); w.y = pk2(t[2], t[3]); *(v2u*)(urow + ci) = w; }
}
__device__ __forceinline__ void pass_pre(const float* hlat, const float* hctx, const float* g, const float* mod, int sh_off, int sc_off, bf16* U, int nrows, int gw, int NGW, int lane, LAS float* lp, int tid) {
    lds_vec(lp + 2048, g, tid);
#pragma unroll
    for (int vi = 0; vi < 3; ++vi) { lds_vec(lp + 4096 + (3 * vi + 1) * 2048, mod + vi * 12288 + sh_off, tid); lds_vec(lp + 4096 + (3 * vi + 2) * 2048, mod + vi * 12288 + sc_off, tid); }
    __syncthreads();
    for (int m0 = gw; m0 < nrows; m0 += 2 * NGW) {
        int mr[2]; mr[0] = m0; mr[1] = m0 + NGW; const bool two = mr[1] < nrows; if (!two) mr[1] = m0;
        f32x4 v[2][8]; float ss[2];
#pragma unroll
        for (int r = 0; r < 2; ++r) { const int m = mr[r]; const float* src = m < MLAT ? hlat + (size_t)m * DM : hctx + (size_t)(m - MLAT) * DM;
#pragma unroll
            for (int j = 0; j < 8; ++j) v[r][j] = *(const f32x4*)(src + 256 * j + 4 * lane); }
#pragma unroll
        for (int r = 0; r < 2; ++r) { ss[r] = 0.f;
#pragma unroll
            for (int j = 0; j < 8; ++j) ss[r] += (v[r][j][0] * v[r][j][0] + v[r][j][1] * v[r][j][1]) + (v[r][j][2] * v[r][j][2] + v[r][j][3] * v[r][j][3]); }
#pragma unroll
        for (int r = 0; r < 2; ++r) { if (r == 1 && !two) break; const int m = mr[r]; const LAS float* mv = lp + 4096 + 3 * (m < MLAT ? (m >> 13) : 2) * 2048;
            const float rstd = rsqrtf(wave_sum(ss[r], lane) * (1.0f / DM) + EPS);
            store_u(U + (size_t)m * DM, lane, v[r], rstd, lp + 2048, mv + 2048, mv + 4096); }
    }
}
__device__ __forceinline__ void pass_post(const bf16* o16, const float* opart, const float* hlat, const float* hctx, const bf16* h16in, float* olat, float* octx, bf16* h16out, const float* gpost, const float* mod, int gt_off,
                                          const float* gpre, const float* modu, int sh_off, int sc_off, bf16* U, int nrows, int gw, int NGW, int lane, LAS float* lp, int tid) {
    lds_vec(lp, gpost, tid); if (U) lds_vec(lp + 2048, gpre, tid);
#pragma unroll
    for (int vi = 0; vi < 3; ++vi) { lds_vec(lp + 4096 + (3 * vi) * 2048, mod + vi * 12288 + gt_off, tid);
        if (U) { lds_vec(lp + 4096 + (3 * vi + 1) * 2048, modu + vi * 12288 + sh_off, tid); lds_vec(lp + 4096 + (3 * vi + 2) * 2048, modu + vi * 12288 + sc_off, tid); } }
    __syncthreads();
    for (int m0 = gw; m0 < nrows; m0 += 2 * NGW) {
        int mr[2]; mr[0] = m0; mr[1] = m0 + NGW; const bool two = mr[1] < nrows; if (!two) mr[1] = m0;
        f32x4 v[2][8], hh[2][8]; float ss[2];
#pragma unroll
        for (int r = 0; r < 2; ++r) { const int m = mr[r]; ss[r] = 0.f;
            const float* hs = m < MLAT ? hlat + (size_t)m * DM : hctx + (size_t)(m - MLAT) * DM;
            if (m < MLAT) { const bf16* orow = o16 + (size_t)m * DM;
#pragma unroll
                for (int j = 0; j < 8; ++j) { const v2u raw = *(const v2u*)(orow + 256 * j + 4 * lane);
                    v[r][j] = (f32x4){__uint_as_float(raw.x << 16), __uint_as_float(raw.x & 0xffff0000u), __uint_as_float(raw.y << 16), __uint_as_float(raw.y & 0xffff0000u)}; }
            } else { const float* orow = opart + (size_t)(m - MLAT) * DM;
#pragma unroll
                for (int j = 0; j < 8; ++j) { const int ci = 256 * j + 4 * lane;
                    v[r][j] = (*(const f32x4*)(orow + ci) + *(const f32x4*)(orow + ci + (size_t)512 * DM)) + (*(const f32x4*)(orow + ci + (size_t)1024 * DM) + *(const f32x4*)(orow + ci + (size_t)1536 * DM)); } }
            if (h16in) { const bf16* hrow = h16in + (size_t)m * DM;
#pragma unroll
                for (int j = 0; j < 8; ++j) { const v2u raw = *(const v2u*)(hrow + 256 * j + 4 * lane);
                    hh[r][j] = (f32x4){__uint_as_float(raw.x << 16), __uint_as_float(raw.x & 0xffff0000u), __uint_as_float(raw.y << 16), __uint_as_float(raw.y & 0xffff0000u)}; }
            } else {
#pragma unroll
                for (int j = 0; j < 8; ++j) hh[r][j] = *(const f32x4*)(hs + 256 * j + 4 * lane); }
        }
#pragma unroll
        for (int r = 0; r < 2; ++r)
#pragma unroll
            for (int j = 0; j < 8; ++j) ss[r] += (v[r][j][0] * v[r][j][0] + v[r][j][1] * v[r][j][1]) + (v[r][j][2] * v[r][j][2] + v[r][j][3] * v[r][j][3]);
#pragma unroll
        for (int r = 0; r < 2; ++r) { const int m = mr[r]; if (r == 1 && !two) break;
            float* hd = m < MLAT ? olat + (size_t)m * DM : octx + (size_t)(m - MLAT) * DM; const int vi = (m < MLAT ? (m >> 13) : 2); const LAS float* mv = lp + 4096 + 3 * vi * 2048;
            const float rstd = rsqrtf(wave_sum(ss[r], lane) * (1.0f / DM) + EPS); float s2 = 0.f;
#pragma unroll
            for (int j = 0; j < 8; ++j) { const int ci = 256 * j + 4 * lane; const f32x4 g4 = *(const LAS f32x4*)(lp + ci), t4 = *(const LAS f32x4*)(mv + ci);
                const f32x4 nv = hh[r][j] + t4 * (v[r][j] * rstd * g4); v[r][j] = nv;
                if (h16out) { v2u w; w.x = pk2(nv[0], nv[1]); w.y = pk2(nv[2], nv[3]); *(v2u*)(h16out + (size_t)m * DM + ci) = w; } else *(f32x4*)(hd + ci) = nv;
                s2 += (nv[0] * nv[0] + nv[1] * nv[1]) + (nv[2] * nv[2] + nv[3] * nv[3]); }
            if (U) { const float rstd2 = rsqrtf(wave_sum(s2, lane) * (1.0f / DM) + EPS); store_u(U + (size_t)m * DM, lane, v[r], rstd2, lp + 2048, mv + 2048, mv + 4096); }
        }
    }
}
__device__ __forceinline__ void rope_cs(float pos, int j, float inv_nf, float& cs, float& sn) {
    const float inv_freq = __builtin_amdgcn_exp2f(-(float)j * inv_nf * 13.287712379549449f);
    float rev = pos * inv_freq * 0.15915494309189535f; rev -= rintf(rev);
    sn = __builtin_amdgcn_sinf(rev); cs = __builtin_amdgcn_cosf(rev);
}
template <int NH> __device__ __forceinline__ void heads_load(const bf16* base, int ia, float (&x)[NH], float (&y)[NH]) {
#pragma unroll
    for (int h = 0; h < NH; ++h) { x[h] = bf2f(base[h * 128 + ia]); y[h] = bf2f(base[h * 128 + ia + 32]); }
}
template <int NH> __device__ __forceinline__ void heads_finish(bf16* base, int ia, float (&x)[NH], float (&y)[NH], const float* gain, bool rope, float cs, float sn, int lane) {
    const float ga = gain[ia], gb = gain[ia + 32];
#pragma unroll
    for (int h = 0; h < NH; ++h) {
        const float rstd = rsqrtf(wave_sum(x[h] * x[h] + y[h] * y[h], lane) * (1.0f / 128.0f) + EPS);
        float a = x[h] * rstd * ga, b = y[h] * rstd * gb;
        if (rope) { const float na = a * cs - b * sn, nb = b * cs + a * sn; a = na; b = nb; }
        base[h * 128 + ia] = (bf16)f2bf(a); base[h * 128 + ia + 32] = (bf16)f2bf(b); }
}
__device__ __forceinline__ void unpack8(const v4u raw, float (&x)[8]) {
#pragma unroll
    for (int i = 0; i < 4; ++i) { x[2 * i] = __uint_as_float(raw[i] << 16); x[2 * i + 1] = __uint_as_float(raw[i] & 0xffff0000u); }
}
__device__ __forceinline__ void norm512_finish(bf16* p, const float (&x)[8], const float* gain, int lane) {
    float ss = 0.f;
#pragma unroll
    for (int i = 0; i < 8; ++i) ss += x[i] * x[i];
    const float rstd = rsqrtf(wave_sum(ss, lane) * (1.0f / 512.0f) + EPS);
    const f32x4 g0 = *(const f32x4*)(gain + 8 * lane), g1 = *(const f32x4*)(gain + 8 * lane + 4);
    v4u w; w.x = pk2(x[0] * rstd * g0[0], x[1] * rstd * g0[1]); w.y = pk2(x[2] * rstd * g0[2], x[3] * rstd * g0[3]); w.z = pk2(x[4] * rstd * g1[0], x[5] * rstd * g1[1]); w.w = pk2(x[6] * rstd * g1[2], x[7] * rstd * g1[3]);
    *(v4u*)(p + 8 * lane) = w;
}
__device__ __forceinline__ void rope64(bf16* p, float prow, float pcol, int l32) {
    const int j = l32 & 15, s = (l32 >> 4) & 1, ia = 32 * s + j, ib = ia + 16;
    const float x = bf2f(p[ia]), y = bf2f(p[ib]); float cs, sn; rope_cs(s ? pcol : prow, j, 1.0f / 16.0f, cs, sn);
    p[ia] = (bf16)f2bf(x * cs - y * sn); p[ib] = (bf16)f2bf(y * cs + x * sn);
}
__device__ __forceinline__ void prep_ab(bf16* P, const float* aqn, const float* akn, const float* bqn, const float* bkvn, int gw, int NGW, int lane) {
    const int ia = 64 * (lane >> 5) + (lane & 31);
    for (int m = gw; m < MALL; m += NGW) {
        bf16* row = P + (size_t)m * N_IN0; const bool lat = m < MLAT; const int t = m & (SEQ - 1); const float pr = (float)(t >> 6), pc = (float)(t & 63);
        float xk[2], yk[2], c1[8], c2[8];
        heads_load<2>(row + 1024, ia, xk, yk);
        unpack8(*(const v4u*)(row + 1536 + 8 * lane), c1); unpack8(*(const v4u*)(row + 2048 + 8 * lane), c2);
        if (lat && lane < 32) rope64(row + 2560, pr, pc, lane);
        float cs = 1.f, sn = 0.f; if (lat) rope_cs((lane >> 5) ? pc : pr, lane & 31, 1.0f / 32.0f, cs, sn);
        heads_finish<2>(row + 1024, ia, xk, yk, akn, lat, cs, sn, lane);
        norm512_finish(row + 1536, c1, bqn, lane); norm512_finish(row + 2048, c2, bkvn, lane);
    }
}
__device__ __forceinline__ void prep_qb(bf16* QB, int gw, int NGW, int lane) {
    for (int m = gw; m < MLAT; m += NGW) {
        bf16* row = QB + (size_t)m * N_UQ; const int t = m & (SEQ - 1); const float pr = (float)(t >> 6), pc = (float)(t & 63);
#pragma unroll
        for (int i = 0; i < 4; ++i) rope64(row + (2 * i + (lane >> 5)) * 192 + 128, pr, pc, lane & 31);
    }
}
__device__ __forceinline__ void prep_cd(bf16* P, const float* cqn, const float* ckn, const float* dqn, const float* dkn, int gw, int NGW, int lane) {
    const int ia = 64 * (lane >> 5) + (lane & 31);
    for (int m = gw; m < MALL; m += NGW) {
        bf16* row = P + (size_t)m * N_IN1; const bool lat = m < MLAT; const int t = m & (SEQ - 1); const float pr = (float)(t >> 6), pc = (float)(t & 63);
        float cs = 1.f, sn = 0.f; if (lat) rope_cs((lane >> 5) ? pc : pr, lane & 31, 1.0f / 32.0f, cs, sn);
        float xk[2], yk[2], xd[8], yd[8];
        heads_load<2>(row + 1024, ia, xk, yk); heads_load<8>(row + 2560, ia, xd, yd);
        heads_finish<2>(row + 1024, ia, xk, yk, ckn, lat, cs, sn, lane); heads_finish<8>(row + 2560, ia, xd, yd, dkn, false, 1.f, 0.f, lane);
    }
}
constexpr float LOG2E = 1.4426950408889634f;
__device__ __forceinline__ void attn_phase_ab(const bf16* P0, const bf16* QB, const bf16* KVB, bf16* OB, const float* aqn, char* lds, const int wave0) {
    const int c = blockIdx.x, G = gridDim.x;
    for (int id = c; id < 1024 + 32; id += G) {
        att::Args a{};
        int mixer, b, h, qrow0, NT;
        if (id < 1024) { const int rnd = id >> 8, cc = id & 255; mixer = rnd >> 1; b = rnd & 1; h = cc & 7; qrow0 = b * SEQ + (cc >> 3) * 256; NT = 132; }
        else { const int cc = id - 1024; mixer = cc >> 4; b = (cc >> 3) & 1; h = cc & 7; qrow0 = MLAT + b * NCTX; NT = 4; }
        a.NT = NT; a.nctx = 4; a.ctx_row0 = MLAT + b * NCTX; a.lat_row0 = b * SEQ; a.ldo = DM; a.qrope_t0 = (id < 1024) ? (qrow0 - b * SEQ) : -1;
        if (mixer == 0) {
            a.Q = P0 + (size_t)qrow0 * N_IN0 + h * 128; a.ldq = N_IN0; a.K = P0 + 1024 + (h >> 2) * 128; a.ldk = N_IN0; a.K2 = nullptr; a.ldk2 = 0; a.V = P0 + 1280 + (h >> 2) * 128; a.ldv = N_IN0;
            a.O = OB + (size_t)qrow0 * DM + h * 128; const float scale = 0.08838834764831845f; a.C = scale * LOG2E; a.thr_raw = 8.0f * LOG2E; a.qgain = aqn;

#ifndef DIS_A
            att::attn_unit<128, 0>(a, lds, wave0);
#endif

        } else {
            a.Q = QB + (size_t)qrow0 * N_UQ + h * 192; a.ldq = N_UQ; a.K = KVB + h * 256; a.ldk = N_UKV; a.K2 = P0 + 2560; a.ldk2 = N_IN0; a.V = KVB + h * 256 + 128; a.ldv = N_UKV;
            a.O = OB + (size_t)qrow0 * DM + 1024 + h * 128; const float scale = 0.07216878364870322f; a.C = scale * LOG2E; a.thr_raw = 8.0f * LOG2E;

#ifndef DIS_B
            att::attn_unit<192, 0>(a, lds, wave0);
#endif

        }
    }
}
__device__ __forceinline__ void attn_phase_cd(const bf16* P1, bf16* OB, const float* sink, const float* rpb, const float* cqn, const float* dqn, char* lds, const int wave0) {
    const int c = blockIdx.x, G = gridDim.x;
    for (int id = c; id < 1024; id += G) {
        att::Args a{};
        const int rnd = id >> 8, cc = id & 255, mixer = rnd >> 1, b = rnd & 1, h = cc & 7, qb = cc >> 3, qrow0 = b * SEQ + qb * 256;
        a.nctx = 4; a.ctx_row0 = MLAT + b * NCTX; a.ldo = DM; a.ldq = a.ldk = a.ldv = N_IN1; a.K2 = nullptr; a.ldk2 = 0;
        const float scale = 0.08838834764831845f; a.C = scale * LOG2E; a.thr_raw = 8.0f * LOG2E; a.inv_scale = LOG2E;
        if (mixer == 0) {
            const int kbase = min(max(qb * 256 - 128, 0), SEQ - 512);
            a.NT = 12; a.lat_row0 = b * SEQ + kbase; a.qpos0 = qb * 256; a.kpos0 = kbase; a.sink_l2 = __uint_as_float((unsigned)__builtin_amdgcn_readfirstlane((int)__float_as_uint(sink[h]))) * LOG2E;
            a.qgain = cqn; a.qrope_t0 = qb * 256; a.Q = P1 + (size_t)qrow0 * N_IN1 + h * 128; a.K = P1 + 1024 + (h >> 2) * 128; a.V = P1 + 1280 + (h >> 2) * 128; a.O = OB + (size_t)qrow0 * DM + h * 128;

#ifndef DIS_C
            att::attn_unit<128, 1>(a, lds, wave0);
#endif

        } else {
            const int r0 = qb * 4, klo = min(max(r0 - 4, 0), 116);
            a.NT = 16; a.lat_row0 = b * SEQ + klo * 64; a.r0 = r0; a.klo = klo; a.rpb = rpb + h * (15 * 31);
            a.qgain = dqn; a.qrope_t0 = -1; a.Q = P1 + (size_t)qrow0 * N_IN1 + 1536 + h * 128; a.K = P1 + 2560 + h * 128; a.V = P1 + 3584 + h * 128; a.O = OB + (size_t)qrow0 * DM + 1024 + h * 128;

#ifndef DIS_D
            att::attn_unit<128, 2>(a, lds, wave0);
#endif

        }
    }
}

__global__ void __launch_bounds__(NTHR, 2) fwd_megakernel(KArgs args) {
    extern __shared__ __attribute__((aligned(16))) unsigned char lds[];
    cg::grid_group grid = cg::this_grid();
    LAS unsigned char* ldsl = (LAS unsigned char*)lds;
    const int wave0 = __builtin_amdgcn_readfirstlane(threadIdx.x >> 6);
    const int G = gridDim.x, NGW = G * NWAVES;
#define PHASE_IDS() const int tid = fresh_tid(wave0); const int lane = tid & 63, wave = __builtin_amdgcn_readfirstlane(tid >> 6), gw = blockIdx.x * NWAVES + wave; (void)wave; (void)gw; (void)lane
#define WSB (kargs()->ws)
#define x_ (kargs()->in[0])
#define ctx_ (kargs()->in[2])
#define out_ (kargs()->out)
#define hctx_ ((float*)(WSB + WS_HCTX))
#define MOD_ ((const float*)(WSB + WS_MOD))
#define UA_ ((bf16*)(WSB + WS_UO))
#define OB_ ((bf16*)(WSB + WS_OB))
#define FB_ ((bf16*)(WSB + WS_UO))
#define FP_ ((float*)(WSB + WS_FP))
#define HB_ ((bf16*)(WSB + WS_OB))
#define OFB_ ((bf16*)(WSB + WS_BIG))
#define OFP_ ((float*)(WSB + WS_BIG + 128 * MiB))
#define PB_ ((bf16*)(WSB + WS_BIG))
#define OF_ ((float*)(WSB + WS_BIG))
#define ACT_ ((bf16*)(WSB + WS_BIG))
#define QB_ ((bf16*)(WSB + WS_QB))
#define KVB_ ((bf16*)(WSB + WS_KVB))
#define UB_ ((bf16*)(WSB + WS_UB))
#ifndef PROBE_G
#define PROBE_G 1
#endif
#ifndef PROBE_A
#define PROBE_A 1
#endif
#ifndef PROBE_S
#define PROBE_S 1
#endif
#define GSYNC() do { for (int s_ = 0; s_ < PROBE_S; ++s_) { xcd_barrier(bar); } } while (0)
    volatile LAS unsigned* MISC = (volatile LAS unsigned*)(ldsl + 131072 + 64);
    if (threadIdx.x < 2) MISC[threadIdx.x] = 0u;
    __syncthreads();
    grid.sync();
    XcdBarrier bar = xcd_barrier_post((unsigned*)(kargs()->ws + WS_BAR), MISC);

    for (int rep_ = 0; rep_ < PROBE_S; ++rep_) {
    { PHASE_IDS(); p0_mod(kargs(), ldsl, tid); }
    { PHASE_IDS(); p0_weights(kargs(), ldsl, gw, NGW, wave, lane); }
    }
    GSYNC();
    { PHASE_IDS(); pass_pre(x_, ctx_, kargs()->in[6], MOD_, 0, DM, UA_, MALL, gw, NGW, lane, (LAS float*)ldsl, tid); }
    GSYNC();
    for (int L = 0; L < 2; ++L) {

        const int Mrows = L == 0 ? MALL : MLAT;
        { pg8::Gemm g = pg8::mk_gemm(L == 0 ? UA_ : UB_, (const bf16*)(WSB + (L == 0 ? WS_WIN0 : WS_WIN1)), MALL, L == 0 ? N_IN0 : N_IN1, DM, DM);
          pg8::StaticOrder S; S.init(g.M, g.N, G, (int)blockIdx.x); pg8::EpiBf16 E{PB_, g.N};
          for (int rep_ = 0; rep_ < PROBE_G; ++rep_) pg8::gemm_phase<pg8::EpiBf16, pg8::StaticOrder, true, true>(ldsl, g, S, E, wave0); }
        GSYNC();
        if (L == 0) {
            { PHASE_IDS(); prep_ab(PB_, kargs()->in[15], kargs()->in[16], kargs()->in[17], kargs()->in[18], gw, NGW, lane); }
            GSYNC();
            for (int q = 0; q < 2; ++q) {
                pg8::Gemm g = pg8::mk_gemm(PB_ + (q == 0 ? 1536 : 2048), (const bf16*)(WSB + (q == 0 ? WS_WUQ : WS_WUKV)), MALL, q == 0 ? N_UQ : N_UKV, 512, N_IN0);
                pg8::StaticOrder S; S.init(g.M, g.N, G, (int)blockIdx.x); pg8::EpiBf16 E{q == 0 ? QB_ : KVB_, g.N};
                for (int rep_ = 0; rep_ < PROBE_G; ++rep_) pg8::gemm_phase<pg8::EpiBf16, pg8::StaticOrder, true, true>(ldsl, g, S, E, wave0);
            }
            GSYNC();
            for (int rep_ = 0; rep_ < PROBE_A; ++rep_) attn_phase_ab(PB_, QB_, KVB_, OB_, kargs()->in[15], (char*)lds, wave0);
        } else {
            { PHASE_IDS(); prep_cd(PB_, kargs()->in[23], kargs()->in[24], kargs()->in[26], kargs()->in[27], gw, NGW, lane); }
            GSYNC();
            for (int rep_ = 0; rep_ < PROBE_A; ++rep_) attn_phase_cd(PB_, OB_, kargs()->in[25], kargs()->in[28], kargs()->in[23], kargs()->in[26], (char*)lds, wave0);
        }
        GSYNC();
        { pg8::Gemm g = pg8::mk_gemm(OB_, (const bf16*)(WSB + (L == 0 ? WS_WOUT0 : WS_WOUT1)), MLAT, DM, DM, DM);
          pg8::StaticOrder S; S.init(g.M, g.N, G, (int)blockIdx.x); pg8::EpiBf16 E{OFB_, DM};
          for (int rep_ = 0; rep_ < PROBE_G; ++rep_) pg8::gemm_phase<pg8::EpiBf16, pg8::StaticOrder, true, true>(ldsl, g, S, E, wave0); }
        if (L == 0) { pg8::Gemm g = pg8::mk_gemm(OB_ + (size_t)MLAT * DM, (const bf16*)(WSB + WS_WOUT0), 2 * NCTX, 4 * DM, DM / 4, DM); g.ldb = DM; g.nNr = DM / 256;
          pg8::StaticOrder S; S.init(g.M, g.N, G, (int)blockIdx.x); pg8::EpiF32Split E{OFP_, DM, DM / 256, (size_t)2 * NCTX * DM};
          for (int rep_ = 0; rep_ < PROBE_G; ++rep_) pg8::gemm_phase<pg8::EpiF32Split, pg8::StaticOrder, true, true>(ldsl, g, S, E, wave0); }
        GSYNC();
        { PHASE_IDS(); pass_post(OFB_, OFP_, L == 0 ? x_ : out_, L == 0 ? ctx_ : hctx_, nullptr, out_, hctx_, HB_, kargs()->in[7] + L * DM, MOD_ + (size_t)L * 3 * 12288, 2 * DM, kargs()->in[8] + L * DM, MOD_ + (size_t)L * 3 * 12288, 3 * DM, 4 * DM, UA_, Mrows, gw, NGW, lane, (LAS float*)ldsl, tid); }
        GSYNC();
        { pg8::Gemm g = pg8::mk_gemm(UA_, (const bf16*)(WSB + WS_WGU + (size_t)L * 44 * MiB), Mrows, N_GU, DM, DM);
          pg8::StaticOrder S; S.init(g.M, g.N, G, (int)blockIdx.x); pg8::EpiSwiglu E{ACT_, DFF};
          for (int rep_ = 0; rep_ < PROBE_G; ++rep_) pg8::gemm_phase<pg8::EpiSwiglu, pg8::StaticOrder, true, true>(ldsl, g, S, E, wave0); }
        GSYNC();
        { pg8::Gemm g = pg8::mk_gemm(ACT_, (const bf16*)(WSB + WS_WD + (size_t)L * 22 * MiB), MLAT, DM, DFF, DFF);
          pg8::StaticOrder S; S.init(g.M, g.N, G, (int)blockIdx.x); pg8::EpiBf16 E{FB_, DM};
          for (int rep_ = 0; rep_ < PROBE_G; ++rep_) pg8::gemm_phase<pg8::EpiBf16, pg8::StaticOrder, true, true>(ldsl, g, S, E, wave0); }
        if (L == 0) { pg8::Gemm g = pg8::mk_gemm(ACT_ + (size_t)MLAT * DFF, (const bf16*)(WSB + WS_WD), 2 * NCTX, 4 * DM, DFF / 4, DFF); g.ldb = DFF; g.nNr = DM / 256;
          pg8::StaticOrder S; S.init(g.M, g.N, G, (int)blockIdx.x); pg8::EpiF32Split E{FP_, DM, DM / 256, (size_t)2 * NCTX * DM};
          for (int rep_ = 0; rep_ < PROBE_G; ++rep_) pg8::gemm_phase<pg8::EpiF32Split, pg8::StaticOrder, true, true>(ldsl, g, S, E, wave0); }
        GSYNC();
        { PHASE_IDS(); pass_post(FB_, FP_, out_, hctx_, HB_, out_, hctx_, nullptr, kargs()->in[9] + L * DM, MOD_ + (size_t)L * 3 * 12288, 5 * DM, kargs()->in[6] + DM, MOD_ + (size_t)3 * 12288, 0, DM, L == 0 ? UB_ : nullptr, Mrows, gw, NGW, lane, (LAS float*)ldsl, tid); }
        if (L == 0) GSYNC();
    }
#undef GSYNC
}

constexpr int LDS_BYTES = 131072 + 1024;
extern "C" void kernel_launch(void* const* d_in, const int* in_sizes, int n_in, void* d_out, int out_size, void* d_ws, size_t ws_size, hipStream_t stream) {
    static int grid = 0;
    if (grid == 0) {
        if (n_in != 29 || out_size != MLAT * DM || ws_size < WS_END) { fprintf(stderr, "kernel_launch: unexpected shapes: n_in %d out %d ws %zu (need %zu)\n", n_in, out_size, ws_size, (size_t)WS_END); grid = -1; return; }
        int dev = 0, cus = 0, per_cu = 0;
        hipGetDevice(&dev); hipDeviceGetAttribute(&cus, hipDeviceAttributeMultiprocessorCount, dev);
        if (hipFuncSetAttribute((const void*)fwd_megakernel, hipFuncAttributeMaxDynamicSharedMemorySize, LDS_BYTES) != hipSuccess) { fprintf(stderr, "kernel_launch: hipFuncSetAttribute failed\n"); grid = -1; return; }
        if (hipOccupancyMaxActiveBlocksPerMultiprocessor(&per_cu, (const void*)fwd_megakernel, NTHR, LDS_BYTES) != hipSuccess || per_cu < 1) { fprintf(stderr, "kernel_launch: occupancy query says %d\n", per_cu); per_cu = 1; }
        (void)hipGetLastError();
        grid = cus;
        fprintf(stderr, "kernel_launch: grid %d (per_cu %d)\n", grid, per_cu);
    }
    if (grid < 0) return;
    if (hipMemsetAsync((char*)d_ws + WS_BAR, 0, BAR_BYTES, stream) != hipSuccess) { fprintf(stderr, "kernel_launch: hipMemsetAsync failed\n"); return; }
    KArgs a{};
    for (int i = 0; i < 29; ++i) a.in[i] = (const float*)d_in[i];
    a.out = (float*)d_out; a.ws = (unsigned char*)d_ws;
    void* params[] = {&a};
    const hipError_t e = hipLaunchCooperativeKernel((const void*)fwd_megakernel, dim3(grid), dim3(NTHR), params, LDS_BYTES, stream);
    if (e != hipSuccess) fprintf(stderr, "kernel_launch: cooperative launch failed: %s (grid %d)\n", hipGetErrorString(e), grid);
}
```
